# Optimizing an MI355X kernel written in HIP

```python
import math
import jax, jax.numpy as jnp
from jax import lax
import numpy as np

D_MODEL = 2048
BATCH = 2
SEQ = 4096
DEPTH = 2

GRID_W = 64
CTX_LEN = 256
HEAD_DIM = 128
A_Q_HEADS = 6
A_KV_HEADS = 2
B_HEADS = 4
B_QK_DIM = 64
B_V_DIM = 2 * B_QK_DIM
C_Q_HEADS = 6
C_KV_HEADS = 2
WINDOW = 128
QBLK = 128
N_EXPERTS = 16
EXPERT_FF = 1024
EC_CAPACITY = 2
ROPE_THETA = 10000.0
EPS = 1e-6
NEG_INF = -1e30

A_Q_W = A_Q_HEADS * HEAD_DIM
A_KV_W = A_KV_HEADS * HEAD_DIM
B_QK_W = B_HEADS * 2 * B_QK_DIM
B_V_W = B_HEADS * B_V_DIM
C_Q_W = C_Q_HEADS * HEAD_DIM
C_KV_W = C_KV_HEADS * HEAD_DIM
KV_W = 2 * A_KV_W + B_QK_W + B_V_W + 2 * C_KV_W
Q_W = A_Q_W + B_QK_W + C_Q_W
GATE_W = 3 * D_MODEL
IN_W = KV_W + Q_W + GATE_W
KV_SPLITS = (A_KV_W, 2 * A_KV_W, 2 * A_KV_W + B_QK_W, 2 * A_KV_W + B_QK_W + B_V_W,
             2 * A_KV_W + B_QK_W + B_V_W + C_KV_W)
Q_SPLITS = (A_Q_W, A_Q_W + B_QK_W)

kernel_name = "hybrid_parallel_gqa_diff_window_ec_moe"


def rms_norm(x, g):
    xf = x.astype(jnp.float32)
    y = xf * lax.rsqrt(jnp.mean(xf * xf, axis=-1, keepdims=True) + EPS)
    return y.astype(x.dtype) * g


def modulate(h, shift, scale):
    return h * (1 + scale) + shift


def axial_rope_tables(row, col, dh, dtype):
    d_ax = dh // 2
    inv = ROPE_THETA ** (-jnp.arange(0, d_ax, 2, dtype=jnp.float32) / d_ax)
    fr = row.astype(jnp.float32)[:, None] * inv
    fc = col.astype(jnp.float32)[:, None] * inv
    ang = jnp.concatenate([fr, fr, fc, fc], axis=-1)
    return jnp.cos(ang)[:, None, :].astype(dtype), jnp.sin(ang)[:, None, :].astype(dtype)


def rotate_quarters(x):
    x1, x2, x3, x4 = jnp.split(x, 4, axis=-1)
    return jnp.concatenate([-x2, x1, -x4, x3], axis=-1)


def apply_rope(t, rope):
    cos, sin = rope
    return t * cos + rotate_quarters(t) * sin


def qk_heads(t, n, d, gain, rope):
    t = rms_norm(t.reshape(t.shape[0], t.shape[1], n, d), gain)
    if rope is not None:
        t = apply_rope(t, rope)
    return t.transpose(0, 2, 1, 3)


def v_heads(t, n, d):
    return t.reshape(t.shape[0], t.shape[1], n, d).transpose(0, 2, 1, 3)


def group_heads(t, n_kv):
    b, h, tt, d = t.shape
    return t.reshape(b, n_kv, h // n_kv, tt, d)


def split_pairs(t):
    b, h2, tt, d = t.shape
    t = t.reshape(b, h2 // 2, 2, tt, d)
    return t[:, :, 0], t[:, :, 1]


def heads_to_tokens(o):
    b, tt, d = o.shape[0], o.shape[-2], o.shape[-1]
    return o.reshape(b, -1, tt, d).transpose(0, 2, 1, 3).reshape(b, tt, -1)


def gqa_block(q, k, v, sink=None):
    s = jnp.einsum('bhgqd,bhkd->bhgqk', q, k).astype(jnp.float32) * (q.shape[-1] ** -0.5)
    if sink is not None:
        s_sink = jnp.broadcast_to(sink.astype(jnp.float32)[None, :, :, None, None], s.shape[:-1] + (1,))
        p = jax.nn.softmax(jnp.concatenate([s, s_sink], axis=-1), axis=-1)[..., :-1]
    else:
        p = jax.nn.softmax(s, axis=-1)
    return jnp.einsum('bhgqk,bhkd->bhgqd', p.astype(v.dtype), v)


def diff_block(q1, q2, k1, k2, v, lam):
    scale = q1.shape[-1] ** -0.5
    s1 = jnp.einsum('bhqd,bhkd->bhqk', q1, k1).astype(jnp.float32) * scale
    s2 = jnp.einsum('bhqd,bhkd->bhqk', q2, k2).astype(jnp.float32) * scale
    p = jax.nn.softmax(s1, axis=-1) - lam * jax.nn.softmax(s2, axis=-1)
    return jnp.einsum('bhqk,bhkd->bhqd', p.astype(v.dtype), v)


def sweep_blocks(fn, qs):
    nb = qs[0].shape[-2] // QBLK

    def to_blocks(q):
        return jnp.moveaxis(q.reshape(q.shape[:-2] + (nb, QBLK, q.shape[-1])), -3, 0)

    o = lax.map(lambda qb: fn(*qb), tuple(to_blocks(q) for q in qs))
    o = jnp.moveaxis(o, 0, -3)
    return o.reshape(o.shape[:-3] + (nb * QBLK, o.shape[-1]))


def window_attention(q, k, v, k_ctx, v_ctx, sink):
    b, hkv, g, s_len, d = q.shape
    nb = s_len // QBLK
    scale = d ** -0.5
    qb = q.reshape(b, hkv, g, nb, QBLK, d)

    def band(t):
        tp = jnp.pad(t, ((0, 0), (0, 0), (QBLK, QBLK), (0, 0))).reshape(b, hkv, nb + 2, QBLK, d)
        return jnp.concatenate([tp[:, :, :-2], tp[:, :, 1:-1], tp[:, :, 2:]], axis=3)

    kb, vb = band(k), band(v)
    s_loc = jnp.einsum('bhgnqd,bhnkd->bhgnqk', qb, kb).astype(jnp.float32) * scale
    blk = jnp.arange(nb)[:, None, None]
    qpos = blk * QBLK + jnp.arange(QBLK)[None, :, None]
    kpos = (blk - 1) * QBLK + jnp.arange(3 * QBLK)[None, None, :]
    valid = (jnp.abs(kpos - qpos) <= WINDOW) & (kpos >= 0) & (kpos < s_len)
    s_loc = jnp.where(valid, s_loc, NEG_INF)
    s_ctx = jnp.einsum('bhgnqd,bhkd->bhgnqk', qb, k_ctx).astype(jnp.float32) * scale
    s_sink = jnp.broadcast_to(sink.astype(jnp.float32)[None, :, :, None, None, None], s_loc.shape[:-1] + (1,))
    p = jax.nn.softmax(jnp.concatenate([s_loc, s_ctx, s_sink], axis=-1), axis=-1)
    n_loc, n_ctx = 3 * QBLK, k_ctx.shape[2]
    o = (jnp.einsum('bhgnqk,bhnkd->bhgnqd', p[..., :n_loc].astype(v.dtype), vb)
         + jnp.einsum('bhgnqk,bhkd->bhgnqd', p[..., n_loc:n_loc + n_ctx].astype(v.dtype), v_ctx))
    return o.reshape(b, hkv, g, s_len, d)


def token_mixers(h_lat, h_ctx, rope128, rope64, lambda_init, ctx_out, w_in, qn_a, kn_a, qn_b, kn_b,
                 lam_q1, lam_k1, lam_q2, lam_k2, subln_b, qn_c, kn_c, sink_c,
                 w_br_a, w_br_b, w_br_c, w_out):
    p_lat = h_lat @ w_in
    p_ctx = h_ctx @ (w_in if ctx_out else w_in[:, :KV_W])
    kA_l, vA_l, kB_l, vB_l, kC_l, vC_l = jnp.split(p_lat[..., :KV_W], KV_SPLITS, axis=-1)
    kA_c, vA_c, kB_c, vB_c, kC_c, vC_c = jnp.split(p_ctx[..., :KV_W], KV_SPLITS, axis=-1)

    kA_cx = qk_heads(kA_c, A_KV_HEADS, HEAD_DIM, kn_a, None)
    vA_cx = v_heads(vA_c, A_KV_HEADS, HEAD_DIM)
    kB_cx = qk_heads(kB_c, 2 * B_HEADS, B_QK_DIM, kn_b, None)
    vB_cx = v_heads(vB_c, B_HEADS, B_V_DIM)
    kC_cx = qk_heads(kC_c, C_KV_HEADS, HEAD_DIM, kn_c, None)
    vC_cx = v_heads(vC_c, C_KV_HEADS, HEAD_DIM)

    kA = jnp.concatenate([qk_heads(kA_l, A_KV_HEADS, HEAD_DIM, kn_a, rope128), kA_cx], axis=2)
    vA = jnp.concatenate([v_heads(vA_l, A_KV_HEADS, HEAD_DIM), vA_cx], axis=2)
    kB1, kB2 = split_pairs(jnp.concatenate([qk_heads(kB_l, 2 * B_HEADS, B_QK_DIM, kn_b, rope64), kB_cx], axis=2))
    vB = jnp.concatenate([v_heads(vB_l, B_HEADS, B_V_DIM), vB_cx], axis=2)
    kC_lat = qk_heads(kC_l, C_KV_HEADS, HEAD_DIM, kn_c, rope128)
    vC_lat = v_heads(vC_l, C_KV_HEADS, HEAD_DIM)

    lam = (jnp.exp(jnp.sum(lam_q1.astype(jnp.float32) * lam_k1.astype(jnp.float32)))
           - jnp.exp(jnp.sum(lam_q2.astype(jnp.float32) * lam_k2.astype(jnp.float32))) + lambda_init)
    sink = sink_c.reshape(C_KV_HEADS, C_Q_HEADS // C_KV_HEADS)

    def queries(p, rope_a, rope_b):
        qA, qB, qC = jnp.split(p[..., KV_W:KV_W + Q_W], Q_SPLITS, axis=-1)
        qA = group_heads(qk_heads(qA, A_Q_HEADS, HEAD_DIM, qn_a, rope_a), A_KV_HEADS)
        qB1, qB2 = split_pairs(qk_heads(qB, 2 * B_HEADS, B_QK_DIM, qn_b, rope_b))
        qC = group_heads(qk_heads(qC, C_Q_HEADS, HEAD_DIM, qn_c, rope_a), C_KV_HEADS)
        gates = jax.nn.sigmoid(p[..., KV_W + Q_W:])
        return qA, qB1, qB2, qC, gates

    def merge(oA, oB, oC, gates):
        gA, gB, gC = jnp.split(gates, 3, axis=-1)
        oB = rms_norm(oB, subln_b) * (1.0 - lambda_init)
        m = (gA * (heads_to_tokens(oA) @ w_br_a) + gB * (heads_to_tokens(oB) @ w_br_b)
             + gC * (heads_to_tokens(oC) @ w_br_c))
        return m @ w_out

    qA, qB1, qB2, qC, g = queries(p_lat, rope128, rope64)
    oA = sweep_blocks(lambda q: gqa_block(q, kA, vA), (qA,))
    oB = sweep_blocks(lambda q1, q2: diff_block(q1, q2, kB1, kB2, vB, lam), (qB1, qB2))
    oC = window_attention(qC, kC_lat, vC_lat, kC_cx, vC_cx, sink)
    out_lat = merge(oA, oB, oC, g)
    if not ctx_out:
        return out_lat, None

    qA, qB1, qB2, qC, g = queries(p_ctx, None, None)
    kB1c, kB2c = split_pairs(kB_cx)
    oA = gqa_block(qA, kA_cx, vA_cx)
    oB = diff_block(qB1, qB2, kB1c, kB2c, vB_cx, lam)
    oC = gqa_block(qC, kC_cx, vC_cx, sink)
    out_ctx = merge(oA, oB, oC, g)
    return out_lat, out_ctx


def ec_moe(h, w_router, w_gate, w_up, w_down):
    b, n, _ = h.shape
    cap = EC_CAPACITY * n // N_EXPERTS
    aff = jax.nn.softmax((h @ w_router).astype(jnp.float32), axis=-1)
    g, idx = lax.top_k(aff.transpose(0, 2, 1), cap)
    xg = h[jnp.arange(b)[:, None], idx.reshape(b, -1)].reshape(b, N_EXPERTS, cap, -1)
    u = jnp.einsum('becd,edf->becf', xg, w_gate)
    v = jnp.einsum('becd,edf->becf', xg, w_up)
    y = jnp.einsum('becf,efd->becd', jax.nn.silu(u) * v, w_down) * g[..., None].astype(h.dtype)
    return jnp.zeros_like(h).at[jnp.arange(b)[:, None, None], idx].add(y)


def setup_inputs(seed: int = 0) -> dict:
    key = jax.random.key(seed)
    ks = jax.random.split(key, 32)

    def nrm(k, shape, scale):
        return jax.random.normal(k, shape, jnp.float32) * scale

    return {
        "x": nrm(ks[0], (BATCH, SEQ, D_MODEL), 1.0),
        "c": nrm(ks[1], (BATCH, D_MODEL), 1.0),
        "ctx": nrm(ks[2], (BATCH, CTX_LEN, D_MODEL), 1.0),
        "c_ctx": nrm(ks[3], (D_MODEL,), 1.0),
        "w_mod": nrm(ks[4], (DEPTH, D_MODEL, 6 * D_MODEL), 0.5 * D_MODEL ** -0.5),
        "b_mod": nrm(ks[5], (DEPTH, 6 * D_MODEL), 0.02),
        "norm_mix": 1.0 + nrm(ks[6], (DEPTH, D_MODEL), 0.02),
        "norm_ffn": 1.0 + nrm(ks[7], (DEPTH, D_MODEL), 0.02),
        "w_in": nrm(ks[8], (DEPTH, D_MODEL, IN_W), D_MODEL ** -0.5),
        "qn_a": 1.0 + nrm(ks[9], (DEPTH, HEAD_DIM), 0.02),
        "kn_a": 1.0 + nrm(ks[10], (DEPTH, HEAD_DIM), 0.02),
        "qn_b": 1.0 + nrm(ks[11], (DEPTH, B_QK_DIM), 0.02),
        "kn_b": 1.0 + nrm(ks[12], (DEPTH, B_QK_DIM), 0.02),
        "lam_q1": nrm(ks[13], (DEPTH, B_QK_DIM), 0.1),
        "lam_k1": nrm(ks[14], (DEPTH, B_QK_DIM), 0.1),
        "lam_q2": nrm(ks[15], (DEPTH, B_QK_DIM), 0.1),
        "lam_k2": nrm(ks[16], (DEPTH, B_QK_DIM), 0.1),
        "subln_b": 1.0 + nrm(ks[17], (DEPTH, B_V_DIM), 0.02),
        "qn_c": 1.0 + nrm(ks[18], (DEPTH, HEAD_DIM), 0.02),
        "kn_c": 1.0 + nrm(ks[19], (DEPTH, HEAD_DIM), 0.02),
        "sink_c": nrm(ks[20], (DEPTH, C_Q_HEADS), 0.5),
        "w_br_a": nrm(ks[21], (DEPTH, A_Q_W, D_MODEL), A_Q_W ** -0.5),
        "w_br_b": nrm(ks[22], (DEPTH, B_V_W, D_MODEL), B_V_W ** -0.5),
        "w_br_c": nrm(ks[23], (DEPTH, C_Q_W, D_MODEL), C_Q_W ** -0.5),
        "w_out": nrm(ks[24], (DEPTH, D_MODEL, D_MODEL), D_MODEL ** -0.5),
        "w_router": nrm(ks[25], (DEPTH, D_MODEL, N_EXPERTS), D_MODEL ** -0.5),
        "w_gate": nrm(ks[26], (DEPTH, N_EXPERTS, D_MODEL, EXPERT_FF), D_MODEL ** -0.5),
        "w_up": nrm(ks[27], (DEPTH, N_EXPERTS, D_MODEL, EXPERT_FF), D_MODEL ** -0.5),
        "w_down": nrm(ks[28], (DEPTH, N_EXPERTS, EXPERT_FF, D_MODEL), EXPERT_FF ** -0.5),
    }


def reference(x, c, ctx, c_ctx, w_mod, b_mod, norm_mix, norm_ffn, w_in, qn_a, kn_a, qn_b, kn_b,
              lam_q1, lam_k1, lam_q2, lam_k2, subln_b, qn_c, kn_c, sink_c,
              w_br_a, w_br_b, w_br_c, w_out, w_router, w_gate, w_up, w_down):
    s_len = x.shape[1]
    rows = s_len // GRID_W
    row = jnp.repeat(jnp.arange(rows, dtype=jnp.int32), GRID_W)
    col = jnp.arange(s_len, dtype=jnp.int32) % GRID_W
    rope128 = axial_rope_tables(row, col, HEAD_DIM, x.dtype)
    rope64 = axial_rope_tables(row, col, B_QK_DIM, x.dtype)
    sc = jax.nn.silu(c)
    scc = jax.nn.silu(c_ctx)
    xc = ctx
    for l in range(DEPTH):
        last = l == DEPTH - 1
        lambda_init = 0.8 - 0.6 * math.exp(-0.3 * l)
        mod = (sc @ w_mod[l] + b_mod[l])[:, None, :]
        sh1, s1, g1, sh2, s2, g2 = jnp.split(mod, 6, axis=-1)
        n_mod_ctx = 2 if last else 6
        mc = jnp.split(scc @ w_mod[l][:, :n_mod_ctx * D_MODEL] + b_mod[l][:n_mod_ctx * D_MODEL], n_mod_ctx)
        h_lat = modulate(rms_norm(x, norm_mix[l]), sh1, s1)
        h_ctx = modulate(rms_norm(xc, norm_mix[l]), mc[0], mc[1])
        o_lat, o_ctx = token_mixers(h_lat, h_ctx, rope128, rope64, lambda_init, not last, w_in[l],
                                    qn_a[l], kn_a[l], qn_b[l], kn_b[l], lam_q1[l], lam_k1[l],
                                    lam_q2[l], lam_k2[l], subln_b[l], qn_c[l], kn_c[l], sink_c[l],
                                    w_br_a[l], w_br_b[l], w_br_c[l], w_out[l])
        x = x + g1 * o_lat
        x = x + g2 * ec_moe(modulate(rms_norm(x, norm_ffn[l]), sh2, s2),
                            w_router[l], w_gate[l], w_up[l], w_down[l])
        if not last:
            xc = xc + mc[2] * o_ctx
            xc = xc + mc[5] * ec_moe(modulate(rms_norm(xc, norm_ffn[l]), mc[3], mc[4]),
                                     w_router[l], w_gate[l], w_up[l], w_down[l])
    return x
```

```cpp
#include <hip/hip_runtime.h>
#include <cstdio>
#include <cstdint>
#include <cmath>
#define ONE_LAUNCH 1
#define LAS __attribute__((address_space(3)))
#define GAS __attribute__((address_space(1)))
typedef unsigned short bf16_t;
typedef short bf16x8 __attribute__((ext_vector_type(8)));
typedef short s16x4 __attribute__((ext_vector_type(4)));
typedef float f32x2 __attribute__((ext_vector_type(2)));
typedef float f32x4 __attribute__((ext_vector_type(4)));
typedef float f32x16 __attribute__((ext_vector_type(16)));
typedef unsigned u32x2 __attribute__((ext_vector_type(2)));
typedef unsigned u32x4 __attribute__((ext_vector_type(4)));
typedef int i32x4 __attribute__((ext_vector_type(4)));
typedef int i32x8 __attribute__((ext_vector_type(8)));

__device__ __forceinline__ unsigned cvt_pk_bf16(float lo, float hi) { unsigned r; asm volatile("v_cvt_pk_bf16_f32 %0, %1, %2" : "=v"(r) : "v"(lo), "v"(hi)); return r; }
__device__ __forceinline__ float bf_lo(unsigned w) { return __uint_as_float(w << 16); }
__device__ __forceinline__ float bf_hi(unsigned w) { return __uint_as_float(w & 0xffff0000u); }
__device__ __forceinline__ float bf2f(bf16_t b) { return __uint_as_float(((unsigned)b) << 16); }
__device__ __forceinline__ float shx(float v, int lane, int o) { return __uint_as_float((unsigned)__builtin_amdgcn_ds_bpermute((lane ^ o) << 2, (int)__float_as_uint(v))); }
__device__ __forceinline__ unsigned pk4_fp8(float a, float b, float c, float d) { int w = __builtin_amdgcn_cvt_pk_fp8_f32(a, b, 0, false); w = __builtin_amdgcn_cvt_pk_fp8_f32(c, d, w, true); return (unsigned)w; }
__device__ __forceinline__ float fast_sigmoid(float x) { return __builtin_amdgcn_rcpf(1.f + __builtin_amdgcn_exp2f(-1.4426950408889634f * x)); }

namespace pg8 {
constexpr int BM = 256, BK = 64, HALF = 128, HTB = HALF * BK * 2  , STAGE_BYTES = 8 * HTB;
__host__ __device__ __forceinline__ int lds_byte(int r, int c) { const int st = (r >> 4) * 2 + (c >> 5), rr = r & 15, cc = c & 31, ob = rr * 64 + cc * 2; return st * 1024 + (ob ^ (((ob >> 9) & 1) << 5)); }
__host__ __device__ __forceinline__ void stage_rc(int b, int& R, int& C) { const int st = b / 1024, sb = b % 1024, swz = sb ^ (((sb >> 9) & 1) << 5); R = (st >> 1) * 16 + swz / 64; C = (st & 1) * 32 + (swz % 64) / 2; }
__host__ __device__ __forceinline__ int perm32(int rho) { const int n = rho >> 4, i = rho & 15; return 8 * (i >> 2) + 4 * n + (i & 3); }

struct GUnit { const char* a; const char* b; int nt; int pm, pn, aux; int f8; int q; };

__device__ __forceinline__ bool grid_order(long L, int nM, int nN, int& pm, int& pn) {
    const int nwg = nM * nN; if (L >= nwg) return false;
    int wgid = (int)L; { const int q = nwg / 8, r = nwg % 8, xcd = wgid % 8, off = wgid / 8; wgid = (xcd < r ? xcd * (q + 1) : r * (q + 1) + (xcd - r) * q) + off; }
    const int nig = 8 * nN, gid = wgid / nig, fm = gid * 8, gsz = (nM - fm) < 8 ? (nM - fm) : 8;
    pm = fm + ((wgid % nig) % gsz); pn = (wgid % nig) / gsz; return true;
}

template <class Epi, class Sched, bool F8 = false>
__device__ __forceinline__ void gemm_phase(LAS unsigned char* lds, const int lda, const int ldb, const Sched& S, const Epi& E) {
    int tz = threadIdx.x; asm volatile("" : "+v"(tz));
    const int tid = tz, wid = __builtin_amdgcn_readfirstlane(tid >> 6), lane = tid & 63, wr = wid >> 2, wc = wid & 3, fr = lane & 15, fq = lane >> 4;
    unsigned voffA[2], voffB[2];
#pragma unroll
    for (int i = 0; i < 2; ++i) { int R, C; stage_rc(tid * 16 + i * 8192, R, C); const int Rb = Epi::PERM ? ((R & ~31) + perm32(R & 31)) : R;
        voffA[i] = (unsigned)(R * lda + C * 2); voffB[i] = (unsigned)(Rb * ldb + C * 2); }
    const size_t kstep = (size_t)(BK * 2);
    const size_t hstepA = (size_t)HALF * lda, hstepB = (size_t)HALF * ldb;
    const unsigned ldsw = (unsigned)wid * 1024u;
    const int aoff = lds_byte(wr * 64 + fr, fq * 8), boff = lds_byte(wc * 32 + fr, fq * 8);
#define PG8_SA(b, h) (((b) * 2 + (h)) * HTB)
#define PG8_SB(b, h) ((4 + (b) * 2 + (h)) * HTB)
#define PG8_STAGE(bufoff, gbase, voff) do { _Pragma("unroll") for (int _i = 0; _i < 2; ++_i) \
        __builtin_amdgcn_global_load_lds((const unsigned*)((const char*)(gbase) + (voff)[_i]), (LAS unsigned*)(lds + (bufoff) + ldsw + _i * 8192), 16, 0, 0); } while (0)
#define PG8_LDA16(dst, b, h) do { _Pragma("unroll") for (int m = 0; m < 4; ++m) _Pragma("unroll") for (int k = 0; k < 2; ++k) dst[m][k] = *(const LAS bf16x8*)(lds + PG8_SA(b, h) + aoff + m * 2048 + k * 1024); } while (0)
#define PG8_LDB16(dst, b, h) do { _Pragma("unroll") for (int n = 0; n < 2; ++n) _Pragma("unroll") for (int k = 0; k < 2; ++k) dst[n][k] = *(const LAS bf16x8*)(lds + PG8_SB(b, h) + boff + n * 2048 + k * 1024); } while (0)
#define PG8_LD8(p) __builtin_shufflevector(*(const LAS i32x4*)(p), *(const LAS i32x4*)((p) + 1024), 0, 1, 2, 3, 4, 5, 6, 7)
#define PG8_LDA8(dst, b, h) do { _Pragma("unroll") for (int m = 0; m < 4; ++m) dst[m] = PG8_LD8(lds + PG8_SA(b, h) + aoff + m * 2048); } while (0)
#define PG8_LDB8(dst, b, h) do { _Pragma("unroll") for (int n = 0; n < 2; ++n) dst[n] = PG8_LD8(lds + PG8_SB(b, h) + boff + n * 2048); } while (0)
#define PG8_LDA(dst, b, h) do { if constexpr (F8) PG8_LDA8(dst##8, b, h); else PG8_LDA16(dst, b, h); } while (0)
#define PG8_LDB(dst, b, h) do { if constexpr (F8) PG8_LDB8(dst##8, b, h); else PG8_LDB16(dst, b, h); } while (0)
#define PG8_MMA16(ai, bj, At, Bt) do { __builtin_amdgcn_s_setprio(1); _Pragma("unroll") for (int m = 0; m < 4; ++m) _Pragma("unroll") for (int n = 0; n < 2; ++n) _Pragma("unroll") for (int k = 0; k < 2; ++k) \
        acc[ai][bj][m][n] = __builtin_amdgcn_mfma_f32_16x16x32_bf16(Bt[n][k], At[m][k], acc[ai][bj][m][n], 0, 0, 0); __builtin_amdgcn_s_setprio(0); } while (0)
#define PG8_MMA8(ai, bj, At, Bt) do { __builtin_amdgcn_s_setprio(1); _Pragma("unroll") for (int m = 0; m < 4; ++m) _Pragma("unroll") for (int n = 0; n < 2; ++n) \
        asm volatile("v_mfma_f32_16x16x128_f8f6f4 %0, %1, %2, %0" : "+v"(acc[ai][bj][m][n]) : "v"(Bt[n]), "v"(At[m])); __builtin_amdgcn_s_setprio(0); } while (0)
#define PG8_MFMA_DRAIN() do { if constexpr (F8) asm volatile("s_nop 15\n\ts_nop 15" ::: "memory"); } while (0)
#define PG8_MMA(ai, bj, At, Bt) do { if constexpr (F8) PG8_MMA8(ai, bj, At##8, Bt##8); else PG8_MMA16(ai, bj, At, Bt); } while (0)
#define PG8_WAIT_V(n) asm volatile("s_waitcnt vmcnt(" #n ")" ::: "memory")
#define PG8_WAIT_L(n) asm volatile("s_waitcnt lgkmcnt(" #n ")" ::: "memory")
#define PG8_BAR __builtin_amdgcn_s_barrier()
#define PG8_SCHED __builtin_amdgcn_sched_barrier(0)
    GUnit cur, nxt; int ui = 0;
    if (!S.next(0, cur)) return;
    f32x4 acc[2][2][4][2];
#pragma unroll
    for (int a = 0; a < 2; ++a)
#pragma unroll
        for (int b = 0; b < 2; ++b)
#pragma unroll
            for (int m = 0; m < 4; ++m)
#pragma unroll
                for (int n = 0; n < 2; ++n) acc[a][b][m][n] = (f32x4){0.f, 0.f, 0.f, 0.f};
    bf16x8 At[4][2], B0[2][2], B1[2][2];
    i32x8 At8[4], B08[2], B18[2];
    const char* cA = cur.a; const char* cB = cur.b;
    PG8_STAGE(PG8_SB(0, 0), cB, voffB); PG8_STAGE(PG8_SB(0, 1), cB + hstepB, voffB); PG8_STAGE(PG8_SA(0, 0), cA, voffA); PG8_STAGE(PG8_SA(0, 1), cA + hstepA, voffA);
    if (wr == 1) PG8_BAR;
    PG8_WAIT_V(2); PG8_BAR;
    PG8_STAGE(PG8_SB(1, 0), cB + kstep, voffB); PG8_STAGE(PG8_SA(1, 0), cA + kstep, voffA); PG8_STAGE(PG8_SB(1, 1), cB + hstepB + kstep, voffB);
    PG8_WAIT_V(6); PG8_BAR;
    for (;;) {
        const bool has_next = S.next(ui + 1, nxt);
        const char* nA = has_next ? nxt.a : cA; const char* nB = has_next ? nxt.b : cB;
        const int nt = cur.nt;
        bool qs = false; if constexpr (Epi::QSKIP) qs = cur.q != 0;
        const bool do0 = !(qs && wr == 1), do1 = !qs;
#pragma unroll 1
        for (int t = 0; t < nt; t += 2) {
            const bool last = (t == nt - 2);
            const char* a1 = cA + (size_t)(t + 1) * kstep;
            const char* a2 = last ? nA : cA + (size_t)(t + 2) * kstep; const char* b2 = last ? nB : cB + (size_t)(t + 2) * kstep;
            const char* a3 = a2 + kstep; const char* b3 = b2 + kstep;
            PG8_LDB(B0, 0, 0); PG8_LDB(B1, 0, 1); PG8_SCHED; PG8_LDA(At, 0, 0); PG8_STAGE(PG8_SA(1, 1), a1 + hstepA, voffA);
            PG8_WAIT_V(8); PG8_WAIT_L(0); PG8_BAR; if (do0) { PG8_MMA(0, 0, At, B0); PG8_MMA(0, 1, At, B1); } PG8_BAR; PG8_SCHED;
            PG8_LDA(At, 0, 1); PG8_STAGE(PG8_SB(0, 0), b2, voffB); PG8_STAGE(PG8_SB(0, 1), b2 + hstepB, voffB); PG8_STAGE(PG8_SA(0, 0), a2, voffA);
            PG8_WAIT_V(8); PG8_WAIT_L(0); PG8_BAR; if (do1) { PG8_MMA(1, 0, At, B0); PG8_MMA(1, 1, At, B1); } PG8_BAR; PG8_SCHED;
            PG8_LDB(B0, 1, 0); PG8_LDB(B1, 1, 1); PG8_SCHED; PG8_LDA(At, 1, 0); PG8_STAGE(PG8_SA(0, 1), a2 + hstepA, voffA);
            PG8_WAIT_V(8); PG8_WAIT_L(0); PG8_BAR; if (do0) { PG8_MMA(0, 0, At, B0); PG8_MMA(0, 1, At, B1); } PG8_BAR; PG8_SCHED;
            PG8_LDA(At, 1, 1); PG8_STAGE(PG8_SB(1, 0), b3, voffB); PG8_STAGE(PG8_SB(1, 1), b3 + hstepB, voffB); PG8_STAGE(PG8_SA(1, 0), a3, voffA);
            PG8_WAIT_V(8); PG8_WAIT_L(0); PG8_BAR; if (do1) { PG8_MMA(1, 0, At, B0); PG8_MMA(1, 1, At, B1); } PG8_BAR; PG8_SCHED;
        }
        if (wr == 0) PG8_BAR;
        PG8_MFMA_DRAIN();
        E(acc, cur, wr, wc, fr, fq);
        if (!has_next) break;
        bool zero = true; if constexpr (Epi::KEEPS) zero = !E.keep(cur);
        if (zero) {
#pragma unroll
        for (int a = 0; a < 2; ++a)
#pragma unroll
            for (int b = 0; b < 2; ++b)
#pragma unroll
                for (int m = 0; m < 4; ++m)
#pragma unroll
                    for (int n = 0; n < 2; ++n) acc[a][b][m][n] = (f32x4){0.f, 0.f, 0.f, 0.f};
        }
        cur = nxt; cA = nA; cB = nB; ++ui;
        if (wr == 1) PG8_BAR;
    }
    PG8_WAIT_V(0);
    PG8_BAR;
#undef PG8_SA
#undef PG8_SB
#undef PG8_STAGE
#undef PG8_LDA
#undef PG8_LDB
#undef PG8_MMA
#undef PG8_MMA8
#undef PG8_MFMA_DRAIN
#undef PG8_MMA16
#undef PG8_LDA8
#undef PG8_LDB8
#undef PG8_LDA16
#undef PG8_LDB16
#undef PG8_LD8
#undef PG8_WAIT_V
#undef PG8_WAIT_L
#undef PG8_BAR
#undef PG8_SCHED
}
template <class Epi, class Sched>
__device__ __forceinline__ void gemm_phase_mx(LAS unsigned char* lds, const int lda, const int ldb, const int lda8, const int ldb8, const Sched& S, const Epi& E) {
    int tz = threadIdx.x; asm volatile("" : "+v"(tz));
    const int tid = tz, wid = __builtin_amdgcn_readfirstlane(tid >> 6), lane = tid & 63, wr = wid >> 2, wc = wid & 3, fr = lane & 15, fq = lane >> 4;
    unsigned voffA[2], voffB[2], voffA8[2], voffB8[2];
#pragma unroll
    for (int i = 0; i < 2; ++i) { int R, C; stage_rc(tid * 16 + i * 8192, R, C); const int Rb = Epi::PERM ? ((R & ~31) + perm32(R & 31)) : R;
        voffA[i] = (unsigned)(R * lda + C * 2); voffB[i] = (unsigned)(Rb * ldb + C * 2); voffA8[i] = (unsigned)(R * lda8 + C * 2); voffB8[i] = (unsigned)(Rb * ldb8 + C * 2); }
    const size_t kstep = (size_t)(BK * 2);
    const size_t hsA = (size_t)HALF * lda, hsB = (size_t)HALF * ldb, hsA8 = (size_t)HALF * lda8, hsB8 = (size_t)HALF * ldb8;
    const unsigned ldsw = (unsigned)wid * 1024u;
    const int aoff = lds_byte(wr * 64 + fr, fq * 8), boff = lds_byte(wc * 32 + fr, fq * 8);
#define MX_SA(b, h) (((b) * 2 + (h)) * HTB)
#define MX_SB(b, h) ((4 + (b) * 2 + (h)) * HTB)
#define MX_STG(bufoff, gptr, v8, v16, fl) do { _Pragma("unroll") for (int _i = 0; _i < 2; ++_i) { const unsigned _v = (fl) ? (v8)[_i] : (v16)[_i]; \
        __builtin_amdgcn_global_load_lds((const unsigned*)((const char*)(gptr) + _v), (LAS unsigned*)(lds + (bufoff) + ldsw + _i * 8192), 16, 0, 0); } } while (0)
#define MX_STAGE_A(bufoff, gptr, fl) MX_STG(bufoff, gptr, voffA8, voffA, fl)
#define MX_STAGE_B(bufoff, gptr, fl) MX_STG(bufoff, gptr, voffB8, voffB, fl)
#define MX_HSA(fl) ((fl) ? hsA8 : hsA)
#define MX_HSB(fl) ((fl) ? hsB8 : hsB)
#define MX_LDA16(dst, b, h) do { _Pragma("unroll") for (int m = 0; m < 4; ++m) _Pragma("unroll") for (int k = 0; k < 2; ++k) dst[m][k] = *(const LAS bf16x8*)(lds + MX_SA(b, h) + aoff + m * 2048 + k * 1024); } while (0)
#define MX_LDB16(dst, b, h) do { _Pragma("unroll") for (int n = 0; n < 2; ++n) _Pragma("unroll") for (int k = 0; k < 2; ++k) dst[n][k] = *(const LAS bf16x8*)(lds + MX_SB(b, h) + boff + n * 2048 + k * 1024); } while (0)
#define MX_LD8(p) __builtin_shufflevector(*(const LAS i32x4*)(p), *(const LAS i32x4*)((p) + 1024), 0, 1, 2, 3, 4, 5, 6, 7)
#define MX_LDA8(dst, b, h) do { _Pragma("unroll") for (int m = 0; m < 4; ++m) dst[m] = MX_LD8(lds + MX_SA(b, h) + aoff + m * 2048); } while (0)
#define MX_LDB8(dst, b, h) do { _Pragma("unroll") for (int n = 0; n < 2; ++n) dst[n] = MX_LD8(lds + MX_SB(b, h) + boff + n * 2048); } while (0)
#define MX_HALF(x, k) ((k) == 0 ? __builtin_shufflevector(x, x, 0, 1, 2, 3) : __builtin_shufflevector(x, x, 4, 5, 6, 7))
#define MX_MMA16(ai, bj, At, Bt) do { __builtin_amdgcn_s_setprio(1); _Pragma("unroll") for (int k = 0; k < 2; ++k) _Pragma("unroll") for (int m = 0; m < 4; ++m) _Pragma("unroll") for (int n = 0; n < 2; ++n) \
        acc[ai][bj][m][n] = __builtin_amdgcn_mfma_f32_16x16x32_bf16(__builtin_bit_cast(bf16x8, MX_HALF(Bt[n], k)), __builtin_bit_cast(bf16x8, MX_HALF(At[m], k)), acc[ai][bj][m][n], 0, 0, 0); __builtin_amdgcn_s_setprio(0); } while (0)
#define MX_MMA8(ai, bj, At, Bt) do { __builtin_amdgcn_s_setprio(1); _Pragma("unroll") for (int m = 0; m < 4; ++m) _Pragma("unroll") for (int n = 0; n < 2; ++n) \
        asm volatile("v_mfma_f32_16x16x128_f8f6f4 %0, %1, %2, %0" : "+v"(acc[ai][bj][m][n]) : "v"(Bt[n]), "v"(At[m])); __builtin_amdgcn_s_setprio(0); } while (0)
#define MX_WAIT_V(n) asm volatile("s_waitcnt vmcnt(" #n ")" ::: "memory")
#define MX_WAIT_L(n) asm volatile("s_waitcnt lgkmcnt(" #n ")" ::: "memory")
#define MX_BAR __builtin_amdgcn_s_barrier()
#define MX_SCHED __builtin_amdgcn_sched_barrier(0)
    GUnit cur, nxt; int ui = 0;
    if (!S.next(0, cur)) return;
    f32x4 acc[2][2][4][2];
#pragma unroll
    for (int a = 0; a < 2; ++a)
#pragma unroll
        for (int b = 0; b < 2; ++b)
#pragma unroll
            for (int m = 0; m < 4; ++m)
#pragma unroll
                for (int n = 0; n < 2; ++n) acc[a][b][m][n] = (f32x4){0.f, 0.f, 0.f, 0.f};
    i32x8 At8[4], B08[2], B18[2];
    const char* cA = cur.a; const char* cB = cur.b;
    { const bool fc = cur.f8 != 0;
      MX_STAGE_B(MX_SB(0, 0), cB, fc); MX_STAGE_B(MX_SB(0, 1), cB + MX_HSB(fc), fc); MX_STAGE_A(MX_SA(0, 0), cA, fc); MX_STAGE_A(MX_SA(0, 1), cA + MX_HSA(fc), fc);
      if (wr == 1) MX_BAR;
      MX_WAIT_V(2); MX_BAR;
      MX_STAGE_B(MX_SB(1, 0), cB + kstep, fc); MX_STAGE_A(MX_SA(1, 0), cA + kstep, fc); MX_STAGE_B(MX_SB(1, 1), cB + MX_HSB(fc) + kstep, fc);
      MX_WAIT_V(6); MX_BAR; }
    for (;;) {
        const bool has_next = S.next(ui + 1, nxt);
        const char* nA = has_next ? nxt.a : cA; const char* nB = has_next ? nxt.b : cB;
        const bool fc = cur.f8 != 0, fnx = has_next ? (nxt.f8 != 0) : fc;
        const int nt = cur.nt;
#pragma unroll 1
        for (int t = 0; t < nt; t += 2) {
            const bool last = (t == nt - 2); const bool f2 = last ? fnx : fc;
            const char* a1 = cA + (size_t)(t + 1) * kstep;
            const char* a2 = last ? nA : cA + (size_t)(t + 2) * kstep; const char* b2 = last ? nB : cB + (size_t)(t + 2) * kstep;
            const char* a3 = a2 + kstep; const char* b3 = b2 + kstep;
            MX_LDB8(B08, 0, 0); MX_LDB8(B18, 0, 1); MX_SCHED; MX_LDA8(At8, 0, 0);
            MX_STAGE_A(MX_SA(1, 1), a1 + MX_HSA(fc), fc);
            MX_WAIT_V(8); MX_WAIT_L(0); MX_BAR; if (fc) { MX_MMA8(0, 0, At8, B08); MX_MMA8(0, 1, At8, B18); } else { MX_MMA16(0, 0, At8, B08); MX_MMA16(0, 1, At8, B18); } MX_BAR; MX_SCHED;
            MX_LDA8(At8, 0, 1);
            MX_STAGE_B(MX_SB(0, 0), b2, f2); MX_STAGE_B(MX_SB(0, 1), b2 + MX_HSB(f2), f2); MX_STAGE_A(MX_SA(0, 0), a2, f2);
            MX_WAIT_V(8); MX_WAIT_L(0); MX_BAR; if (fc) { MX_MMA8(1, 0, At8, B08); MX_MMA8(1, 1, At8, B18); } else { MX_MMA16(1, 0, At8, B08); MX_MMA16(1, 1, At8, B18); } MX_BAR; MX_SCHED;
            MX_LDB8(B08, 1, 0); MX_LDB8(B18, 1, 1); MX_SCHED; MX_LDA8(At8, 1, 0);
            MX_STAGE_A(MX_SA(0, 1), a2 + MX_HSA(f2), f2);
            MX_WAIT_V(8); MX_WAIT_L(0); MX_BAR; if (fc) { MX_MMA8(0, 0, At8, B08); MX_MMA8(0, 1, At8, B18); } else { MX_MMA16(0, 0, At8, B08); MX_MMA16(0, 1, At8, B18); } MX_BAR; MX_SCHED;
            MX_LDA8(At8, 1, 1);
            MX_STAGE_B(MX_SB(1, 0), b3, f2); MX_STAGE_B(MX_SB(1, 1), b3 + MX_HSB(f2), f2); MX_STAGE_A(MX_SA(1, 0), a3, f2);
            MX_WAIT_V(8); MX_WAIT_L(0); MX_BAR; if (fc) { MX_MMA8(1, 0, At8, B08); MX_MMA8(1, 1, At8, B18); } else { MX_MMA16(1, 0, At8, B08); MX_MMA16(1, 1, At8, B18); } MX_BAR; MX_SCHED;
        }
        if (wr == 0) MX_BAR;
        asm volatile("s_nop 15\n\ts_nop 15" ::: "memory");
        E(acc, cur, wr, wc, fr, fq);
        if (!has_next) break;
        bool zero = true; if constexpr (Epi::KEEPS) zero = !E.keep(cur);
        if (zero) {
#pragma unroll
        for (int a = 0; a < 2; ++a)
#pragma unroll
            for (int b = 0; b < 2; ++b)
#pragma unroll
                for (int m = 0; m < 4; ++m)
#pragma unroll
                    for (int n = 0; n < 2; ++n) acc[a][b][m][n] = (f32x4){0.f, 0.f, 0.f, 0.f};
        }
        cur = nxt; cA = nA; cB = nB; ++ui;
        if (wr == 1) MX_BAR;
    }
    MX_WAIT_V(0);
    MX_BAR;
#undef MX_SA
#undef MX_SB
#undef MX_STG
#undef MX_STAGE_A
#undef MX_STAGE_B
#undef MX_HSA
#undef MX_HSB
#undef MX_LDA16
#undef MX_LDB16
#undef MX_LD8
#undef MX_HALF
#undef MX_LDA8
#undef MX_LDB8
#undef MX_MMA16
#undef MX_MMA8
#undef MX_WAIT_V
#undef MX_WAIT_L
#undef MX_BAR
#undef MX_SCHED
}
}
#ifndef ATT_STAGGER
#define ATT_STAGGER 0
#endif
#ifndef ATT_PRIO
#define ATT_PRIO 1
#endif
#ifndef ATT_PKSUM
#define ATT_PKSUM 0
#endif
#ifndef ATT_WIDE_ST
#define ATT_WIDE_ST 1
#endif
#ifndef ATT_ILV
#define ATT_ILV 0
#endif
#ifndef ATT_NV
#define ATT_NV 5
#endif
#ifndef ATT_NE
#define ATT_NE 1
#endif
#ifndef ATT_QKPIPE
#define ATT_QKPIPE 1
#endif
namespace att {
constexpr int LDP = 10240, LDO = 2048, KVBLK = 64;
constexpr int SHM_V = KVBLK * 128 * 2, SHM_K = KVBLK * 128 * 2;
constexpr int LDS_WS = 2 * SHM_V + 2 * SHM_K, LDS_BYTES = LDS_WS + 8 * 64 * 4;
constexpr float THR2 = 11.5415603f;
#define KSWZ(row, colB) ((row) * 256 + ((colB) ^ (((row) & 7) << 4)))
#define SBAR() __builtin_amdgcn_sched_barrier(0)
__device__ __forceinline__ int crow(int r, int hi) { return (r & 3) + 8 * (r >> 2) + 4 * hi; }

struct AUnit {
    int qrow0;
    int qcol, kcol, vcol;
    int ocol;
    int nlat_t;
    int lat_row0;
    int ctx_row0;
    int dpos;
    float sink2;
};

#define AEXP(x) (VAR == 2 ? (x) * 0.001f : __builtin_amdgcn_exp2f(x))
template <int KIND, int VAR = 0> __device__ __forceinline__ void partialSM(f32x16& p0, f32x16& p1, float& m_reg, float& mn, float& alpha, bool do_mask, int jrel, int hi) {
    if (KIND == 2) { if (do_mask) {
#pragma unroll
        for (int r = 0; r < 16; ++r) { const int d0 = jrel + crow(r, hi), d1 = d0 + 32;
            p0[r] = (d0 <= 128 && d0 >= -128) ? p0[r] : -1e30f; p1[r] = (d1 <= 128 && d1 >= -128) ? p1[r] : -1e30f; } } }
    if (VAR == 20) {
        mn = 0.f; alpha = 1.f;
#pragma unroll
        for (int r = 0; r < 16; ++r) p0[r] = __builtin_amdgcn_exp2f(p0[r]);
        return; }
    float pmax = p0[0];
#pragma unroll
    for (int r = 1; r < 16; ++r) pmax = fmaxf(pmax, p0[r]);
#pragma unroll
    for (int r = 0; r < 16; ++r) pmax = fmaxf(pmax, p1[r]);
    { auto rr = __builtin_amdgcn_permlane32_swap(__float_as_uint(pmax), __float_as_uint(pmax), false, false);
      pmax = fmaxf(__uint_as_float(rr[0]), __uint_as_float(rr[1])); }
    if (__builtin_expect(__all(pmax - m_reg <= THR2), 1)) { mn = m_reg; alpha = 1.f; }
    else { mn = fmaxf(m_reg, pmax); alpha = __builtin_amdgcn_exp2f(m_reg - mn); m_reg = mn; }
#pragma unroll
    for (int r = 0; r < 16; ++r) p0[r] = p0[r] - mn;
#pragma unroll
    for (int r = 0; r < 16; ++r) p1[r] = p1[r] - mn;
#pragma unroll
    for (int r = 0; r < 16; ++r) p0[r] = AEXP(p0[r]);
}
template <int VAR = 0> __device__ __forceinline__ void finishSM(f32x16& p0, f32x16& p1, float alpha, float& l_reg, bf16x8& pa0, bf16x8& pa1, bf16x8& pa2, bf16x8& pa3) {
#pragma unroll
    for (int r = 0; r < 16; ++r) p1[r] = AEXP(p1[r]);
#if ATT_PKSUM
    f32x2 s2a = {p0[0], p0[1]}, s2b = {p1[0], p1[1]};
#pragma unroll
    for (int r = 1; r < 8; ++r) { s2a = s2a + (f32x2){p0[2 * r], p0[2 * r + 1]}; s2b = s2b + (f32x2){p1[2 * r], p1[2 * r + 1]}; }
    s2a = s2a + s2b; float ps = s2a[0] + s2a[1];
#else
    float ps = 0;
#pragma unroll
    for (int r = 0; r < 16; ++r) ps += p0[r];
#pragma unroll
    for (int r = 0; r < 16; ++r) ps += p1[r];
#endif
    { auto rr = __builtin_amdgcn_permlane32_swap(__float_as_uint(ps), __float_as_uint(ps), false, false);
      ps = __uint_as_float(rr[0]) + __uint_as_float(rr[1]); }
    l_reg = VAR == 20 ? l_reg + ps : l_reg * alpha + ps;
#define PK4(P, BASE, OUT) do { unsigned a0 = cvt_pk_bf16(P[BASE + 0], P[BASE + 1]), a1 = cvt_pk_bf16(P[BASE + 2], P[BASE + 3]);   \
    unsigned b0 = cvt_pk_bf16(P[BASE + 4], P[BASE + 5]), b1 = cvt_pk_bf16(P[BASE + 6], P[BASE + 7]);                              \
    auto r0 = __builtin_amdgcn_permlane32_swap(a0, b0, false, false); auto r1 = __builtin_amdgcn_permlane32_swap(a1, b1, false, false); \
    u32x4 w = {r0[0], r1[0], r0[1], r1[1]}; OUT = *reinterpret_cast<bf16x8*>(&w); } while (0)
    PK4(p0, 0, pa0); PK4(p0, 8, pa1); PK4(p1, 0, pa2); PK4(p1, 8, pa3);
#undef PK4
}
template <int DQ, int VAR = 0> __device__ __forceinline__ void qkt(f32x16& p0, f32x16& p1, const LAS char* Ks, const bf16x8* qr, int r32, int hi, int dbase) {
    p0 = f32x16{}; p1 = f32x16{};
    if (VAR == 3) {
#pragma unroll
        for (int r = 0; r < 16; ++r) { p0[r] = (float)(r + r32) * 0.01f; p1[r] = (float)(r - hi) * 0.02f; }
        return; }
#if ATT_QKPIPE
    bf16x8 kb[2][2];
    { const int cb = (dbase * 16 + hi * 8) * 2; kb[0][0] = *reinterpret_cast<const LAS bf16x8*>(Ks + KSWZ(r32, cb)); kb[0][1] = *reinterpret_cast<const LAS bf16x8*>(Ks + KSWZ(32 + r32, cb)); }
#pragma unroll
    for (int d0 = 0; d0 < DQ; ++d0) {
        if (VAR == 9) { kb[(d0 + 1) & 1][0] = kb[d0 & 1][0]; kb[(d0 + 1) & 1][1] = kb[d0 & 1][1]; }
        else if (d0 + 1 < DQ) { const int cb = ((dbase + d0 + 1) * 16 + hi * 8) * 2;
            kb[(d0 + 1) & 1][0] = *reinterpret_cast<const LAS bf16x8*>(Ks + KSWZ(r32, cb)); kb[(d0 + 1) & 1][1] = *reinterpret_cast<const LAS bf16x8*>(Ks + KSWZ(32 + r32, cb)); }
        p0 = __builtin_amdgcn_mfma_f32_32x32x16_bf16(kb[d0 & 1][0], qr[d0], p0, 0, 0, 0);
        p1 = __builtin_amdgcn_mfma_f32_32x32x16_bf16(kb[d0 & 1][1], qr[d0], p1, 0, 0, 0); }
    if (VAR != 9 && !ATT_ILV) { __builtin_amdgcn_sched_group_barrier(0x100, 2, 0);
#pragma unroll
    for (int d0 = 0; d0 < DQ; ++d0) { if (d0 + 1 < DQ) __builtin_amdgcn_sched_group_barrier(0x100, 2, 0); __builtin_amdgcn_sched_group_barrier(0x008, 2, 0); } }
#else
#pragma unroll
    for (int d0 = 0; d0 < DQ; ++d0) { const int cb = ((dbase + d0) * 16 + hi * 8) * 2;
        const bf16x8 b0 = *reinterpret_cast<const LAS bf16x8*>(Ks + KSWZ(r32, cb));
        const bf16x8 b1 = *reinterpret_cast<const LAS bf16x8*>(Ks + KSWZ(32 + r32, cb));
        p0 = __builtin_amdgcn_mfma_f32_32x32x16_bf16(b0, qr[d0], p0, 0, 0, 0);
        p1 = __builtin_amdgcn_mfma_f32_32x32x16_bf16(b1, qr[d0], p1, 0, 0, 0); }
#endif
}
__device__ __forceinline__ int v_st(int k, int c) { const int kk = (k & ~0xC) | ((k & 4) << 1) | ((k & 8) >> 1); return ((kk >> 3) * 4 + (c >> 5)) * 512 + ((kk & 7) * 32 + (c & 31)) * 2; }
__device__ __forceinline__ int v_rd_base(int lane) { return ((lane & 3) << 3) | (((lane >> 2) & 3) << 6) | (((lane >> 4) & 1) << 5) | (((lane >> 5) & 1) << 8); }
constexpr int v_rd_off(int d0, int ks, int half) { return d0 * 512 + ks * 4096 + half * 2048; }
template <int OFF> __device__ __forceinline__ s16x4 tr_read(int vb) {
    s16x4 r; asm volatile("ds_read_b64_tr_b16 %0, %1 offset:%2" : "=&v"(r) : "v"(vb), "i"(OFF) : "memory"); return r;
}
template <int D0> __device__ __forceinline__ void pv_one(f32x16& od, int vb, bf16x8 pa0, bf16x8 pa1, bf16x8 pa2, bf16x8 pa3) {
    const s16x4 l0 = tr_read<v_rd_off(D0, 0, 0)>(vb), h0 = tr_read<v_rd_off(D0, 0, 1)>(vb), l1 = tr_read<v_rd_off(D0, 1, 0)>(vb), h1 = tr_read<v_rd_off(D0, 1, 1)>(vb);
    const s16x4 l2 = tr_read<v_rd_off(D0, 2, 0)>(vb), h2 = tr_read<v_rd_off(D0, 2, 1)>(vb), l3 = tr_read<v_rd_off(D0, 3, 0)>(vb), h3 = tr_read<v_rd_off(D0, 3, 1)>(vb);
    asm volatile("s_waitcnt lgkmcnt(0)" ::: "memory"); SBAR();
#define PKV(L, H) (bf16x8){L[0], L[1], L[2], L[3], H[0], H[1], H[2], H[3]}
    od = __builtin_amdgcn_mfma_f32_32x32x16_bf16(pa0, PKV(l0, h0), od, 0, 0, 0);
    od = __builtin_amdgcn_mfma_f32_32x32x16_bf16(pa1, PKV(l1, h1), od, 0, 0, 0);
    od = __builtin_amdgcn_mfma_f32_32x32x16_bf16(pa2, PKV(l2, h2), od, 0, 0, 0);
    od = __builtin_amdgcn_mfma_f32_32x32x16_bf16(pa3, PKV(l3, h3), od, 0, 0, 0);
#undef PKV
}
__device__ __forceinline__ void pv_d0(f32x16* o, int vb, bf16x8 pa0, bf16x8 pa1, bf16x8 pa2, bf16x8 pa3) {
    pv_one<0>(o[0], vb, pa0, pa1, pa2, pa3); pv_one<1>(o[1], vb, pa0, pa1, pa2, pa3); pv_one<2>(o[2], vb, pa0, pa1, pa2, pa3); pv_one<3>(o[3], vb, pa0, pa1, pa2, pa3);
}

template <int D0> __device__ __forceinline__ void pv_one_b(f32x16& od, const LAS char* vp, bf16x8 pa0, bf16x8 pa1, bf16x8 pa2, bf16x8 pa3) {
#define TRB(OFF) __builtin_amdgcn_ds_read_tr16_b64_v4i16((LAS s16x4*)(vp + (OFF)))
    const s16x4 l0 = TRB(v_rd_off(D0, 0, 0)), h0 = TRB(v_rd_off(D0, 0, 1)), l1 = TRB(v_rd_off(D0, 1, 0)), h1 = TRB(v_rd_off(D0, 1, 1));
    const s16x4 l2 = TRB(v_rd_off(D0, 2, 0)), h2 = TRB(v_rd_off(D0, 2, 1)), l3 = TRB(v_rd_off(D0, 3, 0)), h3 = TRB(v_rd_off(D0, 3, 1));
#undef TRB
#define PKV(L, H) (bf16x8){L[0], L[1], L[2], L[3], H[0], H[1], H[2], H[3]}
    od = __builtin_amdgcn_mfma_f32_32x32x16_bf16(pa0, PKV(l0, h0), od, 0, 0, 0);
    od = __builtin_amdgcn_mfma_f32_32x32x16_bf16(pa1, PKV(l1, h1), od, 0, 0, 0);
    od = __builtin_amdgcn_mfma_f32_32x32x16_bf16(pa2, PKV(l2, h2), od, 0, 0, 0);
    od = __builtin_amdgcn_mfma_f32_32x32x16_bf16(pa3, PKV(l3, h3), od, 0, 0, 0);
#undef PKV
}
__device__ __forceinline__ void pv_d0_b(f32x16* o, const LAS char* vp, bf16x8 pa0, bf16x8 pa1, bf16x8 pa2, bf16x8 pa3) {
    pv_one_b<0>(o[0], vp, pa0, pa1, pa2, pa3); pv_one_b<1>(o[1], vp, pa0, pa1, pa2, pa3); pv_one_b<2>(o[2], vp, pa0, pa1, pa2, pa3); pv_one_b<3>(o[3], vp, pa0, pa1, pa2, pa3);
}
template <int NM, int NV> __device__ __forceinline__ void ilv_qk() {
    __builtin_amdgcn_sched_group_barrier(0x100, 4, 0);
#pragma unroll
    for (int i = 0; i < NM; ++i) { __builtin_amdgcn_sched_group_barrier(0x008, 1, 0); __builtin_amdgcn_sched_group_barrier(0x400, ATT_NE, 0); __builtin_amdgcn_sched_group_barrier(0x002, NV, 0); if ((i & 1) && i + 3 < NM) __builtin_amdgcn_sched_group_barrier(0x100, 2, 0); }
}
template <int NV> __device__ __forceinline__ void ilv_pv() {
    __builtin_amdgcn_sched_group_barrier(0x100, 8, 0);
#pragma unroll
    for (int i = 0; i < 16; ++i) { __builtin_amdgcn_sched_group_barrier(0x008, 1, 0); __builtin_amdgcn_sched_group_barrier(0x002, NV, 0); __builtin_amdgcn_sched_group_barrier(0x400, ATT_NE, 0); if (i < 12) __builtin_amdgcn_sched_group_barrier(0x100, 2, 0); }
}
__device__ __forceinline__ float vadd_pin(float a, float b) { float r; asm volatile("v_add_f32 %0, %1, %2" : "=v"(r) : "v"(a), "v"(b)); return r; }
__device__ __forceinline__ float vexp_pin(float a) { float r; asm volatile("v_exp_f32 %0, %1" : "=v"(r) : "v"(a)); return r; }
__device__ __forceinline__ void plswap_pin(unsigned& a, unsigned& b) { asm volatile("v_permlane32_swap_b32 %0, %1" : "+v"(a), "+v"(b)); }
template <int DQ>
__device__ __forceinline__ void qk_fin(f32x16& q0, f32x16& q1, const LAS char* Ks, const bf16x8* qr, int r32, int hi, int dbase,
                                       f32x16& p0, f32x16& p1, float alpha, float& l_reg, bf16x8& pa0, bf16x8& pa1, bf16x8& pa2, bf16x8& pa3) {
    q0 = f32x16{}; q1 = f32x16{};
    constexpr int SPM = 8 / DQ;
    bf16x8 ka, kc;
    { const int cb = (dbase * 16 + hi * 8) * 2; ka = *reinterpret_cast<const LAS bf16x8*>(Ks + KSWZ(r32, cb)); kc = *reinterpret_cast<const LAS bf16x8*>(Ks + KSWZ(32 + r32, cb)); }
    float psa = 0.f, psb = 0.f; unsigned c0 = 0, c1 = 0, c2 = 0, c3 = 0;
#define QF_PERM(OUT) do { plswap_pin(c0, c2); plswap_pin(c1, c3); u32x4 w_ = {c0, c1, c2, c3}; OUT = *reinterpret_cast<bf16x8*>(&w_); } while (0)
#define QF_CVT(P, B, k) do { const unsigned v_ = cvt_pk_bf16(P[(B) + 2 * (k)], P[(B) + 2 * (k) + 1]); if ((k) == 0) c0 = v_; else if ((k) == 1) c1 = v_; else if ((k) == 2) c2 = v_; else c3 = v_; } while (0)
#pragma unroll
    for (int d0 = 0; d0 < DQ; ++d0) {
        const int cbn = ((dbase + d0 + 1) * 16 + hi * 8) * 2;
#pragma unroll
        for (int h = 0; h < 2; ++h) {
            SBAR();
            if (h == 0) { q0 = __builtin_amdgcn_mfma_f32_32x32x16_bf16(ka, qr[d0], q0, 0, 0, 0); if (d0 + 1 < DQ) ka = *reinterpret_cast<const LAS bf16x8*>(Ks + KSWZ(r32, cbn)); }
            else        { q1 = __builtin_amdgcn_mfma_f32_32x32x16_bf16(kc, qr[d0], q1, 0, 0, 0); if (d0 + 1 < DQ) kc = *reinterpret_cast<const LAS bf16x8*>(Ks + KSWZ(32 + r32, cbn)); }
#pragma unroll
            for (int s_ = 0; s_ < SPM; ++s_) { const int i = (2 * d0 + h) * SPM + s_;
                p1[i] = vexp_pin(p1[i]); psa = vadd_pin(psa, p0[i]); if (i > 0) psb = vadd_pin(psb, p1[i - 1]);
                if (i < 4) QF_CVT(p0, 0, i); else if (i == 4) QF_PERM(pa0);
                else if (i < 9) QF_CVT(p0, 8, i - 5); else if (i == 9) QF_PERM(pa1);
                else if (i < 14) QF_CVT(p1, 0, i - 10); else if (i == 14) QF_PERM(pa2); }
        }
    }
    SBAR();
    psb += p1[15];
    QF_CVT(p1, 8, 0); QF_CVT(p1, 8, 1); QF_CVT(p1, 8, 2); QF_CVT(p1, 8, 3); QF_PERM(pa3);
    float ps = psa + psb;
    { auto rr = __builtin_amdgcn_permlane32_swap(__float_as_uint(ps), __float_as_uint(ps), false, false); ps = __uint_as_float(rr[0]) + __uint_as_float(rr[1]); }
    l_reg = l_reg * alpha + ps;
#undef QF_PERM
#undef QF_CVT
}
template <int KIND, bool G2, int VAR>
__device__ __forceinline__ void attn_unit_impl(const AUnit u, const bf16_t* __restrict__ P, bf16_t* __restrict__ O, unsigned char* __restrict__ O8  , LAS char* lds, float lam, float osc, const float* __restrict__ subln) {
    constexpr int DQ = KIND == 1 ? 4 : 8;
    int tz = threadIdx.x; asm volatile("" : "+v"(tz));
    const int tid = tz, wid = __builtin_amdgcn_readfirstlane(tid >> 6), lane = tid & 63, r32 = lane & 31, hi = lane >> 5;
    if (ATT_PRIO && wid >= 4) __builtin_amdgcn_s_setprio(1);
    LAS char* V_lds = lds; LAS char* K_lds = lds + 2 * SHM_V;
    LAS float* ws = (LAS float*)(lds + LDS_WS) + wid * 64; LAS float* li_l = ws; LAS float* al_l = ws + 32;
    float m_reg = VAR == 20 ? 0.f : -1e30f, l_reg = 0; f32x16 o[4] = {}; bf16x8 qr[DQ];
    const int wq = KIND == 1 ? (wid & 3) : wid, mp = KIND == 1 ? (wid >> 2) : 0, dbase = mp * 4;
    const bf16_t* Qw = P + (long)(u.qrow0 + wq * 32 + r32) * LDP + u.qcol + mp * 64 + hi * 8;
#pragma unroll
    for (int d0 = 0; d0 < DQ; ++d0) qr[d0] = *reinterpret_cast<const bf16x8*>(Qw + d0 * 16);
    const int sr = tid >> 4, sc = (tid & 15) * 8, vst0 = v_st(sr, sc), vst1 = v_st(32 + sr, sc);
    const int vb0 = (int)(unsigned)(size_t)V_lds + v_rd_base(lane);
    const int NT = 4 + u.nlat_t;
    const bf16_t* Kc = P + u.kcol + sc; const bf16_t* Vc = P + u.vcol + sc;
    struct { bf16x8 vs0, vs1, ks0, ks1; } sr_[2];
#define TROW(t) ((t) < 4 ? u.ctx_row0 + (t) * KVBLK : u.lat_row0 + ((t) - 4) * KVBLK)
#define SLOAD(i, t) do { if (VAR >= 5 && VAR <= 6 && (t) > 0) break; const long _r0 = (long)(TROW(t) + sr) * LDP, _r1 = _r0 + 32L * LDP; \
    sr_[i].vs0 = *reinterpret_cast<const bf16x8*>(Vc + _r0); sr_[i].vs1 = *reinterpret_cast<const bf16x8*>(Vc + _r1); \
    sr_[i].ks0 = *reinterpret_cast<const bf16x8*>(Kc + _r0); sr_[i].ks1 = *reinterpret_cast<const bf16x8*>(Kc + _r1); } while (0)
#define SWRITE(b, i) do { if (VAR == 6 && started) break; *(LAS bf16x8*)(V_lds + (b) * SHM_V + vst0) = sr_[i].vs0; *(LAS bf16x8*)(V_lds + (b) * SHM_V + vst1) = sr_[i].vs1; const int kc = sc * 2; \
    *(LAS bf16x8*)(K_lds + (b) * SHM_K + KSWZ(sr, kc)) = sr_[i].ks0; *(LAS bf16x8*)(K_lds + (b) * SHM_K + KSWZ(32 + sr, kc)) = sr_[i].ks1; } while (0)
#define SWAIT() asm volatile("s_waitcnt vmcnt(4)" ::: "memory")
#define RESC(a) do { if (VAR != 20 && __any((a) < 1.f)) { if (hi == 0) al_l[r32] = (a); asm volatile("s_waitcnt lgkmcnt(0)" ::: "memory"); \
    _Pragma("unroll") for (int d = 0; d < 4; ++d) _Pragma("unroll") for (int r = 0; r < 16; ++r) o[d][r] *= al_l[crow(r, hi)]; } } while (0)
    const int jq = u.dpos - (wq * 32 + r32);
#define JREL(t) (jq + ((t) - 4) * KVBLK)
#define PVD(vb) do { if (VAR == 10) { const s16x4 l0 = tr_read<v_rd_off(0, 0, 0)>(vb), h0 = tr_read<v_rd_off(0, 0, 1)>(vb), l1 = tr_read<v_rd_off(0, 1, 0)>(vb), h1 = tr_read<v_rd_off(0, 1, 1)>(vb); asm volatile("s_waitcnt lgkmcnt(0)" ::: "memory"); \
        const bf16x8 f0 = (bf16x8){l0[0], l0[1], l0[2], l0[3], h0[0], h0[1], h0[2], h0[3]}, f1 = (bf16x8){l1[0], l1[1], l1[2], l1[3], h1[0], h1[1], h1[2], h1[3]}; \
        _Pragma("unroll") for (int d_ = 0; d_ < 4; ++d_) { o[d_] = __builtin_amdgcn_mfma_f32_32x32x16_bf16(pa0, f0, o[d_], 0, 0, 0); o[d_] = __builtin_amdgcn_mfma_f32_32x32x16_bf16(pa1, f1, o[d_], 0, 0, 0); o[d_] = __builtin_amdgcn_mfma_f32_32x32x16_bf16(pa2, f0, o[d_], 0, 0, 0); o[d_] = __builtin_amdgcn_mfma_f32_32x32x16_bf16(pa3, f1, o[d_], 0, 0, 0); } } else if (VAR == 4) { const u32x4 a_ = *(const u32x4*)&pa0, b_ = *(const u32x4*)&pa1, c_ = *(const u32x4*)&pa2, d_ = *(const u32x4*)&pa3; const u32x4 x_ = a_ ^ b_ ^ c_ ^ d_; o[0][0] += __uint_as_float((x_.x ^ x_.y ^ x_.z ^ x_.w) & 0x3fffffffu) * 1e-30f; } else if (ATT_ILV) pv_d0_b(o, (const LAS char*)(size_t)0 + (vb), pa0, pa1, pa2, pa3); else pv_d0(o, vb, pa0, pa1, pa2, pa3); } while (0)
#define LSYNC() do { if (VAR != 7) __syncthreads(); } while (0)
    f32x16 pA0, pA1, pB0, pB1; float mnA, mnB, alA, alB; bf16x8 pa0, pa1, pa2, pa3;
    constexpr int SE = 0, SO = 1; bool started = false;
    SLOAD(SE, 0); asm volatile("s_waitcnt vmcnt(0)" ::: "memory"); SWRITE(0, SE); __syncthreads();
    qkt<DQ, VAR>(pA0, pA1, K_lds, qr, r32, hi, dbase); partialSM<KIND, VAR>(pA0, pA1, m_reg, mnA, alA, false, 0, hi);
    SLOAD(SO, 1); if (2 < NT) SLOAD(SE, 2);
    SWAIT(); SWRITE(1, SO); __syncthreads(); started = true;
    constexpr bool g2 = G2;
    for (int j = 1; j + 1 < NT; j += 2) {
        if (!g2) {
            if (ATT_ILV == 2 && (VAR == 0 || VAR == 8 || VAR == 20)) { SBAR(); qk_fin<DQ>(pB0, pB1, K_lds + SHM_K, qr, r32, hi, dbase, pA0, pA1, alA, l_reg, pa0, pa1, pa2, pa3); SBAR(); } else {
            SBAR(); qkt<DQ, VAR>(pB0, pB1, K_lds + SHM_K, qr, r32, hi, dbase);
            finishSM<VAR>(pA0, pA1, alA, l_reg, pa0, pa1, pa2, pa3); if (ATT_ILV == 1) ilv_qk<2 * DQ, ATT_NV>(); SBAR(); }
            SLOAD(SO, j + 2); SBAR();
            PVD(vb0); partialSM<KIND, VAR>(pB0, pB1, m_reg, mnB, alB, j >= 4, JREL(j), hi); if (ATT_ILV == 1) ilv_pv<ATT_NV>();
        } else {
            SBAR(); finishSM<VAR>(pA0, pA1, alA, l_reg, pa0, pa1, pa2, pa3); SBAR();
            qkt<DQ, VAR>(pB0, pB1, K_lds + SHM_K, qr, r32, hi, dbase); SLOAD(SO, j + 2); SBAR();
            partialSM<KIND, VAR>(pB0, pB1, m_reg, mnB, alB, j >= 4, JREL(j), hi); SBAR();
            PVD(vb0);
        }
        LSYNC(); SWAIT(); SWRITE(0, SE);
        RESC(alB); LSYNC();
        if (!g2) {
            if (ATT_ILV == 2 && (VAR == 0 || VAR == 8 || VAR == 20)) { SBAR(); qk_fin<DQ>(pA0, pA1, K_lds, qr, r32, hi, dbase, pB0, pB1, alB, l_reg, pa0, pa1, pa2, pa3); SBAR(); } else {
            SBAR(); qkt<DQ, VAR>(pA0, pA1, K_lds, qr, r32, hi, dbase);
            finishSM<VAR>(pB0, pB1, alB, l_reg, pa0, pa1, pa2, pa3); if (ATT_ILV == 1) ilv_qk<2 * DQ, ATT_NV>(); SBAR(); }
            if (j + 3 < NT) SLOAD(SE, j + 3); SBAR();
            PVD(vb0 + SHM_V); partialSM<KIND, VAR>(pA0, pA1, m_reg, mnA, alA, j + 1 >= 4, JREL(j + 1), hi); if (ATT_ILV == 1) ilv_pv<ATT_NV>();
        } else {
            SBAR(); finishSM<VAR>(pB0, pB1, alB, l_reg, pa0, pa1, pa2, pa3); SBAR();
            qkt<DQ, VAR>(pA0, pA1, K_lds, qr, r32, hi, dbase); if (j + 3 < NT) SLOAD(SE, j + 3); SBAR();
            partialSM<KIND, VAR>(pA0, pA1, m_reg, mnA, alA, j + 1 >= 4, JREL(j + 1), hi); SBAR();
            PVD(vb0 + SHM_V);
        }
        LSYNC(); SWAIT(); SWRITE(1, SO);
        RESC(alA); LSYNC();
    }
    SBAR(); qkt<DQ, VAR>(pB0, pB1, K_lds + SHM_K, qr, r32, hi, dbase);
    finishSM<VAR>(pA0, pA1, alA, l_reg, pa0, pa1, pa2, pa3); SBAR();
    PVD(vb0); partialSM<KIND, VAR>(pB0, pB1, m_reg, mnB, alB, NT - 1 >= 4, JREL(NT - 1), hi);
    __syncthreads(); RESC(alB);
    finishSM<VAR>(pB0, pB1, alB, l_reg, pa0, pa1, pa2, pa3); SBAR();
    PVD(vb0 + SHM_V);
    if (KIND == 2) l_reg += __builtin_amdgcn_exp2f(u.sink2 - m_reg);
    if (hi == 0) li_l[r32] = l_reg; asm volatile("s_waitcnt lgkmcnt(0)" ::: "memory");
    float rli[16];
#pragma unroll
    for (int r = 0; r < 16; ++r) rli[r] = __builtin_amdgcn_rcpf(li_l[crow(r, hi)]);
    const bool st_ok = VAR == 0 || VAR == 20 || u.sink2 == 1234.5f;
    if (KIND != 1) {
        if (!st_ok) {} else if (O8) {
#if ATT_WIDE_ST
            LAS unsigned char* stg = (LAS unsigned char*)K_lds + wid * 4096;
#pragma unroll
            for (int r = 0; r < 16; ++r) { const int orow = crow(r, hi);
#pragma unroll
                for (int d0 = 0; d0 < 4; ++d0) { const float v = o[d0][r] * rli[r]; stg[orow * 128 + d0 * 32 + r32] = (unsigned char)(__builtin_amdgcn_cvt_pk_fp8_f32(v, v, 0, false) & 0xff); } }
            asm volatile("s_waitcnt lgkmcnt(0)" ::: "memory");
            unsigned char* Og = O8 + (long)(u.qrow0 + wid * 32) * LDO + u.ocol;
#pragma unroll
            for (int j = 0; j < 4; ++j) { const int c = j * 64 + lane; const u32x4 w = *(const LAS u32x4*)(stg + c * 16); *(u32x4*)(Og + (long)(c >> 3) * LDO + (c & 7) * 16) = w; }
#else
            unsigned char* Ow8 = O8 + (long)(u.qrow0 + wid * 32) * LDO + u.ocol + r32;
#pragma unroll
            for (int r = 0; r < 16; ++r) { const int orow = crow(r, hi);
#pragma unroll
                for (int d0 = 0; d0 < 4; ++d0) { const float v = o[d0][r] * rli[r]; Ow8[(long)orow * LDO + d0 * 32] = (unsigned char)(__builtin_amdgcn_cvt_pk_fp8_f32(v, v, 0, false) & 0xff); } }
#endif
        }
        else { bf16_t* Ow = O + (long)(u.qrow0 + wid * 32) * LDO + u.ocol + r32;
#pragma unroll
        for (int r = 0; r < 16; ++r) { const int orow = crow(r, hi);
#pragma unroll
            for (int d0 = 0; d0 < 4; ++d0) Ow[(long)orow * LDO + d0 * 32] = (bf16_t)(cvt_pk_bf16(o[d0][r] * rli[r], 0.f) & 0xffffu); } }
        __syncthreads();
    } else {
        __syncthreads();
        LAS float* X2 = (LAS float*)lds + (wid & 3) * 4096;
        if (wid >= 4) {
#pragma unroll
            for (int r = 0; r < 16; ++r) { const int orow = crow(r, hi);
#pragma unroll
                for (int d0 = 0; d0 < 4; ++d0) X2[orow * 128 + d0 * 32 + r32] = o[d0][r] * rli[r]; }
        }
        __syncthreads();
        if (wid < 4 && st_ok) {
            float ss[16];
#pragma unroll
            for (int r = 0; r < 16; ++r) { const int orow = crow(r, hi); float s = 0.f;
#pragma unroll
                for (int d0 = 0; d0 < 4; ++d0) { const float v = o[d0][r] * rli[r] - lam * X2[orow * 128 + d0 * 32 + r32]; o[d0][r] = v; s += v * v; }
                ss[r] = s; }
#pragma unroll
            for (int off = 1; off < 32; off <<= 1) {
#pragma unroll
                for (int r = 0; r < 16; ++r) ss[r] += shx(ss[r], lane, off); }
            float g4[4];
#pragma unroll
            for (int d0 = 0; d0 < 4; ++d0) g4[d0] = subln[d0 * 32 + r32] * osc;
#if ATT_WIDE_ST
            LAS bf16_t* stg = (LAS bf16_t*)X2;
#pragma unroll
            for (int r = 0; r < 16; ++r) { const int orow = crow(r, hi); const float rs = rsqrtf(ss[r] * (1.f / 128.f) + 1e-6f);
#pragma unroll
                for (int d0 = 0; d0 < 4; ++d0) stg[orow * 128 + d0 * 32 + r32] = (bf16_t)(cvt_pk_bf16(o[d0][r] * rs * g4[d0], 0.f) & 0xffffu); }
            asm volatile("s_waitcnt lgkmcnt(0)" ::: "memory");
            bf16_t* Og = O + (long)(u.qrow0 + wid * 32) * LDO + u.ocol;
#pragma unroll
            for (int j = 0; j < 8; ++j) { const int c = j * 64 + lane; const u32x4 w = *(const LAS u32x4*)((const LAS char*)stg + c * 16); *(u32x4*)(Og + (long)(c >> 4) * LDO + (c & 15) * 8) = w; }
#else
            bf16_t* Ow = O + (long)(u.qrow0 + wid * 32) * LDO + u.ocol + r32;
#pragma unroll
            for (int r = 0; r < 16; ++r) { const int orow = crow(r, hi); const float rs = rsqrtf(ss[r] * (1.f / 128.f) + 1e-6f);
#pragma unroll
                for (int d0 = 0; d0 < 4; ++d0) Ow[(long)orow * LDO + d0 * 32] = (bf16_t)(cvt_pk_bf16(o[d0][r] * rs * g4[d0], 0.f) & 0xffffu); }
#endif
        }
        __syncthreads();
    }
#undef TROW
#undef SLOAD
#undef SWRITE
#undef SWAIT
#undef RESC
#undef JREL
#undef PVD
#undef LSYNC
    if (ATT_PRIO) __builtin_amdgcn_s_setprio(0);
}
template <int KIND, int VAR = 0>
__device__ __forceinline__ void attn_unit(const AUnit u, const bf16_t* __restrict__ P, bf16_t* __restrict__ O, unsigned char* __restrict__ O8, LAS char* lds, float lam, float osc, const float* __restrict__ subln) {
    const int wv_ = __builtin_amdgcn_readfirstlane((int)(threadIdx.x >> 6));
    if (ATT_STAGGER && (ATT_STAGGER == 1 ? wv_ >= 4 : ATT_STAGGER == 2 ? (wv_ & 1) : ((wv_ >> 1) & 1))) attn_unit_impl<KIND, true, VAR>(u, P, O, O8, lds, lam, osc, subln);
    else attn_unit_impl<KIND, false, VAR>(u, P, O, O8, lds, lam, osc, subln);
}
}
#define XB_TMO      128
#define XB_XCNT(j)  (256  + 64 * (j))
#define XB_XSUB(j)  (1280 + 64 * (j))
#define XB_XGEN(j)  (2304 + 64 * (j))
#define XB_TOP      3328
#define XB_TOPGEN   3392
#define XCD_BAR_WORDS 3456
#define XB_SPIN_CAP (1u << 18)
__device__ __forceinline__ unsigned xb_ld(unsigned* p)              { return __hip_atomic_load(p, __ATOMIC_RELAXED, __HIP_MEMORY_SCOPE_AGENT); }
__device__ __forceinline__ unsigned xb_add(unsigned* p, unsigned v) { return __hip_atomic_fetch_add(p, v, __ATOMIC_RELAXED, __HIP_MEMORY_SCOPE_AGENT); }
__device__ __forceinline__ unsigned xb_xcc_id() { return (unsigned)__builtin_amdgcn_s_getreg((3 << 11) | 20) & 0xFu; }
#define XB_SPIN(cond, bar) do { unsigned _sp = 0; while (cond) { __builtin_amdgcn_s_sleep(1); \
    if ((++_sp & 255u) == 0u) { if (xb_ld(&(bar)[XB_TMO])) break; if (_sp > XB_SPIN_CAP) { atomicAdd(&(bar)[XB_TMO], 1u); break; } } } } while (0)
struct XcdBarrier { unsigned* bar; unsigned x; volatile LAS unsigned* st; };
__device__ __forceinline__ XcdBarrier xcd_barrier_post(unsigned* bar, volatile LAS unsigned* st) {
    XcdBarrier b; b.bar = bar; b.x = xb_xcc_id(); b.st = st;
    if (threadIdx.x == 0) (void)xb_add(&bar[XB_XCNT(b.x)], 1u);
    return b;
}
__device__ __forceinline__ void xcd_barrier_complete(unsigned* bar, unsigned x, unsigned& nloc, unsigned& nx) {
    const unsigned G = gridDim.x * gridDim.y * gridDim.z;
    unsigned sum, cnt, mine, sp = 0u;
    for (;;) {
        sum = 0u; cnt = 0u; mine = 0u;
#pragma unroll
        for (unsigned j = 0; j < 16; ++j) { const unsigned c = xb_ld(&bar[XB_XCNT(j)]); sum += c; cnt += (c > 0u) ? 1u : 0u; mine = (j == x) ? c : mine; }
        if (sum == G) break;
        __builtin_amdgcn_s_sleep(1);
        if ((++sp & 255u) == 0u) { if (xb_ld(&bar[XB_TMO])) break; if (sp > XB_SPIN_CAP) { atomicAdd(&bar[XB_TMO], 1u); break; } }
    }
    nloc = mine > 0u ? mine : 1u; nx = cnt > 0u ? cnt : 1u;
}
__device__ __forceinline__ void xcd_barrier(const XcdBarrier& b) {
    asm volatile("s_waitcnt vmcnt(0)" ::: "memory");
    __syncthreads();
    if (threadIdx.x == 0) {
        unsigned* bar = b.bar;
        __builtin_amdgcn_s_waitcnt(0);
        unsigned nloc = b.st[0], nx = b.st[1];
        if (nloc == 0u) { xcd_barrier_complete(bar, b.x, nloc, nx); b.st[0] = nloc; b.st[1] = nx; }
        const unsigned old = xb_add(&bar[XB_XSUB(b.x)], 1u);
        const unsigned gen = old / nloc;
        if (old + 1u == (gen + 1u) * nloc) {
            __builtin_amdgcn_fence(__ATOMIC_RELEASE, "agent");
            asm volatile("s_waitcnt vmcnt(0)" ::: "memory");
            const unsigned og = xb_add(&bar[XB_TOP], 1u);
            const unsigned tg = og / nx;
            if (og + 1u == (tg + 1u) * nx) xb_add(&bar[XB_TOPGEN], 1u);
            else XB_SPIN(xb_ld(&bar[XB_TOPGEN]) == tg, bar);
            __builtin_amdgcn_fence(__ATOMIC_ACQUIRE, "agent");
            xb_add(&bar[XB_XGEN(b.x)], 1u);
            asm volatile("s_waitcnt vmcnt(0)" ::: "memory");
        } else {
            XB_SPIN(xb_ld(&bar[XB_XGEN(b.x)]) == gen, bar);
            __builtin_amdgcn_fence(__ATOMIC_ACQUIRE, "agent");
            asm volatile("s_waitcnt vmcnt(0)" ::: "memory");
        }
    }
    __syncthreads();
}

#ifndef FUSE_QK
#define FUSE_QK 1
#endif
#ifndef FP8_EXPERTS
#define FP8_EXPERTS 1
#endif
#ifndef FP8_AC
#define FP8_AC 1
#endif
#ifndef FP8_OUT
#define FP8_OUT 0
#endif
#ifndef FP8_BR
#define FP8_BR 1
#endif
#ifndef FP8_GATES
#define FP8_GATES 1
#endif
#ifndef CTX_CHAIN
#define CTX_CHAIN 1
#endif
#ifndef BG_CONV
#define BG_CONV 0
#endif
#ifndef FUSE_ROUTER
#define FUSE_ROUTER 0
#endif
#ifndef ROUTER_V3
#define ROUTER_V3 0
#endif
#ifndef CTX_GATES_IN_CHAIN
#define CTX_GATES_IN_CHAIN 1
#endif
namespace fk {
constexpr int DM = 2048, SEQ = 4096, CTXL = 256, NLAT = 8192, MROWS = 8704, INW = 10240, NEXP = 16, FF = 1024, MODW = 12288;
constexpr int EROWS = 1088, EPAD = 1280;
constexpr float EPS = 1e-6f, LOG2E = 1.4426950408889634f;
constexpr int NWAVES = 8, NTHR = 512;
constexpr size_t MiB = 1u << 20;
constexpr size_t WS_CTL = 0, CTL_ZERO_BYTES = 1 * MiB;
constexpr size_t WS_MODV = 512 * 1024  , WS_ROPE128 = 2 * MiB, WS_ROPE64 = 4 * MiB, WS_AFFT = 5 * MiB, WS_SEL = 6 * MiB, WS_GW = 7 * MiB, WS_BIASR = 7 * MiB + 128 * 1024  ;
constexpr size_t WS_H = 8 * MiB, WS_P = 42 * MiB, WS_XG = 42 * MiB, WS_ACT = 122 * MiB, WS_OATT = 212 * MiB, WS_MM = 246 * MiB, WS_Y = 212 * MiB, WS_X = 280 * MiB;
constexpr size_t WS_WIN8 = 588 * MiB  , WS_H8 = 640 * MiB  , WS_WBR8 = 660 * MiB  , WS_OATT8 = 672 * MiB  , WS_XCH = 692 * MiB  ;
static_assert(!FP8_GATES || FP8_EXPERTS, "WIN8 / H8 live in the half of the W1 region that the fp8 expert weights leave free");
constexpr size_t WS_WIN = 348 * MiB, WS_WBR = 428 * MiB, WS_WOUT = 444 * MiB, WS_W1 = 460 * MiB, WS_W2 = 716 * MiB, WS_END = 844 * MiB;
static_assert((size_t)MROWS * DM * 2 <= 34 * MiB && (size_t)MROWS * INW * 2 <= 170 * MiB && (size_t)16 * EPAD * DM * 2 <= 80 * MiB && (size_t)16 * EPAD * FF * 2 <= 40 * MiB &&
              (size_t)16 * EROWS * DM * 2 <= 68 * MiB && (size_t)MROWS * DM * 4 <= 68 * MiB, "d_ws map");
constexpr int CW_BAR = 4096;
constexpr int CW_QUEUE = 1024;
constexpr int CW_BGQ = 3520;
constexpr int CW_RP = 10240;
constexpr int CW_DONE = 8192;
constexpr int CW_CTX = 3200;
constexpr int RING_BYTES = 131072, LDS_BYTES = 147456, MISC_OFF = LDS_BYTES - 256;

typedef const float* cfp;
struct Args { cfp in[29]; float* out; unsigned char* ws; int ph_lo, ph_hi; };

template <int CTRL> __device__ __forceinline__ float dppm(float v) { return __uint_as_float((unsigned)__builtin_amdgcn_update_dpp(0, (int)__float_as_uint(v), CTRL, 0xf, 0xf, false)); }
__device__ __forceinline__ float xsum16(float v) { const auto rr = __builtin_amdgcn_permlane16_swap(__float_as_uint(v), __float_as_uint(v), false, false); return __uint_as_float(rr[0]) + __uint_as_float(rr[1]); }
__device__ __forceinline__ float xsum32(float v) { const auto rr = __builtin_amdgcn_permlane32_swap(__float_as_uint(v), __float_as_uint(v), false, false); return __uint_as_float(rr[0]) + __uint_as_float(rr[1]); }
__device__ __forceinline__ float row_sum16(float v) { v += dppm<0xB1>(v); v += dppm<0x4E>(v); v += dppm<0x141>(v); v += dppm<0x140>(v); return v; }
__device__ __forceinline__ float row_max16(float v) { v = fmaxf(v, dppm<0xB1>(v)); v = fmaxf(v, dppm<0x4E>(v)); v = fmaxf(v, dppm<0x141>(v)); v = fmaxf(v, dppm<0x140>(v)); return v; }
__device__ __forceinline__ float wave_sum(float v, int lane) { (void)lane; return xsum32(xsum16(row_sum16(v))); }
__device__ __forceinline__ float wave_max(float v, int lane) { (void)lane; v = row_max16(v);
    { const auto rr = __builtin_amdgcn_permlane16_swap(__float_as_uint(v), __float_as_uint(v), false, false); v = fmaxf(__uint_as_float(rr[0]), __uint_as_float(rr[1])); }
    { const auto rr = __builtin_amdgcn_permlane32_swap(__float_as_uint(v), __float_as_uint(v), false, false); v = fmaxf(__uint_as_float(rr[0]), __uint_as_float(rr[1])); }
    return v; }
__device__ __forceinline__ float sink_bound(const float* s6) { float m = 0.f;
#pragma unroll
    for (int i = 0; i < 6; ++i) m = fmaxf(m, fabsf(s6[i]) * 1.4426950408889634f);
    return m; }
__device__ __forceinline__ int modrow(int row) { return row < SEQ ? 0 : (row < NLAT ? 1 : 2); }

__host__ __device__ __forceinline__ int pos128(int d) { const int half = d >> 6, r = d & 63, n = r >> 5, r2 = r & 31, wcl = r2 >> 4, r3 = r2 & 15; return (half * 2 + wcl) * 32 + (r3 >> 2) * 8 + n * 4 + (r3 & 3); }
__host__ __device__ __forceinline__ int pos64(int d) { const int wcl = d >> 5, r = d & 31, n = r >> 4, r3 = r & 15; return wcl * 32 + (r3 >> 2) * 8 + n * 4 + (r3 & 3); }
template <int MODE  > __device__ __forceinline__ void transpose_item(f32x4 (&v)[16], const float* __restrict__ W, int N, int k0, int n0, bf16_t* __restrict__ dst  , int ldd, int perm, LAS float* scr, int lane) {
    const int kq = lane >> 4, nq = lane & 15;
    if (MODE != 2) {
#pragma unroll
        for (int i = 0; i < 16; ++i) v[i] = __builtin_nontemporal_load((const f32x4*)(W + (size_t)(k0 + 4 * i + kq) * N + n0 + 4 * nq)); }
    if (MODE == 1) return;
#pragma unroll
    for (int i = 0; i < 16; ++i) { LAS float* s = scr + (4 * i + kq) * 65 + 4 * nq; s[0] = v[i][0]; s[1] = v[i][1]; s[2] = v[i][2]; s[3] = v[i][3]; }
    asm volatile("s_waitcnt lgkmcnt(0)" ::: "memory");
#pragma unroll
    for (int j = 0; j < 8; ++j) { const int n = j * 8 + (lane >> 3), c = lane & 7; const LAS float* s = scr + (8 * c) * 65 + n;
        const int sc = n0 + n; const int drow = perm == 0 ? sc : (perm == 1 ? (sc & ~127) + pos128(sc & 127) : (sc & ~63) + pos64(sc & 63));
        u32x4 o; o.x = cvt_pk_bf16(s[0 * 65], s[1 * 65]); o.y = cvt_pk_bf16(s[2 * 65], s[3 * 65]); o.z = cvt_pk_bf16(s[4 * 65], s[5 * 65]); o.w = cvt_pk_bf16(s[6 * 65], s[7 * 65]);
        *(u32x4*)(dst + (size_t)drow * ldd + 8 * c) = o; }
    asm volatile("s_waitcnt lgkmcnt(0)" ::: "memory");
}
template <int MODE> __device__ __forceinline__ void transpose_item_f8(f32x4 (&v)[16], const float* __restrict__ W, int N, int k0, int n0, unsigned char* __restrict__ dst  , int ldd, float mul, LAS float* scr, int lane, int perm = 0) {
    const int kq = lane >> 4, nq = lane & 15;
    if (MODE != 2) {
#pragma unroll
        for (int i = 0; i < 16; ++i) v[i] = __builtin_nontemporal_load((const f32x4*)(W + (size_t)(k0 + 4 * i + kq) * N + n0 + 4 * nq)); }
    if (MODE == 1) return;
#pragma unroll
    for (int i = 0; i < 16; ++i) { LAS float* s = scr + (4 * i + kq) * 65 + 4 * nq; s[0] = v[i][0] * mul; s[1] = v[i][1] * mul; s[2] = v[i][2] * mul; s[3] = v[i][3] * mul; }
    asm volatile("s_waitcnt lgkmcnt(0)" ::: "memory");
#pragma unroll
    for (int j = 0; j < 4; ++j) { const int n = j * 16 + (lane >> 2), c = lane & 3; const LAS float* s = scr + (16 * c) * 65 + n;
        u32x4 o; o.x = pk4_fp8(s[0 * 65], s[1 * 65], s[2 * 65], s[3 * 65]); o.y = pk4_fp8(s[4 * 65], s[5 * 65], s[6 * 65], s[7 * 65]);
        o.z = pk4_fp8(s[8 * 65], s[9 * 65], s[10 * 65], s[11 * 65]); o.w = pk4_fp8(s[12 * 65], s[13 * 65], s[14 * 65], s[15 * 65]);
        const int sc = n0 + n; const int drow = perm == 0 ? sc : (perm == 1 ? (sc & ~127) + pos128(sc & 127) : (sc & ~63) + pos64(sc & 63));
        *(u32x4*)(dst + (size_t)drow * ldd + 16 * c) = o; }
    asm volatile("s_waitcnt lgkmcnt(0)" ::: "memory");
}
__host__ __device__ __forceinline__ bool win_fp8_tile(int pn) { return FP8_GATES && (pn >= 16 || (FP8_AC && !(pn == 2 || pn == 3 || pn == 4 || pn == 5 || pn == 11 || pn == 12))); }
__host__ __device__ __forceinline__ int win_perm(int c) { return c < 256 ? 1 : c < 512 ? 0 : c < 1024 ? 2 : c < 1536 ? 0 : c < 1792 ? 1 : c < 2048 ? 0 : c < 2816 ? 1 : c < 3328 ? 2 : c < 4096 ? 1 : 0; }
constexpr int CV_I_IN = 32 * 160, CV_I_BRA = 12 * 32, CV_I_BRB = 8 * 32, CV_I_OUT = 32 * 32, CV_I_G = 32 * 16, CV_I_D = 16 * 32;
constexpr int CV_D1 = CV_I_IN + 2 * CV_I_BRA + CV_I_BRB + CV_I_OUT;
constexpr int CV_PER_L = CV_D1 + 16 * (2 * CV_I_G + CV_I_D);
template <int MODE> __device__ __forceinline__ void conv_item_m(f32x4 (&v)[16], const Args& A, int it, LAS float* scr, int lane) {
    unsigned char* ws = A.ws;
    constexpr int I_IN = CV_I_IN, I_BRA = CV_I_BRA, I_BRB = CV_I_BRB, I_OUT = CV_I_OUT, I_G = CV_I_G, I_D = CV_I_D, PER_L = CV_PER_L;
    {
        const int l = it / PER_L; int r = it % PER_L;
        if (r < I_IN) { const int kb = r / 160, nb = r % 160;
            if (win_fp8_tile(nb >> 2)) { transpose_item_f8<MODE>(v, A.in[8] + (size_t)l * DM * INW, INW, kb * 64, nb * 64, (unsigned char*)(ws + WS_WIN8) + ((size_t)l * INW) * DM + kb * 64, DM, 64.f, scr, lane, FUSE_QK ? win_perm(nb * 64) : 0); return; }
            transpose_item<MODE>(v, A.in[8] + (size_t)l * DM * INW, INW, kb * 64, nb * 64, (bf16_t*)(ws + WS_WIN) + ((size_t)l * INW) * DM + kb * 64, DM, FUSE_QK ? win_perm(nb * 64) : 0, scr, lane); return; } r -= I_IN;
        if (r < I_BRA) { const int kb = r / 32, nb = r % 32;
            if (FP8_BR) transpose_item_f8<MODE>(v, A.in[21] + (size_t)l * 768 * DM, DM, kb * 64, nb * 64, (unsigned char*)(ws + WS_WBR8) + ((size_t)l * DM) * DM + kb * 64, DM, 64.f, scr, lane);
            else transpose_item<MODE>(v, A.in[21] + (size_t)l * 768 * DM, DM, kb * 64, nb * 64, (bf16_t*)(ws + WS_WBR) + ((size_t)l * DM) * DM + kb * 64, DM, 0, scr, lane);
            return; } r -= I_BRA;
        if (r < I_BRB) { const int kb = r / 32, nb = r % 32; transpose_item<MODE>(v, A.in[22] + (size_t)l * 512 * DM, DM, kb * 64, nb * 64, (bf16_t*)(ws + WS_WBR) + ((size_t)l * DM) * DM + 768 + kb * 64, DM, 0, scr, lane); return; } r -= I_BRB;
        if (r < I_BRA) { const int kb = r / 32, nb = r % 32;
            if (FP8_BR) transpose_item_f8<MODE>(v, A.in[23] + (size_t)l * 768 * DM, DM, kb * 64, nb * 64, (unsigned char*)(ws + WS_WBR8) + ((size_t)l * DM) * DM + 1280 + kb * 64, DM, 64.f, scr, lane);
            else transpose_item<MODE>(v, A.in[23] + (size_t)l * 768 * DM, DM, kb * 64, nb * 64, (bf16_t*)(ws + WS_WBR) + ((size_t)l * DM) * DM + 1280 + kb * 64, DM, 0, scr, lane);
            return; } r -= I_BRA;
        if (r < I_OUT) { const int kb = r / 32, nb = r % 32;
            if (FP8_OUT) transpose_item_f8<MODE>(v, A.in[24] + (size_t)l * DM * DM, DM, kb * 64, nb * 64, (unsigned char*)(ws + WS_WOUT) + ((size_t)l * DM) * DM + kb * 64, DM, 64.f, scr, lane);
            else transpose_item<MODE>(v, A.in[24] + (size_t)l * DM * DM, DM, kb * 64, nb * 64, (bf16_t*)(ws + WS_WOUT) + ((size_t)l * DM) * DM + kb * 64, DM, 0, scr, lane);
            return; } r -= I_OUT;
        const int e = r / (2 * I_G + I_D); r %= (2 * I_G + I_D);
        if (r < 2 * I_G) { const int up = r / I_G; r %= I_G; const int kb = r / 16, nb = r % 16, f0 = nb * 64;
            const size_t drow0 = ((size_t)l * 16 + e) * 2048 + (f0 >> 7) * 256 + up * 128 + (f0 & 127) - f0;
            if (FP8_EXPERTS) transpose_item_f8<MODE>(v, A.in[26 + up] + ((size_t)l * 16 + e) * DM * FF, FF, kb * 64, f0, (unsigned char*)(ws + WS_W1) + drow0 * DM + kb * 64, DM, 64.f, scr, lane);
            else transpose_item<MODE>(v, A.in[26 + up] + ((size_t)l * 16 + e) * DM * FF, FF, kb * 64, f0, (bf16_t*)(ws + WS_W1) + drow0 * DM + kb * 64, DM, 0, scr, lane);
            return; }
        r -= 2 * I_G;
        { const int kb = r / 32, nb = r % 32;
          if (FP8_EXPERTS) transpose_item_f8<MODE>(v, A.in[28] + ((size_t)l * 16 + e) * FF * DM, DM, kb * 64, nb * 64, (unsigned char*)(ws + WS_W2) + (((size_t)l * 16 + e) * 2048) * FF + kb * 64, FF, 64.f, scr, lane);
          else transpose_item<MODE>(v, A.in[28] + ((size_t)l * 16 + e) * FF * DM, DM, kb * 64, nb * 64, (bf16_t*)(ws + WS_W2) + (((size_t)l * 16 + e) * 2048) * FF + kb * 64, FF, 0, scr, lane); }
    }
}
__device__ __forceinline__ void conv_item(const Args& A, int it, LAS float* scr, int lane) { f32x4 v[16]; conv_item_m<0>(v, A, it, scr, lane); }
__device__ __forceinline__ void bg_loop(const Args& A, LAS unsigned char* lds, unsigned* ctl, volatile LAS unsigned* MISC, int seam, int force_upto, int G) {
    int tz = threadIdx.x; asm volatile("" : "+v"(tz)); const int tid = tz, lane = tz & 63, wave = __builtin_amdgcn_readfirstlane(tz >> 6);
    LAS float* scr = (LAS float*)(lds + wave * 16640);
    unsigned* bgq = ctl + CW_BGQ; unsigned* done = ctl + CW_DONE + 64 * seam;
    __syncthreads();
    if (tid == 0) (void)xb_add(done, 1u);
    for (;;) {
        if (tid == 0) { unsigned base = 0xffffffffu; const unsigned head = xb_ld(bgq);
            if (head < (unsigned)CV_PER_L && (head < (unsigned)force_upto || xb_ld(done) < (unsigned)G)) base = xb_add(bgq, 8u);
            MISC[1] = base; }
        __syncthreads();
        const unsigned base = MISC[1];
        __syncthreads();
        if (base >= (unsigned)CV_PER_L) break;
        const int item = (int)base + wave; if (item < CV_PER_L) conv_item(A, CV_PER_L + item, scr, lane);
    }
}
__device__ __forceinline__ void p0_prologue(const Args& A, LAS unsigned char* lds, int wave, int lane, int gw, int NGW, int n_items) {
    unsigned char* ws = A.ws;
    LAS float* scr = (LAS float*)(lds + wave * 16640);
    for (int it = gw; it < n_items; it += NGW) conv_item(A, it, scr, lane);
    float* r128 = (float*)(ws + WS_ROPE128); float* r64 = (float*)(ws + WS_ROPE64);
    for (int i = gw * 64 + lane; i < 4096 * 64; i += NGW * 64) { const int t = i >> 6, j = i & 63, q = j & 31, pos = j < 32 ? (t >> 6) : (t & 63);
        const float ang = (float)pos * powf(10000.f, -(float)(2 * q) / 64.f); r128[2 * i] = cosf(ang); r128[2 * i + 1] = sinf(ang); }
    for (int i = gw * 64 + lane; i < 4096 * 32; i += NGW * 64) { const int t = i >> 5, j = i & 31, q = j & 15, pos = j < 16 ? (t >> 6) : (t & 63);
        const float ang = (float)pos * powf(10000.f, -(float)(2 * q) / 32.f); r64[2 * i] = cosf(ang); r64[2 * i + 1] = sinf(ang); }
}
__device__ __forceinline__ void p0_convert_dyn2(const Args& A, LAS unsigned char* lds, unsigned* q, volatile LAS unsigned* MISC, int tid, int wave, int lane, int n_items, int item0) {
    LAS float* scr = (LAS float*)(lds + wave * 16640);
    unsigned nxt = 0u; if (tid == 0) nxt = xb_add(q, 16u);
    for (;;) {
        if (tid == 0) MISC[2] = nxt;
        __syncthreads();
        const unsigned base = MISC[2];
        if (base >= (unsigned)n_items) break;
        if (tid == 0) nxt = xb_add(q, 16u);
        const int ia = (int)base + wave, ib = ia + 8; f32x4 va[16], vb[16];
        if (ia < n_items) conv_item_m<1>(va, A, item0 + ia, scr, lane);
        if (ib < n_items) conv_item_m<1>(vb, A, item0 + ib, scr, lane);
        if (ia < n_items) conv_item_m<2>(va, A, item0 + ia, scr, lane);
        if (ib < n_items) conv_item_m<2>(vb, A, item0 + ib, scr, lane);
        __syncthreads();
    }
    __syncthreads();
}
__device__ __forceinline__ void p0_convert_dyn(const Args& A, LAS unsigned char* lds, unsigned* q, volatile LAS unsigned* MISC, int tid, int wave, int lane, int n_items, int item0 = 0) {
    LAS float* scr = (LAS float*)(lds + wave * 16640);
    unsigned nxt = 0u; if (tid == 0) nxt = xb_add(q, 8u);
    for (;;) {
        if (tid == 0) MISC[2] = nxt;
        __syncthreads();
        const unsigned base = MISC[2];
        if (base >= (unsigned)n_items) break;
        if (tid == 0) nxt = xb_add(q, 8u);
        const int item = (int)base + wave; if (item < n_items) conv_item(A, item0 + item, scr, lane);
        __syncthreads();
    }
    __syncthreads();
}
__device__ __forceinline__ void p0_modv(const Args& A, LAS unsigned char* lds, int tid, int lane, int wave, int wg, int G, int job0 = 0, int job1 = 2 * 96) {
    LAS float* sv = (LAS float*)lds;
    LAS float* part = (LAS float*)(lds + 24576);
    for (int i = tid; i < 3 * DM; i += NTHR) { const int r = i / DM, k = i % DM; const float v = r < 2 ? A.in[1][r * DM + k] : A.in[3][k]; sv[i] = v / (1.f + expf(-v)); }
    __syncthreads();
    float* modv = (float*)(A.ws + WS_MODV);
    for (int job = job0 + wg; job < job1; job += G) {
        const int l = job / 96, cg = job % 96, j = cg * 128 + lane * 2;
        const float* w = A.in[4] + (size_t)l * DM * MODW + (size_t)(wave * 256) * MODW + j;
        f32x2 a0 = {0.f, 0.f}, a1 = a0, a2 = a0;
#pragma unroll 16
        for (int k = 0; k < 256; ++k) { const f32x2 wv = __builtin_nontemporal_load((const f32x2*)(w + (size_t)k * MODW)); const int kk = wave * 256 + k; a0 = a0 + wv * sv[kk]; a1 = a1 + wv * sv[DM + kk]; a2 = a2 + wv * sv[2 * DM + kk]; }
        LAS float* pw = part + wave * 384 + lane * 2;
        pw[0] = a0[0]; pw[1] = a0[1]; pw[128] = a1[0]; pw[129] = a1[1]; pw[256] = a2[0]; pw[257] = a2[1];
        __syncthreads();
        if (wave < 3) { float s0 = 0.f, s1 = 0.f;
#pragma unroll
            for (int q = 0; q < 8; ++q) { s0 += part[q * 384 + wave * 128 + lane * 2]; s1 += part[q * 384 + wave * 128 + lane * 2 + 1]; }
            const f32x2 bb = *(const f32x2*)(A.in[5] + l * MODW + j);
            *(f32x2*)(modv + (size_t)(l * 3 + wave) * MODW + j) = (f32x2){s0 + bb[0], s1 + bb[1]}; }
        __syncthreads();
    }
}

__device__ __forceinline__ float treduce16(const float (&v)[16], int lane) {
    const bool b3 = (lane & 8) != 0, b2 = (lane & 4) != 0;
    float a[8], b[4], c[2];
#pragma unroll
    for (int i = 0; i < 8; ++i) { const auto rr = __builtin_amdgcn_permlane32_swap(__float_as_uint(v[i]), __float_as_uint(v[i + 8]), false, false); a[i] = __uint_as_float(rr[0]) + __uint_as_float(rr[1]); }
#pragma unroll
    for (int i = 0; i < 4; ++i) { const auto rr = __builtin_amdgcn_permlane16_swap(__float_as_uint(a[i]), __float_as_uint(a[i + 4]), false, false); b[i] = __uint_as_float(rr[0]) + __uint_as_float(rr[1]); }
#pragma unroll
    for (int i = 0; i < 2; ++i) { const float keep = b3 ? b[i + 2] : b[i], send = b3 ? b[i] : b[i + 2]; c[i] = keep + dppm<0x128>(send); }
    const float keep = b2 ? c[1] : c[0], send = b2 ? c[0] : c[1]; float d = keep + dppm<0x141>(send);
    d += dppm<0x4E>(d); d += dppm<0xB1>(d); return d;
}
template <int MODE  >
__device__ __forceinline__ void row_phase_a(const Args& A, int l, int lane, int gw, int NGW) {
    unsigned char* ws = A.ws; float* X = (float*)(ws + WS_X); bf16_t* H = (bf16_t*)(ws + WS_H); const bf16_t* Y = (const bf16_t*)(ws + WS_Y); const int* SEL = (const int*)(ws + WS_SEL);
    const float* modv = (const float*)(ws + WS_MODV);
    const int nrows = MODE == 2 ? NLAT : MROWS;
    if ((ROUTER_V3 || FUSE_ROUTER) && MODE != 2 && gw < 3) {
        const float* sh2 = modv + (size_t)(l * 3 + gw) * MODW + 3 * DM; const float* wr = A.in[25] + (size_t)l * DM * 16; float pb[16];
#pragma unroll
        for (int e = 0; e < 16; ++e) pb[e] = 0.f;
        for (int i = 0; i < 32; ++i) { const int k = lane + 64 * i; const float s = sh2[k];
#pragma unroll
            for (int q = 0; q < 4; ++q) { const f32x4 w4 = *(const f32x4*)(wr + (size_t)k * 16 + 4 * q); pb[4 * q] += s * w4[0]; pb[4 * q + 1] += s * w4[1]; pb[4 * q + 2] += s * w4[2]; pb[4 * q + 3] += s * w4[3]; } }
        const float bt = treduce16(pb, lane);
        if ((lane & 3) == 0) ((float*)(ws + WS_BIASR))[(l * 3 + gw) * 16 + (lane >> 2)] = bt;
    }
#ifndef CONV_IN_EXP
#define CONV_IN_EXP 0
#endif
#ifndef CONV_EXP_PART1
#define CONV_EXP_PART1 4352
#endif
#ifndef MODV1_IN_ATT
#define MODV1_IN_ATT 0
#endif
#ifndef P0_DYN
#define P0_DYN 1
#endif
#ifndef CONV_IN_ATT
#define CONV_IN_ATT 2
#endif
#ifndef NORM_EVEN
#define NORM_EVEN 1
#endif
    const bool evn = NORM_EVEN && NGW == 2048 && nrows == 256 * 34;
    const int r_lo = evn ? (gw >> 3) * 34 + (gw & 7) : gw, r_hi = evn ? (gw >> 3) * 34 + 34 : nrows, r_st = evn ? 8 : NGW;
    for (int row = r_lo; row < r_hi; row += r_st) {
        f32x4 v[8];
        if (MODE == 0) { const float* src = row < NLAT ? A.in[0] + (size_t)row * DM : A.in[2] + (size_t)(row - NLAT) * DM;
#pragma unroll
            for (int i = 0; i < 8; ++i) v[i] = *(const f32x4*)(src + (lane + 64 * i) * 4); }
        else {
            const float* xr = X + (size_t)row * DM;
#pragma unroll
            for (int i = 0; i < 8; ++i) v[i] = *(const f32x4*)(xr + (lane + 64 * i) * 4);
            const float* g2 = modv + (size_t)((l - 1) * 3 + modrow(row)) * MODW + 5 * DM;
            f32x4 acc[8];
#pragma unroll
            for (int i = 0; i < 8; ++i) acc[i] = (f32x4){0.f, 0.f, 0.f, 0.f};
            const int mysel = lane < 16 ? SEL[(size_t)row * 16 + lane] : -1;
            for (int e = 0; e < 16; ++e) { const int slot = __builtin_amdgcn_readlane(mysel, e); if (slot < 0) continue;
                const bf16_t* yr = Y + ((size_t)e * EROWS + slot) * DM;
#pragma unroll
                for (int i = 0; i < 8; ++i) { const u32x2 w = *(const u32x2*)(yr + (lane + 64 * i) * 4); acc[i][0] += bf_lo(w.x); acc[i][1] += bf_hi(w.x); acc[i][2] += bf_lo(w.y); acc[i][3] += bf_hi(w.y); } }
#pragma unroll
            for (int i = 0; i < 8; ++i) { const f32x4 g = *(const f32x4*)(g2 + (lane + 64 * i) * 4); v[i] = v[i] + g * acc[i]; }
            float* dst = MODE == 2 ? A.out + (size_t)row * DM : X + (size_t)row * DM;
#pragma unroll
            for (int i = 0; i < 8; ++i) *(f32x4*)(dst + (lane + 64 * i) * 4) = v[i];
        }
        if (MODE == 2) continue;
        float ss = 0.f;
#pragma unroll
        for (int i = 0; i < 8; ++i) ss += (v[i][0] * v[i][0] + v[i][1] * v[i][1]) + (v[i][2] * v[i][2] + v[i][3] * v[i][3]);
        const float rstd = rsqrtf(wave_sum(ss, lane) * (1.f / DM) + EPS);
        const float* mv = modv + (size_t)(l * 3 + modrow(row)) * MODW; const float* gain = A.in[6] + l * DM;
#pragma unroll
        for (int i = 0; i < 8; ++i) { const int c = (lane + 64 * i) * 4; const f32x4 g = *(const f32x4*)(gain + c), sh = *(const f32x4*)(mv + c), sc = *(const f32x4*)(mv + DM + c);
            const f32x4 h = v[i] * rstd * g * (sc + 1.f) + sh; u32x2 w; w.x = cvt_pk_bf16(h[0], h[1]); w.y = cvt_pk_bf16(h[2], h[3]); *(u32x2*)(H + (size_t)row * DM + c) = w;
            if (FP8_GATES) *(unsigned*)((unsigned char*)(ws + WS_H8) + (size_t)row * DM + c) = pk4_fp8(h[0], h[1], h[2], h[3]); }
    }
}
#ifndef ROUTER_PK
#define ROUTER_PK 1
#endif
#ifndef ROUTER_PROBE
#define ROUTER_PROBE 0
#endif
__device__ __forceinline__ void row_phase_g(const Args& A, LAS unsigned char* lds, int l, int tid, int lane, int wave, int wg, int G, bool prb = false) {
    unsigned char* ws = A.ws; const float* X = (const float*)(ws + WS_X); bf16_t* H = (bf16_t*)(ws + WS_H); float* AFFT = (float*)(ws + WS_AFFT);
    const float* modv = (const float*)(ws + WS_MODV); const float* wr = A.in[25] + (size_t)l * DM * 16; const float* gain = A.in[7] + l * DM;
    LAS float* part = (LAS float*)lds;
    LAS float* biasp = part + 2 * 640;
    const int k0 = wave * 256 + lane * 4;
    const int ecode = ((lane >> 5) & 1) * 8 + ((lane >> 4) & 1) * 4 + ((lane >> 3) & 1) * 2 + ((lane >> 2) & 1);
    float Wl[4][16], gsc[4], sh[4]; float bias_e = 0.f; int cur_mr = -1;
    const int ngr = MROWS / 4, gq = ngr / G, grm = ngr % G, g0 = wg < grm ? wg * (gq + 1) : grm * (gq + 1) + (wg - grm) * gq; (void)g0;
    const bool even = (G == 256) && (MROWS == 256 * 34);
    const int rbase = even ? wg * 34 : 4 * g0, nri = (ROUTER_PROBE == 6 && prb) ? 0 : (ROUTER_PROBE >= 4 && prb) ? 4 : (even ? 34 : 4 * (wg < grm ? gq + 1 : gq));
#define RG_ROW(i) (rbase + (i))
    f32x4 xq[4], xnq[4];
#pragma unroll
    for (int j = 0; j < 4; ++j) { xnq[j] = (f32x4){0.f, 0.f, 0.f, 0.f}; if (j < nri) xnq[j] = *(const f32x4*)(X + (size_t)RG_ROW(j) * DM + k0); }
    __syncthreads();
    for (int i0 = 0; i0 < nri; i0 += 4) {
#pragma unroll
        for (int j = 0; j < 4; ++j) { xq[j] = xnq[j]; if (i0 + 4 + j < nri && !(ROUTER_PROBE == 3 && prb)) xnq[j] = *(const f32x4*)(X + (size_t)RG_ROW(i0 + 4 + j) * DM + k0); }
        const int mr = modrow(RG_ROW(i0));
        if (mr != cur_mr) {
            cur_mr = mr; const float* mv = modv + (size_t)(l * 3 + mr) * MODW;
            const f32x4 g4 = *(const f32x4*)(gain + k0), sh4 = *(const f32x4*)(mv + 3 * DM + k0), sc4 = *(const f32x4*)(mv + 4 * DM + k0);
            float pb[16];
#pragma unroll
            for (int e = 0; e < 16; ++e) pb[e] = 0.f;
#pragma unroll
            for (int jj = 0; jj < 4; ++jj) { gsc[jj] = g4[jj] * (1.f + sc4[jj]); sh[jj] = sh4[jj];
#pragma unroll
                for (int q = 0; q < 4; ++q) { f32x4 w4; if (ROUTER_PROBE == 5 && prb) w4 = (f32x4){0.01f * jj, 0.02f, 0.03f * q, 0.04f}; else w4 = *(const f32x4*)(wr + (size_t)(k0 + jj) * 16 + 4 * q);
#pragma unroll
                    for (int t = 0; t < 4; ++t) { Wl[jj][4 * q + t] = gsc[jj] * w4[t]; pb[4 * q + t] += sh[jj] * w4[t]; } } }
            const float bt = treduce16(pb, lane);
            __syncthreads();
            if ((lane & 3) == 0) biasp[wave * 16 + ecode] = bt;
            __syncthreads();
            bias_e = 0.f;
            if (lane < 16) {
#pragma unroll
                for (int w = 0; w < 8; ++w) bias_e += biasp[w * 16 + lane]; }
        }
        LAS float* pp = part + ((i0 >> 2) & 1) * 640;
#pragma unroll
        for (int j = 0; j < 4; ++j) {
            const f32x4 x = xq[j]; float pl[16];
#if ROUTER_PK
            {
                const f32x2 x0 = {x[0], x[0]}, x1 = {x[1], x[1]}, x2 = {x[2], x[2]}, x3 = {x[3], x[3]};
#pragma unroll
                for (int e2 = 0; e2 < 8; ++e2) { const f32x2 w0 = {Wl[0][2 * e2], Wl[0][2 * e2 + 1]}, w1 = {Wl[1][2 * e2], Wl[1][2 * e2 + 1]}, w2 = {Wl[2][2 * e2], Wl[2][2 * e2 + 1]}, w3 = {Wl[3][2 * e2], Wl[3][2 * e2 + 1]};
                    f32x2 a = x0 * w0; a = __builtin_elementwise_fma(x1, w1, a); a = __builtin_elementwise_fma(x2, w2, a); a = __builtin_elementwise_fma(x3, w3, a); pl[2 * e2] = a[0]; pl[2 * e2 + 1] = a[1]; } }
#else
#pragma unroll
            for (int e = 0; e < 16; ++e) pl[e] = x[0] * Wl[0][e] + x[1] * Wl[1][e] + x[2] * Wl[2][e] + x[3] * Wl[3][e];
#endif
            float pt; if (ROUTER_PROBE == 1 && prb) pt = pl[lane & 15]; else pt = treduce16(pl, lane);
            const float ssw = wave_sum((x[0] * x[0] + x[1] * x[1]) + (x[2] * x[2] + x[3] * x[3]), lane);
            if ((lane & 3) == 0) pp[(j * 8 + wave) * 20 + ecode] = pt;
            if (lane == 0) pp[(j * 8 + wave) * 20 + 16] = ssw;
        }
        __syncthreads();
#pragma unroll
        for (int j = 0; j < 4; ++j) {
            if (i0 + j >= nri) break;
            const int row = RG_ROW(i0 + j); const f32x4 x = xq[j];
            float sst = 0.f;
#pragma unroll
            for (int w = 0; w < 8; ++w) sst += pp[(j * 8 + w) * 20 + 16];
            const float rstd = rsqrtf(sst * (1.f / DM) + EPS);
            { u32x2 w2; w2.x = cvt_pk_bf16(x[0] * rstd * gsc[0] + sh[0], x[1] * rstd * gsc[1] + sh[1]); w2.y = cvt_pk_bf16(x[2] * rstd * gsc[2] + sh[2], x[3] * rstd * gsc[3] + sh[3]);
              if (!(ROUTER_PROBE == 2 && prb)) *(u32x2*)(H + (size_t)row * DM + k0) = w2; }
            if (wave == j) {
                float t = 0.f;
                if (lane < 16) {
#pragma unroll
                    for (int w = 0; w < 8; ++w) t += pp[(j * 8 + w) * 20 + lane]; }
                const float logit = lane < 16 ? rstd * t + bias_e : -3.0e38f;
                const float mx = row_max16(logit);
                const float ex = lane < 16 ? expf(logit - mx) : 0.f; const float s = row_sum16(ex);
                if (lane < 16) AFFT[(size_t)lane * MROWS + row] = ex / s;
            }
        }
    }
    __syncthreads();
}
#undef RG_ROW
__device__ __forceinline__ void row_phase_g3(const Args& A, LAS unsigned char* lds, int l, int tid, int lane, int wave, int wg, int G) {
    unsigned char* ws = A.ws; const float* X = (const float*)(ws + WS_X); bf16_t* H = (bf16_t*)(ws + WS_H); float* AFFT = (float*)(ws + WS_AFFT);
    const float* modv = (const float*)(ws + WS_MODV); const float* wr = A.in[25] + (size_t)l * DM * 16; const float* gain = A.in[7] + l * DM; const float* biasr = (const float*)(ws + WS_BIASR) + l * 48;
    LAS f32x4* Wl = (LAS f32x4*)lds;
    const int ngr = MROWS / 4, gq = ngr / G, grm = ngr % G, g0 = wg < grm ? wg * (gq + 1) : grm * (gq + 1) + (wg - grm) * gq, nrows = 4 * (wg < grm ? gq + 1 : gq), row0 = 4 * g0;
    const int ecode = lane >> 2;
    int cur_mr = -1; f32x4 gsc[8], sh[8]; float bias_e = 0.f;
    f32x4 xn[8];
    { const int r = row0 + wave; if (wave < nrows) {
#pragma unroll
        for (int i = 0; i < 8; ++i) xn[i] = *(const f32x4*)(X + (size_t)r * DM + (lane + 64 * i) * 4); } }
    for (int rb = 0; rb < nrows; rb += 8) {
        const int mr_lo = modrow(row0 + rb), mr_hi = modrow(row0 + (rb + 7 < nrows ? rb + 7 : nrows - 1));
        for (int pass = 0; pass < (mr_lo == mr_hi ? 1 : 2); ++pass) {
            const int mr = pass == 0 ? mr_lo : mr_hi;
            if (mr != cur_mr) {
                cur_mr = mr; const float* mv = modv + (size_t)(l * 3 + mr) * MODW;
                __syncthreads();
                for (int t = tid; t < 8192; t += NTHR) { const int ln = t & 63, q = (t >> 6) & 3, j = (t >> 8) & 3, i = t >> 10, k = 4 * (ln + 64 * i) + j;
                    const float g = gain[k] * (1.f + mv[4 * DM + k]); const f32x4 w4 = *(const f32x4*)(wr + (size_t)k * 16 + 4 * q); Wl[t] = w4 * g; }
#pragma unroll
                for (int i = 0; i < 8; ++i) { const int c = (lane + 64 * i) * 4; const f32x4 g4 = *(const f32x4*)(gain + c), sc4 = *(const f32x4*)(mv + 4 * DM + c); gsc[i] = g4 * (sc4 + 1.f); sh[i] = *(const f32x4*)(mv + 3 * DM + c); }
                bias_e = biasr[mr * 16 + ecode];
                __syncthreads();
            }
            const int ri = rb + wave; const bool mine = ri < nrows && modrow(row0 + ri) == mr && (pass == 0 || mr_lo != mr_hi);
            if (mine && !(pass == 1 && modrow(row0 + ri) == mr_lo)) {
                const int row = row0 + ri; f32x4 x[8];
#pragma unroll
                for (int i = 0; i < 8; ++i) x[i] = xn[i];
                if (ri + 8 < nrows) {
#pragma unroll
                    for (int i = 0; i < 8; ++i) xn[i] = *(const f32x4*)(X + (size_t)(row + 8) * DM + (lane + 64 * i) * 4); }
                float pl[16]; float ss = 0.f;
#pragma unroll
                for (int e = 0; e < 16; ++e) pl[e] = 0.f;
#pragma unroll
                for (int i = 0; i < 8; ++i) { ss += (x[i][0] * x[i][0] + x[i][1] * x[i][1]) + (x[i][2] * x[i][2] + x[i][3] * x[i][3]);
#pragma unroll
                    for (int j = 0; j < 4; ++j)
#pragma unroll
                        for (int q = 0; q < 4; ++q) { const f32x4 w4 = Wl[((i * 4 + j) * 4 + q) * 64 + lane]; const float xv = x[i][j];
                            pl[4 * q] += xv * w4[0]; pl[4 * q + 1] += xv * w4[1]; pl[4 * q + 2] += xv * w4[2]; pl[4 * q + 3] += xv * w4[3]; } }
                const float pt = treduce16(pl, lane);
                const float rstd = rsqrtf(wave_sum(ss, lane) * (1.f / DM) + EPS);
#pragma unroll
                for (int i = 0; i < 8; ++i) { const f32x4 h = x[i] * rstd * gsc[i] + sh[i]; u32x2 w2; w2.x = cvt_pk_bf16(h[0], h[1]); w2.y = cvt_pk_bf16(h[2], h[3]); *(u32x2*)(H + (size_t)row * DM + (lane + 64 * i) * 4) = w2; }
                const float logit = rstd * pt + bias_e;
                float mx = logit;
#pragma unroll
                for (int o = 4; o < 64; o <<= 1) mx = fmaxf(mx, shx(mx, lane, o));
                const float ex = expf(logit - mx); float s = ex;
#pragma unroll
                for (int o = 4; o < 64; o <<= 1) s += shx(s, lane, o);
                if ((lane & 3) == 0) AFFT[(size_t)ecode * MROWS + row] = ex / s;
            }
        }
    }
    __syncthreads();
}
__device__ __forceinline__ void row_phase_c(const Args& A, int l, int lane, int gw, int NGW) {
    unsigned char* ws = A.ws; bf16_t* P = (bf16_t*)(ws + WS_P); const float* r128 = (const float*)(ws + WS_ROPE128); const float* r64 = (const float*)(ws + WS_ROPE64);
    constexpr float QS128 = 0.08838834764831845f * LOG2E, QS64 = 0.125f * LOG2E;
    for (int job = gw; job < MROWS * 12; job += NGW) {
        const int row = job / 12, j = job % 12; const bool lat = row < NLAT; const int t = row & (SEQ - 1);
        bf16_t* p = P + (size_t)row * INW;
        if (j < 8) {
            const int hsel = lane >> 5, i = lane & 31; int col; const float* gain; float qs = 1.f;
            if (j == 0) { col = hsel * 128; gain = A.in[10] + l * 128; }
            else if (j == 1) { col = 1536 + hsel * 128; gain = A.in[19] + l * 128; }
            else if (j < 5) { col = 2048 + ((j - 2) * 2 + hsel) * 128; gain = A.in[9] + l * 128; qs = QS128; }
            else { col = 3328 + ((j - 5) * 2 + hsel) * 128; gain = A.in[18] + l * 128; qs = QS128; }
            float x0 = bf2f(p[col + i]), x1 = bf2f(p[col + i + 32]), x2 = bf2f(p[col + i + 64]), x3 = bf2f(p[col + i + 96]);
            float ss = x0 * x0 + x1 * x1 + x2 * x2 + x3 * x3;
#pragma unroll
            for (int o = 1; o < 32; o <<= 1) ss += shx(ss, lane, o);
            const float rstd = rsqrtf(ss * (1.f / 128.f) + EPS) * qs;
            x0 *= rstd * gain[i]; x1 *= rstd * gain[i + 32]; x2 *= rstd * gain[i + 64]; x3 *= rstd * gain[i + 96];
            if (lat) { const float* rp = r128 + (size_t)t * 128; const float cr = rp[2 * i], sr = rp[2 * i + 1], cc = rp[2 * (32 + i)], sc = rp[2 * (32 + i) + 1];
                const float y0 = x0 * cr - x1 * sr, y1 = x1 * cr + x0 * sr, y2 = x2 * cc - x3 * sc, y3 = x3 * cc + x2 * sc; x0 = y0; x1 = y1; x2 = y2; x3 = y3; }
            p[col + i] = (bf16_t)(cvt_pk_bf16(x0, 0.f) & 0xffffu); p[col + i + 32] = (bf16_t)(cvt_pk_bf16(x1, 0.f) & 0xffffu);
            p[col + i + 64] = (bf16_t)(cvt_pk_bf16(x2, 0.f) & 0xffffu); p[col + i + 96] = (bf16_t)(cvt_pk_bf16(x3, 0.f) & 0xffffu);
        } else {
            const int hsel = lane >> 4, i = lane & 15; int col; const float* gain; float qs = 1.f;
            if (j < 10) { col = 512 + ((j - 8) * 4 + hsel) * 64; gain = A.in[12] + l * 64; }
            else { col = 2816 + ((j - 10) * 4 + hsel) * 64; gain = A.in[11] + l * 64; qs = QS64; }
            float x0 = bf2f(p[col + i]), x1 = bf2f(p[col + i + 16]), x2 = bf2f(p[col + i + 32]), x3 = bf2f(p[col + i + 48]);
            float ss = x0 * x0 + x1 * x1 + x2 * x2 + x3 * x3;
#pragma unroll
            for (int o = 1; o < 16; o <<= 1) ss += shx(ss, lane, o);
            const float rstd = rsqrtf(ss * (1.f / 64.f) + EPS) * qs;
            x0 *= rstd * gain[i]; x1 *= rstd * gain[i + 16]; x2 *= rstd * gain[i + 32]; x3 *= rstd * gain[i + 48];
            if (lat) { const float* rp = r64 + (size_t)t * 64; const float cr = rp[2 * i], sr = rp[2 * i + 1], cc = rp[2 * (16 + i)], sc = rp[2 * (16 + i) + 1];
                const float y0 = x0 * cr - x1 * sr, y1 = x1 * cr + x0 * sr, y2 = x2 * cc - x3 * sc, y3 = x3 * cc + x2 * sc; x0 = y0; x1 = y1; x2 = y2; x3 = y3; }
            p[col + i] = (bf16_t)(cvt_pk_bf16(x0, 0.f) & 0xffffu); p[col + i + 16] = (bf16_t)(cvt_pk_bf16(x1, 0.f) & 0xffffu);
            p[col + i + 32] = (bf16_t)(cvt_pk_bf16(x2, 0.f) & 0xffffu); p[col + i + 48] = (bf16_t)(cvt_pk_bf16(x3, 0.f) & 0xffffu);
        }
    }
}
#ifndef RANK_GQ
#define RANK_GQ 4
#endif
__device__ __forceinline__ void rank_pair(const Args& A, LAS unsigned char* lds, int set, int e, int tok0, int ntok_here, int n, int cap, int tid, int wave, int lane) {
    unsigned char* ws = A.ws; const unsigned* AFFT = (const unsigned*)(ws + WS_AFFT); int* SEL = (int*)(ws + WS_SEL); float* GW = (float*)(ws + WS_GW);
    const bf16_t* H = (const bf16_t*)(ws + WS_H); bf16_t* XG = (bf16_t*)(ws + WS_XG);
    LAS unsigned* col = (LAS unsigned*)lds; LAS unsigned* list = (LAS unsigned*)(lds + 16384); LAS unsigned* wd = (LAS unsigned*)(lds + 20480);
    const int base = set < 2 ? set * SEQ : NLAT + (set - 2) * CTXL;
    __syncthreads();
    unsigned mv[8];
#pragma unroll
    for (int j = 0; j < 8; ++j) { const int i = tid + j * NTHR; const unsigned v = i < n ? AFFT[(size_t)e * MROWS + base + i] : 0u; mv[j] = v; if (i < n) col[i] = v; }
    if (tid == 0) wd[40] = 0u;
    unsigned T = 0u;
    for (int bit = 30; bit >= 0; --bit) {
        const unsigned cand = T | (1u << bit); unsigned c = 0u;
#pragma unroll
        for (int j = 0; j < 8; ++j) c += (unsigned)__popcll(__ballot(mv[j] >= cand));
        LAS unsigned* cw = wd + (bit & 1) * 8;
        if (lane == 0) cw[wave] = c;
        __syncthreads();
        unsigned tot = 0u;
#pragma unroll
        for (int w = 0; w < 8; ++w) tot += cw[w];
        if (tot >= (unsigned)cap) T = cand;
    }
    unsigned cg = 0u, pg = 0u, pe = 0u;
#pragma unroll
    for (int j = 0; j < 8; ++j) { const int i = tid + j * NTHR; cg += (unsigned)__popcll(__ballot(mv[j] > T)); pg += (unsigned)__popcll(__ballot(i < tok0 && mv[j] > T)); pe += (unsigned)__popcll(__ballot(i < tok0 && mv[j] == T)); }
    const int t = tok0 + tid; const bool have = tid < ntok_here; const unsigned mine = have ? col[t] : 0u;
    const bool isg = have && mine > T, isq = have && mine == T;
    const unsigned long long bg = __ballot(isg), bq = __ballot(isq); const unsigned long long lt = (1ull << lane) - 1ull;
    if (lane == 0) { wd[16 + wave] = cg; wd[24 + wave] = pg; wd[32 + wave] = pe; wd[48 + wave] = (unsigned)__popcll(bg); wd[56 + wave] = (unsigned)__popcll(bq); }
    __syncthreads();
    unsigned count_gt = 0u, base_gt = 0u, base_eq = 0u;
#pragma unroll
    for (int w = 0; w < 8; ++w) { count_gt += wd[16 + w]; base_gt += wd[24 + w]; base_eq += wd[32 + w]; if (w < wave) { base_gt += wd[48 + w]; base_eq += wd[56 + w]; } }
    const unsigned need_eq = (unsigned)cap - count_gt;
    const unsigned gt_before = base_gt + (unsigned)__popcll(bg & lt), eq_before = base_eq + (unsigned)__popcll(bq & lt);
    const bool chosen = isg || (isq && eq_before < need_eq);
    if (have) {
        int pos = -1;
        if (chosen) { const unsigned slot = gt_before + (eq_before < need_eq ? eq_before : need_eq); pos = set < 2 ? set * 512 + (int)slot : 1024 + (set - 2) * 32 + (int)slot; GW[e * EPAD + pos] = __uint_as_float(mine);
            const unsigned k = atomicAdd((unsigned*)(wd + 40), 1u); list[2 * k] = (unsigned)(base + t); list[2 * k + 1] = (unsigned)pos; }
        SEL[(size_t)(base + t) * 16 + e] = pos;
    }
    __syncthreads();
    const int nsel = (int)wd[40];
    constexpr int GQ = RANK_GQ;
    for (int k0 = wave; k0 < nsel; k0 += GQ * NWAVES) {
        u32x4 v[GQ][4]; unsigned pos[GQ]; bool ok[GQ];
#pragma unroll
        for (int q = 0; q < GQ; ++q) { const int k = k0 + q * NWAVES; ok[q] = k < nsel; const unsigned row = ok[q] ? list[2 * k] : 0u; pos[q] = ok[q] ? list[2 * k + 1] : 0u;
            const u32x4* src = (const u32x4*)(H + (size_t)row * DM);
            if (ok[q]) {
#pragma unroll
                for (int i = 0; i < 4; ++i) v[q][i] = FP8_EXPERTS ? src[lane * 4 + i] : src[lane + 64 * i]; } }
#pragma unroll
        for (int q = 0; q < GQ; ++q) { if (!ok[q]) continue;
            if (FP8_EXPERTS) { u32x4 o0, o1;
                o0.x = pk4_fp8(bf_lo(v[q][0].x), bf_hi(v[q][0].x), bf_lo(v[q][0].y), bf_hi(v[q][0].y)); o0.y = pk4_fp8(bf_lo(v[q][0].z), bf_hi(v[q][0].z), bf_lo(v[q][0].w), bf_hi(v[q][0].w));
                o0.z = pk4_fp8(bf_lo(v[q][1].x), bf_hi(v[q][1].x), bf_lo(v[q][1].y), bf_hi(v[q][1].y)); o0.w = pk4_fp8(bf_lo(v[q][1].z), bf_hi(v[q][1].z), bf_lo(v[q][1].w), bf_hi(v[q][1].w));
                o1.x = pk4_fp8(bf_lo(v[q][2].x), bf_hi(v[q][2].x), bf_lo(v[q][2].y), bf_hi(v[q][2].y)); o1.y = pk4_fp8(bf_lo(v[q][2].z), bf_hi(v[q][2].z), bf_lo(v[q][2].w), bf_hi(v[q][2].w));
                o1.z = pk4_fp8(bf_lo(v[q][3].x), bf_hi(v[q][3].x), bf_lo(v[q][3].y), bf_hi(v[q][3].y)); o1.w = pk4_fp8(bf_lo(v[q][3].z), bf_hi(v[q][3].z), bf_lo(v[q][3].w), bf_hi(v[q][3].w));
                u32x4* dst = (u32x4*)((unsigned char*)XG + ((size_t)e * EPAD + pos[q]) * DM); dst[lane * 2] = o0; dst[lane * 2 + 1] = o1; }
            else { u32x4* dst = (u32x4*)(XG + ((size_t)e * EPAD + pos[q]) * DM);
#pragma unroll
                for (int i = 0; i < 4; ++i) dst[lane + 64 * i] = v[q][i]; } }
    }
}
__device__ __forceinline__ void phase_rank(const Args& A, LAS unsigned char* lds, int l, int wg, int G, int tid, int wave, int lane) {
#ifndef RANK_XCD
#define RANK_XCD 0
#endif
#ifndef E_XCD
#define E_XCD 1
#endif
    if (RANK_XCD && E_XCD && G == 256) {
        const int x = wg & 7, k = wg >> 3; rank_pair(A, lds, k >> 4, 2 * x + ((k >> 3) & 1), (k & 7) * 512, 512, SEQ, 512, tid, wave, lane); }
    else
    for (int w = wg; w < 256; w += G) { const int pair = w >> 3, chunk = w & 7; rank_pair(A, lds, pair >> 4, pair & 15, chunk * 512, 512, SEQ, 512, tid, wave, lane); }
#ifndef RANK_CTX_SPLIT
#define RANK_CTX_SPLIT 0
#endif
    if (l == 0) {
        if (RANK_CTX_SPLIT) for (int w = wg; w < 256; w += G) rank_pair(A, lds, 2 + (w >> 7), (w >> 3) & 15, (w & 7) * 32, 32, CTXL, 32, tid, wave, lane);
        else for (int w = wg; w < 32; w += G) rank_pair(A, lds, 2 + (w >> 4), w & 15, 0, 256, CTXL, 32, tid, wave, lane); }
    __syncthreads();
}

#ifndef E_XCD
#define E_XCD 1
#endif
#ifndef IN_BLOCK
#define IN_BLOCK 0
#endif
#ifndef IN_XCD
#define IN_XCD 1
#endif
struct SchedIn { const char* A; const char* B; int G, c, l;
    __device__ __forceinline__ bool next(int i, pg8::GUnit& u) const { long L = (long)i * G + c; int pm, pn;
        if (!FP8_GATES) {
            if (l == 0) { if (!pg8::grid_order(L, 34, 40, pm, pn)) return false; }
            else { if (L < 1280) { pg8::grid_order(L, 32, 40, pm, pn); } else if (L < 1296) { const int r = (int)L - 1280; pm = 32 + (r >> 3); pn = r & 7; } else return false; }
        } else if (!FP8_AC) {
            if (l == 0) { if (!pg8::grid_order(L, 34, 16, pm, pn)) return false; }
            else { if (L < 512) { pg8::grid_order(L, 32, 16, pm, pn); } else if (L < 528) { const int r = (int)L - 512; pm = 32 + (r >> 3); pn = r & 7; } else return false; }
        } else {
            if (IN_BLOCK && G == 256 && (l == 1 || (CTX_CHAIN && CTX_GATES_IN_CHAIN))) {
                if (i > 0) return false; const int x = c & 7, k = c >> 3; int q6;
                if (k < 24) { pm = 4 * x + k / 6; q6 = k % 6; pn = q6 < 4 ? 2 + q6 : 7 + q6; }
                else { const int sidx = k - 24, nb = l == 0 ? (x < 4 ? 2 : 1) : 1; if (sidx >= nb) return false;
                    if (l == 0) { const int g = x < 4 ? 2 * x + sidx : 8 + (x - 4); pm = 32 + g / 6; q6 = g % 6; pn = q6 < 4 ? 2 + q6 : 7 + q6; }
                    else { pm = 32 + (x >> 2); pn = 2 + (x & 3); } }
                u.a = A + (size_t)pm * 256 * DM * 2; u.b = B + (size_t)pn * 256 * DM * 2; u.nt = DM / 64; u.pm = pm; u.pn = pn; u.aux = 0; return true; }
            if (IN_XCD && G == 256) L = (long)i * G + ((c & 7) * 32 + (c >> 3));
            const int nlat = (l == 0 ? 34 : 32) * 6;
            if (L < nlat) { const int q = (int)(L % 6); pm = (int)(L / 6); pn = q < 4 ? 2 + q : 7 + q; }
            else if (l == 1 && L < nlat + 8) { const int r = (int)L - nlat; pm = 32 + (r >> 2); pn = 2 + (r & 3); } else return false;
        }
        u.a = A + (size_t)pm * 256 * DM * 2; u.b = B + (size_t)pn * 256 * DM * 2; u.nt = DM / 64; u.pm = pm; u.pn = pn; u.aux = 0; return true; } };
struct SchedIn8 { const char* A; const char* B; int G, c, l;
    __device__ __forceinline__ bool next(int i, pg8::GUnit& u) const { long L; int pm, pn;
        if (!FP8_AC) { const int nM = l == 0 ? 34 : 32;
            if (G == 256) { const int lo = l == 0 ? 32 : 16, n2 = 256 - lo, hi0 = l == 0 ? 176 : 16, hi1 = l == 0 ? 256 : 32;
                if (i < 2) L = (long)i * 256 + c; else if (i == 2) { if (c < lo) return false; L = 512 + (c - lo); } else if (i == 3) { if (c < hi0 || c >= hi1) return false; L = 512 + n2 + (c - hi0); } else return false; }
            else L = (long)i * G + c;
            if (!pg8::grid_order(L, nM, 24, pm, pn)) return false; pn += 16;
        } else {
            constexpr bool CG = CTX_CHAIN && CTX_GATES_IN_CHAIN;
            if (IN_BLOCK && G == 256 && (l == 1 || CG)) {
                const int x = c & 7, k = c >> 3; int q;
                if (i < 4) { pm = 4 * x + (k >> 3); q = 8 * i + (k & 7); pn = q < 2 ? q : (q < 7 ? 4 + q : 6 + q); }
                else { const int sidx = k - 24, nb = l == 0 ? (x < 4 ? 2 : 1) : 1, nf = l == 0 ? (x < 4 ? 2 : 3) : 1;
                    if (sidx < nb || i > 5) return false; const int n = 2 * (sidx - nb) + (i - 4); if (n >= 8 + nf) return false;
                    if (n < 8) { pm = 4 * x + (n >> 1); pn = 38 + (n & 1); }
                    else { const int r = n - 8;
                        if (l == 0) { const int gf = x < 4 ? 2 * x + r : 8 + 3 * (x - 4) + r; pm = 32 + gf / 10; q = gf % 10; pn = q < 2 ? q : (q < 7 ? 4 + q : 6 + q); }
                        else { pm = 32 + (x >> 2); q = x & 3; pn = q < 2 ? q : 4 + q; } } }
                u.a = A + (size_t)pm * 256 * DM; u.b = B + (size_t)pn * 256 * DM; u.nt = DM / 128; u.pm = pm; u.pn = pn; u.aux = 0; return true; }
            const int ntot = l == 0 ? (CG ? 1108 : 1156) : 1096, nlat = l == 0 ? (CG ? 1088 : 1156) : 1088;
            if (G == 256) { int cnt, start; const int c = IN_XCD ? ((this->c & 7) * 32 + (this->c >> 3)) : this->c;
                if (l == 0 && CG) { if (c < 204) { cnt = 4; start = 4 * c; } else if (c < 236) { cnt = 6; start = 816 + 6 * (c - 204); } else { cnt = 5; start = 1008 + 5 * (c - 236); } }
                else if (l == 0) { if (c < 28) { cnt = 5; start = 5 * c; } else if (c < 204) { cnt = 4; start = 140 + 4 * (c - 28); } else { cnt = 6; start = 844 + 6 * (c - 204); } }
                else { if (c < 200) { cnt = 4; start = 4 * c; } else if (c < 240) { cnt = 5; start = 800 + 5 * (c - 200); } else { cnt = 6; start = 1000 + 6 * (c - 240); } }
                if (i >= cnt) return false; L = start + i; }
            else L = (long)i * G + c;
            if (L >= ntot) return false;
            if (L < nlat) { const int q = (int)(L % 34); pm = (int)(L / 34); pn = q < 2 ? q : (q < 7 ? 4 + q : 6 + q); }
            else if (l == 0) { const int r = (int)L - nlat; pm = 32 + r / 10; const int q = r % 10; pn = q < 2 ? q : (q < 7 ? 4 + q : 6 + q); }
            else { const int r = (int)L - nlat; pm = 32 + (r >> 2); const int q = r & 3; pn = q < 2 ? q : 4 + q; }
        }
        u.a = A + (size_t)pm * 256 * DM; u.b = B + (size_t)pn * 256 * DM; u.nt = DM / 128; u.pm = pm; u.pn = pn; u.aux = 0; return true; } };
struct EpiIn { static constexpr bool PERM = true, KEEPS = false, QSKIP = false; float gmul  ; bf16_t* P; LAS float* ssx; const float* r128; const float* r64; const float *kn_a, *kn_b, *kn_c, *qn_a, *qn_b, *qn_c;
    __device__ __forceinline__ void operator()(f32x4 (&acc)[2][2][4][2], const pg8::GUnit& u, int wr, int wc, int fr, int fq) const {
        const int row0 = u.pm * 256 + wr * 64 + fr, col0 = u.pn * 256 + wc * 32 + 8 * fq, pn = u.pn;
        int cls = 0; const float* gain = nullptr; float qs = 1.f;
        constexpr float QS128 = 0.08838834764831845f * LOG2E, QS64 = 0.125f * LOG2E;
        if (pn >= 16) cls = 1;
        else if (FUSE_QK) {
            if (pn == 0) { cls = 2; gain = kn_a; } else if (pn == 6) { cls = 2; gain = kn_c; } else if (pn >= 8 && pn <= 10) { cls = 2; gain = qn_a; qs = QS128; } else if (pn >= 13) { cls = 2; gain = qn_c; qs = QS128; }
            else if (pn == 2 || pn == 3) { cls = 3; gain = kn_b; } else if (pn == 11 || pn == 12) { cls = 3; gain = qn_b; qs = QS64; }
        }
        if (cls < 2) {
#pragma unroll
            for (int ai = 0; ai < 2; ++ai)
#pragma unroll
                for (int m = 0; m < 4; ++m) { bf16_t* rowp = P + (size_t)(row0 + ai * 128 + m * 16) * INW + col0;
#pragma unroll
                    for (int bj = 0; bj < 2; ++bj) { f32x4 v0 = acc[ai][bj][m][0] * gmul, v1 = acc[ai][bj][m][1] * gmul;
                        if (cls == 1) {
#pragma unroll
                            for (int j = 0; j < 4; ++j) { v0[j] = fast_sigmoid(v0[j]); v1[j] = fast_sigmoid(v1[j]); } }
                        u32x4 w; w.x = cvt_pk_bf16(v0[0], v0[1]); w.y = cvt_pk_bf16(v0[2], v0[3]); w.z = cvt_pk_bf16(v1[0], v1[1]); w.w = cvt_pk_bf16(v1[2], v1[3]);
                        *(u32x4*)(rowp + bj * 128) = w; } }
            return;
        }
        const int lane = fq * 16 + fr; const bool lat = u.pm < 32; const bool h128 = cls == 2;
        float ss[2][4][2];
#pragma unroll
        for (int ai = 0; ai < 2; ++ai)
#pragma unroll
            for (int m = 0; m < 4; ++m)
#pragma unroll
                for (int bj = 0; bj < 2; ++bj) { const f32x4 a = acc[ai][bj][m][0] * gmul, b = acc[ai][bj][m][1] * gmul;
                    float s = (a[0] * a[0] + a[1] * a[1]) + (a[2] * a[2] + a[3] * a[3]) + (b[0] * b[0] + b[1] * b[1]) + (b[2] * b[2] + b[3] * b[3]);
                    s = xsum32(xsum16(s)); ss[ai][m][bj] = s; }
        if (fq == 0) {
#pragma unroll
            for (int ai = 0; ai < 2; ++ai)
#pragma unroll
                for (int m = 0; m < 4; ++m)
#pragma unroll
                    for (int bj = 0; bj < 2; ++bj) ssx[(ai * 128 + wr * 64 + m * 16 + fr) * 8 + bj * 4 + wc] = ss[ai][m][bj]; }
        asm volatile("s_waitcnt lgkmcnt(0)" ::: "memory"); __builtin_amdgcn_s_barrier(); asm volatile("" ::: "memory");
        const int dimA = h128 ? ((wc >= 2 ? 64 : 0) + (wc & 1) * 16 + fq * 4) : ((wc & 1) * 32 + fq * 4);
        const int q0 = h128 ? ((wc >= 2 ? 32 : 0) + (wc & 1) * 16 + fq * 4) : ((wc & 1) * 16 + fq * 4);
        const f32x4 ga = *(const f32x4*)(gain + dimA), gb = *(const f32x4*)(gain + dimA + (h128 ? 32 : 16));
        const float inv_dh = h128 ? (1.f / 128.f) : (1.f / 64.f);
#pragma unroll
        for (int ai = 0; ai < 2; ++ai)
#pragma unroll
            for (int m = 0; m < 4; ++m) { const int rl = ai * 128 + wr * 64 + m * 16 + fr, row = u.pm * 256 + rl; bf16_t* rowp = P + (size_t)row * INW + col0;
                f32x4 cv = {1.f, 1.f, 1.f, 1.f}, sv = {0.f, 0.f, 0.f, 0.f};
                if (lat) { const float* rp = (h128 ? r128 + (size_t)(row & (SEQ - 1)) * 128 : r64 + (size_t)(row & (SEQ - 1)) * 64) + 2 * q0;
                    const f32x4 c01 = *(const f32x4*)rp, c23 = *(const f32x4*)(rp + 4); cv = (f32x4){c01[0], c01[2], c23[0], c23[2]}; sv = (f32x4){c01[1], c01[3], c23[1], c23[3]}; }
#pragma unroll
                for (int bj = 0; bj < 2; ++bj) { const f32x4 p4 = *(const LAS f32x4*)(ssx + rl * 8 + bj * 4);
                    const float tot = h128 ? (p4[0] + p4[1]) + (p4[2] + p4[3]) : (wc < 2 ? p4[0] + p4[1] : p4[2] + p4[3]);
                    const float rstd = rsqrtf(tot * inv_dh + EPS) * qs * gmul;
                    const f32x4 xa = acc[ai][bj][m][0] * rstd * ga, xb = acc[ai][bj][m][1] * rstd * gb;
                    const f32x4 ya = xa * cv - xb * sv, yb = xb * cv + xa * sv;
                    u32x4 w; w.x = cvt_pk_bf16(ya[0], ya[1]); w.y = cvt_pk_bf16(ya[2], ya[3]); w.z = cvt_pk_bf16(yb[0], yb[1]); w.w = cvt_pk_bf16(yb[2], yb[3]);
                    *(u32x4*)(rowp + bj * 128) = w; } }
    } };
struct SchedBr { const char* A; const char* B; const char* A8; const char* B8; int G, c, ntiles_m;
    __device__ __forceinline__ bool next(int i, pg8::GUnit& u) const { const int s = i % 3; const long L = (long)(i / 3) * G + c; int pm, pn; if (!pg8::grid_order(L, ntiles_m, 8, pm, pn)) return false;
        const int koff = s == 0 ? 0 : (s == 1 ? 768 : 1280); u.pm = pm; u.pn = pn; u.aux = s;
        if (FP8_BR && s != 1) { u.a = A8 + (size_t)pm * 256 * DM + koff; u.b = B8 + (size_t)pn * 256 * DM + koff; u.nt = 6; u.f8 = 1; }
        else { u.a = A + ((size_t)pm * 256 * DM + koff) * 2; u.b = B + ((size_t)pn * 256 * DM + koff) * 2; u.nt = s == 1 ? 8 : 12; u.f8 = 0; }
        return true; } };
struct EpiBr { static constexpr bool PERM = true, KEEPS = true, QSKIP = false; const bf16_t* P; bf16_t* MM;
    __device__ __forceinline__ bool keep(const pg8::GUnit& u) const { return u.aux < 2; }
    __device__ __forceinline__ void operator()(f32x4 (&acc)[2][2][4][2], const pg8::GUnit& u, int wr, int wc, int fr, int fq) const {
        const int row0 = u.pm * 256 + wr * 64 + fr, col0 = u.pn * 256 + wc * 32 + 8 * fq, s = u.aux;
#pragma unroll
        for (int ai = 0; ai < 2; ++ai)
#pragma unroll
            for (int m = 0; m < 4; ++m) { const size_t row = (size_t)(row0 + ai * 128 + m * 16); const bf16_t* gp = P + row * INW + 4096 + s * 2048 + col0; bf16_t* mp = MM + row * DM + col0;
#pragma unroll
                for (int bj = 0; bj < 2; ++bj) { const u32x4 g = *(const u32x4*)(gp + bj * 128);
                    f32x4 g0 = {bf_lo(g.x), bf_hi(g.x), bf_lo(g.y), bf_hi(g.y)}, g1 = {bf_lo(g.z), bf_hi(g.z), bf_lo(g.w), bf_hi(g.w)};
                    if (s < 2) { const u32x4 h = *(const u32x4*)(gp + 2048 + bj * 128);
                        const f32x4 h0 = {bf_lo(h.x), bf_hi(h.x), bf_lo(h.y), bf_hi(h.y)}, h1 = {bf_lo(h.z), bf_hi(h.z), bf_lo(h.w), bf_hi(h.w)};
                        const float bs = 1.f;
#pragma unroll
                        for (int j = 0; j < 4; ++j) { g0[j] *= bs * __builtin_amdgcn_rcpf(fmaxf(h0[j], 1e-20f)); g1[j] *= bs * __builtin_amdgcn_rcpf(fmaxf(h1[j], 1e-20f)); }
                        acc[ai][bj][m][0] = acc[ai][bj][m][0] * g0; acc[ai][bj][m][1] = acc[ai][bj][m][1] * g1; }
                    else { constexpr float fs = 1.f; const f32x4 v0 = acc[ai][bj][m][0] * g0 * fs, v1 = acc[ai][bj][m][1] * g1 * fs;
                        if (FP8_OUT) { u32x2 w; w.x = pk4_fp8(v0[0], v0[1], v0[2], v0[3]); w.y = pk4_fp8(v1[0], v1[1], v1[2], v1[3]); *(u32x2*)((unsigned char*)MM + row * DM + col0 + bj * 128) = w; }
                        else { u32x4 w; w.x = cvt_pk_bf16(v0[0], v0[1]); w.y = cvt_pk_bf16(v0[2], v0[3]); w.z = cvt_pk_bf16(v1[0], v1[1]); w.w = cvt_pk_bf16(v1[2], v1[3]);
                        *(u32x4*)(mp + bj * 128) = w; } } } }
    } };
struct SchedBrAC { const char* A8; const char* B8; int G, c, ntiles_m;
    __device__ __forceinline__ bool next(int i, pg8::GUnit& u) const { const int s = (i & 1) * 2; const long L = (long)(i >> 1) * G + c; int pm, pn; if (!pg8::grid_order(L, ntiles_m, 8, pm, pn)) return false;
        const int koff = s == 0 ? 0 : 1280; u.a = A8 + (size_t)pm * 256 * DM + koff; u.b = B8 + (size_t)pn * 256 * DM + koff; u.nt = 6; u.pm = pm; u.pn = pn; u.aux = s; u.f8 = 1; return true; } };
struct SchedBrB { const char* A; const char* B; int G, c, ntiles_m;
    __device__ __forceinline__ bool next(int i, pg8::GUnit& u) const { const long L = (long)i * G + c; int pm, pn; if (!pg8::grid_order(L, ntiles_m, 8, pm, pn)) return false;
        u.a = A + ((size_t)pm * 256 * DM + 768) * 2; u.b = B + ((size_t)pn * 256 * DM + 768) * 2; u.nt = 8; u.pm = pm; u.pn = pn; u.aux = 1; u.f8 = 0; return true; } };
struct SchedOneBrAC { const char* A8; const char* B8; int pm, pn;
    __device__ __forceinline__ bool next(int i, pg8::GUnit& u) const { if (i >= 2) return false; const int s = i * 2, koff = s == 0 ? 0 : 1280;
        u.a = A8 + (size_t)pm * 256 * DM + koff; u.b = B8 + (size_t)pn * 256 * DM + koff; u.nt = 6; u.pm = pm; u.pn = pn; u.aux = s; u.f8 = 1; return true; } };
struct SchedOneBrB { const char* A; const char* B; int pm, pn;
    __device__ __forceinline__ bool next(int i, pg8::GUnit& u) const { if (i >= 1) return false;
        u.a = A + ((size_t)pm * 256 * DM + 768) * 2; u.b = B + ((size_t)pn * 256 * DM + 768) * 2; u.nt = 8; u.pm = pm; u.pn = pn; u.aux = 1; u.f8 = 0; return true; } };
struct EpiBrAC { static constexpr bool PERM = true, KEEPS = true, QSKIP = false; const bf16_t* P; bf16_t* MM;
    __device__ __forceinline__ bool keep(const pg8::GUnit& u) const { return u.aux == 0; }
    __device__ __forceinline__ void operator()(f32x4 (&acc)[2][2][4][2], const pg8::GUnit& u, int wr, int wc, int fr, int fq) const {
        const int row0 = u.pm * 256 + wr * 64 + fr, col0 = u.pn * 256 + wc * 32 + 8 * fq, s = u.aux;
#pragma unroll
        for (int ai = 0; ai < 2; ++ai)
#pragma unroll
            for (int m = 0; m < 4; ++m) { const size_t row = (size_t)(row0 + ai * 128 + m * 16); const bf16_t* gp = P + row * INW + 4096 + col0; bf16_t* mp = MM + row * DM + col0;
#pragma unroll
                for (int bj = 0; bj < 2; ++bj) { const u32x4 gc = *(const u32x4*)(gp + 2 * 2048 + bj * 128);
                    f32x4 c0 = {bf_lo(gc.x), bf_hi(gc.x), bf_lo(gc.y), bf_hi(gc.y)}, c1 = {bf_lo(gc.z), bf_hi(gc.z), bf_lo(gc.w), bf_hi(gc.w)};
                    if (s == 0) { const u32x4 ga = *(const u32x4*)(gp + bj * 128);
                        const f32x4 a0 = {bf_lo(ga.x), bf_hi(ga.x), bf_lo(ga.y), bf_hi(ga.y)}, a1 = {bf_lo(ga.z), bf_hi(ga.z), bf_lo(ga.w), bf_hi(ga.w)};
#pragma unroll
                        for (int j = 0; j < 4; ++j) { c0[j] = a0[j] * __builtin_amdgcn_rcpf(fmaxf(c0[j], 1e-20f)); c1[j] = a1[j] * __builtin_amdgcn_rcpf(fmaxf(c1[j], 1e-20f)); }
                        acc[ai][bj][m][0] = acc[ai][bj][m][0] * c0; acc[ai][bj][m][1] = acc[ai][bj][m][1] * c1; }
                    else { const f32x4 v0 = acc[ai][bj][m][0] * c0 * (1.f / 64.f), v1 = acc[ai][bj][m][1] * c1 * (1.f / 64.f); u32x4 w;
                        w.x = cvt_pk_bf16(v0[0], v0[1]); w.y = cvt_pk_bf16(v0[2], v0[3]); w.z = cvt_pk_bf16(v1[0], v1[1]); w.w = cvt_pk_bf16(v1[2], v1[3]);
                        *(u32x4*)(mp + bj * 128) = w; } } }
    } };
struct EpiBrB { static constexpr bool PERM = true, KEEPS = false, QSKIP = false; const bf16_t* P; bf16_t* MM;
    __device__ __forceinline__ void operator()(f32x4 (&acc)[2][2][4][2], const pg8::GUnit& u, int wr, int wc, int fr, int fq) const {
        const int row0 = u.pm * 256 + wr * 64 + fr, col0 = u.pn * 256 + wc * 32 + 8 * fq;
#pragma unroll
        for (int ai = 0; ai < 2; ++ai)
#pragma unroll
            for (int m = 0; m < 4; ++m) { const size_t row = (size_t)(row0 + ai * 128 + m * 16); const bf16_t* gp = P + row * INW + 4096 + 2048 + col0; bf16_t* mp = MM + row * DM + col0;
#pragma unroll
                for (int bj = 0; bj < 2; ++bj) { const u32x4 g = *(const u32x4*)(gp + bj * 128); const u32x4 pv = *(const u32x4*)(mp + bj * 128);
                    const f32x4 v0 = acc[ai][bj][m][0], v1 = acc[ai][bj][m][1]; u32x4 w;
                    w.x = cvt_pk_bf16(bf_lo(pv.x) + bf_lo(g.x) * v0[0], bf_hi(pv.x) + bf_hi(g.x) * v0[1]); w.y = cvt_pk_bf16(bf_lo(pv.y) + bf_lo(g.y) * v0[2], bf_hi(pv.y) + bf_hi(g.y) * v0[3]);
                    w.z = cvt_pk_bf16(bf_lo(pv.z) + bf_lo(g.z) * v1[0], bf_hi(pv.z) + bf_hi(g.z) * v1[1]); w.w = cvt_pk_bf16(bf_lo(pv.w) + bf_lo(g.w) * v1[2], bf_hi(pv.w) + bf_hi(g.w) * v1[3]);
                    *(u32x4*)(mp + bj * 128) = w; } }
    } };
struct SchedOut { const char* A; const char* B; int G, c, ntiles_m;
    __device__ __forceinline__ bool next(int i, pg8::GUnit& u) const { const long L = (long)i * G + c; int pm, pn; if (!pg8::grid_order(L, ntiles_m, 8, pm, pn)) return false;
        constexpr int OS = FP8_OUT ? 1 : 2; u.a = A + (size_t)pm * 256 * DM * OS; u.b = B + (size_t)pn * 256 * DM * OS; u.nt = DM * OS / 128; u.pm = pm; u.pn = pn; u.aux = 0; return true; } };
struct EpiOut { static constexpr bool PERM = false, KEEPS = false, QSKIP = false; const float* base_lat; const float* base_ctx; float* X; const float* g1;
    __device__ __forceinline__ void operator()(f32x4 (&acc)[2][2][4][2], const pg8::GUnit& u, int wr, int wc, int fr, int fq) const {
        const int row0 = u.pm * 256 + wr * 64 + fr, col0 = u.pn * 256 + wc * 32 + 4 * fq; const float* gv = g1 + (size_t)(u.pm < 16 ? 0 : (u.pm < 32 ? 1 : 2)) * MODW + col0;
        f32x4 g[2][2];
#pragma unroll
        for (int bj = 0; bj < 2; ++bj)
#pragma unroll
            for (int n = 0; n < 2; ++n) g[bj][n] = *(const f32x4*)(gv + bj * 128 + n * 16);
#pragma unroll
        for (int ai = 0; ai < 2; ++ai)
#pragma unroll
            for (int m = 0; m < 4; ++m) { const int row = row0 + ai * 128 + m * 16; const float* bp = (u.pm < 32 ? base_lat + (size_t)row * DM : base_ctx + (size_t)(row - NLAT) * DM) + col0; float* xp = X + (size_t)row * DM + col0;
#pragma unroll
                for (int bj = 0; bj < 2; ++bj)
#pragma unroll
                    for (int n = 0; n < 2; ++n) { const f32x4 b = *(const f32x4*)(bp + bj * 128 + n * 16); *(f32x4*)(xp + bj * 128 + n * 16) = b + g[bj][n] * (acc[ai][bj][m][n] * (FP8_OUT ? (1.f / 64.f) : 1.f)); }
                asm volatile("" ::: "memory"); }
    } };
struct SchedE1 { const char* A; const char* B; int G, c, nrt;
    __device__ __forceinline__ bool next(int i, pg8::GUnit& u) const { int pn, e, rt;
        if (E_XCD && G == 256) {
            const int x = c & 7, k = c >> 3, ui = i * 32 + k, per = nrt * 8; if (ui >= 2 * per) return false;
            e = 2 * x + ui / per; const int rem = ui % per; rt = rem >> 3; pn = rem & 7;
        } else { const long L = (long)i * G + c; if (L >= (long)16 * nrt * 8) return false;
            pn = (int)(L & 7); const int er = (int)(L >> 3); e = er / nrt; rt = er % nrt; }
        constexpr int ES = FP8_EXPERTS ? 1 : 2; u.a = A + ((size_t)e * EPAD + rt * 256) * DM * ES; u.b = B + ((size_t)e * 2048 + pn * 256) * DM * ES; u.nt = DM * ES / 128; u.pm = rt; u.pn = pn; u.aux = e; u.q = rt == 4; return true; } };
struct EpiE1 { static constexpr bool PERM = true, KEEPS = false, QSKIP = true; bf16_t* ACT; int nrows;
    __device__ __forceinline__ void operator()(f32x4 (&acc)[2][2][4][2], const pg8::GUnit& u, int wr, int wc, int fr, int fq) const {
        const int row0 = u.pm * 256 + wr * 64 + fr, col0 = u.pn * 128 + wc * 32 + 8 * fq;
#pragma unroll
        for (int ai = 0; ai < 2; ++ai)
#pragma unroll
            for (int m = 0; m < 4; ++m) { const int row = row0 + ai * 128 + m * 16; if (row >= nrows) continue;
                constexpr float WS = FP8_EXPERTS ? (1.f / 64.f) : 1.f;
                const f32x4 g0 = acc[ai][0][m][0] * WS, g1 = acc[ai][0][m][1] * WS, u0 = acc[ai][1][m][0] * WS, u1 = acc[ai][1][m][1] * WS; f32x4 a0, a1;
#pragma unroll
                for (int j = 0; j < 4; ++j) { a0[j] = g0[j] * fast_sigmoid(g0[j]) * u0[j]; a1[j] = g1[j] * fast_sigmoid(g1[j]) * u1[j]; }
                if (FP8_EXPERTS) { u32x2 w; w.x = pk4_fp8(a0[0], a0[1], a0[2], a0[3]); w.y = pk4_fp8(a1[0], a1[1], a1[2], a1[3]); *(u32x2*)((unsigned char*)ACT + ((size_t)u.aux * EPAD + row) * FF + col0) = w; }
                else { u32x4 w; w.x = cvt_pk_bf16(a0[0], a0[1]); w.y = cvt_pk_bf16(a0[2], a0[3]); w.z = cvt_pk_bf16(a1[0], a1[1]); w.w = cvt_pk_bf16(a1[2], a1[3]);
                *(u32x4*)(ACT + ((size_t)u.aux * EPAD + row) * FF + col0) = w; } }
    } };
struct SchedE2 { const char* A; const char* B; int G, c, nrt;
    __device__ __forceinline__ bool next(int i, pg8::GUnit& u) const { int pn, e, rt;
        if (E_XCD && G == 256) {
            const int x = c & 7, k = c >> 3, ui = i * 32 + k, per = nrt * 8; if (ui >= 2 * per) return false;
            e = 2 * x + ui / per; const int rem = ui % per; rt = rem >> 3; pn = rem & 7;
        } else { const long L = (long)i * G + c; if (L >= (long)16 * nrt * 8) return false;
            pn = (int)(L & 7); const int er = (int)(L >> 3); e = er / nrt; rt = er % nrt; }
        constexpr int ES = FP8_EXPERTS ? 1 : 2; u.a = A + ((size_t)e * EPAD + rt * 256) * FF * ES; u.b = B + ((size_t)e * 2048 + pn * 256) * FF * ES; u.nt = FF * ES / 128; u.pm = rt; u.pn = pn; u.aux = e; u.q = rt == 4; return true; } };
struct EpiE2 { static constexpr bool PERM = true, KEEPS = false, QSKIP = true; bf16_t* Y; const float* GW; int nrows;
    __device__ __forceinline__ void operator()(f32x4 (&acc)[2][2][4][2], const pg8::GUnit& u, int wr, int wc, int fr, int fq) const {
        const int row0 = u.pm * 256 + wr * 64 + fr, col0 = u.pn * 256 + wc * 32 + 8 * fq;
#pragma unroll
        for (int ai = 0; ai < 2; ++ai)
#pragma unroll
            for (int m = 0; m < 4; ++m) { const int row = row0 + ai * 128 + m * 16; if (row >= nrows) continue; const float gw = GW[u.aux * EPAD + row] * (FP8_EXPERTS ? (1.f / 64.f) : 1.f);
                bf16_t* yp = Y + ((size_t)u.aux * EROWS + row) * DM + col0;
#pragma unroll
                for (int bj = 0; bj < 2; ++bj) { const f32x4 v0 = acc[ai][bj][m][0] * gw, v1 = acc[ai][bj][m][1] * gw;
                    u32x4 w; w.x = cvt_pk_bf16(v0[0], v0[1]); w.y = cvt_pk_bf16(v0[2], v0[3]); w.z = cvt_pk_bf16(v1[0], v1[1]); w.w = cvt_pk_bf16(v1[2], v1[3]);
                    *(u32x4*)(yp + bj * 128) = w; } }
    } };

template <int KIND> __device__ __forceinline__ void attn_decode(int idx, bool ctx, att::AUnit& u, const float* sink_l) {
    u.dpos = 0; u.sink2 = 0.f;
    if (KIND == 0) {
        if (!ctx) { const int b = idx / 96, r = idx % 96, h = r / 16, qb = r % 16;
            u.qrow0 = b * SEQ + qb * 256; u.qcol = 2048 + h * 128; u.kcol = (h / 3) * 128; u.vcol = 256 + (h / 3) * 128; u.ocol = h * 128; u.nlat_t = 64; u.lat_row0 = b * SEQ; u.ctx_row0 = NLAT + b * CTXL; }
        else { const int b = idx / 6, h = idx % 6;
            u.qrow0 = NLAT + b * CTXL; u.qcol = 2048 + h * 128; u.kcol = (h / 3) * 128; u.vcol = 256 + (h / 3) * 128; u.ocol = h * 128; u.nlat_t = 0; u.lat_row0 = 0; u.ctx_row0 = NLAT + b * CTXL; }
    } else if (KIND == 1) {
        if (!ctx) { const int b = idx / 128, r = idx % 128, h = r / 32, qb = r % 32;
            u.qrow0 = b * SEQ + qb * 128; u.qcol = 2816 + h * 128; u.kcol = 512 + h * 128; u.vcol = 1024 + h * 128; u.ocol = 768 + h * 128; u.nlat_t = 64; u.lat_row0 = b * SEQ; u.ctx_row0 = NLAT + b * CTXL; }
        else { const int b = idx / 8, r = idx % 8, h = r / 2, qb = r % 2;
            u.qrow0 = NLAT + b * CTXL + qb * 128; u.qcol = 2816 + h * 128; u.kcol = 512 + h * 128; u.vcol = 1024 + h * 128; u.ocol = 768 + h * 128; u.nlat_t = 0; u.lat_row0 = 0; u.ctx_row0 = NLAT + b * CTXL; }
    } else {
        if (!ctx) { const int b = idx / 96, r = idx % 96, h = r / 16, qb = r % 16; const int t0 = qb * 256; const int lo = t0 - 128 < 0 ? 0 : t0 - 128, hi = t0 + 384 > SEQ ? SEQ : t0 + 384;
            u.qrow0 = b * SEQ + t0; u.qcol = 3328 + h * 128; u.kcol = 1536 + (h / 3) * 128; u.vcol = 1792 + (h / 3) * 128; u.ocol = 1280 + h * 128; u.nlat_t = (hi - lo) / 64; u.lat_row0 = b * SEQ + lo; u.ctx_row0 = NLAT + b * CTXL;
            u.dpos = lo - t0; u.sink2 = sink_l[h] * LOG2E; }
        else { const int b = idx / 6, h = idx % 6;
            u.qrow0 = NLAT + b * CTXL; u.qcol = 3328 + h * 128; u.kcol = 1536 + (h / 3) * 128; u.vcol = 1792 + (h / 3) * 128; u.ocol = 1280 + h * 128; u.nlat_t = 0; u.lat_row0 = 0; u.ctx_row0 = NLAT + b * CTXL; u.sink2 = sink_l[h] * LOG2E; }
    }
}
__device__ __forceinline__ void publish_inc(unsigned* ctr, int tid) {
    asm volatile("s_waitcnt vmcnt(0)" ::: "memory"); __syncthreads();
    if (tid == 0) { __builtin_amdgcn_fence(__ATOMIC_RELEASE, "agent"); asm volatile("s_waitcnt vmcnt(0)" ::: "memory"); (void)xb_add(ctr, 1u); }
}
__device__ __forceinline__ void wait_ge(unsigned* ctr, unsigned want, int tid) {
    if (tid == 0) { unsigned sp = 0u; while (xb_ld(ctr) < want) { __builtin_amdgcn_s_sleep(2); if (++sp > (1u << 20)) break; }
        __builtin_amdgcn_fence(__ATOMIC_ACQUIRE, "agent"); asm volatile("s_waitcnt vmcnt(0)" ::: "memory"); }
    __syncthreads();
}
__device__ __forceinline__ void router_tile(const Args& A, int l, int pm, int pn, unsigned* pctr) {
    int tz = threadIdx.x; asm volatile("" : "+v"(tz)); const int tid = tz, lane = tz & 63, wave = __builtin_amdgcn_readfirstlane(tz >> 6);
    unsigned char* ws = A.ws; const float* X = (const float*)(ws + WS_X); bf16_t* H = (bf16_t*)(ws + WS_H); float* AFFT = (float*)(ws + WS_AFFT); float* XCH = (float*)(ws + WS_XCH);
    const int mr = pm < 16 ? 0 : (pm < 32 ? 1 : 2);
    const float* mv = (const float*)(ws + WS_MODV) + (size_t)(l * 3 + mr) * MODW; const float* wr = A.in[25] + (size_t)l * DM * 16; const float* gain = A.in[7] + l * DM;
    const float* biasr = (const float*)(ws + WS_BIASR) + (l * 3 + mr) * 16;
    if (tid == 0) { __builtin_amdgcn_fence(__ATOMIC_ACQUIRE, "agent"); asm volatile("s_waitcnt vmcnt(0)" ::: "memory"); }
    __syncthreads();
    const int c0 = pn * 256 + 4 * lane, row0 = pm * 256 + wave * 32;
    f32x4 gsc, sh; { const f32x4 g4 = *(const f32x4*)(gain + c0), sc4 = *(const f32x4*)(mv + 4 * DM + c0); gsc = g4 * (sc4 + 1.f); sh = *(const f32x4*)(mv + 3 * DM + c0); }
    f32x4 x[32];
#pragma unroll
    for (int i = 0; i < 32; ++i) x[i] = *(const f32x4*)(X + (size_t)(row0 + i) * DM + c0);
    {   float Wl[4][16];
#pragma unroll
        for (int j = 0; j < 4; ++j)
#pragma unroll
            for (int q = 0; q < 4; ++q) { const f32x4 w4 = *(const f32x4*)(wr + (size_t)(c0 + j) * 16 + 4 * q);
#pragma unroll
                for (int t = 0; t < 4; ++t) Wl[j][4 * q + t] = gsc[j] * w4[t]; }
#pragma unroll
        for (int i = 0; i < 32; ++i) { float pl[16];
#pragma unroll
            for (int e = 0; e < 16; ++e) pl[e] = x[i][0] * Wl[0][e] + x[i][1] * Wl[1][e] + x[i][2] * Wl[2][e] + x[i][3] * Wl[3][e];
            const float pt = treduce16(pl, lane);
            const float ss = wave_sum((x[i][0] * x[i][0] + x[i][1] * x[i][1]) + (x[i][2] * x[i][2] + x[i][3] * x[i][3]), lane);
            float* slot = XCH + ((size_t)(row0 + i) * 8 + pn) * 20;
            if ((lane & 3) == 0) slot[lane >> 2] = pt;
            if (lane == 0) slot[16] = ss; }
    }
    publish_inc(pctr, tid);
    wait_ge(pctr, 8u, tid);
    const float bias = lane < 16 ? biasr[lane] : 0.f;
#pragma unroll
    for (int i0 = 0; i0 < 32; i0 += 8) { float part[8];
#pragma unroll
        for (int i = 0; i < 8; ++i) { const int row = row0 + i0 + i; float s = 0.f;
            if (lane < 17) {
#pragma unroll
                for (int q = 0; q < 8; ++q) s += XCH[((size_t)row * 8 + q) * 20 + lane]; }
            part[i] = s; }
#pragma unroll
        for (int i = 0; i < 8; ++i) { const int row = row0 + i0 + i;
            const float sst = __uint_as_float((unsigned)__builtin_amdgcn_readlane((int)__float_as_uint(part[i]), 16));
            const float rstd = rsqrtf(sst * (1.f / DM) + EPS);
            { const f32x4 h = x[i0 + i] * rstd * gsc + sh; u32x2 w2; w2.x = cvt_pk_bf16(h[0], h[1]); w2.y = cvt_pk_bf16(h[2], h[3]); *(u32x2*)(H + (size_t)row * DM + c0) = w2; }
            if (pn == 0) {
                const float logit = lane < 16 ? rstd * part[i] + bias : -3.0e38f; const float mx = row_max16(logit);
                const float ex = lane < 16 ? expf(logit - mx) : 0.f; const float s = row_sum16(ex);
                if (lane < 16) AFFT[(size_t)lane * MROWS + row] = ex / s; } }
    }
}
struct SchedOneBr { const char* A; const char* B; const char* A8; const char* B8; int pm, pn;
    __device__ __forceinline__ bool next(int i, pg8::GUnit& u) const { if (i >= 3) return false; const int s = i, koff = s == 0 ? 0 : (s == 1 ? 768 : 1280); u.pm = pm; u.pn = pn; u.aux = s;
        if (FP8_BR && s != 1) { u.a = A8 + (size_t)pm * 256 * DM + koff; u.b = B8 + (size_t)pn * 256 * DM + koff; u.nt = 6; u.f8 = 1; }
        else { u.a = A + ((size_t)pm * 256 * DM + koff) * 2; u.b = B + ((size_t)pn * 256 * DM + koff) * 2; u.nt = s == 1 ? 8 : 12; u.f8 = 0; }
        return true; } };
struct SchedGate3 { const char* A; const char* B; int pm, pn;
    __device__ __forceinline__ bool next(int i, pg8::GUnit& u) const { if (i >= 3) return false; const int gp = 16 + 8 * i + pn;
        u.a = A + (size_t)pm * 256 * DM; u.b = B + (size_t)gp * 256 * DM; u.nt = DM / 128; u.pm = pm; u.pn = gp; u.aux = 0; return true; } };
struct SchedOneOut { const char* A; const char* B; int pm, pn;
    __device__ __forceinline__ bool next(int i, pg8::GUnit& u) const { if (i >= 1) return false; constexpr int OS = FP8_OUT ? 1 : 2;
        u.a = A + (size_t)pm * 256 * DM * OS; u.b = B + (size_t)pn * 256 * DM * OS; u.nt = DM * OS / 128; u.pm = pm; u.pn = pn; u.aux = 0; return true; } };

constexpr int N_PHASES = 22;
__global__ void __launch_bounds__(NTHR, 2) mega(Args args) {
    extern __shared__ __attribute__((aligned(16))) unsigned char lds_raw[];
    LAS unsigned char* lds = (LAS unsigned char*)lds_raw;
    const int G = gridDim.x, wg = blockIdx.x, NGW = G * NWAVES;
    unsigned char* ws = args.ws; unsigned* ctl = (unsigned*)(ws + WS_CTL);
    volatile LAS unsigned* MISC = (volatile LAS unsigned*)(lds + MISC_OFF);
    if (threadIdx.x < 32) MISC[threadIdx.x] = 0u;
    __syncthreads();
    const int lo = args.ph_lo, hi = args.ph_hi; const bool multi = (hi - lo) > 1;
    const bool fuse_router = FUSE_ROUTER && CTX_CHAIN && G == 256;
    XcdBarrier bar; bar.bar = ctl + CW_BAR; bar.x = 0; bar.st = nullptr;
    if (multi) bar = xcd_barrier_post(ctl + CW_BAR, MISC + 8);
#ifndef PH_MASK
#define PH_MASK 0xffffffffu
#endif
#define PHON(b) ((PH_MASK >> (b)) & 1u)
#ifndef REP_MASK
#define REP_MASK 0u
#endif
#define REPEAT(b) _Pragma("unroll 1") for (int rep = 0; rep < ((((REP_MASK >> (b)) & 1u) && ((b) != 6 || l == 0)) ? 2 : 1); ++rep)
#define REPBAR() do { if (rep && multi) xcd_barrier(bar); } while (0)
#define IN(k) (lo <= (k) && (k) < hi)
#define HIDE_TID() int tz = threadIdx.x; asm volatile("" : "+v"(tz)); const int tid = tz, lane = tz & 63, wave = __builtin_amdgcn_readfirstlane(tz >> 6), gw = wg * NWAVES + wave; (void)tid; (void)lane; (void)wave; (void)gw
#define SEAM(k) do { if (IN(k) && IN((k) + 1)) xcd_barrier(bar); } while (0)
#define SEAM_BG(k, force_upto) do { if (IN(k) && IN((k) + 1)) { if (BG_CONV && multi) bg_loop(args, lds, ctl, MISC, (k), (force_upto), G); xcd_barrier(bar); } } while (0)
    if (PHON(0) && IN(0)) _Pragma("unroll 1") for (int rep = 0; rep < ((REP_MASK & 1u) ? 2 : 1); ++rep) { REPBAR(); HIDE_TID();
#ifndef P0_PROBE
#define P0_PROBE 0
#endif
        if (!(P0_PROBE == 1 && rep == 0 && (REP_MASK & 1u))) p0_modv(args, lds, tid, lane, wave, wg, G, 0, (MODV1_IN_ATT && CONV_IN_ATT == 2 && P0_DYN && multi && !BG_CONV) ? 96 : 2 * 96);
#ifndef P0_DYN
#define P0_DYN 1
#endif
        if (!(P0_PROBE == 2 && rep == 0 && (REP_MASK & 1u))) {
#ifndef CONV_PIPE
#define CONV_PIPE 1
#endif
#ifndef CONV_IN_ATT
#define CONV_IN_ATT 2
#endif
#ifndef CONV_SEL
#define CONV_SEL(wg) ((((wg) >> 3) & 3) == 3)
#endif
            if (P0_DYN && multi && !BG_CONV) { p0_convert_dyn(args, lds, ctl + CW_BGQ + 64 + 64 * rep, MISC, tid, wave, lane, CONV_IN_ATT == 2 ? CV_D1 : (CONV_IN_ATT ? CV_PER_L : 2 * CV_PER_L)); p0_prologue(args, lds, wave, lane, gw, NGW, 0); }
            else p0_prologue(args, lds, wave, lane, gw, NGW, (BG_CONV && multi) ? CV_PER_L : 2 * CV_PER_L); } }
    SEAM(0);
#pragma unroll 1
    for (int l = 0; l < 2; ++l) {
        const int pb = 1 + 10 * l;
        const float* modv_l = (const float*)(ws + WS_MODV) + (size_t)l * 3 * MODW;
#ifdef BAR_PROBE
        if (multi && l == 0) { for (int bi = 0; bi < BAR_PROBE; ++bi) xcd_barrier(bar); }
#endif
        if (PHON(1) && IN(pb + 0)) { HIDE_TID(); if (l == 0) row_phase_a<0>(args, l, lane, gw, NGW); else row_phase_a<1>(args, l, lane, gw, NGW); }
        SEAM_BG(pb + 0, l == 1 ? CV_D1 : 0);
        if (PHON(2) && IN(pb + 1)) REPEAT(2) {
            REPBAR();
            SchedIn S{(const char*)(ws + WS_H), (const char*)(ws + WS_WIN) + (size_t)l * INW * DM * 2, G, wg, l}; EpiIn E{1.f, (bf16_t*)(ws + WS_P), (LAS float*)(lds + RING_BYTES), (const float*)(ws + WS_ROPE128), (const float*)(ws + WS_ROPE64), args.in[10] + l * 128, args.in[12] + l * 64, args.in[19] + l * 128, args.in[9] + l * 128, args.in[11] + l * 64, args.in[18] + l * 128};
            if (!IN_BLOCK) pg8::gemm_phase<EpiIn, SchedIn>(lds, DM * 2, DM * 2, S, E);
            if (FP8_GATES) { SchedIn8 S8{(const char*)(ws + WS_H8), (const char*)(ws + WS_WIN8) + (size_t)l * INW * DM, G, wg, l}; const EpiIn E8{1.f / 64.f, (bf16_t*)(ws + WS_P), (LAS float*)(lds + RING_BYTES), (const float*)(ws + WS_ROPE128), (const float*)(ws + WS_ROPE64), args.in[10] + l * 128, args.in[12] + l * 64, args.in[19] + l * 128, args.in[9] + l * 128, args.in[11] + l * 64, args.in[18] + l * 128};
                pg8::gemm_phase<EpiIn, SchedIn8, true>(lds, DM, DM, S8, E8); }
            if (IN_BLOCK) pg8::gemm_phase<EpiIn, SchedIn>(lds, DM * 2, DM * 2, S, E);
        }
        SEAM_BG(pb + 1, 0);
        if (!FUSE_QK) { if (PHON(3) && IN(pb + 2)) { HIDE_TID(); row_phase_c(args, l, lane, gw, NGW); }
        SEAM(pb + 2); }
        if (PHON(4) && IN(pb + 3)) REPEAT(4) {
            REPBAR(); HIDE_TID();
            const float lambda_init = 0.8f - 0.6f * expf(-0.3f * (float)l);
            float lam; { const float a = wave_sum(args.in[13][l * 64 + lane] * args.in[14][l * 64 + lane], lane), b = wave_sum(args.in[15][l * 64 + lane] * args.in[16][l * 64 + lane], lane); lam = expf(a) - expf(b) + lambda_init; lam = __uint_as_float((unsigned)__builtin_amdgcn_readfirstlane((int)__float_as_uint(lam))); }
            const bf16_t* P = (const bf16_t*)(ws + WS_P); bf16_t* O = (bf16_t*)(ws + WS_OATT);
#ifndef ATT_NOMAX
#define ATT_NOMAX 1
#endif
            bool nomax_ac = false, nomax_b = false;
            if (ATT_NOMAX) {
                const float ga = fmaxf(fabsf(args.in[9][l * 128 + lane]), fabsf(args.in[9][l * 128 + 64 + lane])), ka = fmaxf(fabsf(args.in[10][l * 128 + lane]), fabsf(args.in[10][l * 128 + 64 + lane]));
                const float gc = fmaxf(fabsf(args.in[18][l * 128 + lane]), fabsf(args.in[18][l * 128 + 64 + lane])), kc = fmaxf(fabsf(args.in[19][l * 128 + lane]), fabsf(args.in[19][l * 128 + 64 + lane]));
                const float gb = fabsf(args.in[11][l * 64 + lane]), kb = fabsf(args.in[12][l * 64 + lane]);
                const float ba = wave_max(ga, lane) * wave_max(ka, lane), bc = wave_max(gc, lane) * wave_max(kc, lane), bb = wave_max(gb, lane) * wave_max(kb, lane);
                const float sk = fabsf(sink_bound(args.in[20] + l * 6));
                nomax_ac = __builtin_amdgcn_readfirstlane((int)(fmaxf(ba, bc) * 16.33f < 100.f && sk < 60.f)) != 0;
                nomax_b = __builtin_amdgcn_readfirstlane((int)(bb * 11.55f < 100.f)) != 0;
            }
            const float* sink_l = args.in[20] + l * 6; const float* subln = args.in[17] + l * 128;
#ifndef ATT_KINDS
#define ATT_KINDS 7
#endif
            const bool ctxl = (l == 0);
            unsigned* qb = ctl + CW_QUEUE + 64 * (rep * 16 + l * 8); unsigned* cctr = ctl + CW_CTX + 128 * rep;
            if (CONV_IN_ATT == 2 && P0_DYN && multi && !BG_CONV && rep == 0 && CONV_SEL(wg)) {
                if (MODV1_IN_ATT && l == 0) { p0_modv(args, lds, tid, lane, wave, (wg >> 5) * 8 + (wg & 7), 64, 96, 2 * 96); __syncthreads(); }
#ifndef CONV_SPLIT_BR
#define CONV_SPLIT_BR 1
#endif
                const int i0 = l == 0 ? CV_D1 : (CONV_SPLIT_BR ? CV_PER_L + CV_I_IN : CV_PER_L + CV_D1);
                const int nn = l == 0 ? ((CONV_IN_EXP && E_XCD && G == 256) ? CV_PER_L - CV_D1 : (CONV_SPLIT_BR ? CV_PER_L - CV_D1 + CV_I_IN : CV_PER_L)) : (CONV_SPLIT_BR ? CV_PER_L - CV_I_IN : CV_PER_L - CV_D1);
                if (CONV_PIPE) p0_convert_dyn2(args, lds, ctl + CW_BGQ + 192 + 64 * l, MISC, tid, wave, lane, nn, i0); else p0_convert_dyn(args, lds, ctl + CW_BGQ + 192 + 64 * l, MISC, tid, wave, lane, nn, i0); }
            else if (CONV_IN_ATT == 1 && P0_DYN && multi && !BG_CONV && l == 0 && rep == 0 && CONV_SEL(wg)) { if (CONV_PIPE) p0_convert_dyn2(args, lds, ctl + CW_BGQ + 192, MISC, tid, wave, lane, CV_PER_L, CV_PER_L); else p0_convert_dyn(args, lds, ctl + CW_BGQ + 192, MISC, tid, wave, lane, CV_PER_L, CV_PER_L); }
#define ATT_CLAIM(q) ({ __syncthreads(); if (tid == 0) MISC[0] = atomicAdd(qb + 64 * (q), 1u); __syncthreads(); __builtin_amdgcn_readfirstlane((int)MISC[0]); })
#define ATT_RUN(KIND, idx, isctx) do { att::AUnit u; attn_decode<KIND>(idx, isctx, u, sink_l); unsigned char* o8_ = FP8_BR ? (unsigned char*)(ws + WS_OATT8) : (unsigned char*)nullptr; \
    if (ATT_NOMAX && (KIND == 1 ? nomax_b : nomax_ac)) att::attn_unit<KIND, 20>(u, P, O, o8_, (LAS char*)lds, lam, 1.f - lambda_init, subln); else att::attn_unit<KIND>(u, P, O, o8_, (LAS char*)lds, lam, 1.f - lambda_init, subln); } while (0)
#ifndef ATT_PROBE
#define ATT_PROBE 0
#endif
#ifndef ATT_PROBE_KINDS
#define ATT_PROBE_KINDS 7
#endif
            if (ATT_PROBE && multi) {
                unsigned* qp = ctl + CW_QUEUE + 64 * (16 + l * 8);
#define ATT_CLAIMP(q) ({ __syncthreads(); if (tid == 0) MISC[0] = atomicAdd(qp + 64 * (q), 1u); __syncthreads(); __builtin_amdgcn_readfirstlane((int)MISC[0]); })
#define ATT_RUNP(KIND, idx) do { att::AUnit u; attn_decode<KIND>(idx, false, u, sink_l); att::attn_unit<KIND, ATT_PROBE == 1 ? 8 : ATT_PROBE>(u, P, O, FP8_BR ? (unsigned char*)(ws + WS_OATT8) : (unsigned char*)nullptr, (LAS char*)lds, lam, 1.f - lambda_init, subln); } while (0)
                if (ATT_PROBE_KINDS & 1) for (;;) { const int qi = ATT_CLAIMP(1); if (qi >= 192) break; ATT_RUNP(0, qi); }
                if (ATT_PROBE_KINDS & 2) for (;;) { const int qi = ATT_CLAIMP(2); if (qi >= 256) break; ATT_RUNP(1, qi); }
                if (ATT_PROBE_KINDS & 4) for (;;) { const int qi = ATT_CLAIMP(3); if (qi >= 192) break; ATT_RUNP(2, qi); }
                xcd_barrier(bar);
            }
#define ATT_CHAIN_BODY() do { \
                        if (FP8_GATES && FP8_AC && CTX_GATES_IN_CHAIN) { \
                            SchedGate3 S{(const char*)(ws + WS_H8), (const char*)(ws + WS_WIN8) + (size_t)l * INW * DM, pm, pn}; \
                            const EpiIn E8{1.f / 64.f, (bf16_t*)(ws + WS_P), (LAS float*)(lds + RING_BYTES), (const float*)(ws + WS_ROPE128), (const float*)(ws + WS_ROPE64), args.in[10] + l * 128, args.in[12] + l * 64, args.in[19] + l * 128, args.in[9] + l * 128, args.in[11] + l * 64, args.in[18] + l * 128}; \
                            pg8::gemm_phase<EpiIn, SchedGate3, true>(lds, DM, DM, S, E8); } \
                        wait_ge(cctr, 40u, tid); \
                        { SchedOneBr S{(const char*)(ws + WS_OATT), (const char*)(ws + WS_WBR) + (size_t)l * DM * DM * 2, (const char*)(ws + WS_OATT8), (const char*)(ws + WS_WBR8) + (size_t)l * DM * DM, pm, pn}; EpiBr E{(const bf16_t*)(ws + WS_P), (bf16_t*)(ws + WS_MM)}; \
                          if (FP8_BR) { SchedOneBrAC S1{(const char*)(ws + WS_OATT8), (const char*)(ws + WS_WBR8) + (size_t)l * DM * DM, pm, pn}; EpiBrAC E1{(const bf16_t*)(ws + WS_P), (bf16_t*)(ws + WS_MM)}; \
                              pg8::gemm_phase<EpiBrAC, SchedOneBrAC, true>(lds, DM, DM, S1, E1); \
                              SchedOneBrB S2{(const char*)(ws + WS_OATT), (const char*)(ws + WS_WBR) + (size_t)l * DM * DM * 2, pm, pn}; EpiBrB E2{(const bf16_t*)(ws + WS_P), (bf16_t*)(ws + WS_MM)}; \
                              pg8::gemm_phase<EpiBrB, SchedOneBrB>(lds, DM * 2, DM * 2, S2, E2); } \
                          else pg8::gemm_phase<EpiBr, SchedOneBr>(lds, DM * 2, DM * 2, S, E); } \
                        publish_inc(cctr + 64, tid); \
                        wait_ge(cctr + 64, 16u, tid); \
                        { SchedOneOut S{(const char*)(ws + WS_MM), (const char*)(ws + WS_WOUT) + (size_t)l * DM * DM * (FP8_OUT ? 1 : 2), pm, pn}; \
                          EpiOut E{args.in[0], args.in[2], (float*)(ws + WS_X), modv_l + 2 * DM}; \
                          if (FP8_OUT) pg8::gemm_phase<EpiOut, SchedOneOut, true>(lds, DM, DM, S, E); else pg8::gemm_phase<EpiOut, SchedOneOut>(lds, DM * 2, DM * 2, S, E); } \
                        if (fuse_router) router_tile(args, l, pm, pn, ctl + CW_RP + 64 * (64 * l + pm)); \
    } while (0)
#ifndef ATT_ONEQ
#define ATT_ONEQ 1
#endif
#if ATT_ONEQ && ATT_KINDS == 7
            {
                const int nch = (ctxl && CTX_CHAIN) ? 16 : 0, ncA = ctxl ? 12 : 0, ncB = ctxl ? 16 : 0;
                const int e0 = ctxl ? 12 : 0, e1 = e0 + ncA + 192, e2 = e1 + ncB + nch + 256, e3 = e2 + 192;
                int gi = ATT_CLAIM(0);
                for (; gi < e0; gi = ATT_CLAIM(0)) { ATT_RUN(2, gi, true); if (CTX_CHAIN) publish_inc(cctr, tid); }
                for (; gi < e1; gi = ATT_CLAIM(0)) { const int qi = gi - e0; const bool isctx = qi < ncA; ATT_RUN(0, isctx ? qi : qi - ncA, isctx); if (CTX_CHAIN && isctx) publish_inc(cctr, tid); }
                for (; gi < e2; gi = ATT_CLAIM(0)) { const int qi = gi - e1; const int nctx = ncB;
                    if (qi >= nctx && qi < nctx + nch) {
                        const int j = qi - nctx, pm = 32 + (j >> 3), pn = j & 7;
                        ATT_CHAIN_BODY();
                        continue; }
                    const bool isctx = qi < nctx; ATT_RUN(1, isctx ? qi : qi - nctx - nch, isctx); if (CTX_CHAIN && isctx) publish_inc(cctr, tid); }
                for (; gi < e3; gi = ATT_CLAIM(0)) { ATT_RUN(2, gi - e2, false); }
            }
#else
            if (ctxl && (ATT_KINDS & 4)) for (;;) { const int qi = ATT_CLAIM(0); if (qi >= 12) break; ATT_RUN(2, qi, true); if (CTX_CHAIN) publish_inc(cctr, tid); }
#ifndef ATT_XCD
#define ATT_XCD 0
#endif
            const bool axcd = ATT_XCD && G == 256;
            if (ATT_KINDS & 1) { const int nctx = ctxl ? 12 : 0, nlatq = axcd ? 0 : 192;
                for (;;) { const int qi = ATT_CLAIM(1); if (qi >= nctx + nlatq) break; const bool isctx = qi < nctx; ATT_RUN(0, isctx ? qi : qi - nctx, isctx); if (CTX_CHAIN && isctx) publish_inc(cctr, tid); }
                if (axcd) { const int x = wg & 7, k = wg >> 3; if (k < 24) { const int u_ = (x & 1) * 24 + k, g_ = x >> 1; ATT_RUN(0, (g_ >> 1) * 96 + ((g_ & 1) * 3 + u_ / 16) * 16 + (u_ & 15), false); } } }
            if (ATT_KINDS & 2) { const int nctx = ctxl ? 16 : 0, nch = (ctxl && CTX_CHAIN) ? 16 : 0;
                for (;;) { const int qi = ATT_CLAIM(2); if (qi >= nctx + nch + (axcd ? 0 : 256)) break;
                    if (qi >= nctx && qi < nctx + nch) {
                        const int j = qi - nctx, pm = 32 + (j >> 3), pn = j & 7;
                        ATT_CHAIN_BODY();
                        continue; }
                    const bool isctx = qi < nctx; ATT_RUN(1, isctx ? qi : qi - nctx - nch, isctx); if (CTX_CHAIN && isctx) publish_inc(cctr, tid); }
                if (axcd) ATT_RUN(1, (wg & 7) * 32 + (wg >> 3), false); }
            if (ATT_KINDS & 4) for (;;) { const int qi = ATT_CLAIM(3); if (qi >= 192) break; ATT_RUN(2, qi, false); }
#endif
#undef ATT_CLAIM
#undef ATT_RUN
#undef ATT_CHAIN_BODY
        }
        SEAM_BG(pb + 3, 0);
        if (PHON(5) && IN(pb + 4)) REPEAT(5) {
            REPBAR();
            SchedBr S{(const char*)(ws + WS_OATT), (const char*)(ws + WS_WBR) + (size_t)l * DM * DM * 2, (const char*)(ws + WS_OATT8), (const char*)(ws + WS_WBR8) + (size_t)l * DM * DM, G, wg, (l == 0 && !CTX_CHAIN) ? 34 : 32}; EpiBr E{(const bf16_t*)(ws + WS_P), (bf16_t*)(ws + WS_MM)};
            if (FP8_BR) { const int ntm = (l == 0 && !CTX_CHAIN) ? 34 : 32;
                SchedBrAC S1{(const char*)(ws + WS_OATT8), (const char*)(ws + WS_WBR8) + (size_t)l * DM * DM, G, wg, ntm}; EpiBrAC E1{(const bf16_t*)(ws + WS_P), (bf16_t*)(ws + WS_MM)};
                pg8::gemm_phase<EpiBrAC, SchedBrAC, true>(lds, DM, DM, S1, E1);
                SchedBrB S2{(const char*)(ws + WS_OATT), (const char*)(ws + WS_WBR) + (size_t)l * DM * DM * 2, G, wg, ntm}; EpiBrB E2{(const bf16_t*)(ws + WS_P), (bf16_t*)(ws + WS_MM)};
                pg8::gemm_phase<EpiBrB, SchedBrB>(lds, DM * 2, DM * 2, S2, E2); }
            else pg8::gemm_phase<EpiBr, SchedBr>(lds, DM * 2, DM * 2, S, E);
        }
        SEAM(pb + 4);
        if (PHON(6) && IN(pb + 5)) REPEAT(6) {
            REPBAR();
            SchedOut S{(const char*)(ws + WS_MM), (const char*)(ws + WS_WOUT) + (size_t)l * DM * DM * (FP8_OUT ? 1 : 2), G, wg, (l == 0 && !CTX_CHAIN) ? 34 : 32};
            const float* X = (const float*)(ws + WS_X);
            EpiOut E{l == 0 ? args.in[0] : X, l == 0 ? args.in[2] : X + (size_t)NLAT * DM, (float*)(ws + WS_X), modv_l + 2 * DM};
            if (FP8_OUT) pg8::gemm_phase<EpiOut, SchedOut, true>(lds, DM, DM, S, E); else pg8::gemm_phase<EpiOut, SchedOut>(lds, DM * 2, DM * 2, S, E);
            if (fuse_router) { int pm, pn; if (pg8::grid_order((long)wg, 32, 8, pm, pn)) router_tile(args, l, pm, pn, ctl + CW_RP + 64 * (64 * l + pm)); }
        }
        SEAM(pb + 5);
        if (!fuse_router) { if (PHON(7) && IN(pb + 6)) REPEAT(7) { REPBAR(); HIDE_TID(); if (ROUTER_V3) row_phase_g3(args, lds, l, tid, lane, wave, wg, G); else row_phase_g(args, lds, l, tid, lane, wave, wg, G, ROUTER_PROBE != 0 && rep == 0 && ((REP_MASK >> 7) & 1u)); }
        SEAM(pb + 6); }
        if (PHON(8) && IN(pb + 7)) REPEAT(8) { REPBAR(); HIDE_TID(); phase_rank(args, lds, l, wg, G, tid, wave, lane); }
        SEAM_BG(pb + 7, l == 1 ? CV_PER_L : 0);
        if (PHON(9) && IN(pb + 8)) REPEAT(9) {
            REPBAR();
            SchedE1 S{(const char*)(ws + WS_XG), (const char*)(ws + WS_W1) + (size_t)l * 16 * 2048 * DM * (FP8_EXPERTS ? 1 : 2), G, wg, l == 0 ? 5 : 4}; EpiE1 E{(bf16_t*)(ws + WS_ACT), l == 0 ? EROWS : 1024};
            if (FP8_EXPERTS) pg8::gemm_phase<EpiE1, SchedE1, true>(lds, DM, DM, S, E); else pg8::gemm_phase<EpiE1, SchedE1>(lds, DM * 2, DM * 2, S, E);
            if (CONV_IN_EXP && CONV_IN_ATT == 2 && P0_DYN && E_XCD && multi && !BG_CONV && G == 256 && l == 0 && rep == 0 && (wg >> 3) >= 16) { HIDE_TID(); p0_convert_dyn2(args, lds, ctl + CW_BGQ + 320, MISC, tid, wave, lane, CONV_EXP_PART1, CV_PER_L); }
        }
        SEAM_BG(pb + 8, 0);
        if (PHON(10) && IN(pb + 9)) REPEAT(10) {
            REPBAR();
            SchedE2 S{(const char*)(ws + WS_ACT), (const char*)(ws + WS_W2) + (size_t)l * 16 * 2048 * FF * (FP8_EXPERTS ? 1 : 2), G, wg, l == 0 ? 5 : 4}; EpiE2 E{(bf16_t*)(ws + WS_Y), (const float*)(ws + WS_GW), l == 0 ? EROWS : 1024};
            if (FP8_EXPERTS) pg8::gemm_phase<EpiE2, SchedE2, true>(lds, FF, FF, S, E); else pg8::gemm_phase<EpiE2, SchedE2>(lds, FF * 2, FF * 2, S, E);
            if (CONV_IN_EXP && CONV_IN_ATT == 2 && P0_DYN && E_XCD && multi && !BG_CONV && G == 256 && l == 0 && rep == 0 && (wg >> 3) >= 16) { HIDE_TID(); p0_convert_dyn2(args, lds, ctl + CW_BGQ + 384, MISC, tid, wave, lane, CV_D1 - CONV_EXP_PART1, CV_PER_L + CONV_EXP_PART1); }
        }
        SEAM_BG(pb + 9, 0);
    }
    if (PHON(11) && IN(21)) { HIDE_TID(); row_phase_a<2>(args, 2, lane, gw, NGW); }
#undef IN
#undef SEAM
}

static int g_grid = 0;
static bool setup() {
    if (g_grid) return g_grid > 0;
    int dev = 0, cus = 0, per_cu = 0;
    if (hipGetDevice(&dev) != hipSuccess || hipDeviceGetAttribute(&cus, hipDeviceAttributeMultiprocessorCount, dev) != hipSuccess) { g_grid = -1; return false; }
    if (hipFuncSetAttribute((const void*)mega, hipFuncAttributeMaxDynamicSharedMemorySize, LDS_BYTES) != hipSuccess) { fprintf(stderr, "kernel_launch: hipFuncSetAttribute failed\n"); g_grid = -1; return false; }
    if (hipOccupancyMaxActiveBlocksPerMultiprocessor(&per_cu, (const void*)mega, NTHR, LDS_BYTES) != hipSuccess || per_cu < 1) { fprintf(stderr, "kernel_launch: occupancy query says %d\n", per_cu); (void)hipGetLastError(); }
    g_grid = cus;
    return true;
}
static void run(void* const* d_in, void* d_out, void* d_ws, bool one_launch, int ph_end, hipStream_t stream) {
    if (!setup()) return;
    (void)hipMemsetAsync((char*)d_ws + WS_CTL, 0, CTL_ZERO_BYTES, stream);
    Args a{}; for (int i = 0; i < 29; ++i) a.in[i] = (const float*)d_in[i];
    a.out = (float*)d_out; a.ws = (unsigned char*)d_ws;
    if (one_launch) { a.ph_lo = 0; a.ph_hi = ph_end; hipLaunchKernelGGL(mega, dim3(g_grid), dim3(NTHR), LDS_BYTES, stream, a); }
    else for (int p = 0; p < ph_end; ++p) { a.ph_lo = p; a.ph_hi = p + 1; hipLaunchKernelGGL(mega, dim3(g_grid), dim3(NTHR), LDS_BYTES, stream, a); }
}
}
#ifndef ONE_LAUNCH
#define ONE_LAUNCH 0
#endif
extern "C" void kernel_launch(void* const* d_in, const int* in_sizes, int n_in, void* d_out, int out_size, void* d_ws, size_t ws_size, hipStream_t stream) {
    if (n_in != 29 || ws_size < fk::WS_END) { fprintf(stderr, "kernel_launch: unexpected n_in %d / ws %zu\n", n_in, ws_size); return; }
    fk::run(d_in, d_out, d_ws, ONE_LAUNCH != 0, fk::N_PHASES, stream);
}
```

```cpp
#include <hip/hip_runtime.h>
#include <cstdio>
#include <cstdint>
#include <cmath>
#define ONE_LAUNCH 1
#define LAS __attribute__((address_space(3)))
#define GAS __attribute__((address_space(1)))
typedef unsigned short bf16_t;
typedef short bf16x8 __attribute__((ext_vector_type(8)));
typedef short s16x4 __attribute__((ext_vector_type(4)));
typedef float f32x2 __attribute__((ext_vector_type(2)));
typedef float f32x4 __attribute__((ext_vector_type(4)));
typedef float f32x16 __attribute__((ext_vector_type(16)));
typedef unsigned u32x2 __attribute__((ext_vector_type(2)));
typedef unsigned u32x4 __attribute__((ext_vector_type(4)));
typedef int i32x4 __attribute__((ext_vector_type(4)));
typedef int i32x8 __attribute__((ext_vector_type(8)));

__device__ __forceinline__ unsigned cvt_pk_bf16(float lo, float hi) { unsigned r; asm volatile("v_cvt_pk_bf16_f32 %0, %1, %2" : "=v"(r) : "v"(lo), "v"(hi)); return r; }
__device__ __forceinline__ float bf_lo(unsigned w) { return __uint_as_float(w << 16); }
__device__ __forceinline__ float bf_hi(unsigned w) { return __uint_as_float(w & 0xffff0000u); }
__device__ __forceinline__ float bf2f(bf16_t b) { return __uint_as_float(((unsigned)b) << 16); }
__device__ __forceinline__ float shx(float v, int lane, int o) { return __uint_as_float((unsigned)__builtin_amdgcn_ds_bpermute((lane ^ o) << 2, (int)__float_as_uint(v))); }
__device__ __forceinline__ unsigned pk4_fp8(float a, float b, float c, float d) { int w = __builtin_amdgcn_cvt_pk_fp8_f32(a, b, 0, false); w = __builtin_amdgcn_cvt_pk_fp8_f32(c, d, w, true); return (unsigned)w; }
__device__ __forceinline__ float fast_sigmoid(float x) { return __builtin_amdgcn_rcpf(1.f + __builtin_amdgcn_exp2f(-1.4426950408889634f * x)); }

namespace pg8 {
constexpr int BM = 256, BK = 64, HALF = 128, HTB = HALF * BK * 2  , STAGE_BYTES = 8 * HTB;
__host__ __device__ __forceinline__ int lds_byte(int r, int c) { const int st = (r >> 4) * 2 + (c >> 5), rr = r & 15, cc = c & 31, ob = rr * 64 + cc * 2; return st * 1024 + (ob ^ (((ob >> 9) & 1) << 5)); }
__host__ __device__ __forceinline__ void stage_rc(int b, int& R, int& C) { const int st = b / 1024, sb = b % 1024, swz = sb ^ (((sb >> 9) & 1) << 5); R = (st >> 1) * 16 + swz / 64; C = (st & 1) * 32 + (swz % 64) / 2; }
__host__ __device__ __forceinline__ int perm32(int rho) { const int n = rho >> 4, i = rho & 15; return 8 * (i >> 2) + 4 * n + (i & 3); }

struct GUnit { const char* a; const char* b; int nt; int pm, pn, aux; int f8; int q; };

__device__ __forceinline__ bool grid_order(long L, int nM, int nN, int& pm, int& pn) {
    const int nwg = nM * nN; if (L >= nwg) return false;
    int wgid = (int)L; { const int q = nwg / 8, r = nwg % 8, xcd = wgid % 8, off = wgid / 8; wgid = (xcd < r ? xcd * (q + 1) : r * (q + 1) + (xcd - r) * q) + off; }
    const int nig = 8 * nN, gid = wgid / nig, fm = gid * 8, gsz = (nM - fm) < 8 ? (nM - fm) : 8;
    pm = fm + ((wgid % nig) % gsz); pn = (wgid % nig) / gsz; return true;
}

template <class Epi, class Sched, bool F8 = false>
__device__ __forceinline__ void gemm_phase(LAS unsigned char* lds, const int lda, const int ldb, const Sched& S, const Epi& E) {
    int tz = threadIdx.x; asm volatile("" : "+v"(tz));
    const int tid = tz, wid = __builtin_amdgcn_readfirstlane(tid >> 6), lane = tid & 63, wr = wid >> 2, wc = wid & 3, fr = lane & 15, fq = lane >> 4;
    unsigned voffA[2], voffB[2];
#pragma unroll
    for (int i = 0; i < 2; ++i) { int R, C; stage_rc(tid * 16 + i * 8192, R, C); const int Rb = Epi::PERM ? ((R & ~31) + perm32(R & 31)) : R;
        voffA[i] = (unsigned)(R * lda + C * 2); voffB[i] = (unsigned)(Rb * ldb + C * 2); }
    const size_t kstep = (size_t)(BK * 2);
    const size_t hstepA = (size_t)HALF * lda, hstepB = (size_t)HALF * ldb;
    const unsigned ldsw = (unsigned)wid * 1024u;
    const int aoff = lds_byte(wr * 64 + fr, fq * 8), boff = lds_byte(wc * 32 + fr, fq * 8);
#define PG8_SA(b, h) (((b) * 2 + (h)) * HTB)
#define PG8_SB(b, h) ((4 + (b) * 2 + (h)) * HTB)
#define PG8_STAGE(bufoff, gbase, voff) do { _Pragma("unroll") for (int _i = 0; _i < 2; ++_i) \
        __builtin_amdgcn_global_load_lds((const unsigned*)((const char*)(gbase) + (voff)[_i]), (LAS unsigned*)(lds + (bufoff) + ldsw + _i * 8192), 16, 0, 0); } while (0)
#define PG8_LDA16(dst, b, h) do { _Pragma("unroll") for (int m = 0; m < 4; ++m) _Pragma("unroll") for (int k = 0; k < 2; ++k) dst[m][k] = *(const LAS bf16x8*)(lds + PG8_SA(b, h) + aoff + m * 2048 + k * 1024); } while (0)
#define PG8_LDB16(dst, b, h) do { _Pragma("unroll") for (int n = 0; n < 2; ++n) _Pragma("unroll") for (int k = 0; k < 2; ++k) dst[n][k] = *(const LAS bf16x8*)(lds + PG8_SB(b, h) + boff + n * 2048 + k * 1024); } while (0)
#define PG8_LD8(p) __builtin_shufflevector(*(const LAS i32x4*)(p), *(const LAS i32x4*)((p) + 1024), 0, 1, 2, 3, 4, 5, 6, 7)
#define PG8_LDA8(dst, b, h) do { _Pragma("unroll") for (int m = 0; m < 4; ++m) dst[m] = PG8_LD8(lds + PG8_SA(b, h) + aoff + m * 2048); } while (0)
#define PG8_LDB8(dst, b, h) do { _Pragma("unroll") for (int n = 0; n < 2; ++n) dst[n] = PG8_LD8(lds + PG8_SB(b, h) + boff + n * 2048); } while (0)
#define PG8_LDA(dst, b, h) do { if constexpr (F8) PG8_LDA8(dst##8, b, h); else PG8_LDA16(dst, b, h); } while (0)
#define PG8_LDB(dst, b, h) do { if constexpr (F8) PG8_LDB8(dst##8, b, h); else PG8_LDB16(dst, b, h); } while (0)
#define PG8_MMA16(ai, bj, At, Bt) do { __builtin_amdgcn_s_setprio(1); _Pragma("unroll") for (int m = 0; m < 4; ++m) _Pragma("unroll") for (int n = 0; n < 2; ++n) _Pragma("unroll") for (int k = 0; k < 2; ++k) \
        acc[ai][bj][m][n] = __builtin_amdgcn_mfma_f32_16x16x32_bf16(Bt[n][k], At[m][k], acc[ai][bj][m][n], 0, 0, 0); __builtin_amdgcn_s_setprio(0); } while (0)
#define PG8_MMA8(ai, bj, At, Bt) do { __builtin_amdgcn_s_setprio(1); _Pragma("unroll") for (int m = 0; m < 4; ++m) _Pragma("unroll") for (int n = 0; n < 2; ++n) \
        asm volatile("v_mfma_f32_16x16x128_f8f6f4 %0, %1, %2, %0" : "+v"(acc[ai][bj][m][n]) : "v"(Bt[n]), "v"(At[m])); __builtin_amdgcn_s_setprio(0); } while (0)
#define PG8_MFMA_DRAIN() do { if constexpr (F8) asm volatile("s_nop 15\n\ts_nop 15" ::: "memory"); } while (0)
#define PG8_MMA(ai, bj, At, Bt) do { if constexpr (F8) PG8_MMA8(ai, bj, At##8, Bt##8); else PG8_MMA16(ai, bj, At, Bt); } while (0)
#define PG8_WAIT_V(n) asm volatile("s_waitcnt vmcnt(" #n ")" ::: "memory")
#define PG8_WAIT_L(n) asm volatile("s_waitcnt lgkmcnt(" #n ")" ::: "memory")
#define PG8_BAR __builtin_amdgcn_s_barrier()
#define PG8_SCHED __builtin_amdgcn_sched_barrier(0)
    GUnit cur, nxt; int ui = 0;
    if (!S.next(0, cur)) return;
    f32x4 acc[2][2][4][2];
#pragma unroll
    for (int a = 0; a < 2; ++a)
#pragma unroll
        for (int b = 0; b < 2; ++b)
#pragma unroll
            for (int m = 0; m < 4; ++m)
#pragma unroll
                for (int n = 0; n < 2; ++n) acc[a][b][m][n] = (f32x4){0.f, 0.f, 0.f, 0.f};
    bf16x8 At[4][2], B0[2][2], B1[2][2];
    i32x8 At8[4], B08[2], B18[2];
    const char* cA = cur.a; const char* cB = cur.b;
    PG8_STAGE(PG8_SB(0, 0), cB, voffB); PG8_STAGE(PG8_SB(0, 1), cB + hstepB, voffB); PG8_STAGE(PG8_SA(0, 0), cA, voffA); PG8_STAGE(PG8_SA(0, 1), cA + hstepA, voffA);
    if (wr == 1) PG8_BAR;
    PG8_WAIT_V(2); PG8_BAR;
    PG8_STAGE(PG8_SB(1, 0), cB + kstep, voffB); PG8_STAGE(PG8_SA(1, 0), cA + kstep, voffA); PG8_STAGE(PG8_SB(1, 1), cB + hstepB + kstep, voffB);
    PG8_WAIT_V(6); PG8_BAR;
    for (;;) {
        const bool has_next = S.next(ui + 1, nxt);
        const char* nA = has_next ? nxt.a : cA; const char* nB = has_next ? nxt.b : cB;
        const int nt = cur.nt;
        bool qs = false; if constexpr (Epi::QSKIP) qs = cur.q != 0;
        const bool do0 = !(qs && wr == 1), do1 = !qs;
#pragma unroll 1
        for (int t = 0; t < nt; t += 2) {
            const bool last = (t == nt - 2);
            const char* a1 = cA + (size_t)(t + 1) * kstep;
            const char* a2 = last ? nA : cA + (size_t)(t + 2) * kstep; const char* b2 = last ? nB : cB + (size_t)(t + 2) * kstep;
            const char* a3 = a2 + kstep; const char* b3 = b2 + kstep;
            PG8_LDB(B0, 0, 0); PG8_LDB(B1, 0, 1); PG8_SCHED; PG8_LDA(At, 0, 0); PG8_STAGE(PG8_SA(1, 1), a1 + hstepA, voffA);
            PG8_WAIT_V(8); PG8_WAIT_L(0); PG8_BAR; if (do0) { PG8_MMA(0, 0, At, B0); PG8_MMA(0, 1, At, B1); } PG8_BAR; PG8_SCHED;
            PG8_LDA(At, 0, 1); PG8_STAGE(PG8_SB(0, 0), b2, voffB); PG8_STAGE(PG8_SB(0, 1), b2 + hstepB, voffB); PG8_STAGE(PG8_SA(0, 0), a2, voffA);
            PG8_WAIT_V(8); PG8_WAIT_L(0); PG8_BAR; if (do1) { PG8_MMA(1, 0, At, B0); PG8_MMA(1, 1, At, B1); } PG8_BAR; PG8_SCHED;
            PG8_LDB(B0, 1, 0); PG8_LDB(B1, 1, 1); PG8_SCHED; PG8_LDA(At, 1, 0); PG8_STAGE(PG8_SA(0, 1), a2 + hstepA, voffA);
            PG8_WAIT_V(8); PG8_WAIT_L(0); PG8_BAR; if (do0) { PG8_MMA(0, 0, At, B0); PG8_MMA(0, 1, At, B1); } PG8_BAR; PG8_SCHED;
            PG8_LDA(At, 1, 1); PG8_STAGE(PG8_SB(1, 0), b3, voffB); PG8_STAGE(PG8_SB(1, 1), b3 + hstepB, voffB); PG8_STAGE(PG8_SA(1, 0), a3, voffA);
            PG8_WAIT_V(8); PG8_WAIT_L(0); PG8_BAR; if (do1) { PG8_MMA(1, 0, At, B0); PG8_MMA(1, 1, At, B1); } PG8_BAR; PG8_SCHED;
        }
        if (wr == 0) PG8_BAR;
        PG8_MFMA_DRAIN();
        E(acc, cur, wr, wc, fr, fq);
        if (!has_next) break;
        bool zero = true; if constexpr (Epi::KEEPS) zero = !E.keep(cur);
        if (zero) {
#pragma unroll
        for (int a = 0; a < 2; ++a)
#pragma unroll
            for (int b = 0; b < 2; ++b)
#pragma unroll
                for (int m = 0; m < 4; ++m)
#pragma unroll
                    for (int n = 0; n < 2; ++n) acc[a][b][m][n] = (f32x4){0.f, 0.f, 0.f, 0.f};
        }
        cur = nxt; cA = nA; cB = nB; ++ui;
        if (wr == 1) PG8_BAR;
    }
    PG8_WAIT_V(0);
    PG8_BAR;
#undef PG8_SA
#undef PG8_SB
#undef PG8_STAGE
#undef PG8_LDA
#undef PG8_LDB
#undef PG8_MMA
#undef PG8_MMA8
#undef PG8_MFMA_DRAIN
#undef PG8_MMA16
#undef PG8_LDA8
#undef PG8_LDB8
#undef PG8_LDA16
#undef PG8_LDB16
#undef PG8_LD8
#undef PG8_WAIT_V
#undef PG8_WAIT_L
#undef PG8_BAR
#undef PG8_SCHED
}
template <class Epi, class Sched>
__device__ __forceinline__ void gemm_phase_mx(LAS unsigned char* lds, const int lda, const int ldb, const int lda8, const int ldb8, const Sched& S, const Epi& E) {
    int tz = threadIdx.x; asm volatile("" : "+v"(tz));
    const int tid = tz, wid = __builtin_amdgcn_readfirstlane(tid >> 6), lane = tid & 63, wr = wid >> 2, wc = wid & 3, fr = lane & 15, fq = lane >> 4;
    unsigned voffA[2], voffB[2], voffA8[2], voffB8[2];
#pragma unroll
    for (int i = 0; i < 2; ++i) { int R, C; stage_rc(tid * 16 + i * 8192, R, C); const int Rb = Epi::PERM ? ((R & ~31) + perm32(R & 31)) : R;
        voffA[i] = (unsigned)(R * lda + C * 2); voffB[i] = (unsigned)(Rb * ldb + C * 2); voffA8[i] = (unsigned)(R * lda8 + C * 2); voffB8[i] = (unsigned)(Rb * ldb8 + C * 2); }
    const size_t kstep = (size_t)(BK * 2);
    const size_t hsA = (size_t)HALF * lda, hsB = (size_t)HALF * ldb, hsA8 = (size_t)HALF * lda8, hsB8 = (size_t)HALF * ldb8;
    const unsigned ldsw = (unsigned)wid * 1024u;
    const int aoff = lds_byte(wr * 64 + fr, fq * 8), boff = lds_byte(wc * 32 + fr, fq * 8);
#define MX_SA(b, h) (((b) * 2 + (h)) * HTB)
#define MX_SB(b, h) ((4 + (b) * 2 + (h)) * HTB)
#define MX_STG(bufoff, gptr, v8, v16, fl) do { _Pragma("unroll") for (int _i = 0; _i < 2; ++_i) { const unsigned _v = (fl) ? (v8)[_i] : (v16)[_i]; \
        __builtin_amdgcn_global_load_lds((const unsigned*)((const char*)(gptr) + _v), (LAS unsigned*)(lds + (bufoff) + ldsw + _i * 8192), 16, 0, 0); } } while (0)
#define MX_STAGE_A(bufoff, gptr, fl) MX_STG(bufoff, gptr, voffA8, voffA, fl)
#define MX_STAGE_B(bufoff, gptr, fl) MX_STG(bufoff, gptr, voffB8, voffB, fl)
#define MX_HSA(fl) ((fl) ? hsA8 : hsA)
#define MX_HSB(fl) ((fl) ? hsB8 : hsB)
#define MX_LDA16(dst, b, h) do { _Pragma("unroll") for (int m = 0; m < 4; ++m) _Pragma("unroll") for (int k = 0; k < 2; ++k) dst[m][k] = *(const LAS bf16x8*)(lds + MX_SA(b, h) + aoff + m * 2048 + k * 1024); } while (0)
#define MX_LDB16(dst, b, h) do { _Pragma("unroll") for (int n = 0; n < 2; ++n) _Pragma("unroll") for (int k = 0; k < 2; ++k) dst[n][k] = *(const LAS bf16x8*)(lds + MX_SB(b, h) + boff + n * 2048 + k * 1024); } while (0)
#define MX_LD8(p) __builtin_shufflevector(*(const LAS i32x4*)(p), *(const LAS i32x4*)((p) + 1024), 0, 1, 2, 3, 4, 5, 6, 7)
#define MX_LDA8(dst, b, h) do { _Pragma("unroll") for (int m = 0; m < 4; ++m) dst[m] = MX_LD8(lds + MX_SA(b, h) + aoff + m * 2048); } while (0)
#define MX_LDB8(dst, b, h) do { _Pragma("unroll") for (int n = 0; n < 2; ++n) dst[n] = MX_LD8(lds + MX_SB(b, h) + boff + n * 2048); } while (0)
#define MX_HALF(x, k) ((k) == 0 ? __builtin_shufflevector(x, x, 0, 1, 2, 3) : __builtin_shufflevector(x, x, 4, 5, 6, 7))
#define MX_MMA16(ai, bj, At, Bt) do { __builtin_amdgcn_s_setprio(1); _Pragma("unroll") for (int k = 0; k < 2; ++k) _Pragma("unroll") for (int m = 0; m < 4; ++m) _Pragma("unroll") for (int n = 0; n < 2; ++n) \
        acc[ai][bj][m][n] = __builtin_amdgcn_mfma_f32_16x16x32_bf16(__builtin_bit_cast(bf16x8, MX_HALF(Bt[n], k)), __builtin_bit_cast(bf16x8, MX_HALF(At[m], k)), acc[ai][bj][m][n], 0, 0, 0); __builtin_amdgcn_s_setprio(0); } while (0)
#define MX_MMA8(ai, bj, At, Bt) do { __builtin_amdgcn_s_setprio(1); _Pragma("unroll") for (int m = 0; m < 4; ++m) _Pragma("unroll") for (int n = 0; n < 2; ++n) \
        asm volatile("v_mfma_f32_16x16x128_f8f6f4 %0, %1, %2, %0" : "+v"(acc[ai][bj][m][n]) : "v"(Bt[n]), "v"(At[m])); __builtin_amdgcn_s_setprio(0); } while (0)
#define MX_WAIT_V(n) asm volatile("s_waitcnt vmcnt(" #n ")" ::: "memory")
#define MX_WAIT_L(n) asm volatile("s_waitcnt lgkmcnt(" #n ")" ::: "memory")
#define MX_BAR __builtin_amdgcn_s_barrier()
#define MX_SCHED __builtin_amdgcn_sched_barrier(0)
    GUnit cur, nxt; int ui = 0;
    if (!S.next(0, cur)) return;
    f32x4 acc[2][2][4][2];
#pragma unroll
    for (int a = 0; a < 2; ++a)
#pragma unroll
        for (int b = 0; b < 2; ++b)
#pragma unroll
            for (int m = 0; m < 4; ++m)
#pragma unroll
                for (int n = 0; n < 2; ++n) acc[a][b][m][n] = (f32x4){0.f, 0.f, 0.f, 0.f};
    i32x8 At8[4], B08[2], B18[2];
    const char* cA = cur.a; const char* cB = cur.b;
    { const bool fc = cur.f8 != 0;
      MX_STAGE_B(MX_SB(0, 0), cB, fc); MX_STAGE_B(MX_SB(0, 1), cB + MX_HSB(fc), fc); MX_STAGE_A(MX_SA(0, 0), cA, fc); MX_STAGE_A(MX_SA(0, 1), cA + MX_HSA(fc), fc);
      if (wr == 1) MX_BAR;
      MX_WAIT_V(2); MX_BAR;
      MX_STAGE_B(MX_SB(1, 0), cB + kstep, fc); MX_STAGE_A(MX_SA(1, 0), cA + kstep, fc); MX_STAGE_B(MX_SB(1, 1), cB + MX_HSB(fc) + kstep, fc);
      MX_WAIT_V(6); MX_BAR; }
    for (;;) {
        const bool has_next = S.next(ui + 1, nxt);
        const char* nA = has_next ? nxt.a : cA; const char* nB = has_next ? nxt.b : cB;
        const bool fc = cur.f8 != 0, fnx = has_next ? (nxt.f8 != 0) : fc;
        const int nt = cur.nt;
#pragma unroll 1
        for (int t = 0; t < nt; t += 2) {
            const bool last = (t == nt - 2); const bool f2 = last ? fnx : fc;
            const char* a1 = cA + (size_t)(t + 1) * kstep;
            const char* a2 = last ? nA : cA + (size_t)(t + 2) * kstep; const char* b2 = last ? nB : cB + (size_t)(t + 2) * kstep;
            const char* a3 = a2 + kstep; const char* b3 = b2 + kstep;
            MX_LDB8(B08, 0, 0); MX_LDB8(B18, 0, 1); MX_SCHED; MX_LDA8(At8, 0, 0);
            MX_STAGE_A(MX_SA(1, 1), a1 + MX_HSA(fc), fc);
            MX_WAIT_V(8); MX_WAIT_L(0); MX_BAR; if (fc) { MX_MMA8(0, 0, At8, B08); MX_MMA8(0, 1, At8, B18); } else { MX_MMA16(0, 0, At8, B08); MX_MMA16(0, 1, At8, B18); } MX_BAR; MX_SCHED;
            MX_LDA8(At8, 0, 1);
            MX_STAGE_B(MX_SB(0, 0), b2, f2); MX_STAGE_B(MX_SB(0, 1), b2 + MX_HSB(f2), f2); MX_STAGE_A(MX_SA(0, 0), a2, f2);
            MX_WAIT_V(8); MX_WAIT_L(0); MX_BAR; if (fc) { MX_MMA8(1, 0, At8, B08); MX_MMA8(1, 1, At8, B18); } else { MX_MMA16(1, 0, At8, B08); MX_MMA16(1, 1, At8, B18); } MX_BAR; MX_SCHED;
            MX_LDB8(B08, 1, 0); MX_LDB8(B18, 1, 1); MX_SCHED; MX_LDA8(At8, 1, 0);
            MX_STAGE_A(MX_SA(0, 1), a2 + MX_HSA(f2), f2);
            MX_WAIT_V(8); MX_WAIT_L(0); MX_BAR; if (fc) { MX_MMA8(0, 0, At8, B08); MX_MMA8(0, 1, At8, B18); } else { MX_MMA16(0, 0, At8, B08); MX_MMA16(0, 1, At8, B18); } MX_BAR; MX_SCHED;
            MX_LDA8(At8, 1, 1);
            MX_STAGE_B(MX_SB(1, 0), b3, f2); MX_STAGE_B(MX_SB(1, 1), b3 + MX_HSB(f2), f2); MX_STAGE_A(MX_SA(1, 0), a3, f2);
            MX_WAIT_V(8); MX_WAIT_L(0); MX_BAR; if (fc) { MX_MMA8(1, 0, At8, B08); MX_MMA8(1, 1, At8, B18); } else { MX_MMA16(1, 0, At8, B08); MX_MMA16(1, 1, At8, B18); } MX_BAR; MX_SCHED;
        }
        if (wr == 0) MX_BAR;
        asm volatile("s_nop 15\n\ts_nop 15" ::: "memory");
        E(acc, cur, wr, wc, fr, fq);
        if (!has_next) break;
        bool zero = true; if constexpr (Epi::KEEPS) zero = !E.keep(cur);
        if (zero) {
#pragma unroll
        for (int a = 0; a < 2; ++a)
#pragma unroll
            for (int b = 0; b < 2; ++b)
#pragma unroll
                for (int m = 0; m < 4; ++m)
#pragma unroll
                    for (int n = 0; n < 2; ++n) acc[a][b][m][n] = (f32x4){0.f, 0.f, 0.f, 0.f};
        }
        cur = nxt; cA = nA; cB = nB; ++ui;
        if (wr == 1) MX_BAR;
    }
    MX_WAIT_V(0);
    MX_BAR;
#undef MX_SA
#undef MX_SB
#undef MX_STG
#undef MX_STAGE_A
#undef MX_STAGE_B
#undef MX_HSA
#undef MX_HSB
#undef MX_LDA16
#undef MX_LDB16
#undef MX_LD8
#undef MX_HALF
#undef MX_LDA8
#undef MX_LDB8
#undef MX_MMA16
#undef MX_MMA8
#undef MX_WAIT_V
#undef MX_WAIT_L
#undef MX_BAR
#undef MX_SCHED
}
}
#ifndef ATT_STAGGER
#define ATT_STAGGER 0
#endif
#ifndef ATT_PRIO
#define ATT_PRIO 1
#endif
#ifndef ATT_PKSUM
#define ATT_PKSUM 0
#endif
#ifndef ATT_WIDE_ST
#define ATT_WIDE_ST 1
#endif
#ifndef ATT_ILV
#define ATT_ILV 0
#endif
#ifndef ATT_NV
#define ATT_NV 5
#endif
#ifndef ATT_NE
#define ATT_NE 1
#endif
#ifndef ATT_QKPIPE
#define ATT_QKPIPE 1
#endif
namespace att {
constexpr int LDP = 10240, LDO = 2048, KVBLK = 64;
constexpr int SHM_V = KVBLK * 128 * 2, SHM_K = KVBLK * 128 * 2;
constexpr int LDS_WS = 2 * SHM_V + 2 * SHM_K, LDS_BYTES = LDS_WS + 8 * 64 * 4;
constexpr float THR2 = 11.5415603f;
#define KSWZ(row, colB) ((row) * 256 + ((colB) ^ (((row) & 7) << 4)))
#define SBAR() __builtin_amdgcn_sched_barrier(0)
__device__ __forceinline__ int crow(int r, int hi) { return (r & 3) + 8 * (r >> 2) + 4 * hi; }

struct AUnit {
    int qrow0;
    int qcol, kcol, vcol;
    int ocol;
    int nlat_t;
    int lat_row0;
    int ctx_row0;
    int dpos;
    float sink2;
};

#define AEXP(x) (VAR == 2 ? (x) * 0.001f : __builtin_amdgcn_exp2f(x))
template <int KIND, int VAR = 0> __device__ __forceinline__ void partialSM(f32x16& p0, f32x16& p1, float& m_reg, float& mn, float& alpha, bool do_mask, int jrel, int hi) {
    if (KIND == 2) { if (do_mask) {
#pragma unroll
        for (int r = 0; r < 16; ++r) { const int d0 = jrel + crow(r, hi), d1 = d0 + 32;
            p0[r] = (d0 <= 128 && d0 >= -128) ? p0[r] : -1e30f; p1[r] = (d1 <= 128 && d1 >= -128) ? p1[r] : -1e30f; } } }
    if (VAR == 20) {
        mn = 0.f; alpha = 1.f;
#pragma unroll
        for (int r = 0; r < 16; ++r) p0[r] = __builtin_amdgcn_exp2f(p0[r]);
        return; }
    float pmax = p0[0];
#pragma unroll
    for (int r = 1; r < 16; ++r) pmax = fmaxf(pmax, p0[r]);
#pragma unroll
    for (int r = 0; r < 16; ++r) pmax = fmaxf(pmax, p1[r]);
    { auto rr = __builtin_amdgcn_permlane32_swap(__float_as_uint(pmax), __float_as_uint(pmax), false, false);
      pmax = fmaxf(__uint_as_float(rr[0]), __uint_as_float(rr[1])); }
    if (__builtin_expect(__all(pmax - m_reg <= THR2), 1)) { mn = m_reg; alpha = 1.f; }
    else { mn = fmaxf(m_reg, pmax); alpha = __builtin_amdgcn_exp2f(m_reg - mn); m_reg = mn; }
#pragma unroll
    for (int r = 0; r < 16; ++r) p0[r] = p0[r] - mn;
#pragma unroll
    for (int r = 0; r < 16; ++r) p1[r] = p1[r] - mn;
#pragma unroll
    for (int r = 0; r < 16; ++r) p0[r] = AEXP(p0[r]);
}
template <int VAR = 0> __device__ __forceinline__ void finishSM(f32x16& p0, f32x16& p1, float alpha, float& l_reg, bf16x8& pa0, bf16x8& pa1, bf16x8& pa2, bf16x8& pa3) {
#pragma unroll
    for (int r = 0; r < 16; ++r) p1[r] = AEXP(p1[r]);
#if ATT_PKSUM
    f32x2 s2a = {p0[0], p0[1]}, s2b = {p1[0], p1[1]};
#pragma unroll
    for (int r = 1; r < 8; ++r) { s2a = s2a + (f32x2){p0[2 * r], p0[2 * r + 1]}; s2b = s2b + (f32x2){p1[2 * r], p1[2 * r + 1]}; }
    s2a = s2a + s2b; float ps = s2a[0] + s2a[1];
#else
    float ps = 0;
#pragma unroll
    for (int r = 0; r < 16; ++r) ps += p0[r];
#pragma unroll
    for (int r = 0; r < 16; ++r) ps += p1[r];
#endif
    { auto rr = __builtin_amdgcn_permlane32_swap(__float_as_uint(ps), __float_as_uint(ps), false, false);
      ps = __uint_as_float(rr[0]) + __uint_as_float(rr[1]); }
    l_reg = VAR == 20 ? l_reg + ps : l_reg * alpha + ps;
#define PK4(P, BASE, OUT) do { unsigned a0 = cvt_pk_bf16(P[BASE + 0], P[BASE + 1]), a1 = cvt_pk_bf16(P[BASE + 2], P[BASE + 3]);   \
    unsigned b0 = cvt_pk_bf16(P[BASE + 4], P[BASE + 5]), b1 = cvt_pk_bf16(P[BASE + 6], P[BASE + 7]);                              \
    auto r0 = __builtin_amdgcn_permlane32_swap(a0, b0, false, false); auto r1 = __builtin_amdgcn_permlane32_swap(a1, b1, false, false); \
    u32x4 w = {r0[0], r1[0], r0[1], r1[1]}; OUT = *reinterpret_cast<bf16x8*>(&w); } while (0)
    PK4(p0, 0, pa0); PK4(p0, 8, pa1); PK4(p1, 0, pa2); PK4(p1, 8, pa3);
#undef PK4
}
template <int DQ, int VAR = 0> __device__ __forceinline__ void qkt(f32x16& p0, f32x16& p1, const LAS char* Ks, const bf16x8* qr, int r32, int hi, int dbase) {
    p0 = f32x16{}; p1 = f32x16{};
    if (VAR == 3) {
#pragma unroll
        for (int r = 0; r < 16; ++r) { p0[r] = (float)(r + r32) * 0.01f; p1[r] = (float)(r - hi) * 0.02f; }
        return; }
#if ATT_QKPIPE
    bf16x8 kb[2][2];
    { const int cb = (dbase * 16 + hi * 8) * 2; kb[0][0] = *reinterpret_cast<const LAS bf16x8*>(Ks + KSWZ(r32, cb)); kb[0][1] = *reinterpret_cast<const LAS bf16x8*>(Ks + KSWZ(32 + r32, cb)); }
#pragma unroll
    for (int d0 = 0; d0 < DQ; ++d0) {
        if (VAR == 9) { kb[(d0 + 1) & 1][0] = kb[d0 & 1][0]; kb[(d0 + 1) & 1][1] = kb[d0 & 1][1]; }
        else if (d0 + 1 < DQ) { const int cb = ((dbase + d0 + 1) * 16 + hi * 8) * 2;
            kb[(d0 + 1) & 1][0] = *reinterpret_cast<const LAS bf16x8*>(Ks + KSWZ(r32, cb)); kb[(d0 + 1) & 1][1] = *reinterpret_cast<const LAS bf16x8*>(Ks + KSWZ(32 + r32, cb)); }
        p0 = __builtin_amdgcn_mfma_f32_32x32x16_bf16(kb[d0 & 1][0], qr[d0], p0, 0, 0, 0);
        p1 = __builtin_amdgcn_mfma_f32_32x32x16_bf16(kb[d0 & 1][1], qr[d0], p1, 0, 0, 0); }
    if (VAR != 9 && !ATT_ILV) { __builtin_amdgcn_sched_group_barrier(0x100, 2, 0);
#pragma unroll
    for (int d0 = 0; d0 < DQ; ++d0) { if (d0 + 1 < DQ) __builtin_amdgcn_sched_group_barrier(0x100, 2, 0); __builtin_amdgcn_sched_group_barrier(0x008, 2, 0); } }
#else
#pragma unroll
    for (int d0 = 0; d0 < DQ; ++d0) { const int cb = ((dbase + d0) * 16 + hi * 8) * 2;
        const bf16x8 b0 = *reinterpret_cast<const LAS bf16x8*>(Ks + KSWZ(r32, cb));
        const bf16x8 b1 = *reinterpret_cast<const LAS bf16x8*>(Ks + KSWZ(32 + r32, cb));
        p0 = __builtin_amdgcn_mfma_f32_32x32x16_bf16(b0, qr[d0], p0, 0, 0, 0);
        p1 = __builtin_amdgcn_mfma_f32_32x32x16_bf16(b1, qr[d0], p1, 0, 0, 0); }
#endif
}
__device__ __forceinline__ int v_st(int k, int c) { const int kk = (k & ~0xC) | ((k & 4) << 1) | ((k & 8) >> 1); return ((kk >> 3) * 4 + (c >> 5)) * 512 + ((kk & 7) * 32 + (c & 31)) * 2; }
__device__ __forceinline__ int v_rd_base(int lane) { return ((lane & 3) << 3) | (((lane >> 2) & 3) << 6) | (((lane >> 4) & 1) << 5) | (((lane >> 5) & 1) << 8); }
constexpr int v_rd_off(int d0, int ks, int half) { return d0 * 512 + ks * 4096 + half * 2048; }
template <int OFF> __device__ __forceinline__ s16x4 tr_read(int vb) {
    s16x4 r; asm volatile("ds_read_b64_tr_b16 %0, %1 offset:%2" : "=&v"(r) : "v"(vb), "i"(OFF) : "memory"); return r;
}
template <int D0> __device__ __forceinline__ void pv_one(f32x16& od, int vb, bf16x8 pa0, bf16x8 pa1, bf16x8 pa2, bf16x8 pa3) {
    const s16x4 l0 = tr_read<v_rd_off(D0, 0, 0)>(vb), h0 = tr_read<v_rd_off(D0, 0, 1)>(vb), l1 = tr_read<v_rd_off(D0, 1, 0)>(vb), h1 = tr_read<v_rd_off(D0, 1, 1)>(vb);
    const s16x4 l2 = tr_read<v_rd_off(D0, 2, 0)>(vb), h2 = tr_read<v_rd_off(D0, 2, 1)>(vb), l3 = tr_read<v_rd_off(D0, 3, 0)>(vb), h3 = tr_read<v_rd_off(D0, 3, 1)>(vb);
    asm volatile("s_waitcnt lgkmcnt(0)" ::: "memory"); SBAR();
#define PKV(L, H) (bf16x8){L[0], L[1], L[2], L[3], H[0], H[1], H[2], H[3]}
    od = __builtin_amdgcn_mfma_f32_32x32x16_bf16(pa0, PKV(l0, h0), od, 0, 0, 0);
    od = __builtin_amdgcn_mfma_f32_32x32x16_bf16(pa1, PKV(l1, h1), od, 0, 0, 0);
    od = __builtin_amdgcn_mfma_f32_32x32x16_bf16(pa2, PKV(l2, h2), od, 0, 0, 0);
    od = __builtin_amdgcn_mfma_f32_32x32x16_bf16(pa3, PKV(l3, h3), od, 0, 0, 0);
#undef PKV
}
__device__ __forceinline__ void pv_d0(f32x16* o, int vb, bf16x8 pa0, bf16x8 pa1, bf16x8 pa2, bf16x8 pa3) {
    pv_one<0>(o[0], vb, pa0, pa1, pa2, pa3); pv_one<1>(o[1], vb, pa0, pa1, pa2, pa3); pv_one<2>(o[2], vb, pa0, pa1, pa2, pa3); pv_one<3>(o[3], vb, pa0, pa1, pa2, pa3);
}

template <int D0> __device__ __forceinline__ void pv_one_b(f32x16& od, const LAS char* vp, bf16x8 pa0, bf16x8 pa1, bf16x8 pa2, bf16x8 pa3) {
#define TRB(OFF) __builtin_amdgcn_ds_read_tr16_b64_v4i16((LAS s16x4*)(vp + (OFF)))
    const s16x4 l0 = TRB(v_rd_off(D0, 0, 0)), h0 = TRB(v_rd_off(D0, 0, 1)), l1 = TRB(v_rd_off(D0, 1, 0)), h1 = TRB(v_rd_off(D0, 1, 1));
    const s16x4 l2 = TRB(v_rd_off(D0, 2, 0)), h2 = TRB(v_rd_off(D0, 2, 1)), l3 = TRB(v_rd_off(D0, 3, 0)), h3 = TRB(v_rd_off(D0, 3, 1));
#undef TRB
#define PKV(L, H) (bf16x8){L[0], L[1], L[2], L[3], H[0], H[1], H[2], H[3]}
    od = __builtin_amdgcn_mfma_f32_32x32x16_bf16(pa0, PKV(l0, h0), od, 0, 0, 0);
    od = __builtin_amdgcn_mfma_f32_32x32x16_bf16(pa1, PKV(l1, h1), od, 0, 0, 0);
    od = __builtin_amdgcn_mfma_f32_32x32x16_bf16(pa2, PKV(l2, h2), od, 0, 0, 0);
    od = __builtin_amdgcn_mfma_f32_32x32x16_bf16(pa3, PKV(l3, h3), od, 0, 0, 0);
#undef PKV
}
__device__ __forceinline__ void pv_d0_b(f32x16* o, const LAS char* vp, bf16x8 pa0, bf16x8 pa1, bf16x8 pa2, bf16x8 pa3) {
    pv_one_b<0>(o[0], vp, pa0, pa1, pa2, pa3); pv_one_b<1>(o[1], vp, pa0, pa1, pa2, pa3); pv_one_b<2>(o[2], vp, pa0, pa1, pa2, pa3); pv_one_b<3>(o[3], vp, pa0, pa1, pa2, pa3);
}
template <int NM, int NV> __device__ __forceinline__ void ilv_qk() {
    __builtin_amdgcn_sched_group_barrier(0x100, 4, 0);
#pragma unroll
    for (int i = 0; i < NM; ++i) { __builtin_amdgcn_sched_group_barrier(0x008, 1, 0); __builtin_amdgcn_sched_group_barrier(0x400, ATT_NE, 0); __builtin_amdgcn_sched_group_barrier(0x002, NV, 0); if ((i & 1) && i + 3 < NM) __builtin_amdgcn_sched_group_barrier(0x100, 2, 0); }
}
template <int NV> __device__ __forceinline__ void ilv_pv() {
    __builtin_amdgcn_sched_group_barrier(0x100, 8, 0);
#pragma unroll
    for (int i = 0; i < 16; ++i) { __builtin_amdgcn_sched_group_barrier(0x008, 1, 0); __builtin_amdgcn_sched_group_barrier(0x002, NV, 0); __builtin_amdgcn_sched_group_barrier(0x400, ATT_NE, 0); if (i < 12) __builtin_amdgcn_sched_group_barrier(0x100, 2, 0); }
}
__device__ __forceinline__ float vadd_pin(float a, float b) { float r; asm volatile("v_add_f32 %0, %1, %2" : "=v"(r) : "v"(a), "v"(b)); return r; }
__device__ __forceinline__ float vexp_pin(float a) { float r; asm volatile("v_exp_f32 %0, %1" : "=v"(r) : "v"(a)); return r; }
__device__ __forceinline__ void plswap_pin(unsigned& a, unsigned& b) { asm volatile("v_permlane32_swap_b32 %0, %1" : "+v"(a), "+v"(b)); }
template <int DQ>
__device__ __forceinline__ void qk_fin(f32x16& q0, f32x16& q1, const LAS char* Ks, const bf16x8* qr, int r32, int hi, int dbase,
                                       f32x16& p0, f32x16& p1, float alpha, float& l_reg, bf16x8& pa0, bf16x8& pa1, bf16x8& pa2, bf16x8& pa3) {
    q0 = f32x16{}; q1 = f32x16{};
    constexpr int SPM = 8 / DQ;
    bf16x8 ka, kc;
    { const int cb = (dbase * 16 + hi * 8) * 2; ka = *reinterpret_cast<const LAS bf16x8*>(Ks + KSWZ(r32, cb)); kc = *reinterpret_cast<const LAS bf16x8*>(Ks + KSWZ(32 + r32, cb)); }
    float psa = 0.f, psb = 0.f; unsigned c0 = 0, c1 = 0, c2 = 0, c3 = 0;
#define QF_PERM(OUT) do { plswap_pin(c0, c2); plswap_pin(c1, c3); u32x4 w_ = {c0, c1, c2, c3}; OUT = *reinterpret_cast<bf16x8*>(&w_); } while (0)
#define QF_CVT(P, B, k) do { const unsigned v_ = cvt_pk_bf16(P[(B) + 2 * (k)], P[(B) + 2 * (k) + 1]); if ((k) == 0) c0 = v_; else if ((k) == 1) c1 = v_; else if ((k) == 2) c2 = v_; else c3 = v_; } while (0)
#pragma unroll
    for (int d0 = 0; d0 < DQ; ++d0) {
        const int cbn = ((dbase + d0 + 1) * 16 + hi * 8) * 2;
#pragma unroll
        for (int h = 0; h < 2; ++h) {
            SBAR();
            if (h == 0) { q0 = __builtin_amdgcn_mfma_f32_32x32x16_bf16(ka, qr[d0], q0, 0, 0, 0); if (d0 + 1 < DQ) ka = *reinterpret_cast<const LAS bf16x8*>(Ks + KSWZ(r32, cbn)); }
            else        { q1 = __builtin_amdgcn_mfma_f32_32x32x16_bf16(kc, qr[d0], q1, 0, 0, 0); if (d0 + 1 < DQ) kc = *reinterpret_cast<const LAS bf16x8*>(Ks + KSWZ(32 + r32, cbn)); }
#pragma unroll
            for (int s_ = 0; s_ < SPM; ++s_) { const int i = (2 * d0 + h) * SPM + s_;
                p1[i] = vexp_pin(p1[i]); psa = vadd_pin(psa, p0[i]); if (i > 0) psb = vadd_pin(psb, p1[i - 1]);
                if (i < 4) QF_CVT(p0, 0, i); else if (i == 4) QF_PERM(pa0);
                else if (i < 9) QF_CVT(p0, 8, i - 5); else if (i == 9) QF_PERM(pa1);
                else if (i < 14) QF_CVT(p1, 0, i - 10); else if (i == 14) QF_PERM(pa2); }
        }
    }
    SBAR();
    psb += p1[15];
    QF_CVT(p1, 8, 0); QF_CVT(p1, 8, 1); QF_CVT(p1, 8, 2); QF_CVT(p1, 8, 3); QF_PERM(pa3);
    float ps = psa + psb;
    { auto rr = __builtin_amdgcn_permlane32_swap(__float_as_uint(ps), __float_as_uint(ps), false, false); ps = __uint_as_float(rr[0]) + __uint_as_float(rr[1]); }
    l_reg = l_reg * alpha + ps;
#undef QF_PERM
#undef QF_CVT
}
template <int KIND, bool G2, int VAR>
__device__ __forceinline__ void attn_unit_impl(const AUnit u, const bf16_t* __restrict__ P, bf16_t* __restrict__ O, unsigned char* __restrict__ O8  , LAS char* lds, float lam, float osc, const float* __restrict__ subln) {
    constexpr int DQ = KIND == 1 ? 4 : 8;
    int tz = threadIdx.x; asm volatile("" : "+v"(tz));
    const int tid = tz, wid = __builtin_amdgcn_readfirstlane(tid >> 6), lane = tid & 63, r32 = lane & 31, hi = lane >> 5;
    if (ATT_PRIO && wid >= 4) __builtin_amdgcn_s_setprio(1);
    LAS char* V_lds = lds; LAS char* K_lds = lds + 2 * SHM_V;
    LAS float* ws = (LAS float*)(lds + LDS_WS) + wid * 64; LAS float* li_l = ws; LAS float* al_l = ws + 32;
    float m_reg = VAR == 20 ? 0.f : -1e30f, l_reg = 0; f32x16 o[4] = {}; bf16x8 qr[DQ];
    const int wq = KIND == 1 ? (wid & 3) : wid, mp = KIND == 1 ? (wid >> 2) : 0, dbase = mp * 4;
    const bf16_t* Qw = P + (long)(u.qrow0 + wq * 32 + r32) * LDP + u.qcol + mp * 64 + hi * 8;
#pragma unroll
    for (int d0 = 0; d0 < DQ; ++d0) qr[d0] = *reinterpret_cast<const bf16x8*>(Qw + d0 * 16);
    const int sr = tid >> 4, sc = (tid & 15) * 8, vst0 = v_st(sr, sc), vst1 = v_st(32 + sr, sc);
    const int vb0 = (int)(unsigned)(size_t)V_lds + v_rd_base(lane);
    const int NT = 4 + u.nlat_t;
    const bf16_t* Kc = P + u.kcol + sc; const bf16_t* Vc = P + u.vcol + sc;
    struct { bf16x8 vs0, vs1, ks0, ks1; } sr_[2];
#define TROW(t) ((t) < 4 ? u.ctx_row0 + (t) * KVBLK : u.lat_row0 + ((t) - 4) * KVBLK)
#define SLOAD(i, t) do { if (VAR >= 5 && VAR <= 6 && (t) > 0) break; const long _r0 = (long)(TROW(t) + sr) * LDP, _r1 = _r0 + 32L * LDP; \
    sr_[i].vs0 = *reinterpret_cast<const bf16x8*>(Vc + _r0); sr_[i].vs1 = *reinterpret_cast<const bf16x8*>(Vc + _r1); \
    sr_[i].ks0 = *reinterpret_cast<const bf16x8*>(Kc + _r0); sr_[i].ks1 = *reinterpret_cast<const bf16x8*>(Kc + _r1); } while (0)
#define SWRITE(b, i) do { if (VAR == 6 && started) break; *(LAS bf16x8*)(V_lds + (b) * SHM_V + vst0) = sr_[i].vs0; *(LAS bf16x8*)(V_lds + (b) * SHM_V + vst1) = sr_[i].vs1; const int kc = sc * 2; \
    *(LAS bf16x8*)(K_lds + (b) * SHM_K + KSWZ(sr, kc)) = sr_[i].ks0; *(LAS bf16x8*)(K_lds + (b) * SHM_K + KSWZ(32 + sr, kc)) = sr_[i].ks1; } while (0)
#define SWAIT() asm volatile("s_waitcnt vmcnt(4)" ::: "memory")
#define RESC(a) do { if (VAR != 20 && __any((a) < 1.f)) { if (hi == 0) al_l[r32] = (a); asm volatile("s_waitcnt lgkmcnt(0)" ::: "memory"); \
    _Pragma("unroll") for (int d = 0; d < 4; ++d) _Pragma("unroll") for (int r = 0; r < 16; ++r) o[d][r] *= al_l[crow(r, hi)]; } } while (0)
    const int jq = u.dpos - (wq * 32 + r32);
#define JREL(t) (jq + ((t) - 4) * KVBLK)
#define PVD(vb) do { if (VAR == 10) { const s16x4 l0 = tr_read<v_rd_off(0, 0, 0)>(vb), h0 = tr_read<v_rd_off(0, 0, 1)>(vb), l1 = tr_read<v_rd_off(0, 1, 0)>(vb), h1 = tr_read<v_rd_off(0, 1, 1)>(vb); asm volatile("s_waitcnt lgkmcnt(0)" ::: "memory"); \
        const bf16x8 f0 = (bf16x8){l0[0], l0[1], l0[2], l0[3], h0[0], h0[1], h0[2], h0[3]}, f1 = (bf16x8){l1[0], l1[1], l1[2], l1[3], h1[0], h1[1], h1[2], h1[3]}; \
        _Pragma("unroll") for (int d_ = 0; d_ < 4; ++d_) { o[d_] = __builtin_amdgcn_mfma_f32_32x32x16_bf16(pa0, f0, o[d_], 0, 0, 0); o[d_] = __builtin_amdgcn_mfma_f32_32x32x16_bf16(pa1, f1, o[d_], 0, 0, 0); o[d_] = __builtin_amdgcn_mfma_f32_32x32x16_bf16(pa2, f0, o[d_], 0, 0, 0); o[d_] = __builtin_amdgcn_mfma_f32_32x32x16_bf16(pa3, f1, o[d_], 0, 0, 0); } } else if (VAR == 4) { const u32x4 a_ = *(const u32x4*)&pa0, b_ = *(const u32x4*)&pa1, c_ = *(const u32x4*)&pa2, d_ = *(const u32x4*)&pa3; const u32x4 x_ = a_ ^ b_ ^ c_ ^ d_; o[0][0] += __uint_as_float((x_.x ^ x_.y ^ x_.z ^ x_.w) & 0x3fffffffu) * 1e-30f; } else if (ATT_ILV) pv_d0_b(o, (const LAS char*)(size_t)0 + (vb), pa0, pa1, pa2, pa3); else pv_d0(o, vb, pa0, pa1, pa2, pa3); } while (0)
#define LSYNC() do { if (VAR != 7) __syncthreads(); } while (0)
    f32x16 pA0, pA1, pB0, pB1; float mnA, mnB, alA, alB; bf16x8 pa0, pa1, pa2, pa3;
    constexpr int SE = 0, SO = 1; bool started = false;
    SLOAD(SE, 0); asm volatile("s_waitcnt vmcnt(0)" ::: "memory"); SWRITE(0, SE); __syncthreads();
    qkt<DQ, VAR>(pA0, pA1, K_lds, qr, r32, hi, dbase); partialSM<KIND, VAR>(pA0, pA1, m_reg, mnA, alA, false, 0, hi);
    SLOAD(SO, 1); if (2 < NT) SLOAD(SE, 2);
    SWAIT(); SWRITE(1, SO); __syncthreads(); started = true;
    constexpr bool g2 = G2;
    for (int j = 1; j + 1 < NT; j += 2) {
        if (!g2) {
            if (ATT_ILV == 2 && (VAR == 0 || VAR == 8 || VAR == 20)) { SBAR(); qk_fin<DQ>(pB0, pB1, K_lds + SHM_K, qr, r32, hi, dbase, pA0, pA1, alA, l_reg, pa0, pa1, pa2, pa3); SBAR(); } else {
            SBAR(); qkt<DQ, VAR>(pB0, pB1, K_lds + SHM_K, qr, r32, hi, dbase);
            finishSM<VAR>(pA0, pA1, alA, l_reg, pa0, pa1, pa2, pa3); if (ATT_ILV == 1) ilv_qk<2 * DQ, ATT_NV>(); SBAR(); }
            SLOAD(SO, j + 2); SBAR();
            PVD(vb0); partialSM<KIND, VAR>(pB0, pB1, m_reg, mnB, alB, j >= 4, JREL(j), hi); if (ATT_ILV == 1) ilv_pv<ATT_NV>();
        } else {
            SBAR(); finishSM<VAR>(pA0, pA1, alA, l_reg, pa0, pa1, pa2, pa3); SBAR();
            qkt<DQ, VAR>(pB0, pB1, K_lds + SHM_K, qr, r32, hi, dbase); SLOAD(SO, j + 2); SBAR();
            partialSM<KIND, VAR>(pB0, pB1, m_reg, mnB, alB, j >= 4, JREL(j), hi); SBAR();
            PVD(vb0);
        }
        LSYNC(); SWAIT(); SWRITE(0, SE);
        RESC(alB); LSYNC();
        if (!g2) {
            if (ATT_ILV == 2 && (VAR == 0 || VAR == 8 || VAR == 20)) { SBAR(); qk_fin<DQ>(pA0, pA1, K_lds, qr, r32, hi, dbase, pB0, pB1, alB, l_reg, pa0, pa1, pa2, pa3); SBAR(); } else {
            SBAR(); qkt<DQ, VAR>(pA0, pA1, K_lds, qr, r32, hi, dbase);
            finishSM<VAR>(pB0, pB1, alB, l_reg, pa0, pa1, pa2, pa3); if (ATT_ILV == 1) ilv_qk<2 * DQ, ATT_NV>(); SBAR(); }
            if (j + 3 < NT) SLOAD(SE, j + 3); SBAR();
            PVD(vb0 + SHM_V); partialSM<KIND, VAR>(pA0, pA1, m_reg, mnA, alA, j + 1 >= 4, JREL(j + 1), hi); if (ATT_ILV == 1) ilv_pv<ATT_NV>();
        } else {
            SBAR(); finishSM<VAR>(pB0, pB1, alB, l_reg, pa0, pa1, pa2, pa3); SBAR();
            qkt<DQ, VAR>(pA0, pA1, K_lds, qr, r32, hi, dbase); if (j + 3 < NT) SLOAD(SE, j + 3); SBAR();
            partialSM<KIND, VAR>(pA0, pA1, m_reg, mnA, alA, j + 1 >= 4, JREL(j + 1), hi); SBAR();
            PVD(vb0 + SHM_V);
        }
        LSYNC(); SWAIT(); SWRITE(1, SO);
        RESC(alA); LSYNC();
    }
    SBAR(); qkt<DQ, VAR>(pB0, pB1, K_lds + SHM_K, qr, r32, hi, dbase);
    finishSM<VAR>(pA0, pA1, alA, l_reg, pa0, pa1, pa2, pa3); SBAR();
    PVD(vb0); partialSM<KIND, VAR>(pB0, pB1, m_reg, mnB, alB, NT - 1 >= 4, JREL(NT - 1), hi);
    __syncthreads(); RESC(alB);
    finishSM<VAR>(pB0, pB1, alB, l_reg, pa0, pa1, pa2, pa3); SBAR();
    PVD(vb0 + SHM_V);
    if (KIND == 2) l_reg += __builtin_amdgcn_exp2f(u.sink2 - m_reg);
    if (hi == 0) li_l[r32] = l_reg; asm volatile("s_waitcnt lgkmcnt(0)" ::: "memory");
    float rli[16];
#pragma unroll
    for (int r = 0; r < 16; ++r) rli[r] = __builtin_amdgcn_rcpf(li_l[crow(r, hi)]);
    const bool st_ok = VAR == 0 || VAR == 20 || u.sink2 == 1234.5f;
    if (KIND != 1) {
        if (!st_ok) {} else if (O8) {
#if ATT_WIDE_ST
            LAS unsigned char* stg = (LAS unsigned char*)K_lds + wid * 4096;
#pragma unroll
            for (int r = 0; r < 16; ++r) { const int orow = crow(r, hi);
#pragma unroll
                for (int d0 = 0; d0 < 4; ++d0) { const float v = o[d0][r] * rli[r]; stg[orow * 128 + d0 * 32 + r32] = (unsigned char)(__builtin_amdgcn_cvt_pk_fp8_f32(v, v, 0, false) & 0xff); } }
            asm volatile("s_waitcnt lgkmcnt(0)" ::: "memory");
            unsigned char* Og = O8 + (long)(u.qrow0 + wid * 32) * LDO + u.ocol;
#pragma unroll
            for (int j = 0; j < 4; ++j) { const int c = j * 64 + lane; const u32x4 w = *(const LAS u32x4*)(stg + c * 16); *(u32x4*)(Og + (long)(c >> 3) * LDO + (c & 7) * 16) = w; }
#else
            unsigned char* Ow8 = O8 + (long)(u.qrow0 + wid * 32) * LDO + u.ocol + r32;
#pragma unroll
            for (int r = 0; r < 16; ++r) { const int orow = crow(r, hi);
#pragma unroll
                for (int d0 = 0; d0 < 4; ++d0) { const float v = o[d0][r] * rli[r]; Ow8[(long)orow * LDO + d0 * 32] = (unsigned char)(__builtin_amdgcn_cvt_pk_fp8_f32(v, v, 0, false) & 0xff); } }
#endif
        }
        else { bf16_t* Ow = O + (long)(u.qrow0 + wid * 32) * LDO + u.ocol + r32;
#pragma unroll
        for (int r = 0; r < 16; ++r) { const int orow = crow(r, hi);
#pragma unroll
            for (int d0 = 0; d0 < 4; ++d0) Ow[(long)orow * LDO + d0 * 32] = (bf16_t)(cvt_pk_bf16(o[d0][r] * rli[r], 0.f) & 0xffffu); } }
        __syncthreads();
    } else {
        __syncthreads();
        LAS float* X2 = (LAS float*)lds + (wid & 3) * 4096;
        if (wid >= 4) {
#pragma unroll
            for (int r = 0; r < 16; ++r) { const int orow = crow(r, hi);
#pragma unroll
                for (int d0 = 0; d0 < 4; ++d0) X2[orow * 128 + d0 * 32 + r32] = o[d0][r] * rli[r]; }
        }
        __syncthreads();
        if (wid < 4 && st_ok) {
            float ss[16];
#pragma unroll
            for (int r = 0; r < 16; ++r) { const int orow = crow(r, hi); float s = 0.f;
#pragma unroll
                for (int d0 = 0; d0 < 4; ++d0) { const float v = o[d0][r] * rli[r] - lam * X2[orow * 128 + d0 * 32 + r32]; o[d0][r] = v; s += v * v; }
                ss[r] = s; }
#pragma unroll
            for (int off = 1; off < 32; off <<= 1) {
#pragma unroll
                for (int r = 0; r < 16; ++r) ss[r] += shx(ss[r], lane, off); }
            float g4[4];
#pragma unroll
            for (int d0 = 0; d0 < 4; ++d0) g4[d0] = subln[d0 * 32 + r32] * osc;
#if ATT_WIDE_ST
            LAS bf16_t* stg = (LAS bf16_t*)X2;
#pragma unroll
            for (int r = 0; r < 16; ++r) { const int orow = crow(r, hi); const float rs = rsqrtf(ss[r] * (1.f / 128.f) + 1e-6f);
#pragma unroll
                for (int d0 = 0; d0 < 4; ++d0) stg[orow * 128 + d0 * 32 + r32] = (bf16_t)(cvt_pk_bf16(o[d0][r] * rs * g4[d0], 0.f) & 0xffffu); }
            asm volatile("s_waitcnt lgkmcnt(0)" ::: "memory");
            bf16_t* Og = O + (long)(u.qrow0 + wid * 32) * LDO + u.ocol;
#pragma unroll
            for (int j = 0; j < 8; ++j) { const int c = j * 64 + lane; const u32x4 w = *(const LAS u32x4*)((const LAS char*)stg + c * 16); *(u32x4*)(Og + (long)(c >> 4) * LDO + (c & 15) * 8) = w; }
#else
            bf16_t* Ow = O + (long)(u.qrow0 + wid * 32) * LDO + u.ocol + r32;
#pragma unroll
            for (int r = 0; r < 16; ++r) { const int orow = crow(r, hi); const float rs = rsqrtf(ss[r] * (1.f / 128.f) + 1e-6f);
#pragma unroll
                for (int d0 = 0; d0 < 4; ++d0) Ow[(long)orow * LDO + d0 * 32] = (bf16_t)(cvt_pk_bf16(o[d0][r] * rs * g4[d0], 0.f) & 0xffffu); }
#endif
        }
        __syncthreads();
    }
#undef TROW
#undef SLOAD
#undef SWRITE
#undef SWAIT
#undef RESC
#undef JREL
#undef PVD
#undef LSYNC
    if (ATT_PRIO) __builtin_amdgcn_s_setprio(0);
}
template <int KIND, int VAR = 0>
__device__ __forceinline__ void attn_unit(const AUnit u, const bf16_t* __restrict__ P, bf16_t* __restrict__ O, unsigned char* __restrict__ O8, LAS char* lds, float lam, float osc, const float* __restrict__ subln) {
    const int wv_ = __builtin_amdgcn_readfirstlane((int)(threadIdx.x >> 6));
    if (ATT_STAGGER && (ATT_STAGGER == 1 ? wv_ >= 4 : ATT_STAGGER == 2 ? (wv_ & 1) : ((wv_ >> 1) & 1))) attn_unit_impl<KIND, true, VAR>(u, P, O, O8, lds, lam, osc, subln);
    else attn_unit_impl<KIND, false, VAR>(u, P, O, O8, lds, lam, osc, subln);
}
}
#define XB_TMO      128
#define XB_XCNT(j)  (256  + 64 * (j))
#define XB_XSUB(j)  (1280 + 64 * (j))
#define XB_XGEN(j)  (2304 + 64 * (j))
#define XB_TOP      3328
#define XB_TOPGEN   3392
#define XCD_BAR_WORDS 3456
#define XB_SPIN_CAP (1u << 18)
__device__ __forceinline__ unsigned xb_ld(unsigned* p)              { return __hip_atomic_load(p, __ATOMIC_RELAXED, __HIP_MEMORY_SCOPE_AGENT); }
__device__ __forceinline__ unsigned xb_add(unsigned* p, unsigned v) { return __hip_atomic_fetch_add(p, v, __ATOMIC_RELAXED, __HIP_MEMORY_SCOPE_AGENT); }
__device__ __forceinline__ unsigned xb_xcc_id() { return (unsigned)__builtin_amdgcn_s_getreg((3 << 11) | 20) & 0xFu; }
#define XB_SPIN(cond, bar) do { unsigned _sp = 0; while (cond) { __builtin_amdgcn_s_sleep(1); \
    if ((++_sp & 255u) == 0u) { if (xb_ld(&(bar)[XB_TMO])) break; if (_sp > XB_SPIN_CAP) { atomicAdd(&(bar)[XB_TMO], 1u); break; } } } } while (0)
struct XcdBarrier { unsigned* bar; unsigned x; volatile LAS unsigned* st; };
__device__ __forceinline__ XcdBarrier xcd_barrier_post(unsigned* bar, volatile LAS unsigned* st) {
    XcdBarrier b; b.bar = bar; b.x = xb_xcc_id(); b.st = st;
    if (threadIdx.x == 0) (void)xb_add(&bar[XB_XCNT(b.x)], 1u);
    return b;
}
__device__ __forceinline__ void xcd_barrier_complete(unsigned* bar, unsigned x, unsigned& nloc, unsigned& nx) {
    const unsigned G = gridDim.x * gridDim.y * gridDim.z;
    unsigned sum, cnt, mine, sp = 0u;
    for (;;) {
        sum = 0u; cnt = 0u; mine = 0u;
#pragma unroll
        for (unsigned j = 0; j < 16; ++j) { const unsigned c = xb_ld(&bar[XB_XCNT(j)]); sum += c; cnt += (c > 0u) ? 1u : 0u; mine = (j == x) ? c : mine; }
        if (sum == G) break;
        __builtin_amdgcn_s_sleep(1);
        if ((++sp & 255u) == 0u) { if (xb_ld(&bar[XB_TMO])) break; if (sp > XB_SPIN_CAP) { atomicAdd(&bar[XB_TMO], 1u); break; } }
    }
    nloc = mine > 0u ? mine : 1u; nx = cnt > 0u ? cnt : 1u;
}
__device__ __forceinline__ void xcd_barrier(const XcdBarrier& b) {
    asm volatile("s_waitcnt vmcnt(0)" ::: "memory");
    __syncthreads();
    if (threadIdx.x == 0) {
        unsigned* bar = b.bar;
        __builtin_amdgcn_s_waitcnt(0);
        unsigned nloc = b.st[0], nx = b.st[1];
        if (nloc == 0u) { xcd_barrier_complete(bar, b.x, nloc, nx); b.st[0] = nloc; b.st[1] = nx; }
        const unsigned old = xb_add(&bar[XB_XSUB(b.x)], 1u);
        const unsigned gen = old / nloc;
        if (old + 1u == (gen + 1u) * nloc) {
            __builtin_amdgcn_fence(__ATOMIC_RELEASE, "agent");
            asm volatile("s_waitcnt vmcnt(0)" ::: "memory");
            const unsigned og = xb_add(&bar[XB_TOP], 1u);
            const unsigned tg = og / nx;
            if (og + 1u == (tg + 1u) * nx) xb_add(&bar[XB_TOPGEN], 1u);
            else XB_SPIN(xb_ld(&bar[XB_TOPGEN]) == tg, bar);
            __builtin_amdgcn_fence(__ATOMIC_ACQUIRE, "agent");
            xb_add(&bar[XB_XGEN(b.x)], 1u);
            asm volatile("s_waitcnt vmcnt(0)" ::: "memory");
        } else {
            XB_SPIN(xb_ld(&bar[XB_XGEN(b.x)]) == gen, bar);
            __builtin_amdgcn_fence(__ATOMIC_ACQUIRE, "agent");
            asm volatile("s_waitcnt vmcnt(0)" ::: "memory");
        }
    }
    __syncthreads();
}

#ifndef FUSE_QK
#define FUSE_QK 1
#endif
#ifndef FP8_EXPERTS
#define FP8_EXPERTS 1
#endif
#ifndef FP8_AC
#define FP8_AC 1
#endif
#ifndef FP8_OUT
#define FP8_OUT 0
#endif
#ifndef FP8_BR
#define FP8_BR 1
#endif
#ifndef FP8_GATES
#define FP8_GATES 1
#endif
#ifndef CTX_CHAIN
#define CTX_CHAIN 1
#endif
#ifndef BG_CONV
#define BG_CONV 0
#endif
#ifndef FUSE_ROUTER
#define FUSE_ROUTER 0
#endif
#ifndef ROUTER_V3
#define ROUTER_V3 0
#endif
#ifndef CTX_GATES_IN_CHAIN
#define CTX_GATES_IN_CHAIN 1
#endif
namespace fk {
constexpr int DM = 2048, SEQ = 4096, CTXL = 256, NLAT = 8192, MROWS = 8704, INW = 10240, NEXP = 16, FF = 1024, MODW = 12288;
constexpr int EROWS = 1088, EPAD = 1280;
constexpr float EPS = 1e-6f, LOG2E = 1.4426950408889634f;
constexpr int NWAVES = 8, NTHR = 512;
constexpr size_t MiB = 1u << 20;
constexpr size_t WS_CTL = 0, CTL_ZERO_BYTES = 1 * MiB;
constexpr size_t WS_MODV = 512 * 1024  , WS_ROPE128 = 2 * MiB, WS_ROPE64 = 4 * MiB, WS_AFFT = 5 * MiB, WS_SEL = 6 * MiB, WS_GW = 7 * MiB, WS_BIASR = 7 * MiB + 128 * 1024  ;
constexpr size_t WS_H = 8 * MiB, WS_P = 42 * MiB, WS_XG = 42 * MiB, WS_ACT = 122 * MiB, WS_OATT = 212 * MiB, WS_MM = 246 * MiB, WS_Y = 212 * MiB, WS_X = 280 * MiB;
constexpr size_t WS_WIN8 = 588 * MiB  , WS_H8 = 640 * MiB  , WS_WBR8 = 660 * MiB  , WS_OATT8 = 672 * MiB  , WS_XCH = 692 * MiB  ;
static_assert(!FP8_GATES || FP8_EXPERTS, "WIN8 / H8 live in the half of the W1 region that the fp8 expert weights leave free");
constexpr size_t WS_WIN = 348 * MiB, WS_WBR = 428 * MiB, WS_WOUT = 444 * MiB, WS_W1 = 460 * MiB, WS_W2 = 716 * MiB, WS_END = 844 * MiB;
static_assert((size_t)MROWS * DM * 2 <= 34 * MiB && (size_t)MROWS * INW * 2 <= 170 * MiB && (size_t)16 * EPAD * DM * 2 <= 80 * MiB && (size_t)16 * EPAD * FF * 2 <= 40 * MiB &&
              (size_t)16 * EROWS * DM * 2 <= 68 * MiB && (size_t)MROWS * DM * 4 <= 68 * MiB, "d_ws map");
constexpr int CW_BAR = 4096;
constexpr int CW_QUEUE = 1024;
constexpr int CW_BGQ = 3520;
constexpr int CW_RP = 10240;
constexpr int CW_DONE = 8192;
constexpr int CW_CTX = 3200;
constexpr int RING_BYTES = 131072, LDS_BYTES = 147456, MISC_OFF = LDS_BYTES - 256;

typedef const float* cfp;
struct Args { cfp in[29]; float* out; unsigned char* ws; int ph_lo, ph_hi; };

template <int CTRL> __device__ __forceinline__ float dppm(float v) { return __uint_as_float((unsigned)__builtin_amdgcn_update_dpp(0, (int)__float_as_uint(v), CTRL, 0xf, 0xf, false)); }
__device__ __forceinline__ float xsum16(float v) { const auto rr = __builtin_amdgcn_permlane16_swap(__float_as_uint(v), __float_as_uint(v), false, false); return __uint_as_float(rr[0]) + __uint_as_float(rr[1]); }
__device__ __forceinline__ float xsum32(float v) { const auto rr = __builtin_amdgcn_permlane32_swap(__float_as_uint(v), __float_as_uint(v), false, false); return __uint_as_float(rr[0]) + __uint_as_float(rr[1]); }
__device__ __forceinline__ float row_sum16(float v) { v += dppm<0xB1>(v); v += dppm<0x4E>(v); v += dppm<0x141>(v); v += dppm<0x140>(v); return v; }
__device__ __forceinline__ float row_max16(float v) { v = fmaxf(v, dppm<0xB1>(v)); v = fmaxf(v, dppm<0x4E>(v)); v = fmaxf(v, dppm<0x141>(v)); v = fmaxf(v, dppm<0x140>(v)); return v; }
__device__ __forceinline__ float wave_sum(float v, int lane) { (void)lane; return xsum32(xsum16(row_sum16(v))); }
__device__ __forceinline__ float wave_max(float v, int lane) { (void)lane; v = row_max16(v);
    { const auto rr = __builtin_amdgcn_permlane16_swap(__float_as_uint(v), __float_as_uint(v), false, false); v = fmaxf(__uint_as_float(rr[0]), __uint_as_float(rr[1])); }
    { const auto rr = __builtin_amdgcn_permlane32_swap(__float_as_uint(v), __float_as_uint(v), false, false); v = fmaxf(__uint_as_float(rr[0]), __uint_as_float(rr[1])); }
    return v; }
__device__ __forceinline__ float sink_bound(const float* s6) { float m = 0.f;
#pragma unroll
    for (int i = 0; i < 6; ++i) m = fmaxf(m, fabsf(s6[i]) * 1.4426950408889634f);
    return m; }
__device__ __forceinline__ int modrow(int row) { return row < SEQ ? 0 : (row < NLAT ? 1 : 2); }

__host__ __device__ __forceinline__ int pos128(int d) { const int half = d >> 6, r = d & 63, n = r >> 5, r2 = r & 31, wcl = r2 >> 4, r3 = r2 & 15; return (half * 2 + wcl) * 32 + (r3 >> 2) * 8 + n * 4 + (r3 & 3); }
__host__ __device__ __forceinline__ int pos64(int d) { const int wcl = d >> 5, r = d & 31, n = r >> 4, r3 = r & 15; return wcl * 32 + (r3 >> 2) * 8 + n * 4 + (r3 & 3); }
#ifndef LDS_XPOSE_V2
#define LDS_XPOSE_V2 1
#endif
template <int MODE  > __device__ __forceinline__ void transpose_item(f32x4 (&v)[16], const float* __restrict__ W, int N, int k0, int n0, bf16_t* __restrict__ dst  , int ldd, int perm, LAS float* scr, int lane) {
    const int kq = lane >> 4, nq = lane & 15;
    if (MODE != 2) {
#pragma unroll
        for (int i = 0; i < 16; ++i) v[i] = __builtin_nontemporal_load((const f32x4*)(W + (size_t)(k0 + 4 * i + kq) * N + n0 + 4 * nq)); }
    if (MODE == 1) return;
#pragma unroll
    for (int i = 0; i < 16; ++i) {
#if LDS_XPOSE_V2
        *(LAS f32x4*)(scr + (4 * i + kq) * 64 + ((nq ^ (2 * (i >> 1))) << 2)) = v[i];
#else
        LAS float* s = scr + (4 * i + kq) * 65 + 4 * nq; s[0] = v[i][0]; s[1] = v[i][1]; s[2] = v[i][2]; s[3] = v[i][3];
#endif
    }
    asm volatile("s_waitcnt lgkmcnt(0)" ::: "memory");
#pragma unroll
    for (int j = 0; j < 8; ++j) { const int n = j * 8 + (lane >> 3), c = lane & 7;
#if LDS_XPOSE_V2
        const LAS float* s = scr + (8 * c) * 64 + (((n >> 2) ^ (2 * c)) << 2) + (n & 3); constexpr int PT = 64;
#else
        const LAS float* s = scr + (8 * c) * 65 + n; constexpr int PT = 65;
#endif
        const int sc = n0 + n; const int drow = perm == 0 ? sc : (perm == 1 ? (sc & ~127) + pos128(sc & 127) : (sc & ~63) + pos64(sc & 63));
        u32x4 o; o.x = cvt_pk_bf16(s[0 * PT], s[1 * PT]); o.y = cvt_pk_bf16(s[2 * PT], s[3 * PT]); o.z = cvt_pk_bf16(s[4 * PT], s[5 * PT]); o.w = cvt_pk_bf16(s[6 * PT], s[7 * PT]);
        *(u32x4*)(dst + (size_t)drow * ldd + 8 * c) = o; }
    asm volatile("s_waitcnt lgkmcnt(0)" ::: "memory");
}
template <int MODE> __device__ __forceinline__ void transpose_item_f8(f32x4 (&v)[16], const float* __restrict__ W, int N, int k0, int n0, unsigned char* __restrict__ dst  , int ldd, float mul, LAS float* scr, int lane, int perm = 0) {
    const int kq = lane >> 4, nq = lane & 15;
    if (MODE != 2) {
#pragma unroll
        for (int i = 0; i < 16; ++i) v[i] = __builtin_nontemporal_load((const f32x4*)(W + (size_t)(k0 + 4 * i + kq) * N + n0 + 4 * nq)); }
    if (MODE == 1) return;
#pragma unroll
    for (int i = 0; i < 16; ++i) {
#if LDS_XPOSE_V2
        *(LAS f32x4*)(scr + (4 * i + kq) * 64 + ((nq ^ (2 * (i >> 1))) << 2)) = v[i] * mul;
#else
        LAS float* s = scr + (4 * i + kq) * 65 + 4 * nq; s[0] = v[i][0] * mul; s[1] = v[i][1] * mul; s[2] = v[i][2] * mul; s[3] = v[i][3] * mul;
#endif
    }
    asm volatile("s_waitcnt lgkmcnt(0)" ::: "memory");
#pragma unroll
    for (int j = 0; j < 4; ++j) { const int n = j * 16 + (lane >> 2), c = lane & 3;
#if LDS_XPOSE_V2
        const LAS float* s = scr + (16 * c) * 64 + (((n >> 2) ^ (4 * c)) << 2) + (n & 3); const LAS float* s2 = scr + (16 * c) * 64 + (((n >> 2) ^ (4 * c + 2)) << 2) + (n & 3); constexpr int PT = 64;
#else
        const LAS float* s = scr + (16 * c) * 65 + n; const LAS float* s2 = s; constexpr int PT = 65;
#endif
        u32x4 o; o.x = pk4_fp8(s[0 * PT], s[1 * PT], s[2 * PT], s[3 * PT]); o.y = pk4_fp8(s[4 * PT], s[5 * PT], s[6 * PT], s[7 * PT]);
        o.z = pk4_fp8(s2[8 * PT], s2[9 * PT], s2[10 * PT], s2[11 * PT]); o.w = pk4_fp8(s2[12 * PT], s2[13 * PT], s2[14 * PT], s2[15 * PT]);
        const int sc = n0 + n; const int drow = perm == 0 ? sc : (perm == 1 ? (sc & ~127) + pos128(sc & 127) : (sc & ~63) + pos64(sc & 63));
        *(u32x4*)(dst + (size_t)drow * ldd + 16 * c) = o; }
    asm volatile("s_waitcnt lgkmcnt(0)" ::: "memory");
}
__host__ __device__ __forceinline__ bool win_fp8_tile(int pn) { return FP8_GATES && (pn >= 16 || (FP8_AC && !(pn == 2 || pn == 3 || pn == 4 || pn == 5 || pn == 11 || pn == 12))); }
__host__ __device__ __forceinline__ int win_perm(int c) { return c < 256 ? 1 : c < 512 ? 0 : c < 1024 ? 2 : c < 1536 ? 0 : c < 1792 ? 1 : c < 2048 ? 0 : c < 2816 ? 1 : c < 3328 ? 2 : c < 4096 ? 1 : 0; }
constexpr int CV_I_IN = 32 * 160, CV_I_BRA = 12 * 32, CV_I_BRB = 8 * 32, CV_I_OUT = 32 * 32, CV_I_G = 32 * 16, CV_I_D = 16 * 32;
constexpr int CV_D1 = CV_I_IN + 2 * CV_I_BRA + CV_I_BRB + CV_I_OUT;
constexpr int CV_PER_L = CV_D1 + 16 * (2 * CV_I_G + CV_I_D);
template <int MODE> __device__ __forceinline__ void conv_item_m(f32x4 (&v)[16], const Args& A, int it, LAS float* scr, int lane) {
    unsigned char* ws = A.ws;
    constexpr int I_IN = CV_I_IN, I_BRA = CV_I_BRA, I_BRB = CV_I_BRB, I_OUT = CV_I_OUT, I_G = CV_I_G, I_D = CV_I_D, PER_L = CV_PER_L;
    {
        const int l = it / PER_L; int r = it % PER_L;
        if (r < I_IN) { const int kb = r / 160, nb = r % 160;
            if (win_fp8_tile(nb >> 2)) { transpose_item_f8<MODE>(v, A.in[8] + (size_t)l * DM * INW, INW, kb * 64, nb * 64, (unsigned char*)(ws + WS_WIN8) + ((size_t)l * INW) * DM + kb * 64, DM, 64.f, scr, lane, FUSE_QK ? win_perm(nb * 64) : 0); return; }
            transpose_item<MODE>(v, A.in[8] + (size_t)l * DM * INW, INW, kb * 64, nb * 64, (bf16_t*)(ws + WS_WIN) + ((size_t)l * INW) * DM + kb * 64, DM, FUSE_QK ? win_perm(nb * 64) : 0, scr, lane); return; } r -= I_IN;
        if (r < I_BRA) { const int kb = r / 32, nb = r % 32;
            if (FP8_BR) transpose_item_f8<MODE>(v, A.in[21] + (size_t)l * 768 * DM, DM, kb * 64, nb * 64, (unsigned char*)(ws + WS_WBR8) + ((size_t)l * DM) * DM + kb * 64, DM, 64.f, scr, lane);
            else transpose_item<MODE>(v, A.in[21] + (size_t)l * 768 * DM, DM, kb * 64, nb * 64, (bf16_t*)(ws + WS_WBR) + ((size_t)l * DM) * DM + kb * 64, DM, 0, scr, lane);
            return; } r -= I_BRA;
        if (r < I_BRB) { const int kb = r / 32, nb = r % 32; transpose_item<MODE>(v, A.in[22] + (size_t)l * 512 * DM, DM, kb * 64, nb * 64, (bf16_t*)(ws + WS_WBR) + ((size_t)l * DM) * DM + 768 + kb * 64, DM, 0, scr, lane); return; } r -= I_BRB;
        if (r < I_BRA) { const int kb = r / 32, nb = r % 32;
            if (FP8_BR) transpose_item_f8<MODE>(v, A.in[23] + (size_t)l * 768 * DM, DM, kb * 64, nb * 64, (unsigned char*)(ws + WS_WBR8) + ((size_t)l * DM) * DM + 1280 + kb * 64, DM, 64.f, scr, lane);
            else transpose_item<MODE>(v, A.in[23] + (size_t)l * 768 * DM, DM, kb * 64, nb * 64, (bf16_t*)(ws + WS_WBR) + ((size_t)l * DM) * DM + 1280 + kb * 64, DM, 0, scr, lane);
            return; } r -= I_BRA;
        if (r < I_OUT) { const int kb = r / 32, nb = r % 32;
            if (FP8_OUT) transpose_item_f8<MODE>(v, A.in[24] + (size_t)l * DM * DM, DM, kb * 64, nb * 64, (unsigned char*)(ws + WS_WOUT) + ((size_t)l * DM) * DM + kb * 64, DM, 64.f, scr, lane);
            else transpose_item<MODE>(v, A.in[24] + (size_t)l * DM * DM, DM, kb * 64, nb * 64, (bf16_t*)(ws + WS_WOUT) + ((size_t)l * DM) * DM + kb * 64, DM, 0, scr, lane);
            return; } r -= I_OUT;
        const int e = r / (2 * I_G + I_D); r %= (2 * I_G + I_D);
        if (r < 2 * I_G) { const int up = r / I_G; r %= I_G; const int kb = r / 16, nb = r % 16, f0 = nb * 64;
            const size_t drow0 = ((size_t)l * 16 + e) * 2048 + (f0 >> 7) * 256 + up * 128 + (f0 & 127) - f0;
            if (FP8_EXPERTS) transpose_item_f8<MODE>(v, A.in[26 + up] + ((size_t)l * 16 + e) * DM * FF, FF, kb * 64, f0, (unsigned char*)(ws + WS_W1) + drow0 * DM + kb * 64, DM, 64.f, scr, lane);
            else transpose_item<MODE>(v, A.in[26 + up] + ((size_t)l * 16 + e) * DM * FF, FF, kb * 64, f0, (bf16_t*)(ws + WS_W1) + drow0 * DM + kb * 64, DM, 0, scr, lane);
            return; }
        r -= 2 * I_G;
        { const int kb = r / 32, nb = r % 32;
          if (FP8_EXPERTS) transpose_item_f8<MODE>(v, A.in[28] + ((size_t)l * 16 + e) * FF * DM, DM, kb * 64, nb * 64, (unsigned char*)(ws + WS_W2) + (((size_t)l * 16 + e) * 2048) * FF + kb * 64, FF, 64.f, scr, lane);
          else transpose_item<MODE>(v, A.in[28] + ((size_t)l * 16 + e) * FF * DM, DM, kb * 64, nb * 64, (bf16_t*)(ws + WS_W2) + (((size_t)l * 16 + e) * 2048) * FF + kb * 64, FF, 0, scr, lane); }
    }
}
__device__ __forceinline__ void conv_item(const Args& A, int it, LAS float* scr, int lane) { f32x4 v[16]; conv_item_m<0>(v, A, it, scr, lane); }
__device__ __forceinline__ void bg_loop(const Args& A, LAS unsigned char* lds, unsigned* ctl, volatile LAS unsigned* MISC, int seam, int force_upto, int G) {
    int tz = threadIdx.x; asm volatile("" : "+v"(tz)); const int tid = tz, lane = tz & 63, wave = __builtin_amdgcn_readfirstlane(tz >> 6);
    LAS float* scr = (LAS float*)(lds + wave * 16640);
    unsigned* bgq = ctl + CW_BGQ; unsigned* done = ctl + CW_DONE + 64 * seam;
    __syncthreads();
    if (tid == 0) (void)xb_add(done, 1u);
    for (;;) {
        if (tid == 0) { unsigned base = 0xffffffffu; const unsigned head = xb_ld(bgq);
            if (head < (unsigned)CV_PER_L && (head < (unsigned)force_upto || xb_ld(done) < (unsigned)G)) base = xb_add(bgq, 8u);
            MISC[1] = base; }
        __syncthreads();
        const unsigned base = MISC[1];
        __syncthreads();
        if (base >= (unsigned)CV_PER_L) break;
        const int item = (int)base + wave; if (item < CV_PER_L) conv_item(A, CV_PER_L + item, scr, lane);
    }
}
__device__ __forceinline__ void p0_prologue(const Args& A, LAS unsigned char* lds, int wave, int lane, int gw, int NGW, int n_items) {
    unsigned char* ws = A.ws;
    LAS float* scr = (LAS float*)(lds + wave * 16640);
    for (int it = gw; it < n_items; it += NGW) conv_item(A, it, scr, lane);
    float* r128 = (float*)(ws + WS_ROPE128); float* r64 = (float*)(ws + WS_ROPE64);
    for (int i = gw * 64 + lane; i < 4096 * 64; i += NGW * 64) { const int t = i >> 6, j = i & 63, q = j & 31, pos = j < 32 ? (t >> 6) : (t & 63);
        const float ang = (float)pos * powf(10000.f, -(float)(2 * q) / 64.f); r128[2 * i] = cosf(ang); r128[2 * i + 1] = sinf(ang); }
    for (int i = gw * 64 + lane; i < 4096 * 32; i += NGW * 64) { const int t = i >> 5, j = i & 31, q = j & 15, pos = j < 16 ? (t >> 6) : (t & 63);
        const float ang = (float)pos * powf(10000.f, -(float)(2 * q) / 32.f); r64[2 * i] = cosf(ang); r64[2 * i + 1] = sinf(ang); }
}
__device__ __forceinline__ void p0_convert_dyn2(const Args& A, LAS unsigned char* lds, unsigned* q, volatile LAS unsigned* MISC, int tid, int wave, int lane, int n_items, int item0) {
    LAS float* scr = (LAS float*)(lds + wave * 16640);
    unsigned nxt = 0u; if (tid == 0) nxt = xb_add(q, 16u);
    for (;;) {
        if (tid == 0) MISC[2] = nxt;
        __syncthreads();
        const unsigned base = MISC[2];
        if (base >= (unsigned)n_items) break;
        if (tid == 0) nxt = xb_add(q, 16u);
        const int ia = (int)base + wave, ib = ia + 8; f32x4 va[16], vb[16];
        if (ia < n_items) conv_item_m<1>(va, A, item0 + ia, scr, lane);
        if (ib < n_items) conv_item_m<1>(vb, A, item0 + ib, scr, lane);
        if (ia < n_items) conv_item_m<2>(va, A, item0 + ia, scr, lane);
        if (ib < n_items) conv_item_m<2>(vb, A, item0 + ib, scr, lane);
        __syncthreads();
    }
    __syncthreads();
}
__device__ __forceinline__ void p0_convert_dyn(const Args& A, LAS unsigned char* lds, unsigned* q, volatile LAS unsigned* MISC, int tid, int wave, int lane, int n_items, int item0 = 0) {
    LAS float* scr = (LAS float*)(lds + wave * 16640);
    unsigned nxt = 0u; if (tid == 0) nxt = xb_add(q, 8u);
    for (;;) {
        if (tid == 0) MISC[2] = nxt;
        __syncthreads();
        const unsigned base = MISC[2];
        if (base >= (unsigned)n_items) break;
        if (tid == 0) nxt = xb_add(q, 8u);
        const int item = (int)base + wave; if (item < n_items) conv_item(A, item0 + item, scr, lane);
        __syncthreads();
    }
    __syncthreads();
}
__device__ __forceinline__ void p0_modv(const Args& A, LAS unsigned char* lds, int tid, int lane, int wave, int wg, int G, int job0 = 0, int job1 = 2 * 96) {
    LAS float* sv = (LAS float*)lds;
    LAS float* part = (LAS float*)(lds + 24576);
    for (int i = tid; i < 3 * DM; i += NTHR) { const int r = i / DM, k = i % DM; const float v = r < 2 ? A.in[1][r * DM + k] : A.in[3][k]; sv[i] = v / (1.f + expf(-v)); }
    __syncthreads();
    float* modv = (float*)(A.ws + WS_MODV);
    for (int job = job0 + wg; job < job1; job += G) {
        const int l = job / 96, cg = job % 96, j = cg * 128 + lane * 2;
        const float* w = A.in[4] + (size_t)l * DM * MODW + (size_t)(wave * 256) * MODW + j;
        f32x2 a0 = {0.f, 0.f}, a1 = a0, a2 = a0;
#pragma unroll 16
        for (int k = 0; k < 256; ++k) { const f32x2 wv = __builtin_nontemporal_load((const f32x2*)(w + (size_t)k * MODW)); const int kk = wave * 256 + k; a0 = a0 + wv * sv[kk]; a1 = a1 + wv * sv[DM + kk]; a2 = a2 + wv * sv[2 * DM + kk]; }
        LAS float* pw = part + wave * 384 + lane * 2;
        pw[0] = a0[0]; pw[1] = a0[1]; pw[128] = a1[0]; pw[129] = a1[1]; pw[256] = a2[0]; pw[257] = a2[1];
        __syncthreads();
        if (wave < 3) { float s0 = 0.f, s1 = 0.f;
#pragma unroll
            for (int q = 0; q < 8; ++q) { s0 += part[q * 384 + wave * 128 + lane * 2]; s1 += part[q * 384 + wave * 128 + lane * 2 + 1]; }
            const f32x2 bb = *(const f32x2*)(A.in[5] + l * MODW + j);
            *(f32x2*)(modv + (size_t)(l * 3 + wave) * MODW + j) = (f32x2){s0 + bb[0], s1 + bb[1]}; }
        __syncthreads();
    }
}

__device__ __forceinline__ float treduce16(const float (&v)[16], int lane) {
    const bool b3 = (lane & 8) != 0, b2 = (lane & 4) != 0;
    float a[8], b[4], c[2];
#pragma unroll
    for (int i = 0; i < 8; ++i) { const auto rr = __builtin_amdgcn_permlane32_swap(__float_as_uint(v[i]), __float_as_uint(v[i + 8]), false, false); a[i] = __uint_as_float(rr[0]) + __uint_as_float(rr[1]); }
#pragma unroll
    for (int i = 0; i < 4; ++i) { const auto rr = __builtin_amdgcn_permlane16_swap(__float_as_uint(a[i]), __float_as_uint(a[i + 4]), false, false); b[i] = __uint_as_float(rr[0]) + __uint_as_float(rr[1]); }
#pragma unroll
    for (int i = 0; i < 2; ++i) { const float keep = b3 ? b[i + 2] : b[i], send = b3 ? b[i] : b[i + 2]; c[i] = keep + dppm<0x128>(send); }
    const float keep = b2 ? c[1] : c[0], send = b2 ? c[0] : c[1]; float d = keep + dppm<0x141>(send);
    d += dppm<0x4E>(d); d += dppm<0xB1>(d); return d;
}
template <int MODE  >
__device__ __forceinline__ void row_phase_a(const Args& A, int l, int lane, int gw, int NGW) {
    unsigned char* ws = A.ws; float* X = (float*)(ws + WS_X); bf16_t* H = (bf16_t*)(ws + WS_H); const bf16_t* Y = (const bf16_t*)(ws + WS_Y); const int* SEL = (const int*)(ws + WS_SEL);
    const float* modv = (const float*)(ws + WS_MODV);
    const int nrows = MODE == 2 ? NLAT : MROWS;
    if ((ROUTER_V3 || FUSE_ROUTER) && MODE != 2 && gw < 3) {
        const float* sh2 = modv + (size_t)(l * 3 + gw) * MODW + 3 * DM; const float* wr = A.in[25] + (size_t)l * DM * 16; float pb[16];
#pragma unroll
        for (int e = 0; e < 16; ++e) pb[e] = 0.f;
        for (int i = 0; i < 32; ++i) { const int k = lane + 64 * i; const float s = sh2[k];
#pragma unroll
            for (int q = 0; q < 4; ++q) { const f32x4 w4 = *(const f32x4*)(wr + (size_t)k * 16 + 4 * q); pb[4 * q] += s * w4[0]; pb[4 * q + 1] += s * w4[1]; pb[4 * q + 2] += s * w4[2]; pb[4 * q + 3] += s * w4[3]; } }
        const float bt = treduce16(pb, lane);
        if ((lane & 3) == 0) ((float*)(ws + WS_BIASR))[(l * 3 + gw) * 16 + (lane >> 2)] = bt;
    }
#ifndef CONV_IN_EXP
#define CONV_IN_EXP 0
#endif
#ifndef CONV_EXP_PART1
#define CONV_EXP_PART1 4352
#endif
#ifndef MODV1_IN_ATT
#define MODV1_IN_ATT 0
#endif
#ifndef P0_DYN
#define P0_DYN 1
#endif
#ifndef CONV_IN_ATT
#define CONV_IN_ATT 2
#endif
#ifndef NORM_EVEN
#define NORM_EVEN 1
#endif
    const bool evn = NORM_EVEN && NGW == 2048 && nrows == 256 * 34;
    const int r_lo = evn ? (gw >> 3) * 34 + (gw & 7) : gw, r_hi = evn ? (gw >> 3) * 34 + 34 : nrows, r_st = evn ? 8 : NGW;
    for (int row = r_lo; row < r_hi; row += r_st) {
        f32x4 v[8];
        if (MODE == 0) { const float* src = row < NLAT ? A.in[0] + (size_t)row * DM : A.in[2] + (size_t)(row - NLAT) * DM;
#pragma unroll
            for (int i = 0; i < 8; ++i) v[i] = *(const f32x4*)(src + (lane + 64 * i) * 4); }
        else {
            const float* xr = X + (size_t)row * DM;
#pragma unroll
            for (int i = 0; i < 8; ++i) v[i] = *(const f32x4*)(xr + (lane + 64 * i) * 4);
            const float* g2 = modv + (size_t)((l - 1) * 3 + modrow(row)) * MODW + 5 * DM;
            f32x4 acc[8];
#pragma unroll
            for (int i = 0; i < 8; ++i) acc[i] = (f32x4){0.f, 0.f, 0.f, 0.f};
            const int mysel = lane < 16 ? SEL[(size_t)row * 16 + lane] : -1;
            for (int e = 0; e < 16; ++e) { const int slot = __builtin_amdgcn_readlane(mysel, e); if (slot < 0) continue;
                const bf16_t* yr = Y + ((size_t)e * EROWS + slot) * DM;
#pragma unroll
                for (int i = 0; i < 8; ++i) { const u32x2 w = *(const u32x2*)(yr + (lane + 64 * i) * 4); acc[i][0] += bf_lo(w.x); acc[i][1] += bf_hi(w.x); acc[i][2] += bf_lo(w.y); acc[i][3] += bf_hi(w.y); } }
#pragma unroll
            for (int i = 0; i < 8; ++i) { const f32x4 g = *(const f32x4*)(g2 + (lane + 64 * i) * 4); v[i] = v[i] + g * acc[i]; }
            float* dst = MODE == 2 ? A.out + (size_t)row * DM : X + (size_t)row * DM;
#pragma unroll
            for (int i = 0; i < 8; ++i) *(f32x4*)(dst + (lane + 64 * i) * 4) = v[i];
        }
        if (MODE == 2) continue;
        float ss = 0.f;
#pragma unroll
        for (int i = 0; i < 8; ++i) ss += (v[i][0] * v[i][0] + v[i][1] * v[i][1]) + (v[i][2] * v[i][2] + v[i][3] * v[i][3]);
        const float rstd = rsqrtf(wave_sum(ss, lane) * (1.f / DM) + EPS);
        const float* mv = modv + (size_t)(l * 3 + modrow(row)) * MODW; const float* gain = A.in[6] + l * DM;
#pragma unroll
        for (int i = 0; i < 8; ++i) { const int c = (lane + 64 * i) * 4; const f32x4 g = *(const f32x4*)(gain + c), sh = *(const f32x4*)(mv + c), sc = *(const f32x4*)(mv + DM + c);
            const f32x4 h = v[i] * rstd * g * (sc + 1.f) + sh; u32x2 w; w.x = cvt_pk_bf16(h[0], h[1]); w.y = cvt_pk_bf16(h[2], h[3]); *(u32x2*)(H + (size_t)row * DM + c) = w;
            if (FP8_GATES) *(unsigned*)((unsigned char*)(ws + WS_H8) + (size_t)row * DM + c) = pk4_fp8(h[0], h[1], h[2], h[3]); }
    }
}
#ifndef ROUTER_PK
#define ROUTER_PK 1
#endif
#ifndef ROUTER_PROBE
#define ROUTER_PROBE 0
#endif
__device__ __forceinline__ void row_phase_g(const Args& A, LAS unsigned char* lds, int l, int tid, int lane, int wave, int wg, int G, bool prb = false) {
    unsigned char* ws = A.ws; const float* X = (const float*)(ws + WS_X); bf16_t* H = (bf16_t*)(ws + WS_H); float* AFFT = (float*)(ws + WS_AFFT);
    const float* modv = (const float*)(ws + WS_MODV); const float* wr = A.in[25] + (size_t)l * DM * 16; const float* gain = A.in[7] + l * DM;
    LAS float* part = (LAS float*)lds;
    LAS float* biasp = part + 2 * 640;
    const int k0 = wave * 256 + lane * 4;
    const int ecode = ((lane >> 5) & 1) * 8 + ((lane >> 4) & 1) * 4 + ((lane >> 3) & 1) * 2 + ((lane >> 2) & 1);
    float Wl[4][16], gsc[4], sh[4]; float bias_e = 0.f; int cur_mr = -1;
    const int ngr = MROWS / 4, gq = ngr / G, grm = ngr % G, g0 = wg < grm ? wg * (gq + 1) : grm * (gq + 1) + (wg - grm) * gq; (void)g0;
    const bool even = (G == 256) && (MROWS == 256 * 34);
    const int rbase = even ? wg * 34 : 4 * g0, nri = (ROUTER_PROBE == 6 && prb) ? 0 : (ROUTER_PROBE >= 4 && prb) ? 4 : (even ? 34 : 4 * (wg < grm ? gq + 1 : gq));
#define RG_ROW(i) (rbase + (i))
    f32x4 xq[4], xnq[4];
#pragma unroll
    for (int j = 0; j < 4; ++j) { xnq[j] = (f32x4){0.f, 0.f, 0.f, 0.f}; if (j < nri) xnq[j] = *(const f32x4*)(X + (size_t)RG_ROW(j) * DM + k0); }
    __syncthreads();
    for (int i0 = 0; i0 < nri; i0 += 4) {
#pragma unroll
        for (int j = 0; j < 4; ++j) { xq[j] = xnq[j]; if (i0 + 4 + j < nri && !(ROUTER_PROBE == 3 && prb)) xnq[j] = *(const f32x4*)(X + (size_t)RG_ROW(i0 + 4 + j) * DM + k0); }
        const int mr = modrow(RG_ROW(i0));
        if (mr != cur_mr) {
            cur_mr = mr; const float* mv = modv + (size_t)(l * 3 + mr) * MODW;
            const f32x4 g4 = *(const f32x4*)(gain + k0), sh4 = *(const f32x4*)(mv + 3 * DM + k0), sc4 = *(const f32x4*)(mv + 4 * DM + k0);
            float pb[16];
#pragma unroll
            for (int e = 0; e < 16; ++e) pb[e] = 0.f;
#pragma unroll
            for (int jj = 0; jj < 4; ++jj) { gsc[jj] = g4[jj] * (1.f + sc4[jj]); sh[jj] = sh4[jj];
#pragma unroll
                for (int q = 0; q < 4; ++q) { f32x4 w4; if (ROUTER_PROBE == 5 && prb) w4 = (f32x4){0.01f * jj, 0.02f, 0.03f * q, 0.04f}; else w4 = *(const f32x4*)(wr + (size_t)(k0 + jj) * 16 + 4 * q);
#pragma unroll
                    for (int t = 0; t < 4; ++t) { Wl[jj][4 * q + t] = gsc[jj] * w4[t]; pb[4 * q + t] += sh[jj] * w4[t]; } } }
            const float bt = treduce16(pb, lane);
            __syncthreads();
            if ((lane & 3) == 0) biasp[wave * 16 + ecode] = bt;
            __syncthreads();
            bias_e = 0.f;
            if (lane < 16) {
#pragma unroll
                for (int w = 0; w < 8; ++w) bias_e += biasp[w * 16 + lane]; }
        }
        LAS float* pp = part + ((i0 >> 2) & 1) * 640;
#pragma unroll
        for (int j = 0; j < 4; ++j) {
            const f32x4 x = xq[j]; float pl[16];
#if ROUTER_PK
            {
                const f32x2 x0 = {x[0], x[0]}, x1 = {x[1], x[1]}, x2 = {x[2], x[2]}, x3 = {x[3], x[3]};
#pragma unroll
                for (int e2 = 0; e2 < 8; ++e2) { const f32x2 w0 = {Wl[0][2 * e2], Wl[0][2 * e2 + 1]}, w1 = {Wl[1][2 * e2], Wl[1][2 * e2 + 1]}, w2 = {Wl[2][2 * e2], Wl[2][2 * e2 + 1]}, w3 = {Wl[3][2 * e2], Wl[3][2 * e2 + 1]};
                    f32x2 a = x0 * w0; a = __builtin_elementwise_fma(x1, w1, a); a = __builtin_elementwise_fma(x2, w2, a); a = __builtin_elementwise_fma(x3, w3, a); pl[2 * e2] = a[0]; pl[2 * e2 + 1] = a[1]; } }
#else
#pragma unroll
            for (int e = 0; e < 16; ++e) pl[e] = x[0] * Wl[0][e] + x[1] * Wl[1][e] + x[2] * Wl[2][e] + x[3] * Wl[3][e];
#endif
            float pt; if (ROUTER_PROBE == 1 && prb) pt = pl[lane & 15]; else pt = treduce16(pl, lane);
            const float ssw = wave_sum((x[0] * x[0] + x[1] * x[1]) + (x[2] * x[2] + x[3] * x[3]), lane);
            if ((lane & 3) == 0) pp[(j * 8 + wave) * 20 + ecode] = pt;
            if (lane == 0) pp[(j * 8 + wave) * 20 + 16] = ssw;
        }
        __syncthreads();
#pragma unroll
        for (int j = 0; j < 4; ++j) {
            if (i0 + j >= nri) break;
            const int row = RG_ROW(i0 + j); const f32x4 x = xq[j];
            float sst = 0.f;
#pragma unroll
            for (int w = 0; w < 8; ++w) sst += pp[(j * 8 + w) * 20 + 16];
            const float rstd = rsqrtf(sst * (1.f / DM) + EPS);
            { u32x2 w2; w2.x = cvt_pk_bf16(x[0] * rstd * gsc[0] + sh[0], x[1] * rstd * gsc[1] + sh[1]); w2.y = cvt_pk_bf16(x[2] * rstd * gsc[2] + sh[2], x[3] * rstd * gsc[3] + sh[3]);
              if (!(ROUTER_PROBE == 2 && prb)) *(u32x2*)(H + (size_t)row * DM + k0) = w2; }
            if (wave == j) {
                float t = 0.f;
                if (lane < 16) {
#pragma unroll
                    for (int w = 0; w < 8; ++w) t += pp[(j * 8 + w) * 20 + lane]; }
                const float logit = lane < 16 ? rstd * t + bias_e : -3.0e38f;
                const float mx = row_max16(logit);
                const float ex = lane < 16 ? expf(logit - mx) : 0.f; const float s = row_sum16(ex);
                if (lane < 16) AFFT[(size_t)lane * MROWS + row] = ex / s;
            }
        }
    }
    __syncthreads();
}
#undef RG_ROW
__device__ __forceinline__ void row_phase_g3(const Args& A, LAS unsigned char* lds, int l, int tid, int lane, int wave, int wg, int G) {
    unsigned char* ws = A.ws; const float* X = (const float*)(ws + WS_X); bf16_t* H = (bf16_t*)(ws + WS_H); float* AFFT = (float*)(ws + WS_AFFT);
    const float* modv = (const float*)(ws + WS_MODV); const float* wr = A.in[25] + (size_t)l * DM * 16; const float* gain = A.in[7] + l * DM; const float* biasr = (const float*)(ws + WS_BIASR) + l * 48;
    LAS f32x4* Wl = (LAS f32x4*)lds;
    const int ngr = MROWS / 4, gq = ngr / G, grm = ngr % G, g0 = wg < grm ? wg * (gq + 1) : grm * (gq + 1) + (wg - grm) * gq, nrows = 4 * (wg < grm ? gq + 1 : gq), row0 = 4 * g0;
    const int ecode = lane >> 2;
    int cur_mr = -1; f32x4 gsc[8], sh[8]; float bias_e = 0.f;
    f32x4 xn[8];
    { const int r = row0 + wave; if (wave < nrows) {
#pragma unroll
        for (int i = 0; i < 8; ++i) xn[i] = *(const f32x4*)(X + (size_t)r * DM + (lane + 64 * i) * 4); } }
    for (int rb = 0; rb < nrows; rb += 8) {
        const int mr_lo = modrow(row0 + rb), mr_hi = modrow(row0 + (rb + 7 < nrows ? rb + 7 : nrows - 1));
        for (int pass = 0; pass < (mr_lo == mr_hi ? 1 : 2); ++pass) {
            const int mr = pass == 0 ? mr_lo : mr_hi;
            if (mr != cur_mr) {
                cur_mr = mr; const float* mv = modv + (size_t)(l * 3 + mr) * MODW;
                __syncthreads();
                for (int t = tid; t < 8192; t += NTHR) { const int ln = t & 63, q = (t >> 6) & 3, j = (t >> 8) & 3, i = t >> 10, k = 4 * (ln + 64 * i) + j;
                    const float g = gain[k] * (1.f + mv[4 * DM + k]); const f32x4 w4 = *(const f32x4*)(wr + (size_t)k * 16 + 4 * q); Wl[t] = w4 * g; }
#pragma unroll
                for (int i = 0; i < 8; ++i) { const int c = (lane + 64 * i) * 4; const f32x4 g4 = *(const f32x4*)(gain + c), sc4 = *(const f32x4*)(mv + 4 * DM + c); gsc[i] = g4 * (sc4 + 1.f); sh[i] = *(const f32x4*)(mv + 3 * DM + c); }
                bias_e = biasr[mr * 16 + ecode];
                __syncthreads();
            }
            const int ri = rb + wave; const bool mine = ri < nrows && modrow(row0 + ri) == mr && (pass == 0 || mr_lo != mr_hi);
            if (mine && !(pass == 1 && modrow(row0 + ri) == mr_lo)) {
                const int row = row0 + ri; f32x4 x[8];
#pragma unroll
                for (int i = 0; i < 8; ++i) x[i] = xn[i];
                if (ri + 8 < nrows) {
#pragma unroll
                    for (int i = 0; i < 8; ++i) xn[i] = *(const f32x4*)(X + (size_t)(row + 8) * DM + (lane + 64 * i) * 4); }
                float pl[16]; float ss = 0.f;
#pragma unroll
                for (int e = 0; e < 16; ++e) pl[e] = 0.f;
#pragma unroll
                for (int i = 0; i < 8; ++i) { ss += (x[i][0] * x[i][0] + x[i][1] * x[i][1]) + (x[i][2] * x[i][2] + x[i][3] * x[i][3]);
#pragma unroll
                    for (int j = 0; j < 4; ++j)
#pragma unroll
                        for (int q = 0; q < 4; ++q) { const f32x4 w4 = Wl[((i * 4 + j) * 4 + q) * 64 + lane]; const float xv = x[i][j];
                            pl[4 * q] += xv * w4[0]; pl[4 * q + 1] += xv * w4[1]; pl[4 * q + 2] += xv * w4[2]; pl[4 * q + 3] += xv * w4[3]; } }
                const float pt = treduce16(pl, lane);
                const float rstd = rsqrtf(wave_sum(ss, lane) * (1.f / DM) + EPS);
#pragma unroll
                for (int i = 0; i < 8; ++i) { const f32x4 h = x[i] * rstd * gsc[i] + sh[i]; u32x2 w2; w2.x = cvt_pk_bf16(h[0], h[1]); w2.y = cvt_pk_bf16(h[2], h[3]); *(u32x2*)(H + (size_t)row * DM + (lane + 64 * i) * 4) = w2; }
                const float logit = rstd * pt + bias_e;
                float mx = logit;
#pragma unroll
                for (int o = 4; o < 64; o <<= 1) mx = fmaxf(mx, shx(mx, lane, o));
                const float ex = expf(logit - mx); float s = ex;
#pragma unroll
                for (int o = 4; o < 64; o <<= 1) s += shx(s, lane, o);
                if ((lane & 3) == 0) AFFT[(size_t)ecode * MROWS + row] = ex / s;
            }
        }
    }
    __syncthreads();
}
__device__ __forceinline__ void row_phase_c(const Args& A, int l, int lane, int gw, int NGW) {
    unsigned char* ws = A.ws; bf16_t* P = (bf16_t*)(ws + WS_P); const float* r128 = (const float*)(ws + WS_ROPE128); const float* r64 = (const float*)(ws + WS_ROPE64);
    constexpr float QS128 = 0.08838834764831845f * LOG2E, QS64 = 0.125f * LOG2E;
    for (int job = gw; job < MROWS * 12; job += NGW) {
        const int row = job / 12, j = job % 12; const bool lat = row < NLAT; const int t = row & (SEQ - 1);
        bf16_t* p = P + (size_t)row * INW;
        if (j < 8) {
            const int hsel = lane >> 5, i = lane & 31; int col; const float* gain; float qs = 1.f;
            if (j == 0) { col = hsel * 128; gain = A.in[10] + l * 128; }
            else if (j == 1) { col = 1536 + hsel * 128; gain = A.in[19] + l * 128; }
            else if (j < 5) { col = 2048 + ((j - 2) * 2 + hsel) * 128; gain = A.in[9] + l * 128; qs = QS128; }
            else { col = 3328 + ((j - 5) * 2 + hsel) * 128; gain = A.in[18] + l * 128; qs = QS128; }
            float x0 = bf2f(p[col + i]), x1 = bf2f(p[col + i + 32]), x2 = bf2f(p[col + i + 64]), x3 = bf2f(p[col + i + 96]);
            float ss = x0 * x0 + x1 * x1 + x2 * x2 + x3 * x3;
#pragma unroll
            for (int o = 1; o < 32; o <<= 1) ss += shx(ss, lane, o);
            const float rstd = rsqrtf(ss * (1.f / 128.f) + EPS) * qs;
            x0 *= rstd * gain[i]; x1 *= rstd * gain[i + 32]; x2 *= rstd * gain[i + 64]; x3 *= rstd * gain[i + 96];
            if (lat) { const float* rp = r128 + (size_t)t * 128; const float cr = rp[2 * i], sr = rp[2 * i + 1], cc = rp[2 * (32 + i)], sc = rp[2 * (32 + i) + 1];
                const float y0 = x0 * cr - x1 * sr, y1 = x1 * cr + x0 * sr, y2 = x2 * cc - x3 * sc, y3 = x3 * cc + x2 * sc; x0 = y0; x1 = y1; x2 = y2; x3 = y3; }
            p[col + i] = (bf16_t)(cvt_pk_bf16(x0, 0.f) & 0xffffu); p[col + i + 32] = (bf16_t)(cvt_pk_bf16(x1, 0.f) & 0xffffu);
            p[col + i + 64] = (bf16_t)(cvt_pk_bf16(x2, 0.f) & 0xffffu); p[col + i + 96] = (bf16_t)(cvt_pk_bf16(x3, 0.f) & 0xffffu);
        } else {
            const int hsel = lane >> 4, i = lane & 15; int col; const float* gain; float qs = 1.f;
            if (j < 10) { col = 512 + ((j - 8) * 4 + hsel) * 64; gain = A.in[12] + l * 64; }
            else { col = 2816 + ((j - 10) * 4 + hsel) * 64; gain = A.in[11] + l * 64; qs = QS64; }
            float x0 = bf2f(p[col + i]), x1 = bf2f(p[col + i + 16]), x2 = bf2f(p[col + i + 32]), x3 = bf2f(p[col + i + 48]);
            float ss = x0 * x0 + x1 * x1 + x2 * x2 + x3 * x3;
#pragma unroll
            for (int o = 1; o < 16; o <<= 1) ss += shx(ss, lane, o);
            const float rstd = rsqrtf(ss * (1.f / 64.f) + EPS) * qs;
            x0 *= rstd * gain[i]; x1 *= rstd * gain[i + 16]; x2 *= rstd * gain[i + 32]; x3 *= rstd * gain[i + 48];
            if (lat) { const float* rp = r64 + (size_t)t * 64; const float cr = rp[2 * i], sr = rp[2 * i + 1], cc = rp[2 * (16 + i)], sc = rp[2 * (16 + i) + 1];
                const float y0 = x0 * cr - x1 * sr, y1 = x1 * cr + x0 * sr, y2 = x2 * cc - x3 * sc, y3 = x3 * cc + x2 * sc; x0 = y0; x1 = y1; x2 = y2; x3 = y3; }
            p[col + i] = (bf16_t)(cvt_pk_bf16(x0, 0.f) & 0xffffu); p[col + i + 16] = (bf16_t)(cvt_pk_bf16(x1, 0.f) & 0xffffu);
            p[col + i + 32] = (bf16_t)(cvt_pk_bf16(x2, 0.f) & 0xffffu); p[col + i + 48] = (bf16_t)(cvt_pk_bf16(x3, 0.f) & 0xffffu);
        }
    }
}
#ifndef RANK_GQ
#define RANK_GQ 4
#endif
__device__ __forceinline__ void rank_pair(const Args& A, LAS unsigned char* lds, int set, int e, int tok0, int ntok_here, int n, int cap, int tid, int wave, int lane) {
    unsigned char* ws = A.ws; const unsigned* AFFT = (const unsigned*)(ws + WS_AFFT); int* SEL = (int*)(ws + WS_SEL); float* GW = (float*)(ws + WS_GW);
    const bf16_t* H = (const bf16_t*)(ws + WS_H); bf16_t* XG = (bf16_t*)(ws + WS_XG);
    LAS unsigned* col = (LAS unsigned*)lds; LAS unsigned* list = (LAS unsigned*)(lds + 16384); LAS unsigned* wd = (LAS unsigned*)(lds + 20480);
    const int base = set < 2 ? set * SEQ : NLAT + (set - 2) * CTXL;
    __syncthreads();
    unsigned mv[8];
#pragma unroll
    for (int j = 0; j < 8; ++j) { const int i = tid + j * NTHR; const unsigned v = i < n ? AFFT[(size_t)e * MROWS + base + i] : 0u; mv[j] = v; if (i < n) col[i] = v; }
    if (tid == 0) wd[40] = 0u;
    unsigned T = 0u;
    for (int bit = 30; bit >= 0; --bit) {
        const unsigned cand = T | (1u << bit); unsigned c = 0u;
#pragma unroll
        for (int j = 0; j < 8; ++j) c += (unsigned)__popcll(__ballot(mv[j] >= cand));
        LAS unsigned* cw = wd + (bit & 1) * 8;
        if (lane == 0) cw[wave] = c;
        __syncthreads();
        unsigned tot = 0u;
#pragma unroll
        for (int w = 0; w < 8; ++w) tot += cw[w];
        if (tot >= (unsigned)cap) T = cand;
    }
    unsigned cg = 0u, pg = 0u, pe = 0u;
#pragma unroll
    for (int j = 0; j < 8; ++j) { const int i = tid + j * NTHR; cg += (unsigned)__popcll(__ballot(mv[j] > T)); pg += (unsigned)__popcll(__ballot(i < tok0 && mv[j] > T)); pe += (unsigned)__popcll(__ballot(i < tok0 && mv[j] == T)); }
    const int t = tok0 + tid; const bool have = tid < ntok_here; const unsigned mine = have ? col[t] : 0u;
    const bool isg = have && mine > T, isq = have && mine == T;
    const unsigned long long bg = __ballot(isg), bq = __ballot(isq); const unsigned long long lt = (1ull << lane) - 1ull;
    if (lane == 0) { wd[16 + wave] = cg; wd[24 + wave] = pg; wd[32 + wave] = pe; wd[48 + wave] = (unsigned)__popcll(bg); wd[56 + wave] = (unsigned)__popcll(bq); }
    __syncthreads();
    unsigned count_gt = 0u, base_gt = 0u, base_eq = 0u;
#pragma unroll
    for (int w = 0; w < 8; ++w) { count_gt += wd[16 + w]; base_gt += wd[24 + w]; base_eq += wd[32 + w]; if (w < wave) { base_gt += wd[48 + w]; base_eq += wd[56 + w]; } }
    const unsigned need_eq = (unsigned)cap - count_gt;
    const unsigned gt_before = base_gt + (unsigned)__popcll(bg & lt), eq_before = base_eq + (unsigned)__popcll(bq & lt);
    const bool chosen = isg || (isq && eq_before < need_eq);
    if (have) {
        int pos = -1;
        if (chosen) { const unsigned slot = gt_before + (eq_before < need_eq ? eq_before : need_eq); pos = set < 2 ? set * 512 + (int)slot : 1024 + (set - 2) * 32 + (int)slot; GW[e * EPAD + pos] = __uint_as_float(mine);
            const unsigned k = atomicAdd((unsigned*)(wd + 40), 1u); list[2 * k] = (unsigned)(base + t); list[2 * k + 1] = (unsigned)pos; }
        SEL[(size_t)(base + t) * 16 + e] = pos;
    }
    __syncthreads();
    const int nsel = (int)wd[40];
    constexpr int GQ = RANK_GQ;
    for (int k0 = wave; k0 < nsel; k0 += GQ * NWAVES) {
        u32x4 v[GQ][4]; unsigned pos[GQ]; bool ok[GQ];
#pragma unroll
        for (int q = 0; q < GQ; ++q) { const int k = k0 + q * NWAVES; ok[q] = k < nsel; const unsigned row = ok[q] ? list[2 * k] : 0u; pos[q] = ok[q] ? list[2 * k + 1] : 0u;
            const u32x4* src = (const u32x4*)(H + (size_t)row * DM);
            if (ok[q]) {
#pragma unroll
                for (int i = 0; i < 4; ++i) v[q][i] = FP8_EXPERTS ? src[lane * 4 + i] : src[lane + 64 * i]; } }
#pragma unroll
        for (int q = 0; q < GQ; ++q) { if (!ok[q]) continue;
            if (FP8_EXPERTS) { u32x4 o0, o1;
                o0.x = pk4_fp8(bf_lo(v[q][0].x), bf_hi(v[q][0].x), bf_lo(v[q][0].y), bf_hi(v[q][0].y)); o0.y = pk4_fp8(bf_lo(v[q][0].z), bf_hi(v[q][0].z), bf_lo(v[q][0].w), bf_hi(v[q][0].w));
                o0.z = pk4_fp8(bf_lo(v[q][1].x), bf_hi(v[q][1].x), bf_lo(v[q][1].y), bf_hi(v[q][1].y)); o0.w = pk4_fp8(bf_lo(v[q][1].z), bf_hi(v[q][1].z), bf_lo(v[q][1].w), bf_hi(v[q][1].w));
                o1.x = pk4_fp8(bf_lo(v[q][2].x), bf_hi(v[q][2].x), bf_lo(v[q][2].y), bf_hi(v[q][2].y)); o1.y = pk4_fp8(bf_lo(v[q][2].z), bf_hi(v[q][2].z), bf_lo(v[q][2].w), bf_hi(v[q][2].w));
                o1.z = pk4_fp8(bf_lo(v[q][3].x), bf_hi(v[q][3].x), bf_lo(v[q][3].y), bf_hi(v[q][3].y)); o1.w = pk4_fp8(bf_lo(v[q][3].z), bf_hi(v[q][3].z), bf_lo(v[q][3].w), bf_hi(v[q][3].w));
                u32x4* dst = (u32x4*)((unsigned char*)XG + ((size_t)e * EPAD + pos[q]) * DM); dst[lane * 2] = o0; dst[lane * 2 + 1] = o1; }
            else { u32x4* dst = (u32x4*)(XG + ((size_t)e * EPAD + pos[q]) * DM);
#pragma unroll
                for (int i = 0; i < 4; ++i) dst[lane + 64 * i] = v[q][i]; } }
    }
}
__device__ __forceinline__ void phase_rank(const Args& A, LAS unsigned char* lds, int l, int wg, int G, int tid, int wave, int lane) {
#ifndef RANK_XCD
#define RANK_XCD 0
#endif
#ifndef E_XCD
#define E_XCD 1
#endif
    if (RANK_XCD && E_XCD && G == 256) {
        const int x = wg & 7, k = wg >> 3; rank_pair(A, lds, k >> 4, 2 * x + ((k >> 3) & 1), (k & 7) * 512, 512, SEQ, 512, tid, wave, lane); }
    else
    for (int w = wg; w < 256; w += G) { const int pair = w >> 3, chunk = w & 7; rank_pair(A, lds, pair >> 4, pair & 15, chunk * 512, 512, SEQ, 512, tid, wave, lane); }
#ifndef RANK_CTX_SPLIT
#define RANK_CTX_SPLIT 0
#endif
    if (l == 0) {
        if (RANK_CTX_SPLIT) for (int w = wg; w < 256; w += G) rank_pair(A, lds, 2 + (w >> 7), (w >> 3) & 15, (w & 7) * 32, 32, CTXL, 32, tid, wave, lane);
        else for (int w = wg; w < 32; w += G) rank_pair(A, lds, 2 + (w >> 4), w & 15, 0, 256, CTXL, 32, tid, wave, lane); }
    __syncthreads();
}

#ifndef E_XCD
#define E_XCD 1
#endif
#ifndef IN_BLOCK
#define IN_BLOCK 0
#endif
#ifndef IN_XCD
#define IN_XCD 1
#endif
struct SchedIn { const char* A; const char* B; int G, c, l;
    __device__ __forceinline__ bool next(int i, pg8::GUnit& u) const { long L = (long)i * G + c; int pm, pn;
        if (!FP8_GATES) {
            if (l == 0) { if (!pg8::grid_order(L, 34, 40, pm, pn)) return false; }
            else { if (L < 1280) { pg8::grid_order(L, 32, 40, pm, pn); } else if (L < 1296) { const int r = (int)L - 1280; pm = 32 + (r >> 3); pn = r & 7; } else return false; }
        } else if (!FP8_AC) {
            if (l == 0) { if (!pg8::grid_order(L, 34, 16, pm, pn)) return false; }
            else { if (L < 512) { pg8::grid_order(L, 32, 16, pm, pn); } else if (L < 528) { const int r = (int)L - 512; pm = 32 + (r >> 3); pn = r & 7; } else return false; }
        } else {
            if (IN_BLOCK && G == 256 && (l == 1 || (CTX_CHAIN && CTX_GATES_IN_CHAIN))) {
                if (i > 0) return false; const int x = c & 7, k = c >> 3; int q6;
                if (k < 24) { pm = 4 * x + k / 6; q6 = k % 6; pn = q6 < 4 ? 2 + q6 : 7 + q6; }
                else { const int sidx = k - 24, nb = l == 0 ? (x < 4 ? 2 : 1) : 1; if (sidx >= nb) return false;
                    if (l == 0) { const int g = x < 4 ? 2 * x + sidx : 8 + (x - 4); pm = 32 + g / 6; q6 = g % 6; pn = q6 < 4 ? 2 + q6 : 7 + q6; }
                    else { pm = 32 + (x >> 2); pn = 2 + (x & 3); } }
                u.a = A + (size_t)pm * 256 * DM * 2; u.b = B + (size_t)pn * 256 * DM * 2; u.nt = DM / 64; u.pm = pm; u.pn = pn; u.aux = 0; return true; }
            if (IN_XCD && G == 256) L = (long)i * G + ((c & 7) * 32 + (c >> 3));
            const int nlat = (l == 0 ? 34 : 32) * 6;
            if (L < nlat) { const int q = (int)(L % 6); pm = (int)(L / 6); pn = q < 4 ? 2 + q : 7 + q; }
            else if (l == 1 && L < nlat + 8) { const int r = (int)L - nlat; pm = 32 + (r >> 2); pn = 2 + (r & 3); } else return false;
        }
        u.a = A + (size_t)pm * 256 * DM * 2; u.b = B + (size_t)pn * 256 * DM * 2; u.nt = DM / 64; u.pm = pm; u.pn = pn; u.aux = 0; return true; } };
struct SchedIn8 { const char* A; const char* B; int G, c, l;
    __device__ __forceinline__ bool next(int i, pg8::GUnit& u) const { long L; int pm, pn;
        if (!FP8_AC) { const int nM = l == 0 ? 34 : 32;
            if (G == 256) { const int lo = l == 0 ? 32 : 16, n2 = 256 - lo, hi0 = l == 0 ? 176 : 16, hi1 = l == 0 ? 256 : 32;
                if (i < 2) L = (long)i * 256 + c; else if (i == 2) { if (c < lo) return false; L = 512 + (c - lo); } else if (i == 3) { if (c < hi0 || c >= hi1) return false; L = 512 + n2 + (c - hi0); } else return false; }
            else L = (long)i * G + c;
            if (!pg8::grid_order(L, nM, 24, pm, pn)) return false; pn += 16;
        } else {
            constexpr bool CG = CTX_CHAIN && CTX_GATES_IN_CHAIN;
            if (IN_BLOCK && G == 256 && (l == 1 || CG)) {
                const int x = c & 7, k = c >> 3; int q;
                if (i < 4) { pm = 4 * x + (k >> 3); q = 8 * i + (k & 7); pn = q < 2 ? q : (q < 7 ? 4 + q : 6 + q); }
                else { const int sidx = k - 24, nb = l == 0 ? (x < 4 ? 2 : 1) : 1, nf = l == 0 ? (x < 4 ? 2 : 3) : 1;
                    if (sidx < nb || i > 5) return false; const int n = 2 * (sidx - nb) + (i - 4); if (n >= 8 + nf) return false;
                    if (n < 8) { pm = 4 * x + (n >> 1); pn = 38 + (n & 1); }
                    else { const int r = n - 8;
                        if (l == 0) { const int gf = x < 4 ? 2 * x + r : 8 + 3 * (x - 4) + r; pm = 32 + gf / 10; q = gf % 10; pn = q < 2 ? q : (q < 7 ? 4 + q : 6 + q); }
                        else { pm = 32 + (x >> 2); q = x & 3; pn = q < 2 ? q : 4 + q; } } }
                u.a = A + (size_t)pm * 256 * DM; u.b = B + (size_t)pn * 256 * DM; u.nt = DM / 128; u.pm = pm; u.pn = pn; u.aux = 0; return true; }
            const int ntot = l == 0 ? (CG ? 1108 : 1156) : 1096, nlat = l == 0 ? (CG ? 1088 : 1156) : 1088;
            if (G == 256) { int cnt, start; const int c = IN_XCD ? ((this->c & 7) * 32 + (this->c >> 3)) : this->c;
                if (l == 0 && CG) { if (c < 204) { cnt = 4; start = 4 * c; } else if (c < 236) { cnt = 6; start = 816 + 6 * (c - 204); } else { cnt = 5; start = 1008 + 5 * (c - 236); } }
                else if (l == 0) { if (c < 28) { cnt = 5; start = 5 * c; } else if (c < 204) { cnt = 4; start = 140 + 4 * (c - 28); } else { cnt = 6; start = 844 + 6 * (c - 204); } }
                else { if (c < 200) { cnt = 4; start = 4 * c; } else if (c < 240) { cnt = 5; start = 800 + 5 * (c - 200); } else { cnt = 6; start = 1000 + 6 * (c - 240); } }
                if (i >= cnt) return false; L = start + i; }
            else L = (long)i * G + c;
            if (L >= ntot) return false;
            if (L < nlat) { const int q = (int)(L % 34); pm = (int)(L / 34); pn = q < 2 ? q : (q < 7 ? 4 + q : 6 + q); }
            else if (l == 0) { const int r = (int)L - nlat; pm = 32 + r / 10; const int q = r % 10; pn = q < 2 ? q : (q < 7 ? 4 + q : 6 + q); }
            else { const int r = (int)L - nlat; pm = 32 + (r >> 2); const int q = r & 3; pn = q < 2 ? q : 4 + q; }
        }
        u.a = A + (size_t)pm * 256 * DM; u.b = B + (size_t)pn * 256 * DM; u.nt = DM / 128; u.pm = pm; u.pn = pn; u.aux = 0; return true; } };
struct EpiIn { static constexpr bool PERM = true, KEEPS = false, QSKIP = false; float gmul  ; bf16_t* P; LAS float* ssx; const float* r128; const float* r64; const float *kn_a, *kn_b, *kn_c, *qn_a, *qn_b, *qn_c;
    __device__ __forceinline__ void operator()(f32x4 (&acc)[2][2][4][2], const pg8::GUnit& u, int wr, int wc, int fr, int fq) const {
        const int row0 = u.pm * 256 + wr * 64 + fr, col0 = u.pn * 256 + wc * 32 + 8 * fq, pn = u.pn;
        int cls = 0; const float* gain = nullptr; float qs = 1.f;
        constexpr float QS128 = 0.08838834764831845f * LOG2E, QS64 = 0.125f * LOG2E;
        if (pn >= 16) cls = 1;
        else if (FUSE_QK) {
            if (pn == 0) { cls = 2; gain = kn_a; } else if (pn == 6) { cls = 2; gain = kn_c; } else if (pn >= 8 && pn <= 10) { cls = 2; gain = qn_a; qs = QS128; } else if (pn >= 13) { cls = 2; gain = qn_c; qs = QS128; }
            else if (pn == 2 || pn == 3) { cls = 3; gain = kn_b; } else if (pn == 11 || pn == 12) { cls = 3; gain = qn_b; qs = QS64; }
        }
        if (cls < 2) {
#pragma unroll
            for (int ai = 0; ai < 2; ++ai)
#pragma unroll
                for (int m = 0; m < 4; ++m) { bf16_t* rowp = P + (size_t)(row0 + ai * 128 + m * 16) * INW + col0;
#pragma unroll
                    for (int bj = 0; bj < 2; ++bj) { f32x4 v0 = acc[ai][bj][m][0] * gmul, v1 = acc[ai][bj][m][1] * gmul;
                        if (cls == 1) {
#pragma unroll
                            for (int j = 0; j < 4; ++j) { v0[j] = fast_sigmoid(v0[j]); v1[j] = fast_sigmoid(v1[j]); } }
                        u32x4 w; w.x = cvt_pk_bf16(v0[0], v0[1]); w.y = cvt_pk_bf16(v0[2], v0[3]); w.z = cvt_pk_bf16(v1[0], v1[1]); w.w = cvt_pk_bf16(v1[2], v1[3]);
                        *(u32x4*)(rowp + bj * 128) = w; } }
            return;
        }
        const int lane = fq * 16 + fr; const bool lat = u.pm < 32; const bool h128 = cls == 2;
        float ss[2][4][2];
#pragma unroll
        for (int ai = 0; ai < 2; ++ai)
#pragma unroll
            for (int m = 0; m < 4; ++m)
#pragma unroll
                for (int bj = 0; bj < 2; ++bj) { const f32x4 a = acc[ai][bj][m][0] * gmul, b = acc[ai][bj][m][1] * gmul;
                    float s = (a[0] * a[0] + a[1] * a[1]) + (a[2] * a[2] + a[3] * a[3]) + (b[0] * b[0] + b[1] * b[1]) + (b[2] * b[2] + b[3] * b[3]);
                    s = xsum32(xsum16(s)); ss[ai][m][bj] = s; }
        if (fq == 0) {
#pragma unroll
            for (int ai = 0; ai < 2; ++ai)
#pragma unroll
                for (int m = 0; m < 4; ++m)
#pragma unroll
                    for (int bj = 0; bj < 2; ++bj) ssx[(ai * 128 + wr * 64 + m * 16 + fr) * 8 + bj * 4 + wc] = ss[ai][m][bj]; }
        asm volatile("s_waitcnt lgkmcnt(0)" ::: "memory"); __builtin_amdgcn_s_barrier(); asm volatile("" ::: "memory");
        const int dimA = h128 ? ((wc >= 2 ? 64 : 0) + (wc & 1) * 16 + fq * 4) : ((wc & 1) * 32 + fq * 4);
        const int q0 = h128 ? ((wc >= 2 ? 32 : 0) + (wc & 1) * 16 + fq * 4) : ((wc & 1) * 16 + fq * 4);
        const f32x4 ga = *(const f32x4*)(gain + dimA), gb = *(const f32x4*)(gain + dimA + (h128 ? 32 : 16));
        const float inv_dh = h128 ? (1.f / 128.f) : (1.f / 64.f);
#pragma unroll
        for (int ai = 0; ai < 2; ++ai)
#pragma unroll
            for (int m = 0; m < 4; ++m) { const int rl = ai * 128 + wr * 64 + m * 16 + fr, row = u.pm * 256 + rl; bf16_t* rowp = P + (size_t)row * INW + col0;
                f32x4 cv = {1.f, 1.f, 1.f, 1.f}, sv = {0.f, 0.f, 0.f, 0.f};
                if (lat) { const float* rp = (h128 ? r128 + (size_t)(row & (SEQ - 1)) * 128 : r64 + (size_t)(row & (SEQ - 1)) * 64) + 2 * q0;
                    const f32x4 c01 = *(const f32x4*)rp, c23 = *(const f32x4*)(rp + 4); cv = (f32x4){c01[0], c01[2], c23[0], c23[2]}; sv = (f32x4){c01[1], c01[3], c23[1], c23[3]}; }
#pragma unroll
                for (int bj = 0; bj < 2; ++bj) { const f32x4 p4 = *(const LAS f32x4*)(ssx + rl * 8 + bj * 4);
                    const float tot = h128 ? (p4[0] + p4[1]) + (p4[2] + p4[3]) : (wc < 2 ? p4[0] + p4[1] : p4[2] + p4[3]);
                    const float rstd = rsqrtf(tot * inv_dh + EPS) * qs * gmul;
                    const f32x4 xa = acc[ai][bj][m][0] * rstd * ga, xb = acc[ai][bj][m][1] * rstd * gb;
                    const f32x4 ya = xa * cv - xb * sv, yb = xb * cv + xa * sv;
                    u32x4 w; w.x = cvt_pk_bf16(ya[0], ya[1]); w.y = cvt_pk_bf16(ya[2], ya[3]); w.z = cvt_pk_bf16(yb[0], yb[1]); w.w = cvt_pk_bf16(yb[2], yb[3]);
                    *(u32x4*)(rowp + bj * 128) = w; } }
    } };
struct SchedBr { const char* A; const char* B; const char* A8; const char* B8; int G, c, ntiles_m;
    __device__ __forceinline__ bool next(int i, pg8::GUnit& u) const { const int s = i % 3; const long L = (long)(i / 3) * G + c; int pm, pn; if (!pg8::grid_order(L, ntiles_m, 8, pm, pn)) return false;
        const int koff = s == 0 ? 0 : (s == 1 ? 768 : 1280); u.pm = pm; u.pn = pn; u.aux = s;
        if (FP8_BR && s != 1) { u.a = A8 + (size_t)pm * 256 * DM + koff; u.b = B8 + (size_t)pn * 256 * DM + koff; u.nt = 6; u.f8 = 1; }
        else { u.a = A + ((size_t)pm * 256 * DM + koff) * 2; u.b = B + ((size_t)pn * 256 * DM + koff) * 2; u.nt = s == 1 ? 8 : 12; u.f8 = 0; }
        return true; } };
struct EpiBr { static constexpr bool PERM = true, KEEPS = true, QSKIP = false; const bf16_t* P; bf16_t* MM;
    __device__ __forceinline__ bool keep(const pg8::GUnit& u) const { return u.aux < 2; }
    __device__ __forceinline__ void operator()(f32x4 (&acc)[2][2][4][2], const pg8::GUnit& u, int wr, int wc, int fr, int fq) const {
        const int row0 = u.pm * 256 + wr * 64 + fr, col0 = u.pn * 256 + wc * 32 + 8 * fq, s = u.aux;
#pragma unroll
        for (int ai = 0; ai < 2; ++ai)
#pragma unroll
            for (int m = 0; m < 4; ++m) { const size_t row = (size_t)(row0 + ai * 128 + m * 16); const bf16_t* gp = P + row * INW + 4096 + s * 2048 + col0; bf16_t* mp = MM + row * DM + col0;
#pragma unroll
                for (int bj = 0; bj < 2; ++bj) { const u32x4 g = *(const u32x4*)(gp + bj * 128);
                    f32x4 g0 = {bf_lo(g.x), bf_hi(g.x), bf_lo(g.y), bf_hi(g.y)}, g1 = {bf_lo(g.z), bf_hi(g.z), bf_lo(g.w), bf_hi(g.w)};
                    if (s < 2) { const u32x4 h = *(const u32x4*)(gp + 2048 + bj * 128);
                        const f32x4 h0 = {bf_lo(h.x), bf_hi(h.x), bf_lo(h.y), bf_hi(h.y)}, h1 = {bf_lo(h.z), bf_hi(h.z), bf_lo(h.w), bf_hi(h.w)};
                        const float bs = 1.f;
#pragma unroll
                        for (int j = 0; j < 4; ++j) { g0[j] *= bs * __builtin_amdgcn_rcpf(fmaxf(h0[j], 1e-20f)); g1[j] *= bs * __builtin_amdgcn_rcpf(fmaxf(h1[j], 1e-20f)); }
                        acc[ai][bj][m][0] = acc[ai][bj][m][0] * g0; acc[ai][bj][m][1] = acc[ai][bj][m][1] * g1; }
                    else { constexpr float fs = 1.f; const f32x4 v0 = acc[ai][bj][m][0] * g0 * fs, v1 = acc[ai][bj][m][1] * g1 * fs;
                        if (FP8_OUT) { u32x2 w; w.x = pk4_fp8(v0[0], v0[1], v0[2], v0[3]); w.y = pk4_fp8(v1[0], v1[1], v1[2], v1[3]); *(u32x2*)((unsigned char*)MM + row * DM + col0 + bj * 128) = w; }
                        else { u32x4 w; w.x = cvt_pk_bf16(v0[0], v0[1]); w.y = cvt_pk_bf16(v0[2], v0[3]); w.z = cvt_pk_bf16(v1[0], v1[1]); w.w = cvt_pk_bf16(v1[2], v1[3]);
                        *(u32x4*)(mp + bj * 128) = w; } } } }
    } };
struct SchedBrAC { const char* A8; const char* B8; int G, c, ntiles_m;
    __device__ __forceinline__ bool next(int i, pg8::GUnit& u) const { const int s = (i & 1) * 2; const long L = (long)(i >> 1) * G + c; int pm, pn; if (!pg8::grid_order(L, ntiles_m, 8, pm, pn)) return false;
        const int koff = s == 0 ? 0 : 1280; u.a = A8 + (size_t)pm * 256 * DM + koff; u.b = B8 + (size_t)pn * 256 * DM + koff; u.nt = 6; u.pm = pm; u.pn = pn; u.aux = s; u.f8 = 1; return true; } };
struct SchedBrB { const char* A; const char* B; int G, c, ntiles_m;
    __device__ __forceinline__ bool next(int i, pg8::GUnit& u) const { const long L = (long)i * G + c; int pm, pn; if (!pg8::grid_order(L, ntiles_m, 8, pm, pn)) return false;
        u.a = A + ((size_t)pm * 256 * DM + 768) * 2; u.b = B + ((size_t)pn * 256 * DM + 768) * 2; u.nt = 8; u.pm = pm; u.pn = pn; u.aux = 1; u.f8 = 0; return true; } };
struct SchedOneBrAC { const char* A8; const char* B8; int pm, pn;
    __device__ __forceinline__ bool next(int i, pg8::GUnit& u) const { if (i >= 2) return false; const int s = i * 2, koff = s == 0 ? 0 : 1280;
        u.a = A8 + (size_t)pm * 256 * DM + koff; u.b = B8 + (size_t)pn * 256 * DM + koff; u.nt = 6; u.pm = pm; u.pn = pn; u.aux = s; u.f8 = 1; return true; } };
struct SchedOneBrB { const char* A; const char* B; int pm, pn;
    __device__ __forceinline__ bool next(int i, pg8::GUnit& u) const { if (i >= 1) return false;
        u.a = A + ((size_t)pm * 256 * DM + 768) * 2; u.b = B + ((size_t)pn * 256 * DM + 768) * 2; u.nt = 8; u.pm = pm; u.pn = pn; u.aux = 1; u.f8 = 0; return true; } };
struct EpiBrAC { static constexpr bool PERM = true, KEEPS = true, QSKIP = false; const bf16_t* P; bf16_t* MM;
    __device__ __forceinline__ bool keep(const pg8::GUnit& u) const { return u.aux == 0; }
    __device__ __forceinline__ void operator()(f32x4 (&acc)[2][2][4][2], const pg8::GUnit& u, int wr, int wc, int fr, int fq) const {
        const int row0 = u.pm * 256 + wr * 64 + fr, col0 = u.pn * 256 + wc * 32 + 8 * fq, s = u.aux;
#pragma unroll
        for (int ai = 0; ai < 2; ++ai)
#pragma unroll
            for (int m = 0; m < 4; ++m) { const size_t row = (size_t)(row0 + ai * 128 + m * 16); const bf16_t* gp = P + row * INW + 4096 + col0; bf16_t* mp = MM + row * DM + col0;
#pragma unroll
                for (int bj = 0; bj < 2; ++bj) { const u32x4 gc = *(const u32x4*)(gp + 2 * 2048 + bj * 128);
                    f32x4 c0 = {bf_lo(gc.x), bf_hi(gc.x), bf_lo(gc.y), bf_hi(gc.y)}, c1 = {bf_lo(gc.z), bf_hi(gc.z), bf_lo(gc.w), bf_hi(gc.w)};
                    if (s == 0) { const u32x4 ga = *(const u32x4*)(gp + bj * 128);
                        const f32x4 a0 = {bf_lo(ga.x), bf_hi(ga.x), bf_lo(ga.y), bf_hi(ga.y)}, a1 = {bf_lo(ga.z), bf_hi(ga.z), bf_lo(ga.w), bf_hi(ga.w)};
#pragma unroll
                        for (int j = 0; j < 4; ++j) { c0[j] = a0[j] * __builtin_amdgcn_rcpf(fmaxf(c0[j], 1e-20f)); c1[j] = a1[j] * __builtin_amdgcn_rcpf(fmaxf(c1[j], 1e-20f)); }
                        acc[ai][bj][m][0] = acc[ai][bj][m][0] * c0; acc[ai][bj][m][1] = acc[ai][bj][m][1] * c1; }
                    else { const f32x4 v0 = acc[ai][bj][m][0] * c0 * (1.f / 64.f), v1 = acc[ai][bj][m][1] * c1 * (1.f / 64.f); u32x4 w;
                        w.x = cvt_pk_bf16(v0[0], v0[1]); w.y = cvt_pk_bf16(v0[2], v0[3]); w.z = cvt_pk_bf16(v1[0], v1[1]); w.w = cvt_pk_bf16(v1[2], v1[3]);
                        *(u32x4*)(mp + bj * 128) = w; } } }
    } };
struct EpiBrB { static constexpr bool PERM = true, KEEPS = false, QSKIP = false; const bf16_t* P; bf16_t* MM;
    __device__ __forceinline__ void operator()(f32x4 (&acc)[2][2][4][2], const pg8::GUnit& u, int wr, int wc, int fr, int fq) const {
        const int row0 = u.pm * 256 + wr * 64 + fr, col0 = u.pn * 256 + wc * 32 + 8 * fq;
#pragma unroll
        for (int ai = 0; ai < 2; ++ai)
#pragma unroll
            for (int m = 0; m < 4; ++m) { const size_t row = (size_t)(row0 + ai * 128 + m * 16); const bf16_t* gp = P + row * INW + 4096 + 2048 + col0; bf16_t* mp = MM + row * DM + col0;
#pragma unroll
                for (int bj = 0; bj < 2; ++bj) { const u32x4 g = *(const u32x4*)(gp + bj * 128); const u32x4 pv = *(const u32x4*)(mp + bj * 128);
                    const f32x4 v0 = acc[ai][bj][m][0], v1 = acc[ai][bj][m][1]; u32x4 w;
                    w.x = cvt_pk_bf16(bf_lo(pv.x) + bf_lo(g.x) * v0[0], bf_hi(pv.x) + bf_hi(g.x) * v0[1]); w.y = cvt_pk_bf16(bf_lo(pv.y) + bf_lo(g.y) * v0[2], bf_hi(pv.y) + bf_hi(g.y) * v0[3]);
                    w.z = cvt_pk_bf16(bf_lo(pv.z) + bf_lo(g.z) * v1[0], bf_hi(pv.z) + bf_hi(g.z) * v1[1]); w.w = cvt_pk_bf16(bf_lo(pv.w) + bf_lo(g.w) * v1[2], bf_hi(pv.w) + bf_hi(g.w) * v1[3]);
                    *(u32x4*)(mp + bj * 128) = w; } }
    } };
struct SchedOut { const char* A; const char* B; int G, c, ntiles_m;
    __device__ __forceinline__ bool next(int i, pg8::GUnit& u) const { const long L = (long)i * G + c; int pm, pn; if (!pg8::grid_order(L, ntiles_m, 8, pm, pn)) return false;
        constexpr int OS = FP8_OUT ? 1 : 2; u.a = A + (size_t)pm * 256 * DM * OS; u.b = B + (size_t)pn * 256 * DM * OS; u.nt = DM * OS / 128; u.pm = pm; u.pn = pn; u.aux = 0; return true; } };
struct EpiOut { static constexpr bool PERM = false, KEEPS = false, QSKIP = false; const float* base_lat; const float* base_ctx; float* X; const float* g1;
    __device__ __forceinline__ void operator()(f32x4 (&acc)[2][2][4][2], const pg8::GUnit& u, int wr, int wc, int fr, int fq) const {
        const int row0 = u.pm * 256 + wr * 64 + fr, col0 = u.pn * 256 + wc * 32 + 4 * fq; const float* gv = g1 + (size_t)(u.pm < 16 ? 0 : (u.pm < 32 ? 1 : 2)) * MODW + col0;
        f32x4 g[2][2];
#pragma unroll
        for (int bj = 0; bj < 2; ++bj)
#pragma unroll
            for (int n = 0; n < 2; ++n) g[bj][n] = *(const f32x4*)(gv + bj * 128 + n * 16);
#pragma unroll
        for (int ai = 0; ai < 2; ++ai)
#pragma unroll
            for (int m = 0; m < 4; ++m) { const int row = row0 + ai * 128 + m * 16; const float* bp = (u.pm < 32 ? base_lat + (size_t)row * DM : base_ctx + (size_t)(row - NLAT) * DM) + col0; float* xp = X + (size_t)row * DM + col0;
#pragma unroll
                for (int bj = 0; bj < 2; ++bj)
#pragma unroll
                    for (int n = 0; n < 2; ++n) { const f32x4 b = *(const f32x4*)(bp + bj * 128 + n * 16); *(f32x4*)(xp + bj * 128 + n * 16) = b + g[bj][n] * (acc[ai][bj][m][n] * (FP8_OUT ? (1.f / 64.f) : 1.f)); }
                asm volatile("" ::: "memory"); }
    } };
struct SchedE1 { const char* A; const char* B; int G, c, nrt;
    __device__ __forceinline__ bool next(int i, pg8::GUnit& u) const { int pn, e, rt;
        if (E_XCD && G == 256) {
            const int x = c & 7, k = c >> 3, ui = i * 32 + k, per = nrt * 8; if (ui >= 2 * per) return false;
            e = 2 * x + ui / per; const int rem = ui % per; rt = rem >> 3; pn = rem & 7;
        } else { const long L = (long)i * G + c; if (L >= (long)16 * nrt * 8) return false;
            pn = (int)(L & 7); const int er = (int)(L >> 3); e = er / nrt; rt = er % nrt; }
        constexpr int ES = FP8_EXPERTS ? 1 : 2; u.a = A + ((size_t)e * EPAD + rt * 256) * DM * ES; u.b = B + ((size_t)e * 2048 + pn * 256) * DM * ES; u.nt = DM * ES / 128; u.pm = rt; u.pn = pn; u.aux = e; u.q = rt == 4; return true; } };
struct EpiE1 { static constexpr bool PERM = true, KEEPS = false, QSKIP = true; bf16_t* ACT; int nrows;
    __device__ __forceinline__ void operator()(f32x4 (&acc)[2][2][4][2], const pg8::GUnit& u, int wr, int wc, int fr, int fq) const {
        const int row0 = u.pm * 256 + wr * 64 + fr, col0 = u.pn * 128 + wc * 32 + 8 * fq;
#pragma unroll
        for (int ai = 0; ai < 2; ++ai)
#pragma unroll
            for (int m = 0; m < 4; ++m) { const int row = row0 + ai * 128 + m * 16; if (row >= nrows) continue;
                constexpr float WS = FP8_EXPERTS ? (1.f / 64.f) : 1.f;
                const f32x4 g0 = acc[ai][0][m][0] * WS, g1 = acc[ai][0][m][1] * WS, u0 = acc[ai][1][m][0] * WS, u1 = acc[ai][1][m][1] * WS; f32x4 a0, a1;
#pragma unroll
                for (int j = 0; j < 4; ++j) { a0[j] = g0[j] * fast_sigmoid(g0[j]) * u0[j]; a1[j] = g1[j] * fast_sigmoid(g1[j]) * u1[j]; }
                if (FP8_EXPERTS) { u32x2 w; w.x = pk4_fp8(a0[0], a0[1], a0[2], a0[3]); w.y = pk4_fp8(a1[0], a1[1], a1[2], a1[3]); *(u32x2*)((unsigned char*)ACT + ((size_t)u.aux * EPAD + row) * FF + col0) = w; }
                else { u32x4 w; w.x = cvt_pk_bf16(a0[0], a0[1]); w.y = cvt_pk_bf16(a0[2], a0[3]); w.z = cvt_pk_bf16(a1[0], a1[1]); w.w = cvt_pk_bf16(a1[2], a1[3]);
                *(u32x4*)(ACT + ((size_t)u.aux * EPAD + row) * FF + col0) = w; } }
    } };
struct SchedE2 { const char* A; const char* B; int G, c, nrt;
    __device__ __forceinline__ bool next(int i, pg8::GUnit& u) const { int pn, e, rt;
        if (E_XCD && G == 256) {
            const int x = c & 7, k = c >> 3, ui = i * 32 + k, per = nrt * 8; if (ui >= 2 * per) return false;
            e = 2 * x + ui / per; const int rem = ui % per; rt = rem >> 3; pn = rem & 7;
        } else { const long L = (long)i * G + c; if (L >= (long)16 * nrt * 8) return false;
            pn = (int)(L & 7); const int er = (int)(L >> 3); e = er / nrt; rt = er % nrt; }
        constexpr int ES = FP8_EXPERTS ? 1 : 2; u.a = A + ((size_t)e * EPAD + rt * 256) * FF * ES; u.b = B + ((size_t)e * 2048 + pn * 256) * FF * ES; u.nt = FF * ES / 128; u.pm = rt; u.pn = pn; u.aux = e; u.q = rt == 4; return true; } };
struct EpiE2 { static constexpr bool PERM = true, KEEPS = false, QSKIP = true; bf16_t* Y; const float* GW; int nrows;
    __device__ __forceinline__ void operator()(f32x4 (&acc)[2][2][4][2], const pg8::GUnit& u, int wr, int wc, int fr, int fq) const {
        const int row0 = u.pm * 256 + wr * 64 + fr, col0 = u.pn * 256 + wc * 32 + 8 * fq;
#pragma unroll
        for (int ai = 0; ai < 2; ++ai)
#pragma unroll
            for (int m = 0; m < 4; ++m) { const int row = row0 + ai * 128 + m * 16; if (row >= nrows) continue; const float gw = GW[u.aux * EPAD + row] * (FP8_EXPERTS ? (1.f / 64.f) : 1.f);
                bf16_t* yp = Y + ((size_t)u.aux * EROWS + row) * DM + col0;
#pragma unroll
                for (int bj = 0; bj < 2; ++bj) { const f32x4 v0 = acc[ai][bj][m][0] * gw, v1 = acc[ai][bj][m][1] * gw;
                    u32x4 w; w.x = cvt_pk_bf16(v0[0], v0[1]); w.y = cvt_pk_bf16(v0[2], v0[3]); w.z = cvt_pk_bf16(v1[0], v1[1]); w.w = cvt_pk_bf16(v1[2], v1[3]);
                    *(u32x4*)(yp + bj * 128) = w; } }
    } };

template <int KIND> __device__ __forceinline__ void attn_decode(int idx, bool ctx, att::AUnit& u, const float* sink_l) {
    u.dpos = 0; u.sink2 = 0.f;
    if (KIND == 0) {
        if (!ctx) { const int b = idx / 96, r = idx % 96, h = r / 16, qb = r % 16;
            u.qrow0 = b * SEQ + qb * 256; u.qcol = 2048 + h * 128; u.kcol = (h / 3) * 128; u.vcol = 256 + (h / 3) * 128; u.ocol = h * 128; u.nlat_t = 64; u.lat_row0 = b * SEQ; u.ctx_row0 = NLAT + b * CTXL; }
        else { const int b = idx / 6, h = idx % 6;
            u.qrow0 = NLAT + b * CTXL; u.qcol = 2048 + h * 128; u.kcol = (h / 3) * 128; u.vcol = 256 + (h / 3) * 128; u.ocol = h * 128; u.nlat_t = 0; u.lat_row0 = 0; u.ctx_row0 = NLAT + b * CTXL; }
    } else if (KIND == 1) {
        if (!ctx) { const int b = idx / 128, r = idx % 128, h = r / 32, qb = r % 32;
            u.qrow0 = b * SEQ + qb * 128; u.qcol = 2816 + h * 128; u.kcol = 512 + h * 128; u.vcol = 1024 + h * 128; u.ocol = 768 + h * 128; u.nlat_t = 64; u.lat_row0 = b * SEQ; u.ctx_row0 = NLAT + b * CTXL; }
        else { const int b = idx / 8, r = idx % 8, h = r / 2, qb = r % 2;
            u.qrow0 = NLAT + b * CTXL + qb * 128; u.qcol = 2816 + h * 128; u.kcol = 512 + h * 128; u.vcol = 1024 + h * 128; u.ocol = 768 + h * 128; u.nlat_t = 0; u.lat_row0 = 0; u.ctx_row0 = NLAT + b * CTXL; }
    } else {
        if (!ctx) { const int b = idx / 96, r = idx % 96, h = r / 16, qb = r % 16; const int t0 = qb * 256; const int lo = t0 - 128 < 0 ? 0 : t0 - 128, hi = t0 + 384 > SEQ ? SEQ : t0 + 384;
            u.qrow0 = b * SEQ + t0; u.qcol = 3328 + h * 128; u.kcol = 1536 + (h / 3) * 128; u.vcol = 1792 + (h / 3) * 128; u.ocol = 1280 + h * 128; u.nlat_t = (hi - lo) / 64; u.lat_row0 = b * SEQ + lo; u.ctx_row0 = NLAT + b * CTXL;
            u.dpos = lo - t0; u.sink2 = sink_l[h] * LOG2E; }
        else { const int b = idx / 6, h = idx % 6;
            u.qrow0 = NLAT + b * CTXL; u.qcol = 3328 + h * 128; u.kcol = 1536 + (h / 3) * 128; u.vcol = 1792 + (h / 3) * 128; u.ocol = 1280 + h * 128; u.nlat_t = 0; u.lat_row0 = 0; u.ctx_row0 = NLAT + b * CTXL; u.sink2 = sink_l[h] * LOG2E; }
    }
}
__device__ __forceinline__ void publish_inc(unsigned* ctr, int tid) {
    asm volatile("s_waitcnt vmcnt(0)" ::: "memory"); __syncthreads();
    if (tid == 0) { __builtin_amdgcn_fence(__ATOMIC_RELEASE, "agent"); asm volatile("s_waitcnt vmcnt(0)" ::: "memory"); (void)xb_add(ctr, 1u); }
}
__device__ __forceinline__ void wait_ge(unsigned* ctr, unsigned want, int tid) {
    if (tid == 0) { unsigned sp = 0u; while (xb_ld(ctr) < want) { __builtin_amdgcn_s_sleep(2); if (++sp > (1u << 20)) break; }
        __builtin_amdgcn_fence(__ATOMIC_ACQUIRE, "agent"); asm volatile("s_waitcnt vmcnt(0)" ::: "memory"); }
    __syncthreads();
}
__device__ __forceinline__ void router_tile(const Args& A, int l, int pm, int pn, unsigned* pctr) {
    int tz = threadIdx.x; asm volatile("" : "+v"(tz)); const int tid = tz, lane = tz & 63, wave = __builtin_amdgcn_readfirstlane(tz >> 6);
    unsigned char* ws = A.ws; const float* X = (const float*)(ws + WS_X); bf16_t* H = (bf16_t*)(ws + WS_H); float* AFFT = (float*)(ws + WS_AFFT); float* XCH = (float*)(ws + WS_XCH);
    const int mr = pm < 16 ? 0 : (pm < 32 ? 1 : 2);
    const float* mv = (const float*)(ws + WS_MODV) + (size_t)(l * 3 + mr) * MODW; const float* wr = A.in[25] + (size_t)l * DM * 16; const float* gain = A.in[7] + l * DM;
    const float* biasr = (const float*)(ws + WS_BIASR) + (l * 3 + mr) * 16;
    if (tid == 0) { __builtin_amdgcn_fence(__ATOMIC_ACQUIRE, "agent"); asm volatile("s_waitcnt vmcnt(0)" ::: "memory"); }
    __syncthreads();
    const int c0 = pn * 256 + 4 * lane, row0 = pm * 256 + wave * 32;
    f32x4 gsc, sh; { const f32x4 g4 = *(const f32x4*)(gain + c0), sc4 = *(const f32x4*)(mv + 4 * DM + c0); gsc = g4 * (sc4 + 1.f); sh = *(const f32x4*)(mv + 3 * DM + c0); }
    f32x4 x[32];
#pragma unroll
    for (int i = 0; i < 32; ++i) x[i] = *(const f32x4*)(X + (size_t)(row0 + i) * DM + c0);
    {   float Wl[4][16];
#pragma unroll
        for (int j = 0; j < 4; ++j)
#pragma unroll
            for (int q = 0; q < 4; ++q) { const f32x4 w4 = *(const f32x4*)(wr + (size_t)(c0 + j) * 16 + 4 * q);
#pragma unroll
                for (int t = 0; t < 4; ++t) Wl[j][4 * q + t] = gsc[j] * w4[t]; }
#pragma unroll
        for (int i = 0; i < 32; ++i) { float pl[16];
#pragma unroll
            for (int e = 0; e < 16; ++e) pl[e] = x[i][0] * Wl[0][e] + x[i][1] * Wl[1][e] + x[i][2] * Wl[2][e] + x[i][3] * Wl[3][e];
            const float pt = treduce16(pl, lane);
            const float ss = wave_sum((x[i][0] * x[i][0] + x[i][1] * x[i][1]) + (x[i][2] * x[i][2] + x[i][3] * x[i][3]), lane);
            float* slot = XCH + ((size_t)(row0 + i) * 8 + pn) * 20;
            if ((lane & 3) == 0) slot[lane >> 2] = pt;
            if (lane == 0) slot[16] = ss; }
    }
    publish_inc(pctr, tid);
    wait_ge(pctr, 8u, tid);
    const float bias = lane < 16 ? biasr[lane] : 0.f;
#pragma unroll
    for (int i0 = 0; i0 < 32; i0 += 8) { float part[8];
#pragma unroll
        for (int i = 0; i < 8; ++i) { const int row = row0 + i0 + i; float s = 0.f;
            if (lane < 17) {
#pragma unroll
                for (int q = 0; q < 8; ++q) s += XCH[((size_t)row * 8 + q) * 20 + lane]; }
            part[i] = s; }
#pragma unroll
        for (int i = 0; i < 8; ++i) { const int row = row0 + i0 + i;
            const float sst = __uint_as_float((unsigned)__builtin_amdgcn_readlane((int)__float_as_uint(part[i]), 16));
            const float rstd = rsqrtf(sst * (1.f / DM) + EPS);
            { const f32x4 h = x[i0 + i] * rstd * gsc + sh; u32x2 w2; w2.x = cvt_pk_bf16(h[0], h[1]); w2.y = cvt_pk_bf16(h[2], h[3]); *(u32x2*)(H + (size_t)row * DM + c0) = w2; }
            if (pn == 0) {
                const float logit = lane < 16 ? rstd * part[i] + bias : -3.0e38f; const float mx = row_max16(logit);
                const float ex = lane < 16 ? expf(logit - mx) : 0.f; const float s = row_sum16(ex);
                if (lane < 16) AFFT[(size_t)lane * MROWS + row] = ex / s; } }
    }
}
struct SchedOneBr { const char* A; const char* B; const char* A8; const char* B8; int pm, pn;
    __device__ __forceinline__ bool next(int i, pg8::GUnit& u) const { if (i >= 3) return false; const int s = i, koff = s == 0 ? 0 : (s == 1 ? 768 : 1280); u.pm = pm; u.pn = pn; u.aux = s;
        if (FP8_BR && s != 1) { u.a = A8 + (size_t)pm * 256 * DM + koff; u.b = B8 + (size_t)pn * 256 * DM + koff; u.nt = 6; u.f8 = 1; }
        else { u.a = A + ((size_t)pm * 256 * DM + koff) * 2; u.b = B + ((size_t)pn * 256 * DM + koff) * 2; u.nt = s == 1 ? 8 : 12; u.f8 = 0; }
        return true; } };
struct SchedGate3 { const char* A; const char* B; int pm, pn;
    __device__ __forceinline__ bool next(int i, pg8::GUnit& u) const { if (i >= 3) return false; const int gp = 16 + 8 * i + pn;
        u.a = A + (size_t)pm * 256 * DM; u.b = B + (size_t)gp * 256 * DM; u.nt = DM / 128; u.pm = pm; u.pn = gp; u.aux = 0; return true; } };
struct SchedOneOut { const char* A; const char* B; int pm, pn;
    __device__ __forceinline__ bool next(int i, pg8::GUnit& u) const { if (i >= 1) return false; constexpr int OS = FP8_OUT ? 1 : 2;
        u.a = A + (size_t)pm * 256 * DM * OS; u.b = B + (size_t)pn * 256 * DM * OS; u.nt = DM * OS / 128; u.pm = pm; u.pn = pn; u.aux = 0; return true; } };

constexpr int N_PHASES = 22;
__global__ void __launch_bounds__(NTHR, 2) mega(Args args) {
    extern __shared__ __attribute__((aligned(16))) unsigned char lds_raw[];
    LAS unsigned char* lds = (LAS unsigned char*)lds_raw;
    const int G = gridDim.x, wg = blockIdx.x, NGW = G * NWAVES;
    unsigned char* ws = args.ws; unsigned* ctl = (unsigned*)(ws + WS_CTL);
    volatile LAS unsigned* MISC = (volatile LAS unsigned*)(lds + MISC_OFF);
    if (threadIdx.x < 32) MISC[threadIdx.x] = 0u;
    __syncthreads();
    const int lo = args.ph_lo, hi = args.ph_hi; const bool multi = (hi - lo) > 1;
    const bool fuse_router = FUSE_ROUTER && CTX_CHAIN && G == 256;
    XcdBarrier bar; bar.bar = ctl + CW_BAR; bar.x = 0; bar.st = nullptr;
    if (multi) bar = xcd_barrier_post(ctl + CW_BAR, MISC + 8);
#ifndef PH_MASK
#define PH_MASK 0xffffffffu
#endif
#define PHON(b) ((PH_MASK >> (b)) & 1u)
#ifndef REP_MASK
#define REP_MASK 0u
#endif
#define REPEAT(b) _Pragma("unroll 1") for (int rep = 0; rep < ((((REP_MASK >> (b)) & 1u) && ((b) != 6 || l == 0)) ? 2 : 1); ++rep)
#define REPBAR() do { if (rep && multi) xcd_barrier(bar); } while (0)
#define IN(k) (lo <= (k) && (k) < hi)
#define HIDE_TID() int tz = threadIdx.x; asm volatile("" : "+v"(tz)); const int tid = tz, lane = tz & 63, wave = __builtin_amdgcn_readfirstlane(tz >> 6), gw = wg * NWAVES + wave; (void)tid; (void)lane; (void)wave; (void)gw
#define SEAM(k) do { if (IN(k) && IN((k) + 1)) xcd_barrier(bar); } while (0)
#define SEAM_BG(k, force_upto) do { if (IN(k) && IN((k) + 1)) { if (BG_CONV && multi) bg_loop(args, lds, ctl, MISC, (k), (force_upto), G); xcd_barrier(bar); } } while (0)
    if (PHON(0) && IN(0)) _Pragma("unroll 1") for (int rep = 0; rep < ((REP_MASK & 1u) ? 2 : 1); ++rep) { REPBAR(); HIDE_TID();
#ifndef P0_PROBE
#define P0_PROBE 0
#endif
        if (!(P0_PROBE == 1 && rep == 0 && (REP_MASK & 1u))) p0_modv(args, lds, tid, lane, wave, wg, G, 0, (MODV1_IN_ATT && CONV_IN_ATT == 2 && P0_DYN && multi && !BG_CONV) ? 96 : 2 * 96);
#ifndef P0_DYN
#define P0_DYN 1
#endif
        if (!(P0_PROBE == 2 && rep == 0 && (REP_MASK & 1u))) {
#ifndef CONV_PIPE
#define CONV_PIPE 1
#endif
#ifndef CONV_IN_ATT
#define CONV_IN_ATT 2
#endif
#ifndef CONV_SEL
#define CONV_SEL(wg) ((((wg) >> 3) & 3) == 3)
#endif
            if (P0_DYN && multi && !BG_CONV) { p0_convert_dyn(args, lds, ctl + CW_BGQ + 64 + 64 * rep, MISC, tid, wave, lane, CONV_IN_ATT == 2 ? CV_D1 : (CONV_IN_ATT ? CV_PER_L : 2 * CV_PER_L)); p0_prologue(args, lds, wave, lane, gw, NGW, 0); }
            else p0_prologue(args, lds, wave, lane, gw, NGW, (BG_CONV && multi) ? CV_PER_L : 2 * CV_PER_L); } }
    SEAM(0);
#pragma unroll 1
    for (int l = 0; l < 2; ++l) {
        const int pb = 1 + 10 * l;
        const float* modv_l = (const float*)(ws + WS_MODV) + (size_t)l * 3 * MODW;
#ifdef BAR_PROBE
        if (multi && l == 0) { for (int bi = 0; bi < BAR_PROBE; ++bi) xcd_barrier(bar); }
#endif
        if (PHON(1) && IN(pb + 0)) { HIDE_TID(); if (l == 0) row_phase_a<0>(args, l, lane, gw, NGW); else row_phase_a<1>(args, l, lane, gw, NGW); }
        SEAM_BG(pb + 0, l == 1 ? CV_D1 : 0);
        if (PHON(2) && IN(pb + 1)) REPEAT(2) {
            REPBAR();
            SchedIn S{(const char*)(ws + WS_H), (const char*)(ws + WS_WIN) + (size_t)l * INW * DM * 2, G, wg, l}; EpiIn E{1.f, (bf16_t*)(ws + WS_P), (LAS float*)(lds + RING_BYTES), (const float*)(ws + WS_ROPE128), (const float*)(ws + WS_ROPE64), args.in[10] + l * 128, args.in[12] + l * 64, args.in[19] + l * 128, args.in[9] + l * 128, args.in[11] + l * 64, args.in[18] + l * 128};
            if (!IN_BLOCK) pg8::gemm_phase<EpiIn, SchedIn>(lds, DM * 2, DM * 2, S, E);
            if (FP8_GATES) { SchedIn8 S8{(const char*)(ws + WS_H8), (const char*)(ws + WS_WIN8) + (size_t)l * INW * DM, G, wg, l}; const EpiIn E8{1.f / 64.f, (bf16_t*)(ws + WS_P), (LAS float*)(lds + RING_BYTES), (const float*)(ws + WS_ROPE128), (const float*)(ws + WS_ROPE64), args.in[10] + l * 128, args.in[12] + l * 64, args.in[19] + l * 128, args.in[9] + l * 128, args.in[11] + l * 64, args.in[18] + l * 128};
                pg8::gemm_phase<EpiIn, SchedIn8, true>(lds, DM, DM, S8, E8); }
            if (IN_BLOCK) pg8::gemm_phase<EpiIn, SchedIn>(lds, DM * 2, DM * 2, S, E);
        }
        SEAM_BG(pb + 1, 0);
        if (!FUSE_QK) { if (PHON(3) && IN(pb + 2)) { HIDE_TID(); row_phase_c(args, l, lane, gw, NGW); }
        SEAM(pb + 2); }
        if (PHON(4) && IN(pb + 3)) REPEAT(4) {
            REPBAR(); HIDE_TID();
            const float lambda_init = 0.8f - 0.6f * expf(-0.3f * (float)l);
            float lam; { const float a = wave_sum(args.in[13][l * 64 + lane] * args.in[14][l * 64 + lane], lane), b = wave_sum(args.in[15][l * 64 + lane] * args.in[16][l * 64 + lane], lane); lam = expf(a) - expf(b) + lambda_init; lam = __uint_as_float((unsigned)__builtin_amdgcn_readfirstlane((int)__float_as_uint(lam))); }
            const bf16_t* P = (const bf16_t*)(ws + WS_P); bf16_t* O = (bf16_t*)(ws + WS_OATT);
#ifndef ATT_NOMAX
#define ATT_NOMAX 1
#endif
            bool nomax_ac = false, nomax_b = false;
            if (ATT_NOMAX) {
                const float ga = fmaxf(fabsf(args.in[9][l * 128 + lane]), fabsf(args.in[9][l * 128 + 64 + lane])), ka = fmaxf(fabsf(args.in[10][l * 128 + lane]), fabsf(args.in[10][l * 128 + 64 + lane]));
                const float gc = fmaxf(fabsf(args.in[18][l * 128 + lane]), fabsf(args.in[18][l * 128 + 64 + lane])), kc = fmaxf(fabsf(args.in[19][l * 128 + lane]), fabsf(args.in[19][l * 128 + 64 + lane]));
                const float gb = fabsf(args.in[11][l * 64 + lane]), kb = fabsf(args.in[12][l * 64 + lane]);
                const float ba = wave_max(ga, lane) * wave_max(ka, lane), bc = wave_max(gc, lane) * wave_max(kc, lane), bb = wave_max(gb, lane) * wave_max(kb, lane);
                const float sk = fabsf(sink_bound(args.in[20] + l * 6));
                nomax_ac = __builtin_amdgcn_readfirstlane((int)(fmaxf(ba, bc) * 16.33f < 100.f && sk < 60.f)) != 0;
                nomax_b = __builtin_amdgcn_readfirstlane((int)(bb * 11.55f < 100.f)) != 0;
            }
            const float* sink_l = args.in[20] + l * 6; const float* subln = args.in[17] + l * 128;
#ifndef ATT_KINDS
#define ATT_KINDS 7
#endif
            const bool ctxl = (l == 0);
            unsigned* qb = ctl + CW_QUEUE + 64 * (rep * 16 + l * 8); unsigned* cctr = ctl + CW_CTX + 128 * rep;
            if (CONV_IN_ATT == 2 && P0_DYN && multi && !BG_CONV && rep == 0 && CONV_SEL(wg)) {
                if (MODV1_IN_ATT && l == 0) { p0_modv(args, lds, tid, lane, wave, (wg >> 5) * 8 + (wg & 7), 64, 96, 2 * 96); __syncthreads(); }
#ifndef CONV_SPLIT_BR
#define CONV_SPLIT_BR 0
#endif
                const int i0 = l == 0 ? CV_D1 : (CONV_SPLIT_BR ? CV_PER_L + CV_I_IN : CV_PER_L + CV_D1);
                const int nn = l == 0 ? ((CONV_IN_EXP && E_XCD && G == 256) ? CV_PER_L - CV_D1 : (CONV_SPLIT_BR ? CV_PER_L - CV_D1 + CV_I_IN : CV_PER_L)) : (CONV_SPLIT_BR ? CV_PER_L - CV_I_IN : CV_PER_L - CV_D1);
                if (CONV_PIPE) p0_convert_dyn2(args, lds, ctl + CW_BGQ + 192 + 64 * l, MISC, tid, wave, lane, nn, i0); else p0_convert_dyn(args, lds, ctl + CW_BGQ + 192 + 64 * l, MISC, tid, wave, lane, nn, i0); }
            else if (CONV_IN_ATT == 1 && P0_DYN && multi && !BG_CONV && l == 0 && rep == 0 && CONV_SEL(wg)) { if (CONV_PIPE) p0_convert_dyn2(args, lds, ctl + CW_BGQ + 192, MISC, tid, wave, lane, CV_PER_L, CV_PER_L); else p0_convert_dyn(args, lds, ctl + CW_BGQ + 192, MISC, tid, wave, lane, CV_PER_L, CV_PER_L); }
#define ATT_CLAIM(q) ({ __syncthreads(); if (tid == 0) MISC[0] = atomicAdd(qb + 64 * (q), 1u); __syncthreads(); __builtin_amdgcn_readfirstlane((int)MISC[0]); })
#define ATT_RUN(KIND, idx, isctx) do { att::AUnit u; attn_decode<KIND>(idx, isctx, u, sink_l); unsigned char* o8_ = FP8_BR ? (unsigned char*)(ws + WS_OATT8) : (unsigned char*)nullptr; \
    if (ATT_NOMAX && (KIND == 1 ? nomax_b : nomax_ac)) att::attn_unit<KIND, 20>(u, P, O, o8_, (LAS char*)lds, lam, 1.f - lambda_init, subln); else att::attn_unit<KIND>(u, P, O, o8_, (LAS char*)lds, lam, 1.f - lambda_init, subln); } while (0)
#ifndef ATT_PROBE
#define ATT_PROBE 0
#endif
#ifndef ATT_PROBE_KINDS
#define ATT_PROBE_KINDS 7
#endif
            if (ATT_PROBE && multi) {
                unsigned* qp = ctl + CW_QUEUE + 64 * (16 + l * 8);
#define ATT_CLAIMP(q) ({ __syncthreads(); if (tid == 0) MISC[0] = atomicAdd(qp + 64 * (q), 1u); __syncthreads(); __builtin_amdgcn_readfirstlane((int)MISC[0]); })
#define ATT_RUNP(KIND, idx) do { att::AUnit u; attn_decode<KIND>(idx, false, u, sink_l); att::attn_unit<KIND, ATT_PROBE == 1 ? 8 : ATT_PROBE>(u, P, O, FP8_BR ? (unsigned char*)(ws + WS_OATT8) : (unsigned char*)nullptr, (LAS char*)lds, lam, 1.f - lambda_init, subln); } while (0)
                if (ATT_PROBE_KINDS & 1) for (;;) { const int qi = ATT_CLAIMP(1); if (qi >= 192) break; ATT_RUNP(0, qi); }
                if (ATT_PROBE_KINDS & 2) for (;;) { const int qi = ATT_CLAIMP(2); if (qi >= 256) break; ATT_RUNP(1, qi); }
                if (ATT_PROBE_KINDS & 4) for (;;) { const int qi = ATT_CLAIMP(3); if (qi >= 192) break; ATT_RUNP(2, qi); }
                xcd_barrier(bar);
            }
#define ATT_CHAIN_BODY() do { \
                        if (FP8_GATES && FP8_AC && CTX_GATES_IN_CHAIN) { \
                            SchedGate3 S{(const char*)(ws + WS_H8), (const char*)(ws + WS_WIN8) + (size_t)l * INW * DM, pm, pn}; \
                            const EpiIn E8{1.f / 64.f, (bf16_t*)(ws + WS_P), (LAS float*)(lds + RING_BYTES), (const float*)(ws + WS_ROPE128), (const float*)(ws + WS_ROPE64), args.in[10] + l * 128, args.in[12] + l * 64, args.in[19] + l * 128, args.in[9] + l * 128, args.in[11] + l * 64, args.in[18] + l * 128}; \
                            pg8::gemm_phase<EpiIn, SchedGate3, true>(lds, DM, DM, S, E8); } \
                        wait_ge(cctr, 40u, tid); \
                        { SchedOneBr S{(const char*)(ws + WS_OATT), (const char*)(ws + WS_WBR) + (size_t)l * DM * DM * 2, (const char*)(ws + WS_OATT8), (const char*)(ws + WS_WBR8) + (size_t)l * DM * DM, pm, pn}; EpiBr E{(const bf16_t*)(ws + WS_P), (bf16_t*)(ws + WS_MM)}; \
                          if (FP8_BR) { SchedOneBrAC S1{(const char*)(ws + WS_OATT8), (const char*)(ws + WS_WBR8) + (size_t)l * DM * DM, pm, pn}; EpiBrAC E1{(const bf16_t*)(ws + WS_P), (bf16_t*)(ws + WS_MM)}; \
                              pg8::gemm_phase<EpiBrAC, SchedOneBrAC, true>(lds, DM, DM, S1, E1); \
                              SchedOneBrB S2{(const char*)(ws + WS_OATT), (const char*)(ws + WS_WBR) + (size_t)l * DM * DM * 2, pm, pn}; EpiBrB E2{(const bf16_t*)(ws + WS_P), (bf16_t*)(ws + WS_MM)}; \
                              pg8::gemm_phase<EpiBrB, SchedOneBrB>(lds, DM * 2, DM * 2, S2, E2); } \
                          else pg8::gemm_phase<EpiBr, SchedOneBr>(lds, DM * 2, DM * 2, S, E); } \
                        publish_inc(cctr + 64, tid); \
                        wait_ge(cctr + 64, 16u, tid); \
                        { SchedOneOut S{(const char*)(ws + WS_MM), (const char*)(ws + WS_WOUT) + (size_t)l * DM * DM * (FP8_OUT ? 1 : 2), pm, pn}; \
                          EpiOut E{args.in[0], args.in[2], (float*)(ws + WS_X), modv_l + 2 * DM}; \
                          if (FP8_OUT) pg8::gemm_phase<EpiOut, SchedOneOut, true>(lds, DM, DM, S, E); else pg8::gemm_phase<EpiOut, SchedOneOut>(lds, DM * 2, DM * 2, S, E); } \
                        if (fuse_router) router_tile(args, l, pm, pn, ctl + CW_RP + 64 * (64 * l + pm)); \
    } while (0)
#ifndef ATT_ONEQ
#define ATT_ONEQ 1
#endif
#if ATT_ONEQ && ATT_KINDS == 7
            {
                const int nch = (ctxl && CTX_CHAIN) ? 16 : 0, ncA = ctxl ? 12 : 0, ncB = ctxl ? 16 : 0;
                const int e0 = ctxl ? 12 : 0, e1 = e0 + ncA + 192, e2 = e1 + ncB + nch + 256, e3 = e2 + 192;
                int gi = ATT_CLAIM(0);
                for (; gi < e0; gi = ATT_CLAIM(0)) { ATT_RUN(2, gi, true); if (CTX_CHAIN) publish_inc(cctr, tid); }
                for (; gi < e1; gi = ATT_CLAIM(0)) { const int qi = gi - e0; const bool isctx = qi < ncA; ATT_RUN(0, isctx ? qi : qi - ncA, isctx); if (CTX_CHAIN && isctx) publish_inc(cctr, tid); }
                for (; gi < e2; gi = ATT_CLAIM(0)) { const int qi = gi - e1; const int nctx = ncB;
                    if (qi >= nctx && qi < nctx + nch) {
                        const int j = qi - nctx, pm = 32 + (j >> 3), pn = j & 7;
                        ATT_CHAIN_BODY();
                        continue; }
                    const bool isctx = qi < nctx; ATT_RUN(1, isctx ? qi : qi - nctx - nch, isctx); if (CTX_CHAIN && isctx) publish_inc(cctr, tid); }
                for (; gi < e3; gi = ATT_CLAIM(0)) { ATT_RUN(2, gi - e2, false); }
            }
#else
            if (ctxl && (ATT_KINDS & 4)) for (;;) { const int qi = ATT_CLAIM(0); if (qi >= 12) break; ATT_RUN(2, qi, true); if (CTX_CHAIN) publish_inc(cctr, tid); }
#ifndef ATT_XCD
#define ATT_XCD 0
#endif
            const bool axcd = ATT_XCD && G == 256;
            if (ATT_KINDS & 1) { const int nctx = ctxl ? 12 : 0, nlatq = axcd ? 0 : 192;
                for (;;) { const int qi = ATT_CLAIM(1); if (qi >= nctx + nlatq) break; const bool isctx = qi < nctx; ATT_RUN(0, isctx ? qi : qi - nctx, isctx); if (CTX_CHAIN && isctx) publish_inc(cctr, tid); }
                if (axcd) { const int x = wg & 7, k = wg >> 3; if (k < 24) { const int u_ = (x & 1) * 24 + k, g_ = x >> 1; ATT_RUN(0, (g_ >> 1) * 96 + ((g_ & 1) * 3 + u_ / 16) * 16 + (u_ & 15), false); } } }
            if (ATT_KINDS & 2) { const int nctx = ctxl ? 16 : 0, nch = (ctxl && CTX_CHAIN) ? 16 : 0;
                for (;;) { const int qi = ATT_CLAIM(2); if (qi >= nctx + nch + (axcd ? 0 : 256)) break;
                    if (qi >= nctx && qi < nctx + nch) {
                        const int j = qi - nctx, pm = 32 + (j >> 3), pn = j & 7;
                        ATT_CHAIN_BODY();
                        continue; }
                    const bool isctx = qi < nctx; ATT_RUN(1, isctx ? qi : qi - nctx - nch, isctx); if (CTX_CHAIN && isctx) publish_inc(cctr, tid); }
                if (axcd) ATT_RUN(1, (wg & 7) * 32 + (wg >> 3), false); }
            if (ATT_KINDS & 4) for (;;) { const int qi = ATT_CLAIM(3); if (qi >= 192) break; ATT_RUN(2, qi, false); }
#endif
#undef ATT_CLAIM
#undef ATT_RUN
#undef ATT_CHAIN_BODY
        }
        SEAM_BG(pb + 3, 0);
        if (PHON(5) && IN(pb + 4)) REPEAT(5) {
            REPBAR();
            SchedBr S{(const char*)(ws + WS_OATT), (const char*)(ws + WS_WBR) + (size_t)l * DM * DM * 2, (const char*)(ws + WS_OATT8), (const char*)(ws + WS_WBR8) + (size_t)l * DM * DM, G, wg, (l == 0 && !CTX_CHAIN) ? 34 : 32}; EpiBr E{(const bf16_t*)(ws + WS_P), (bf16_t*)(ws + WS_MM)};
            if (FP8_BR) { const int ntm = (l == 0 && !CTX_CHAIN) ? 34 : 32;
                SchedBrAC S1{(const char*)(ws + WS_OATT8), (const char*)(ws + WS_WBR8) + (size_t)l * DM * DM, G, wg, ntm}; EpiBrAC E1{(const bf16_t*)(ws + WS_P), (bf16_t*)(ws + WS_MM)};
                pg8::gemm_phase<EpiBrAC, SchedBrAC, true>(lds, DM, DM, S1, E1);
                SchedBrB S2{(const char*)(ws + WS_OATT), (const char*)(ws + WS_WBR) + (size_t)l * DM * DM * 2, G, wg, ntm}; EpiBrB E2{(const bf16_t*)(ws + WS_P), (bf16_t*)(ws + WS_MM)};
                pg8::gemm_phase<EpiBrB, SchedBrB>(lds, DM * 2, DM * 2, S2, E2); }
            else pg8::gemm_phase<EpiBr, SchedBr>(lds, DM * 2, DM * 2, S, E);
        }
        SEAM(pb + 4);
        if (PHON(6) && IN(pb + 5)) REPEAT(6) {
            REPBAR();
            SchedOut S{(const char*)(ws + WS_MM), (const char*)(ws + WS_WOUT) + (size_t)l * DM * DM * (FP8_OUT ? 1 : 2), G, wg, (l == 0 && !CTX_CHAIN) ? 34 : 32};
            const float* X = (const float*)(ws + WS_X);
            EpiOut E{l == 0 ? args.in[0] : X, l == 0 ? args.in[2] : X + (size_t)NLAT * DM, (float*)(ws + WS_X), modv_l + 2 * DM};
            if (FP8_OUT) pg8::gemm_phase<EpiOut, SchedOut, true>(lds, DM, DM, S, E); else pg8::gemm_phase<EpiOut, SchedOut>(lds, DM * 2, DM * 2, S, E);
            if (fuse_router) { int pm, pn; if (pg8::grid_order((long)wg, 32, 8, pm, pn)) router_tile(args, l, pm, pn, ctl + CW_RP + 64 * (64 * l + pm)); }
        }
        SEAM(pb + 5);
        if (!fuse_router) { if (PHON(7) && IN(pb + 6)) REPEAT(7) { REPBAR(); HIDE_TID(); if (ROUTER_V3) row_phase_g3(args, lds, l, tid, lane, wave, wg, G); else row_phase_g(args, lds, l, tid, lane, wave, wg, G, ROUTER_PROBE != 0 && rep == 0 && ((REP_MASK >> 7) & 1u)); }
        SEAM(pb + 6); }
        if (PHON(8) && IN(pb + 7)) REPEAT(8) { REPBAR(); HIDE_TID(); phase_rank(args, lds, l, wg, G, tid, wave, lane); }
        SEAM_BG(pb + 7, l == 1 ? CV_PER_L : 0);
        if (PHON(9) && IN(pb + 8)) REPEAT(9) {
            REPBAR();
            SchedE1 S{(const char*)(ws + WS_XG), (const char*)(ws + WS_W1) + (size_t)l * 16 * 2048 * DM * (FP8_EXPERTS ? 1 : 2), G, wg, l == 0 ? 5 : 4}; EpiE1 E{(bf16_t*)(ws + WS_ACT), l == 0 ? EROWS : 1024};
            if (FP8_EXPERTS) pg8::gemm_phase<EpiE1, SchedE1, true>(lds, DM, DM, S, E); else pg8::gemm_phase<EpiE1, SchedE1>(lds, DM * 2, DM * 2, S, E);
            if (CONV_IN_EXP && CONV_IN_ATT == 2 && P0_DYN && E_XCD && multi && !BG_CONV && G == 256 && l == 0 && rep == 0 && (wg >> 3) >= 16) { HIDE_TID(); p0_convert_dyn2(args, lds, ctl + CW_BGQ + 320, MISC, tid, wave, lane, CONV_EXP_PART1, CV_PER_L); }
        }
        SEAM_BG(pb + 8, 0);
        if (PHON(10) && IN(pb + 9)) REPEAT(10) {
            REPBAR();
            SchedE2 S{(const char*)(ws + WS_ACT), (const char*)(ws + WS_W2) + (size_t)l * 16 * 2048 * FF * (FP8_EXPERTS ? 1 : 2), G, wg, l == 0 ? 5 : 4}; EpiE2 E{(bf16_t*)(ws + WS_Y), (const float*)(ws + WS_GW), l == 0 ? EROWS : 1024};
            if (FP8_EXPERTS) pg8::gemm_phase<EpiE2, SchedE2, true>(lds, FF, FF, S, E); else pg8::gemm_phase<EpiE2, SchedE2>(lds, FF * 2, FF * 2, S, E);
            if (CONV_IN_EXP && CONV_IN_ATT == 2 && P0_DYN && E_XCD && multi && !BG_CONV && G == 256 && l == 0 && rep == 0 && (wg >> 3) >= 16) { HIDE_TID(); p0_convert_dyn2(args, lds, ctl + CW_BGQ + 384, MISC, tid, wave, lane, CV_D1 - CONV_EXP_PART1, CV_PER_L + CONV_EXP_PART1); }
        }
        SEAM_BG(pb + 9, 0);
    }
    if (PHON(11) && IN(21)) { HIDE_TID(); row_phase_a<2>(args, 2, lane, gw, NGW); }
#undef IN
#undef SEAM
}

static int g_grid = 0;
static bool setup() {
    if (g_grid) return g_grid > 0;
    int dev = 0, cus = 0, per_cu = 0;
    if (hipGetDevice(&dev) != hipSuccess || hipDeviceGetAttribute(&cus, hipDeviceAttributeMultiprocessorCount, dev) != hipSuccess) { g_grid = -1; return false; }
    if (hipFuncSetAttribute((const void*)mega, hipFuncAttributeMaxDynamicSharedMemorySize, LDS_BYTES) != hipSuccess) { fprintf(stderr, "kernel_launch: hipFuncSetAttribute failed\n"); g_grid = -1; return false; }
    if (hipOccupancyMaxActiveBlocksPerMultiprocessor(&per_cu, (const void*)mega, NTHR, LDS_BYTES) != hipSuccess || per_cu < 1) { fprintf(stderr, "kernel_launch: occupancy query says %d\n", per_cu); (void)hipGetLastError(); }
    g_grid = cus;
    return true;
}
static void run(void* const* d_in, void* d_out, void* d_ws, bool one_launch, int ph_end, hipStream_t stream) {
    if (!setup()) return;
    (void)hipMemsetAsync((char*)d_ws + WS_CTL, 0, CTL_ZERO_BYTES, stream);
    Args a{}; for (int i = 0; i < 29; ++i) a.in[i] = (const float*)d_in[i];
    a.out = (float*)d_out; a.ws = (unsigned char*)d_ws;
    if (one_launch) { a.ph_lo = 0; a.ph_hi = ph_end; hipLaunchKernelGGL(mega, dim3(g_grid), dim3(NTHR), LDS_BYTES, stream, a); }
    else for (int p = 0; p < ph_end; ++p) { a.ph_lo = p; a.ph_hi = p + 1; hipLaunchKernelGGL(mega, dim3(g_grid), dim3(NTHR), LDS_BYTES, stream, a); }
}
}
#ifndef ONE_LAUNCH
#define ONE_LAUNCH 0
#endif
extern "C" void kernel_launch(void* const* d_in, const int* in_sizes, int n_in, void* d_out, int out_size, void* d_ws, size_t ws_size, hipStream_t stream) {
    if (n_in != 29 || ws_size < fk::WS_END) { fprintf(stderr, "kernel_launch: unexpected n_in %d / ws %zu\n", n_in, ws_size); return; }
    fk::run(d_in, d_out, d_ws, ONE_LAUNCH != 0, fk::N_PHASES, stream);
}
```

```cpp
#include <hip/hip_runtime.h>
#include <cstdio>
#include <cstdint>
#include <cmath>
#define ONE_LAUNCH 1
#define LAS __attribute__((address_space(3)))
#define GAS __attribute__((address_space(1)))
typedef unsigned short bf16_t;
typedef short bf16x8 __attribute__((ext_vector_type(8)));
typedef short s16x4 __attribute__((ext_vector_type(4)));
typedef float f32x2 __attribute__((ext_vector_type(2)));
typedef float f32x4 __attribute__((ext_vector_type(4)));
typedef float f32x16 __attribute__((ext_vector_type(16)));
typedef unsigned u32x2 __attribute__((ext_vector_type(2)));
typedef unsigned u32x4 __attribute__((ext_vector_type(4)));
typedef int i32x4 __attribute__((ext_vector_type(4)));
typedef int i32x8 __attribute__((ext_vector_type(8)));

__device__ __forceinline__ unsigned cvt_pk_bf16(float lo, float hi) { unsigned r; asm volatile("v_cvt_pk_bf16_f32 %0, %1, %2" : "=v"(r) : "v"(lo), "v"(hi)); return r; }
__device__ __forceinline__ float bf_lo(unsigned w) { return __uint_as_float(w << 16); }
__device__ __forceinline__ float bf_hi(unsigned w) { return __uint_as_float(w & 0xffff0000u); }
__device__ __forceinline__ float bf2f(bf16_t b) { return __uint_as_float(((unsigned)b) << 16); }
__device__ __forceinline__ float shx(float v, int lane, int o) { return __uint_as_float((unsigned)__builtin_amdgcn_ds_bpermute((lane ^ o) << 2, (int)__float_as_uint(v))); }
__device__ __forceinline__ unsigned pk4_fp8(float a, float b, float c, float d) { int w = __builtin_amdgcn_cvt_pk_fp8_f32(a, b, 0, false); w = __builtin_amdgcn_cvt_pk_fp8_f32(c, d, w, true); return (unsigned)w; }
__device__ __forceinline__ float fast_sigmoid(float x) { return __builtin_amdgcn_rcpf(1.f + __builtin_amdgcn_exp2f(-1.4426950408889634f * x)); }

namespace pg8 {
constexpr int BM = 256, BK = 64, HALF = 128, HTB = HALF * BK * 2  , STAGE_BYTES = 8 * HTB;
__host__ __device__ __forceinline__ int lds_byte(int r, int c) { const int st = (r >> 4) * 2 + (c >> 5), rr = r & 15, cc = c & 31, ob = rr * 64 + cc * 2; return st * 1024 + (ob ^ (((ob >> 9) & 1) << 5)); }
__host__ __device__ __forceinline__ void stage_rc(int b, int& R, int& C) { const int st = b / 1024, sb = b % 1024, swz = sb ^ (((sb >> 9) & 1) << 5); R = (st >> 1) * 16 + swz / 64; C = (st & 1) * 32 + (swz % 64) / 2; }
__host__ __device__ __forceinline__ int perm32(int rho) { const int n = rho >> 4, i = rho & 15; return 8 * (i >> 2) + 4 * n + (i & 3); }

struct GUnit { const char* a; const char* b; int nt; int pm, pn, aux; int f8; int q; };

__device__ __forceinline__ bool grid_order(long L, int nM, int nN, int& pm, int& pn) {
    const int nwg = nM * nN; if (L >= nwg) return false;
    int wgid = (int)L; { const int q = nwg / 8, r = nwg % 8, xcd = wgid % 8, off = wgid / 8; wgid = (xcd < r ? xcd * (q + 1) : r * (q + 1) + (xcd - r) * q) + off; }
    const int nig = 8 * nN, gid = wgid / nig, fm = gid * 8, gsz = (nM - fm) < 8 ? (nM - fm) : 8;
    pm = fm + ((wgid % nig) % gsz); pn = (wgid % nig) / gsz; return true;
}

template <class Epi, class Sched, bool F8 = false>
__device__ __forceinline__ void gemm_phase(LAS unsigned char* lds, const int lda, const int ldb, const Sched& S, const Epi& E) {
    int tz = threadIdx.x; asm volatile("" : "+v"(tz));
    const int tid = tz, wid = __builtin_amdgcn_readfirstlane(tid >> 6), lane = tid & 63, wr = wid >> 2, wc = wid & 3, fr = lane & 15, fq = lane >> 4;
    unsigned voffA[2], voffB[2];
#pragma unroll
    for (int i = 0; i < 2; ++i) { int R, C; stage_rc(tid * 16 + i * 8192, R, C); const int Rb = Epi::PERM ? ((R & ~31) + perm32(R & 31)) : R;
        voffA[i] = (unsigned)(R * lda + C * 2); voffB[i] = (unsigned)(Rb * ldb + C * 2); }
    const size_t kstep = (size_t)(BK * 2);
    const size_t hstepA = (size_t)HALF * lda, hstepB = (size_t)HALF * ldb;
    const unsigned ldsw = (unsigned)wid * 1024u;
    const int aoff = lds_byte(wr * 64 + fr, fq * 8), boff = lds_byte(wc * 32 + fr, fq * 8);
#define PG8_SA(b, h) (((b) * 2 + (h)) * HTB)
#define PG8_SB(b, h) ((4 + (b) * 2 + (h)) * HTB)
#define PG8_STAGE(bufoff, gbase, voff) do { _Pragma("unroll") for (int _i = 0; _i < 2; ++_i) \
        __builtin_amdgcn_global_load_lds((const unsigned*)((const char*)(gbase) + (voff)[_i]), (LAS unsigned*)(lds + (bufoff) + ldsw + _i * 8192), 16, 0, 0); } while (0)
#define PG8_LDA16(dst, b, h) do { _Pragma("unroll") for (int m = 0; m < 4; ++m) _Pragma("unroll") for (int k = 0; k < 2; ++k) dst[m][k] = *(const LAS bf16x8*)(lds + PG8_SA(b, h) + aoff + m * 2048 + k * 1024); } while (0)
#define PG8_LDB16(dst, b, h) do { _Pragma("unroll") for (int n = 0; n < 2; ++n) _Pragma("unroll") for (int k = 0; k < 2; ++k) dst[n][k] = *(const LAS bf16x8*)(lds + PG8_SB(b, h) + boff + n * 2048 + k * 1024); } while (0)
#define PG8_LD8(p) __builtin_shufflevector(*(const LAS i32x4*)(p), *(const LAS i32x4*)((p) + 1024), 0, 1, 2, 3, 4, 5, 6, 7)
#define PG8_LDA8(dst, b, h) do { _Pragma("unroll") for (int m = 0; m < 4; ++m) dst[m] = PG8_LD8(lds + PG8_SA(b, h) + aoff + m * 2048); } while (0)
#define PG8_LDB8(dst, b, h) do { _Pragma("unroll") for (int n = 0; n < 2; ++n) dst[n] = PG8_LD8(lds + PG8_SB(b, h) + boff + n * 2048); } while (0)
#define PG8_LDA(dst, b, h) do { if constexpr (F8) PG8_LDA8(dst##8, b, h); else PG8_LDA16(dst, b, h); } while (0)
#define PG8_LDB(dst, b, h) do { if constexpr (F8) PG8_LDB8(dst##8, b, h); else PG8_LDB16(dst, b, h); } while (0)
#define PG8_MMA16(ai, bj, At, Bt) do { __builtin_amdgcn_s_setprio(1); _Pragma("unroll") for (int m = 0; m < 4; ++m) _Pragma("unroll") for (int n = 0; n < 2; ++n) _Pragma("unroll") for (int k = 0; k < 2; ++k) \
        acc[ai][bj][m][n] = __builtin_amdgcn_mfma_f32_16x16x32_bf16(Bt[n][k], At[m][k], acc[ai][bj][m][n], 0, 0, 0); __builtin_amdgcn_s_setprio(0); } while (0)
#define PG8_MMA8(ai, bj, At, Bt) do { __builtin_amdgcn_s_setprio(1); _Pragma("unroll") for (int m = 0; m < 4; ++m) _Pragma("unroll") for (int n = 0; n < 2; ++n) \
        asm volatile("v_mfma_f32_16x16x128_f8f6f4 %0, %1, %2, %0" : "+v"(acc[ai][bj][m][n]) : "v"(Bt[n]), "v"(At[m])); __builtin_amdgcn_s_setprio(0); } while (0)
#define PG8_MFMA_DRAIN() do { if constexpr (F8) asm volatile("s_nop 15\n\ts_nop 15" ::: "memory"); } while (0)
#define PG8_MMA(ai, bj, At, Bt) do { if constexpr (F8) PG8_MMA8(ai, bj, At##8, Bt##8); else PG8_MMA16(ai, bj, At, Bt); } while (0)
#define PG8_WAIT_V(n) asm volatile("s_waitcnt vmcnt(" #n ")" ::: "memory")
#define PG8_WAIT_L(n) asm volatile("s_waitcnt lgkmcnt(" #n ")" ::: "memory")
#define PG8_BAR __builtin_amdgcn_s_barrier()
#define PG8_SCHED __builtin_amdgcn_sched_barrier(0)
    GUnit cur, nxt; int ui = 0;
    if (!S.next(0, cur)) return;
    f32x4 acc[2][2][4][2];
#pragma unroll
    for (int a = 0; a < 2; ++a)
#pragma unroll
        for (int b = 0; b < 2; ++b)
#pragma unroll
            for (int m = 0; m < 4; ++m)
#pragma unroll
                for (int n = 0; n < 2; ++n) acc[a][b][m][n] = (f32x4){0.f, 0.f, 0.f, 0.f};
    bf16x8 At[4][2], B0[2][2], B1[2][2];
    i32x8 At8[4], B08[2], B18[2];
    const char* cA = cur.a; const char* cB = cur.b;
    PG8_STAGE(PG8_SB(0, 0), cB, voffB); PG8_STAGE(PG8_SB(0, 1), cB + hstepB, voffB); PG8_STAGE(PG8_SA(0, 0), cA, voffA); PG8_STAGE(PG8_SA(0, 1), cA + hstepA, voffA);
    if (wr == 1) PG8_BAR;
    PG8_WAIT_V(2); PG8_BAR;
    PG8_STAGE(PG8_SB(1, 0), cB + kstep, voffB); PG8_STAGE(PG8_SA(1, 0), cA + kstep, voffA); PG8_STAGE(PG8_SB(1, 1), cB + hstepB + kstep, voffB);
    PG8_WAIT_V(6); PG8_BAR;
    for (;;) {
        const bool has_next = S.next(ui + 1, nxt);
        const char* nA = has_next ? nxt.a : cA; const char* nB = has_next ? nxt.b : cB;
        const int nt = cur.nt;
        bool qs = false; if constexpr (Epi::QSKIP) qs = cur.q != 0;
        const bool do0 = !(qs && wr == 1), do1 = !qs;
#pragma unroll 1
        for (int t = 0; t < nt; t += 2) {
            const bool last = (t == nt - 2);
            const char* a1 = cA + (size_t)(t + 1) * kstep;
            const char* a2 = last ? nA : cA + (size_t)(t + 2) * kstep; const char* b2 = last ? nB : cB + (size_t)(t + 2) * kstep;
            const char* a3 = a2 + kstep; const char* b3 = b2 + kstep;
            PG8_LDB(B0, 0, 0); PG8_LDB(B1, 0, 1); PG8_SCHED; PG8_LDA(At, 0, 0); PG8_STAGE(PG8_SA(1, 1), a1 + hstepA, voffA);
            PG8_WAIT_V(8); PG8_WAIT_L(0); PG8_BAR; if (do0) { PG8_MMA(0, 0, At, B0); PG8_MMA(0, 1, At, B1); } PG8_BAR; PG8_SCHED;
            PG8_LDA(At, 0, 1); PG8_STAGE(PG8_SB(0, 0), b2, voffB); PG8_STAGE(PG8_SB(0, 1), b2 + hstepB, voffB); PG8_STAGE(PG8_SA(0, 0), a2, voffA);
            PG8_WAIT_V(8); PG8_WAIT_L(0); PG8_BAR; if (do1) { PG8_MMA(1, 0, At, B0); PG8_MMA(1, 1, At, B1); } PG8_BAR; PG8_SCHED;
            PG8_LDB(B0, 1, 0); PG8_LDB(B1, 1, 1); PG8_SCHED; PG8_LDA(At, 1, 0); PG8_STAGE(PG8_SA(0, 1), a2 + hstepA, voffA);
            PG8_WAIT_V(8); PG8_WAIT_L(0); PG8_BAR; if (do0) { PG8_MMA(0, 0, At, B0); PG8_MMA(0, 1, At, B1); } PG8_BAR; PG8_SCHED;
            PG8_LDA(At, 1, 1); PG8_STAGE(PG8_SB(1, 0), b3, voffB); PG8_STAGE(PG8_SB(1, 1), b3 + hstepB, voffB); PG8_STAGE(PG8_SA(1, 0), a3, voffA);
            PG8_WAIT_V(8); PG8_WAIT_L(0); PG8_BAR; if (do1) { PG8_MMA(1, 0, At, B0); PG8_MMA(1, 1, At, B1); } PG8_BAR; PG8_SCHED;
        }
        if (wr == 0) PG8_BAR;
        PG8_MFMA_DRAIN();
        E(acc, cur, wr, wc, fr, fq);
        if (!has_next) break;
        bool zero = true; if constexpr (Epi::KEEPS) zero = !E.keep(cur);
        if (zero) {
#pragma unroll
        for (int a = 0; a < 2; ++a)
#pragma unroll
            for (int b = 0; b < 2; ++b)
#pragma unroll
                for (int m = 0; m < 4; ++m)
#pragma unroll
                    for (int n = 0; n < 2; ++n) acc[a][b][m][n] = (f32x4){0.f, 0.f, 0.f, 0.f};
        }
        cur = nxt; cA = nA; cB = nB; ++ui;
        if (wr == 1) PG8_BAR;
    }
    PG8_WAIT_V(0);
    PG8_BAR;
#undef PG8_SA
#undef PG8_SB
#undef PG8_STAGE
#undef PG8_LDA
#undef PG8_LDB
#undef PG8_MMA
#undef PG8_MMA8
#undef PG8_MFMA_DRAIN
#undef PG8_MMA16
#undef PG8_LDA8
#undef PG8_LDB8
#undef PG8_LDA16
#undef PG8_LDB16
#undef PG8_LD8
#undef PG8_WAIT_V
#undef PG8_WAIT_L
#undef PG8_BAR
#undef PG8_SCHED
}
template <class Epi, class Sched>
__device__ __forceinline__ void gemm_phase_mx(LAS unsigned char* lds, const int lda, const int ldb, const int lda8, const int ldb8, const Sched& S, const Epi& E) {
    int tz = threadIdx.x; asm volatile("" : "+v"(tz));
    const int tid = tz, wid = __builtin_amdgcn_readfirstlane(tid >> 6), lane = tid & 63, wr = wid >> 2, wc = wid & 3, fr = lane & 15, fq = lane >> 4;
    unsigned voffA[2], voffB[2], voffA8[2], voffB8[2];
#pragma unroll
    for (int i = 0; i < 2; ++i) { int R, C; stage_rc(tid * 16 + i * 8192, R, C); const int Rb = Epi::PERM ? ((R & ~31) + perm32(R & 31)) : R;
        voffA[i] = (unsigned)(R * lda + C * 2); voffB[i] = (unsigned)(Rb * ldb + C * 2); voffA8[i] = (unsigned)(R * lda8 + C * 2); voffB8[i] = (unsigned)(Rb * ldb8 + C * 2); }
    const size_t kstep = (size_t)(BK * 2);
    const size_t hsA = (size_t)HALF * lda, hsB = (size_t)HALF * ldb, hsA8 = (size_t)HALF * lda8, hsB8 = (size_t)HALF * ldb8;
    const unsigned ldsw = (unsigned)wid * 1024u;
    const int aoff = lds_byte(wr * 64 + fr, fq * 8), boff = lds_byte(wc * 32 + fr, fq * 8);
#define MX_SA(b, h) (((b) * 2 + (h)) * HTB)
#define MX_SB(b, h) ((4 + (b) * 2 + (h)) * HTB)
#define MX_STG(bufoff, gptr, v8, v16, fl) do { _Pragma("unroll") for (int _i = 0; _i < 2; ++_i) { const unsigned _v = (fl) ? (v8)[_i] : (v16)[_i]; \
        __builtin_amdgcn_global_load_lds((const unsigned*)((const char*)(gptr) + _v), (LAS unsigned*)(lds + (bufoff) + ldsw + _i * 8192), 16, 0, 0); } } while (0)
#define MX_STAGE_A(bufoff, gptr, fl) MX_STG(bufoff, gptr, voffA8, voffA, fl)
#define MX_STAGE_B(bufoff, gptr, fl) MX_STG(bufoff, gptr, voffB8, voffB, fl)
#define MX_HSA(fl) ((fl) ? hsA8 : hsA)
#define MX_HSB(fl) ((fl) ? hsB8 : hsB)
#define MX_LDA16(dst, b, h) do { _Pragma("unroll") for (int m = 0; m < 4; ++m) _Pragma("unroll") for (int k = 0; k < 2; ++k) dst[m][k] = *(const LAS bf16x8*)(lds + MX_SA(b, h) + aoff + m * 2048 + k * 1024); } while (0)
#define MX_LDB16(dst, b, h) do { _Pragma("unroll") for (int n = 0; n < 2; ++n) _Pragma("unroll") for (int k = 0; k < 2; ++k) dst[n][k] = *(const LAS bf16x8*)(lds + MX_SB(b, h) + boff + n * 2048 + k * 1024); } while (0)
#define MX_LD8(p) __builtin_shufflevector(*(const LAS i32x4*)(p), *(const LAS i32x4*)((p) + 1024), 0, 1, 2, 3, 4, 5, 6, 7)
#define MX_LDA8(dst, b, h) do { _Pragma("unroll") for (int m = 0; m < 4; ++m) dst[m] = MX_LD8(lds + MX_SA(b, h) + aoff + m * 2048); } while (0)
#define MX_LDB8(dst, b, h) do { _Pragma("unroll") for (int n = 0; n < 2; ++n) dst[n] = MX_LD8(lds + MX_SB(b, h) + boff + n * 2048); } while (0)
#define MX_HALF(x, k) ((k) == 0 ? __builtin_shufflevector(x, x, 0, 1, 2, 3) : __builtin_shufflevector(x, x, 4, 5, 6, 7))
#define MX_MMA16(ai, bj, At, Bt) do { __builtin_amdgcn_s_setprio(1); _Pragma("unroll") for (int k = 0; k < 2; ++k) _Pragma("unroll") for (int m = 0; m < 4; ++m) _Pragma("unroll") for (int n = 0; n < 2; ++n) \
        acc[ai][bj][m][n] = __builtin_amdgcn_mfma_f32_16x16x32_bf16(__builtin_bit_cast(bf16x8, MX_HALF(Bt[n], k)), __builtin_bit_cast(bf16x8, MX_HALF(At[m], k)), acc[ai][bj][m][n], 0, 0, 0); __builtin_amdgcn_s_setprio(0); } while (0)
#define MX_MMA8(ai, bj, At, Bt) do { __builtin_amdgcn_s_setprio(1); _Pragma("unroll") for (int m = 0; m < 4; ++m) _Pragma("unroll") for (int n = 0; n < 2; ++n) \
        asm volatile("v_mfma_f32_16x16x128_f8f6f4 %0, %1, %2, %0" : "+v"(acc[ai][bj][m][n]) : "v"(Bt[n]), "v"(At[m])); __builtin_amdgcn_s_setprio(0); } while (0)
#define MX_WAIT_V(n) asm volatile("s_waitcnt vmcnt(" #n ")" ::: "memory")
#define MX_WAIT_L(n) asm volatile("s_waitcnt lgkmcnt(" #n ")" ::: "memory")
#define MX_BAR __builtin_amdgcn_s_barrier()
#define MX_SCHED __builtin_amdgcn_sched_barrier(0)
    GUnit cur, nxt; int ui = 0;
    if (!S.next(0, cur)) return;
    f32x4 acc[2][2][4][2];
#pragma unroll
    for (int a = 0; a < 2; ++a)
#pragma unroll
        for (int b = 0; b < 2; ++b)
#pragma unroll
            for (int m = 0; m < 4; ++m)
#pragma unroll
                for (int n = 0; n < 2; ++n) acc[a][b][m][n] = (f32x4){0.f, 0.f, 0.f, 0.f};
    i32x8 At8[4], B08[2], B18[2];
    const char* cA = cur.a; const char* cB = cur.b;
    { const bool fc = cur.f8 != 0;
      MX_STAGE_B(MX_SB(0, 0), cB, fc); MX_STAGE_B(MX_SB(0, 1), cB + MX_HSB(fc), fc); MX_STAGE_A(MX_SA(0, 0), cA, fc); MX_STAGE_A(MX_SA(0, 1), cA + MX_HSA(fc), fc);
      if (wr == 1) MX_BAR;
      MX_WAIT_V(2); MX_BAR;
      MX_STAGE_B(MX_SB(1, 0), cB + kstep, fc); MX_STAGE_A(MX_SA(1, 0), cA + kstep, fc); MX_STAGE_B(MX_SB(1, 1), cB + MX_HSB(fc) + kstep, fc);
      MX_WAIT_V(6); MX_BAR; }
    for (;;) {
        const bool has_next = S.next(ui + 1, nxt);
        const char* nA = has_next ? nxt.a : cA; const char* nB = has_next ? nxt.b : cB;
        const bool fc = cur.f8 != 0, fnx = has_next ? (nxt.f8 != 0) : fc;
        const int nt = cur.nt;
#pragma unroll 1
        for (int t = 0; t < nt; t += 2) {
            const bool last = (t == nt - 2); const bool f2 = last ? fnx : fc;
            const char* a1 = cA + (size_t)(t + 1) * kstep;
            const char* a2 = last ? nA : cA + (size_t)(t + 2) * kstep; const char* b2 = last ? nB : cB + (size_t)(t + 2) * kstep;
            const char* a3 = a2 + kstep; const char* b3 = b2 + kstep;
            MX_LDB8(B08, 0, 0); MX_LDB8(B18, 0, 1); MX_SCHED; MX_LDA8(At8, 0, 0);
            MX_STAGE_A(MX_SA(1, 1), a1 + MX_HSA(fc), fc);
            MX_WAIT_V(8); MX_WAIT_L(0); MX_BAR; if (fc) { MX_MMA8(0, 0, At8, B08); MX_MMA8(0, 1, At8, B18); } else { MX_MMA16(0, 0, At8, B08); MX_MMA16(0, 1, At8, B18); } MX_BAR; MX_SCHED;
            MX_LDA8(At8, 0, 1);
            MX_STAGE_B(MX_SB(0, 0), b2, f2); MX_STAGE_B(MX_SB(0, 1), b2 + MX_HSB(f2), f2); MX_STAGE_A(MX_SA(0, 0), a2, f2);
            MX_WAIT_V(8); MX_WAIT_L(0); MX_BAR; if (fc) { MX_MMA8(1, 0, At8, B08); MX_MMA8(1, 1, At8, B18); } else { MX_MMA16(1, 0, At8, B08); MX_MMA16(1, 1, At8, B18); } MX_BAR; MX_SCHED;
            MX_LDB8(B08, 1, 0); MX_LDB8(B18, 1, 1); MX_SCHED; MX_LDA8(At8, 1, 0);
            MX_STAGE_A(MX_SA(0, 1), a2 + MX_HSA(f2), f2);
            MX_WAIT_V(8); MX_WAIT_L(0); MX_BAR; if (fc) { MX_MMA8(0, 0, At8, B08); MX_MMA8(0, 1, At8, B18); } else { MX_MMA16(0, 0, At8, B08); MX_MMA16(0, 1, At8, B18); } MX_BAR; MX_SCHED;
            MX_LDA8(At8, 1, 1);
            MX_STAGE_B(MX_SB(1, 0), b3, f2); MX_STAGE_B(MX_SB(1, 1), b3 + MX_HSB(f2), f2); MX_STAGE_A(MX_SA(1, 0), a3, f2);
            MX_WAIT_V(8); MX_WAIT_L(0); MX_BAR; if (fc) { MX_MMA8(1, 0, At8, B08); MX_MMA8(1, 1, At8, B18); } else { MX_MMA16(1, 0, At8, B08); MX_MMA16(1, 1, At8, B18); } MX_BAR; MX_SCHED;
        }
        if (wr == 0) MX_BAR;
        asm volatile("s_nop 15\n\ts_nop 15" ::: "memory");
        E(acc, cur, wr, wc, fr, fq);
        if (!has_next) break;
        bool zero = true; if constexpr (Epi::KEEPS) zero = !E.keep(cur);
        if (zero) {
#pragma unroll
        for (int a = 0; a < 2; ++a)
#pragma unroll
            for (int b = 0; b < 2; ++b)
#pragma unroll
                for (int m = 0; m < 4; ++m)
#pragma unroll
                    for (int n = 0; n < 2; ++n) acc[a][b][m][n] = (f32x4){0.f, 0.f, 0.f, 0.f};
        }
        cur = nxt; cA = nA; cB = nB; ++ui;
        if (wr == 1) MX_BAR;
    }
    MX_WAIT_V(0);
    MX_BAR;
#undef MX_SA
#undef MX_SB
#undef MX_STG
#undef MX_STAGE_A
#undef MX_STAGE_B
#undef MX_HSA
#undef MX_HSB
#undef MX_LDA16
#undef MX_LDB16
#undef MX_LD8
#undef MX_HALF
#undef MX_LDA8
#undef MX_LDB8
#undef MX_MMA16
#undef MX_MMA8
#undef MX_WAIT_V
#undef MX_WAIT_L
#undef MX_BAR
#undef MX_SCHED
}
}
#ifndef ATT_STAGGER
#define ATT_STAGGER 0
#endif
#ifndef ATT_PRIO
#define ATT_PRIO 1
#endif
#ifndef ATT_PKSUM
#define ATT_PKSUM 0
#endif
#ifndef ATT_WIDE_ST
#define ATT_WIDE_ST 1
#endif
#ifndef ATT_ILV
#define ATT_ILV 0
#endif
#ifndef ATT_NV
#define ATT_NV 5
#endif
#ifndef ATT_NE
#define ATT_NE 1
#endif
#ifndef ATT_QKPIPE
#define ATT_QKPIPE 1
#endif
namespace att {
constexpr int LDP = 10240, LDO = 2048, KVBLK = 64;
constexpr int SHM_V = KVBLK * 128 * 2, SHM_K = KVBLK * 128 * 2;
constexpr int LDS_WS = 2 * SHM_V + 2 * SHM_K, LDS_BYTES = LDS_WS + 8 * 64 * 4;
constexpr float THR2 = 11.5415603f;
#define KSWZ(row, colB) ((row) * 256 + ((colB) ^ (((row) & 7) << 4)))
#define SBAR() __builtin_amdgcn_sched_barrier(0)
__device__ __forceinline__ int crow(int r, int hi) { return (r & 3) + 8 * (r >> 2) + 4 * hi; }

struct AUnit {
    int qrow0;
    int qcol, kcol, vcol;
    int ocol;
    int nlat_t;
    int lat_row0;
    int ctx_row0;
    int dpos;
    float sink2;
};

#define AEXP(x) (VAR == 2 ? (x) * 0.001f : __builtin_amdgcn_exp2f(x))
template <int KIND, int VAR = 0> __device__ __forceinline__ void partialSM(f32x16& p0, f32x16& p1, float& m_reg, float& mn, float& alpha, bool do_mask, int jrel, int hi) {
    if (KIND == 2) { if (do_mask) {
#pragma unroll
        for (int r = 0; r < 16; ++r) { const int d0 = jrel + crow(r, hi), d1 = d0 + 32;
            p0[r] = (d0 <= 128 && d0 >= -128) ? p0[r] : -1e30f; p1[r] = (d1 <= 128 && d1 >= -128) ? p1[r] : -1e30f; } } }
    if (VAR == 20) {
        mn = 0.f; alpha = 1.f;
#pragma unroll
        for (int r = 0; r < 16; ++r) p0[r] = __builtin_amdgcn_exp2f(p0[r]);
        return; }
    float pmax = p0[0];
#pragma unroll
    for (int r = 1; r < 16; ++r) pmax = fmaxf(pmax, p0[r]);
#pragma unroll
    for (int r = 0; r < 16; ++r) pmax = fmaxf(pmax, p1[r]);
    { auto rr = __builtin_amdgcn_permlane32_swap(__float_as_uint(pmax), __float_as_uint(pmax), false, false);
      pmax = fmaxf(__uint_as_float(rr[0]), __uint_as_float(rr[1])); }
    if (__builtin_expect(__all(pmax - m_reg <= THR2), 1)) { mn = m_reg; alpha = 1.f; }
    else { mn = fmaxf(m_reg, pmax); alpha = __builtin_amdgcn_exp2f(m_reg - mn); m_reg = mn; }
#pragma unroll
    for (int r = 0; r < 16; ++r) p0[r] = p0[r] - mn;
#pragma unroll
    for (int r = 0; r < 16; ++r) p1[r] = p1[r] - mn;
#pragma unroll
    for (int r = 0; r < 16; ++r) p0[r] = AEXP(p0[r]);
}
template <int VAR = 0> __device__ __forceinline__ void finishSM(f32x16& p0, f32x16& p1, float alpha, float& l_reg, bf16x8& pa0, bf16x8& pa1, bf16x8& pa2, bf16x8& pa3) {
#pragma unroll
    for (int r = 0; r < 16; ++r) p1[r] = AEXP(p1[r]);
#if ATT_PKSUM
    f32x2 s2a = {p0[0], p0[1]}, s2b = {p1[0], p1[1]};
#pragma unroll
    for (int r = 1; r < 8; ++r) { s2a = s2a + (f32x2){p0[2 * r], p0[2 * r + 1]}; s2b = s2b + (f32x2){p1[2 * r], p1[2 * r + 1]}; }
    s2a = s2a + s2b; float ps = s2a[0] + s2a[1];
#else
    float ps = 0;
#pragma unroll
    for (int r = 0; r < 16; ++r) ps += p0[r];
#pragma unroll
    for (int r = 0; r < 16; ++r) ps += p1[r];
#endif
    { auto rr = __builtin_amdgcn_permlane32_swap(__float_as_uint(ps), __float_as_uint(ps), false, false);
      ps = __uint_as_float(rr[0]) + __uint_as_float(rr[1]); }
    l_reg = VAR == 20 ? l_reg + ps : l_reg * alpha + ps;
#define PK4(P, BASE, OUT) do { unsigned a0 = cvt_pk_bf16(P[BASE + 0], P[BASE + 1]), a1 = cvt_pk_bf16(P[BASE + 2], P[BASE + 3]);   \
    unsigned b0 = cvt_pk_bf16(P[BASE + 4], P[BASE + 5]), b1 = cvt_pk_bf16(P[BASE + 6], P[BASE + 7]);                              \
    auto r0 = __builtin_amdgcn_permlane32_swap(a0, b0, false, false); auto r1 = __builtin_amdgcn_permlane32_swap(a1, b1, false, false); \
    u32x4 w = {r0[0], r1[0], r0[1], r1[1]}; OUT = *reinterpret_cast<bf16x8*>(&w); } while (0)
    PK4(p0, 0, pa0); PK4(p0, 8, pa1); PK4(p1, 0, pa2); PK4(p1, 8, pa3);
#undef PK4
}
template <int DQ, int VAR = 0> __device__ __forceinline__ void qkt(f32x16& p0, f32x16& p1, const LAS char* Ks, const bf16x8* qr, int r32, int hi, int dbase) {
    p0 = f32x16{}; p1 = f32x16{};
    if (VAR == 3) {
#pragma unroll
        for (int r = 0; r < 16; ++r) { p0[r] = (float)(r + r32) * 0.01f; p1[r] = (float)(r - hi) * 0.02f; }
        return; }
#if ATT_QKPIPE
    bf16x8 kb[2][2];
    { const int cb = (dbase * 16 + hi * 8) * 2; kb[0][0] = *reinterpret_cast<const LAS bf16x8*>(Ks + KSWZ(r32, cb)); kb[0][1] = *reinterpret_cast<const LAS bf16x8*>(Ks + KSWZ(32 + r32, cb)); }
#pragma unroll
    for (int d0 = 0; d0 < DQ; ++d0) {
        if (VAR == 9) { kb[(d0 + 1) & 1][0] = kb[d0 & 1][0]; kb[(d0 + 1) & 1][1] = kb[d0 & 1][1]; }
        else if (d0 + 1 < DQ) { const int cb = ((dbase + d0 + 1) * 16 + hi * 8) * 2;
            kb[(d0 + 1) & 1][0] = *reinterpret_cast<const LAS bf16x8*>(Ks + KSWZ(r32, cb)); kb[(d0 + 1) & 1][1] = *reinterpret_cast<const LAS bf16x8*>(Ks + KSWZ(32 + r32, cb)); }
        p0 = __builtin_amdgcn_mfma_f32_32x32x16_bf16(kb[d0 & 1][0], qr[d0], p0, 0, 0, 0);
        p1 = __builtin_amdgcn_mfma_f32_32x32x16_bf16(kb[d0 & 1][1], qr[d0], p1, 0, 0, 0); }
    if (VAR != 9 && !ATT_ILV) { __builtin_amdgcn_sched_group_barrier(0x100, 2, 0);
#pragma unroll
    for (int d0 = 0; d0 < DQ; ++d0) { if (d0 + 1 < DQ) __builtin_amdgcn_sched_group_barrier(0x100, 2, 0); __builtin_amdgcn_sched_group_barrier(0x008, 2, 0); } }
#else
#pragma unroll
    for (int d0 = 0; d0 < DQ; ++d0) { const int cb = ((dbase + d0) * 16 + hi * 8) * 2;
        const bf16x8 b0 = *reinterpret_cast<const LAS bf16x8*>(Ks + KSWZ(r32, cb));
        const bf16x8 b1 = *reinterpret_cast<const LAS bf16x8*>(Ks + KSWZ(32 + r32, cb));
        p0 = __builtin_amdgcn_mfma_f32_32x32x16_bf16(b0, qr[d0], p0, 0, 0, 0);
        p1 = __builtin_amdgcn_mfma_f32_32x32x16_bf16(b1, qr[d0], p1, 0, 0, 0); }
#endif
}
__device__ __forceinline__ int v_st(int k, int c) { const int kk = (k & ~0xC) | ((k & 4) << 1) | ((k & 8) >> 1); return ((kk >> 3) * 4 + (c >> 5)) * 512 + ((kk & 7) * 32 + (c & 31)) * 2; }
__device__ __forceinline__ int v_rd_base(int lane) { return ((lane & 3) << 3) | (((lane >> 2) & 3) << 6) | (((lane >> 4) & 1) << 5) | (((lane >> 5) & 1) << 8); }
constexpr int v_rd_off(int d0, int ks, int half) { return d0 * 512 + ks * 4096 + half * 2048; }
template <int OFF> __device__ __forceinline__ s16x4 tr_read(int vb) {
    s16x4 r; asm volatile("ds_read_b64_tr_b16 %0, %1 offset:%2" : "=&v"(r) : "v"(vb), "i"(OFF) : "memory"); return r;
}
template <int D0> __device__ __forceinline__ void pv_one(f32x16& od, int vb, bf16x8 pa0, bf16x8 pa1, bf16x8 pa2, bf16x8 pa3) {
    const s16x4 l0 = tr_read<v_rd_off(D0, 0, 0)>(vb), h0 = tr_read<v_rd_off(D0, 0, 1)>(vb), l1 = tr_read<v_rd_off(D0, 1, 0)>(vb), h1 = tr_read<v_rd_off(D0, 1, 1)>(vb);
    const s16x4 l2 = tr_read<v_rd_off(D0, 2, 0)>(vb), h2 = tr_read<v_rd_off(D0, 2, 1)>(vb), l3 = tr_read<v_rd_off(D0, 3, 0)>(vb), h3 = tr_read<v_rd_off(D0, 3, 1)>(vb);
    asm volatile("s_waitcnt lgkmcnt(0)" ::: "memory"); SBAR();
#define PKV(L, H) (bf16x8){L[0], L[1], L[2], L[3], H[0], H[1], H[2], H[3]}
    od = __builtin_amdgcn_mfma_f32_32x32x16_bf16(pa0, PKV(l0, h0), od, 0, 0, 0);
    od = __builtin_amdgcn_mfma_f32_32x32x16_bf16(pa1, PKV(l1, h1), od, 0, 0, 0);
    od = __builtin_amdgcn_mfma_f32_32x32x16_bf16(pa2, PKV(l2, h2), od, 0, 0, 0);
    od = __builtin_amdgcn_mfma_f32_32x32x16_bf16(pa3, PKV(l3, h3), od, 0, 0, 0);
#undef PKV
}
__device__ __forceinline__ void pv_d0(f32x16* o, int vb, bf16x8 pa0, bf16x8 pa1, bf16x8 pa2, bf16x8 pa3) {
    pv_one<0>(o[0], vb, pa0, pa1, pa2, pa3); pv_one<1>(o[1], vb, pa0, pa1, pa2, pa3); pv_one<2>(o[2], vb, pa0, pa1, pa2, pa3); pv_one<3>(o[3], vb, pa0, pa1, pa2, pa3);
}

template <int D0> __device__ __forceinline__ void pv_one_b(f32x16& od, const LAS char* vp, bf16x8 pa0, bf16x8 pa1, bf16x8 pa2, bf16x8 pa3) {
#define TRB(OFF) __builtin_amdgcn_ds_read_tr16_b64_v4i16((LAS s16x4*)(vp + (OFF)))
    const s16x4 l0 = TRB(v_rd_off(D0, 0, 0)), h0 = TRB(v_rd_off(D0, 0, 1)), l1 = TRB(v_rd_off(D0, 1, 0)), h1 = TRB(v_rd_off(D0, 1, 1));
    const s16x4 l2 = TRB(v_rd_off(D0, 2, 0)), h2 = TRB(v_rd_off(D0, 2, 1)), l3 = TRB(v_rd_off(D0, 3, 0)), h3 = TRB(v_rd_off(D0, 3, 1));
#undef TRB
#define PKV(L, H) (bf16x8){L[0], L[1], L[2], L[3], H[0], H[1], H[2], H[3]}
    od = __builtin_amdgcn_mfma_f32_32x32x16_bf16(pa0, PKV(l0, h0), od, 0, 0, 0);
    od = __builtin_amdgcn_mfma_f32_32x32x16_bf16(pa1, PKV(l1, h1), od, 0, 0, 0);
    od = __builtin_amdgcn_mfma_f32_32x32x16_bf16(pa2, PKV(l2, h2), od, 0, 0, 0);
    od = __builtin_amdgcn_mfma_f32_32x32x16_bf16(pa3, PKV(l3, h3), od, 0, 0, 0);
#undef PKV
}
__device__ __forceinline__ void pv_d0_b(f32x16* o, const LAS char* vp, bf16x8 pa0, bf16x8 pa1, bf16x8 pa2, bf16x8 pa3) {
    pv_one_b<0>(o[0], vp, pa0, pa1, pa2, pa3); pv_one_b<1>(o[1], vp, pa0, pa1, pa2, pa3); pv_one_b<2>(o[2], vp, pa0, pa1, pa2, pa3); pv_one_b<3>(o[3], vp, pa0, pa1, pa2, pa3);
}
template <int NM, int NV> __device__ __forceinline__ void ilv_qk() {
    __builtin_amdgcn_sched_group_barrier(0x100, 4, 0);
#pragma unroll
    for (int i = 0; i < NM; ++i) { __builtin_amdgcn_sched_group_barrier(0x008, 1, 0); __builtin_amdgcn_sched_group_barrier(0x400, ATT_NE, 0); __builtin_amdgcn_sched_group_barrier(0x002, NV, 0); if ((i & 1) && i + 3 < NM) __builtin_amdgcn_sched_group_barrier(0x100, 2, 0); }
}
template <int NV> __device__ __forceinline__ void ilv_pv() {
    __builtin_amdgcn_sched_group_barrier(0x100, 8, 0);
#pragma unroll
    for (int i = 0; i < 16; ++i) { __builtin_amdgcn_sched_group_barrier(0x008, 1, 0); __builtin_amdgcn_sched_group_barrier(0x002, NV, 0); __builtin_amdgcn_sched_group_barrier(0x400, ATT_NE, 0); if (i < 12) __builtin_amdgcn_sched_group_barrier(0x100, 2, 0); }
}
__device__ __forceinline__ float vadd_pin(float a, float b) { float r; asm volatile("v_add_f32 %0, %1, %2" : "=v"(r) : "v"(a), "v"(b)); return r; }
__device__ __forceinline__ float vexp_pin(float a) { float r; asm volatile("v_exp_f32 %0, %1" : "=v"(r) : "v"(a)); return r; }
__device__ __forceinline__ void plswap_pin(unsigned& a, unsigned& b) { asm volatile("v_permlane32_swap_b32 %0, %1" : "+v"(a), "+v"(b)); }
template <int DQ>
__device__ __forceinline__ void qk_fin(f32x16& q0, f32x16& q1, const LAS char* Ks, const bf16x8* qr, int r32, int hi, int dbase,
                                       f32x16& p0, f32x16& p1, float alpha, float& l_reg, bf16x8& pa0, bf16x8& pa1, bf16x8& pa2, bf16x8& pa3) {
    q0 = f32x16{}; q1 = f32x16{};
    constexpr int SPM = 8 / DQ;
    bf16x8 ka, kc;
    { const int cb = (dbase * 16 + hi * 8) * 2; ka = *reinterpret_cast<const LAS bf16x8*>(Ks + KSWZ(r32, cb)); kc = *reinterpret_cast<const LAS bf16x8*>(Ks + KSWZ(32 + r32, cb)); }
    float psa = 0.f, psb = 0.f; unsigned c0 = 0, c1 = 0, c2 = 0, c3 = 0;
#define QF_PERM(OUT) do { plswap_pin(c0, c2); plswap_pin(c1, c3); u32x4 w_ = {c0, c1, c2, c3}; OUT = *reinterpret_cast<bf16x8*>(&w_); } while (0)
#define QF_CVT(P, B, k) do { const unsigned v_ = cvt_pk_bf16(P[(B) + 2 * (k)], P[(B) + 2 * (k) + 1]); if ((k) == 0) c0 = v_; else if ((k) == 1) c1 = v_; else if ((k) == 2) c2 = v_; else c3 = v_; } while (0)
#pragma unroll
    for (int d0 = 0; d0 < DQ; ++d0) {
        const int cbn = ((dbase + d0 + 1) * 16 + hi * 8) * 2;
#pragma unroll
        for (int h = 0; h < 2; ++h) {
            SBAR();
            if (h == 0) { q0 = __builtin_amdgcn_mfma_f32_32x32x16_bf16(ka, qr[d0], q0, 0, 0, 0); if (d0 + 1 < DQ) ka = *reinterpret_cast<const LAS bf16x8*>(Ks + KSWZ(r32, cbn)); }
            else        { q1 = __builtin_amdgcn_mfma_f32_32x32x16_bf16(kc, qr[d0], q1, 0, 0, 0); if (d0 + 1 < DQ) kc = *reinterpret_cast<const LAS bf16x8*>(Ks + KSWZ(32 + r32, cbn)); }
#pragma unroll
            for (int s_ = 0; s_ < SPM; ++s_) { const int i = (2 * d0 + h) * SPM + s_;
                p1[i] = vexp_pin(p1[i]); psa = vadd_pin(psa, p0[i]); if (i > 0) psb = vadd_pin(psb, p1[i - 1]);
                if (i < 4) QF_CVT(p0, 0, i); else if (i == 4) QF_PERM(pa0);
                else if (i < 9) QF_CVT(p0, 8, i - 5); else if (i == 9) QF_PERM(pa1);
                else if (i < 14) QF_CVT(p1, 0, i - 10); else if (i == 14) QF_PERM(pa2); }
        }
    }
    SBAR();
    psb += p1[15];
    QF_CVT(p1, 8, 0); QF_CVT(p1, 8, 1); QF_CVT(p1, 8, 2); QF_CVT(p1, 8, 3); QF_PERM(pa3);
    float ps = psa + psb;
    { auto rr = __builtin_amdgcn_permlane32_swap(__float_as_uint(ps), __float_as_uint(ps), false, false); ps = __uint_as_float(rr[0]) + __uint_as_float(rr[1]); }
    l_reg = l_reg * alpha + ps;
#undef QF_PERM
#undef QF_CVT
}
template <int KIND, bool G2, int VAR>
__device__ __forceinline__ void attn_unit_impl(const AUnit u, const bf16_t* __restrict__ P, bf16_t* __restrict__ O, unsigned char* __restrict__ O8  , LAS char* lds, float lam, float osc, const float* __restrict__ subln) {
    constexpr int DQ = KIND == 1 ? 4 : 8;
    int tz = threadIdx.x; asm volatile("" : "+v"(tz));
    const int tid = tz, wid = __builtin_amdgcn_readfirstlane(tid >> 6), lane = tid & 63, r32 = lane & 31, hi = lane >> 5;
    if (ATT_PRIO && wid >= 4) __builtin_amdgcn_s_setprio(1);
    LAS char* V_lds = lds; LAS char* K_lds = lds + 2 * SHM_V;
    LAS float* ws = (LAS float*)(lds + LDS_WS) + wid * 64; LAS float* li_l = ws; LAS float* al_l = ws + 32;
    float m_reg = VAR == 20 ? 0.f : -1e30f, l_reg = 0; f32x16 o[4] = {}; bf16x8 qr[DQ];
    const int wq = KIND == 1 ? (wid & 3) : wid, mp = KIND == 1 ? (wid >> 2) : 0, dbase = mp * 4;
    const bf16_t* Qw = P + (long)(u.qrow0 + wq * 32 + r32) * LDP + u.qcol + mp * 64 + hi * 8;
#pragma unroll
    for (int d0 = 0; d0 < DQ; ++d0) qr[d0] = *reinterpret_cast<const bf16x8*>(Qw + d0 * 16);
    const int sr = tid >> 4, sc = (tid & 15) * 8, vst0 = v_st(sr, sc), vst1 = v_st(32 + sr, sc);
    const int vb0 = (int)(unsigned)(size_t)V_lds + v_rd_base(lane);
    const int NT = 4 + u.nlat_t;
    const bf16_t* Kc = P + u.kcol + sc; const bf16_t* Vc = P + u.vcol + sc;
    struct { bf16x8 vs0, vs1, ks0, ks1; } sr_[2];
#define TROW(t) ((t) < 4 ? u.ctx_row0 + (t) * KVBLK : u.lat_row0 + ((t) - 4) * KVBLK)
#define SLOAD(i, t) do { if (VAR >= 5 && VAR <= 6 && (t) > 0) break; const long _r0 = (long)(TROW(t) + sr) * LDP, _r1 = _r0 + 32L * LDP; \
    sr_[i].vs0 = *reinterpret_cast<const bf16x8*>(Vc + _r0); sr_[i].vs1 = *reinterpret_cast<const bf16x8*>(Vc + _r1); \
    sr_[i].ks0 = *reinterpret_cast<const bf16x8*>(Kc + _r0); sr_[i].ks1 = *reinterpret_cast<const bf16x8*>(Kc + _r1); } while (0)
#define SWRITE(b, i) do { if (VAR == 6 && started) break; *(LAS bf16x8*)(V_lds + (b) * SHM_V + vst0) = sr_[i].vs0; *(LAS bf16x8*)(V_lds + (b) * SHM_V + vst1) = sr_[i].vs1; const int kc = sc * 2; \
    *(LAS bf16x8*)(K_lds + (b) * SHM_K + KSWZ(sr, kc)) = sr_[i].ks0; *(LAS bf16x8*)(K_lds + (b) * SHM_K + KSWZ(32 + sr, kc)) = sr_[i].ks1; } while (0)
#define SWAIT() asm volatile("s_waitcnt vmcnt(4)" ::: "memory")
#define RESC(a) do { if (VAR != 20 && __any((a) < 1.f)) { if (hi == 0) al_l[r32] = (a); asm volatile("s_waitcnt lgkmcnt(0)" ::: "memory"); \
    _Pragma("unroll") for (int d = 0; d < 4; ++d) _Pragma("unroll") for (int r = 0; r < 16; ++r) o[d][r] *= al_l[crow(r, hi)]; } } while (0)
    const int jq = u.dpos - (wq * 32 + r32);
#define JREL(t) (jq + ((t) - 4) * KVBLK)
#define PVD(vb) do { if (VAR == 10) { const s16x4 l0 = tr_read<v_rd_off(0, 0, 0)>(vb), h0 = tr_read<v_rd_off(0, 0, 1)>(vb), l1 = tr_read<v_rd_off(0, 1, 0)>(vb), h1 = tr_read<v_rd_off(0, 1, 1)>(vb); asm volatile("s_waitcnt lgkmcnt(0)" ::: "memory"); \
        const bf16x8 f0 = (bf16x8){l0[0], l0[1], l0[2], l0[3], h0[0], h0[1], h0[2], h0[3]}, f1 = (bf16x8){l1[0], l1[1], l1[2], l1[3], h1[0], h1[1], h1[2], h1[3]}; \
        _Pragma("unroll") for (int d_ = 0; d_ < 4; ++d_) { o[d_] = __builtin_amdgcn_mfma_f32_32x32x16_bf16(pa0, f0, o[d_], 0, 0, 0); o[d_] = __builtin_amdgcn_mfma_f32_32x32x16_bf16(pa1, f1, o[d_], 0, 0, 0); o[d_] = __builtin_amdgcn_mfma_f32_32x32x16_bf16(pa2, f0, o[d_], 0, 0, 0); o[d_] = __builtin_amdgcn_mfma_f32_32x32x16_bf16(pa3, f1, o[d_], 0, 0, 0); } } else if (VAR == 4) { const u32x4 a_ = *(const u32x4*)&pa0, b_ = *(const u32x4*)&pa1, c_ = *(const u32x4*)&pa2, d_ = *(const u32x4*)&pa3; const u32x4 x_ = a_ ^ b_ ^ c_ ^ d_; o[0][0] += __uint_as_float((x_.x ^ x_.y ^ x_.z ^ x_.w) & 0x3fffffffu) * 1e-30f; } else if (ATT_ILV) pv_d0_b(o, (const LAS char*)(size_t)0 + (vb), pa0, pa1, pa2, pa3); else pv_d0(o, vb, pa0, pa1, pa2, pa3); } while (0)
#define LSYNC() do { if (VAR != 7) __syncthreads(); } while (0)
    f32x16 pA0, pA1, pB0, pB1; float mnA, mnB, alA, alB; bf16x8 pa0, pa1, pa2, pa3;
    constexpr int SE = 0, SO = 1; bool started = false;
    SLOAD(SE, 0); asm volatile("s_waitcnt vmcnt(0)" ::: "memory"); SWRITE(0, SE); __syncthreads();
    qkt<DQ, VAR>(pA0, pA1, K_lds, qr, r32, hi, dbase); partialSM<KIND, VAR>(pA0, pA1, m_reg, mnA, alA, false, 0, hi);
    SLOAD(SO, 1); if (2 < NT) SLOAD(SE, 2);
    SWAIT(); SWRITE(1, SO); __syncthreads(); started = true;
    constexpr bool g2 = G2;
    for (int j = 1; j + 1 < NT; j += 2) {
        if (!g2) {
            if (ATT_ILV == 2 && (VAR == 0 || VAR == 8 || VAR == 20)) { SBAR(); qk_fin<DQ>(pB0, pB1, K_lds + SHM_K, qr, r32, hi, dbase, pA0, pA1, alA, l_reg, pa0, pa1, pa2, pa3); SBAR(); } else {
            SBAR(); qkt<DQ, VAR>(pB0, pB1, K_lds + SHM_K, qr, r32, hi, dbase);
            finishSM<VAR>(pA0, pA1, alA, l_reg, pa0, pa1, pa2, pa3); if (ATT_ILV == 1) ilv_qk<2 * DQ, ATT_NV>(); SBAR(); }
            SLOAD(SO, j + 2); SBAR();
            PVD(vb0); partialSM<KIND, VAR>(pB0, pB1, m_reg, mnB, alB, j >= 4, JREL(j), hi); if (ATT_ILV == 1) ilv_pv<ATT_NV>();
        } else {
            SBAR(); finishSM<VAR>(pA0, pA1, alA, l_reg, pa0, pa1, pa2, pa3); SBAR();
            qkt<DQ, VAR>(pB0, pB1, K_lds + SHM_K, qr, r32, hi, dbase); SLOAD(SO, j + 2); SBAR();
            partialSM<KIND, VAR>(pB0, pB1, m_reg, mnB, alB, j >= 4, JREL(j), hi); SBAR();
            PVD(vb0);
        }
        LSYNC(); SWAIT(); SWRITE(0, SE);
        RESC(alB); LSYNC();
        if (!g2) {
            if (ATT_ILV == 2 && (VAR == 0 || VAR == 8 || VAR == 20)) { SBAR(); qk_fin<DQ>(pA0, pA1, K_lds, qr, r32, hi, dbase, pB0, pB1, alB, l_reg, pa0, pa1, pa2, pa3); SBAR(); } else {
            SBAR(); qkt<DQ, VAR>(pA0, pA1, K_lds, qr, r32, hi, dbase);
            finishSM<VAR>(pB0, pB1, alB, l_reg, pa0, pa1, pa2, pa3); if (ATT_ILV == 1) ilv_qk<2 * DQ, ATT_NV>(); SBAR(); }
            if (j + 3 < NT) SLOAD(SE, j + 3); SBAR();
            PVD(vb0 + SHM_V); partialSM<KIND, VAR>(pA0, pA1, m_reg, mnA, alA, j + 1 >= 4, JREL(j + 1), hi); if (ATT_ILV == 1) ilv_pv<ATT_NV>();
        } else {
            SBAR(); finishSM<VAR>(pB0, pB1, alB, l_reg, pa0, pa1, pa2, pa3); SBAR();
            qkt<DQ, VAR>(pA0, pA1, K_lds, qr, r32, hi, dbase); if (j + 3 < NT) SLOAD(SE, j + 3); SBAR();
            partialSM<KIND, VAR>(pA0, pA1, m_reg, mnA, alA, j + 1 >= 4, JREL(j + 1), hi); SBAR();
            PVD(vb0 + SHM_V);
        }
        LSYNC(); SWAIT(); SWRITE(1, SO);
        RESC(alA); LSYNC();
    }
    SBAR(); qkt<DQ, VAR>(pB0, pB1, K_lds + SHM_K, qr, r32, hi, dbase);
    finishSM<VAR>(pA0, pA1, alA, l_reg, pa0, pa1, pa2, pa3); SBAR();
    PVD(vb0); partialSM<KIND, VAR>(pB0, pB1, m_reg, mnB, alB, NT - 1 >= 4, JREL(NT - 1), hi);
    __syncthreads(); RESC(alB);
    finishSM<VAR>(pB0, pB1, alB, l_reg, pa0, pa1, pa2, pa3); SBAR();
    PVD(vb0 + SHM_V);
    if (KIND == 2) l_reg += __builtin_amdgcn_exp2f(u.sink2 - m_reg);
    if (hi == 0) li_l[r32] = l_reg; asm volatile("s_waitcnt lgkmcnt(0)" ::: "memory");
    float rli[16];
#pragma unroll
    for (int r = 0; r < 16; ++r) rli[r] = __builtin_amdgcn_rcpf(li_l[crow(r, hi)]);
    const bool st_ok = VAR == 0 || VAR == 20 || u.sink2 == 1234.5f;
    if (KIND != 1) {
        if (!st_ok) {} else if (O8) {
#if ATT_WIDE_ST
            LAS unsigned char* stg = (LAS unsigned char*)K_lds + wid * 4096;
#pragma unroll
            for (int r = 0; r < 16; ++r) { const int orow = crow(r, hi);
#pragma unroll
                for (int d0 = 0; d0 < 4; ++d0) { const float v = o[d0][r] * rli[r]; stg[orow * 128 + d0 * 32 + r32] = (unsigned char)(__builtin_amdgcn_cvt_pk_fp8_f32(v, v, 0, false) & 0xff); } }
            asm volatile("s_waitcnt lgkmcnt(0)" ::: "memory");
            unsigned char* Og = O8 + (long)(u.qrow0 + wid * 32) * LDO + u.ocol;
#pragma unroll
            for (int j = 0; j < 4; ++j) { const int c = j * 64 + lane; const u32x4 w = *(const LAS u32x4*)(stg + c * 16); *(u32x4*)(Og + (long)(c >> 3) * LDO + (c & 7) * 16) = w; }
#else
            unsigned char* Ow8 = O8 + (long)(u.qrow0 + wid * 32) * LDO + u.ocol + r32;
#pragma unroll
            for (int r = 0; r < 16; ++r) { const int orow = crow(r, hi);
#pragma unroll
                for (int d0 = 0; d0 < 4; ++d0) { const float v = o[d0][r] * rli[r]; Ow8[(long)orow * LDO + d0 * 32] = (unsigned char)(__builtin_amdgcn_cvt_pk_fp8_f32(v, v, 0, false) & 0xff); } }
#endif
        }
        else { bf16_t* Ow = O + (long)(u.qrow0 + wid * 32) * LDO + u.ocol + r32;
#pragma unroll
        for (int r = 0; r < 16; ++r) { const int orow = crow(r, hi);
#pragma unroll
            for (int d0 = 0; d0 < 4; ++d0) Ow[(long)orow * LDO + d0 * 32] = (bf16_t)(cvt_pk_bf16(o[d0][r] * rli[r], 0.f) & 0xffffu); } }
        __syncthreads();
    } else {
        __syncthreads();
        LAS float* X2 = (LAS float*)lds + (wid & 3) * 4096;
        if (wid >= 4) {
#pragma unroll
            for (int r = 0; r < 16; ++r) { const int orow = crow(r, hi);
#pragma unroll
                for (int d0 = 0; d0 < 4; ++d0) X2[orow * 128 + d0 * 32 + r32] = o[d0][r] * rli[r]; }
        }
        __syncthreads();
        if (wid < 4 && st_ok) {
            float ss[16];
#pragma unroll
            for (int r = 0; r < 16; ++r) { const int orow = crow(r, hi); float s = 0.f;
#pragma unroll
                for (int d0 = 0; d0 < 4; ++d0) { const float v = o[d0][r] * rli[r] - lam * X2[orow * 128 + d0 * 32 + r32]; o[d0][r] = v; s += v * v; }
                ss[r] = s; }
#pragma unroll
            for (int off = 1; off < 32; off <<= 1) {
#pragma unroll
                for (int r = 0; r < 16; ++r) ss[r] += shx(ss[r], lane, off); }
            float g4[4];
#pragma unroll
            for (int d0 = 0; d0 < 4; ++d0) g4[d0] = subln[d0 * 32 + r32] * osc;
#if ATT_WIDE_ST
            LAS bf16_t* stg = (LAS bf16_t*)X2;
#pragma unroll
            for (int r = 0; r < 16; ++r) { const int orow = crow(r, hi); const float rs = rsqrtf(ss[r] * (1.f / 128.f) + 1e-6f);
#pragma unroll
                for (int d0 = 0; d0 < 4; ++d0) stg[orow * 128 + d0 * 32 + r32] = (bf16_t)(cvt_pk_bf16(o[d0][r] * rs * g4[d0], 0.f) & 0xffffu); }
            asm volatile("s_waitcnt lgkmcnt(0)" ::: "memory");
            bf16_t* Og = O + (long)(u.qrow0 + wid * 32) * LDO + u.ocol;
#pragma unroll
            for (int j = 0; j < 8; ++j) { const int c = j * 64 + lane; const u32x4 w = *(const LAS u32x4*)((const LAS char*)stg + c * 16); *(u32x4*)(Og + (long)(c >> 4) * LDO + (c & 15) * 8) = w; }
#else
            bf16_t* Ow = O + (long)(u.qrow0 + wid * 32) * LDO + u.ocol + r32;
#pragma unroll
            for (int r = 0; r < 16; ++r) { const int orow = crow(r, hi); const float rs = rsqrtf(ss[r] * (1.f / 128.f) + 1e-6f);
#pragma unroll
                for (int d0 = 0; d0 < 4; ++d0) Ow[(long)orow * LDO + d0 * 32] = (bf16_t)(cvt_pk_bf16(o[d0][r] * rs * g4[d0], 0.f) & 0xffffu); }
#endif
        }
        __syncthreads();
    }
#undef TROW
#undef SLOAD
#undef SWRITE
#undef SWAIT
#undef RESC
#undef JREL
#undef PVD
#undef LSYNC
    if (ATT_PRIO) __builtin_amdgcn_s_setprio(0);
}
template <int KIND, int VAR = 0>
__device__ __forceinline__ void attn_unit(const AUnit u, const bf16_t* __restrict__ P, bf16_t* __restrict__ O, unsigned char* __restrict__ O8, LAS char* lds, float lam, float osc, const float* __restrict__ subln) {
    const int wv_ = __builtin_amdgcn_readfirstlane((int)(threadIdx.x >> 6));
    if (ATT_STAGGER && (ATT_STAGGER == 1 ? wv_ >= 4 : ATT_STAGGER == 2 ? (wv_ & 1) : ((wv_ >> 1) & 1))) attn_unit_impl<KIND, true, VAR>(u, P, O, O8, lds, lam, osc, subln);
    else attn_unit_impl<KIND, false, VAR>(u, P, O, O8, lds, lam, osc, subln);
}
}
#define XB_TMO      128
#define XB_XCNT(j)  (256  + 64 * (j))
#define XB_XSUB(j)  (1280 + 64 * (j))
#define XB_XGEN(j)  (2304 + 64 * (j))
#define XB_TOP      3328
#define XB_TOPGEN   3392
#define XCD_BAR_WORDS 3456
#define XB_SPIN_CAP (1u << 18)
__device__ __forceinline__ unsigned xb_ld(unsigned* p)              { return __hip_atomic_load(p, __ATOMIC_RELAXED, __HIP_MEMORY_SCOPE_AGENT); }
__device__ __forceinline__ unsigned xb_add(unsigned* p, unsigned v) { return __hip_atomic_fetch_add(p, v, __ATOMIC_RELAXED, __HIP_MEMORY_SCOPE_AGENT); }
__device__ __forceinline__ unsigned xb_xcc_id() { return (unsigned)__builtin_amdgcn_s_getreg((3 << 11) | 20) & 0xFu; }
#define XB_SPIN(cond, bar) do { unsigned _sp = 0; while (cond) { __builtin_amdgcn_s_sleep(1); \
    if ((++_sp & 255u) == 0u) { if (xb_ld(&(bar)[XB_TMO])) break; if (_sp > XB_SPIN_CAP) { atomicAdd(&(bar)[XB_TMO], 1u); break; } } } } while (0)
struct XcdBarrier { unsigned* bar; unsigned x; volatile LAS unsigned* st; };
__device__ __forceinline__ XcdBarrier xcd_barrier_post(unsigned* bar, volatile LAS unsigned* st) {
    XcdBarrier b; b.bar = bar; b.x = xb_xcc_id(); b.st = st;
    if (threadIdx.x == 0) (void)xb_add(&bar[XB_XCNT(b.x)], 1u);
    return b;
}
__device__ __forceinline__ void xcd_barrier_complete(unsigned* bar, unsigned x, unsigned& nloc, unsigned& nx) {
    const unsigned G = gridDim.x * gridDim.y * gridDim.z;
    unsigned sum, cnt, mine, sp = 0u;
    for (;;) {
        sum = 0u; cnt = 0u; mine = 0u;
#pragma unroll
        for (unsigned j = 0; j < 16; ++j) { const unsigned c = xb_ld(&bar[XB_XCNT(j)]); sum += c; cnt += (c > 0u) ? 1u : 0u; mine = (j == x) ? c : mine; }
        if (sum == G) break;
        __builtin_amdgcn_s_sleep(1);
        if ((++sp & 255u) == 0u) { if (xb_ld(&bar[XB_TMO])) break; if (sp > XB_SPIN_CAP) { atomicAdd(&bar[XB_TMO], 1u); break; } }
    }
    nloc = mine > 0u ? mine : 1u; nx = cnt > 0u ? cnt : 1u;
}
__device__ __forceinline__ void xcd_barrier(const XcdBarrier& b) {
    asm volatile("s_waitcnt vmcnt(0)" ::: "memory");
    __syncthreads();
    if (threadIdx.x == 0) {
        unsigned* bar = b.bar;
        __builtin_amdgcn_s_waitcnt(0);
        unsigned nloc = b.st[0], nx = b.st[1];
        if (nloc == 0u) { xcd_barrier_complete(bar, b.x, nloc, nx); b.st[0] = nloc; b.st[1] = nx; }
        const unsigned old = xb_add(&bar[XB_XSUB(b.x)], 1u);
        const unsigned gen = old / nloc;
        if (old + 1u == (gen + 1u) * nloc) {
            __builtin_amdgcn_fence(__ATOMIC_RELEASE, "agent");
            asm volatile("s_waitcnt vmcnt(0)" ::: "memory");
            const unsigned og = xb_add(&bar[XB_TOP], 1u);
            const unsigned tg = og / nx;
            if (og + 1u == (tg + 1u) * nx) xb_add(&bar[XB_TOPGEN], 1u);
            else XB_SPIN(xb_ld(&bar[XB_TOPGEN]) == tg, bar);
            __builtin_amdgcn_fence(__ATOMIC_ACQUIRE, "agent");
            xb_add(&bar[XB_XGEN(b.x)], 1u);
            asm volatile("s_waitcnt vmcnt(0)" ::: "memory");
        } else {
            XB_SPIN(xb_ld(&bar[XB_XGEN(b.x)]) == gen, bar);
            __builtin_amdgcn_fence(__ATOMIC_ACQUIRE, "agent");
            asm volatile("s_waitcnt vmcnt(0)" ::: "memory");
        }
    }
    __syncthreads();
}

#ifndef FUSE_QK
#define FUSE_QK 1
#endif
#ifndef FP8_EXPERTS
#define FP8_EXPERTS 1
#endif
#ifndef FP8_AC
#define FP8_AC 1
#endif
#ifndef FP8_OUT
#define FP8_OUT 0
#endif
#ifndef FP8_BR
#define FP8_BR 1
#endif
#ifndef FP8_GATES
#define FP8_GATES 1
#endif
#ifndef CTX_CHAIN
#define CTX_CHAIN 1
#endif
#ifndef BG_CONV
#define BG_CONV 0
#endif
#ifndef FUSE_ROUTER
#define FUSE_ROUTER 0
#endif
#ifndef ROUTER_V3
#define ROUTER_V3 0
#endif
#ifndef CTX_GATES_IN_CHAIN
#define CTX_GATES_IN_CHAIN 1
#endif
namespace fk {
constexpr int DM = 2048, SEQ = 4096, CTXL = 256, NLAT = 8192, MROWS = 8704, INW = 10240, NEXP = 16, FF = 1024, MODW = 12288;
constexpr int EROWS = 1088, EPAD = 1280;
constexpr float EPS = 1e-6f, LOG2E = 1.4426950408889634f;
constexpr int NWAVES = 8, NTHR = 512;
constexpr size_t MiB = 1u << 20;
constexpr size_t WS_CTL = 0, CTL_ZERO_BYTES = 1 * MiB;
constexpr size_t WS_MODV = 512 * 1024  , WS_ROPE128 = 2 * MiB, WS_ROPE64 = 4 * MiB, WS_AFFT = 5 * MiB, WS_SEL = 6 * MiB, WS_GW = 7 * MiB, WS_BIASR = 7 * MiB + 128 * 1024  ;
constexpr size_t WS_H = 8 * MiB, WS_P = 42 * MiB, WS_XG = 42 * MiB, WS_ACT = 122 * MiB, WS_OATT = 212 * MiB, WS_MM = 246 * MiB, WS_Y = 212 * MiB, WS_X = 280 * MiB;
constexpr size_t WS_WIN8 = 588 * MiB  , WS_H8 = 640 * MiB  , WS_WBR8 = 660 * MiB  , WS_OATT8 = 672 * MiB  , WS_XCH = 692 * MiB  ;
static_assert(!FP8_GATES || FP8_EXPERTS, "WIN8 / H8 live in the half of the W1 region that the fp8 expert weights leave free");
constexpr size_t WS_WIN = 348 * MiB, WS_WBR = 428 * MiB, WS_WOUT = 444 * MiB, WS_W1 = 460 * MiB, WS_W2 = 716 * MiB, WS_END = 844 * MiB;
static_assert((size_t)MROWS * DM * 2 <= 34 * MiB && (size_t)MROWS * INW * 2 <= 170 * MiB && (size_t)16 * EPAD * DM * 2 <= 80 * MiB && (size_t)16 * EPAD * FF * 2 <= 40 * MiB &&
              (size_t)16 * EROWS * DM * 2 <= 68 * MiB && (size_t)MROWS * DM * 4 <= 68 * MiB, "d_ws map");
constexpr int CW_BAR = 4096;
constexpr int CW_QUEUE = 1024;
constexpr int CW_BGQ = 3520;
constexpr int CW_RP = 10240;
constexpr int CW_DONE = 8192;
constexpr int CW_CTX = 3200;
constexpr int RING_BYTES = 131072, LDS_BYTES = 147456, MISC_OFF = LDS_BYTES - 256;

typedef const float* cfp;
struct Args { cfp in[29]; float* out; unsigned char* ws; int ph_lo, ph_hi; };

template <int CTRL> __device__ __forceinline__ float dppm(float v) { return __uint_as_float((unsigned)__builtin_amdgcn_update_dpp(0, (int)__float_as_uint(v), CTRL, 0xf, 0xf, false)); }
__device__ __forceinline__ float xsum16(float v) { const auto rr = __builtin_amdgcn_permlane16_swap(__float_as_uint(v), __float_as_uint(v), false, false); return __uint_as_float(rr[0]) + __uint_as_float(rr[1]); }
__device__ __forceinline__ float xsum32(float v) { const auto rr = __builtin_amdgcn_permlane32_swap(__float_as_uint(v), __float_as_uint(v), false, false); return __uint_as_float(rr[0]) + __uint_as_float(rr[1]); }
__device__ __forceinline__ float row_sum16(float v) { v += dppm<0xB1>(v); v += dppm<0x4E>(v); v += dppm<0x141>(v); v += dppm<0x140>(v); return v; }
__device__ __forceinline__ float row_max16(float v) { v = fmaxf(v, dppm<0xB1>(v)); v = fmaxf(v, dppm<0x4E>(v)); v = fmaxf(v, dppm<0x141>(v)); v = fmaxf(v, dppm<0x140>(v)); return v; }
__device__ __forceinline__ float wave_sum(float v, int lane) { (void)lane; return xsum32(xsum16(row_sum16(v))); }
__device__ __forceinline__ float wave_max(float v, int lane) { (void)lane; v = row_max16(v);
    { const auto rr = __builtin_amdgcn_permlane16_swap(__float_as_uint(v), __float_as_uint(v), false, false); v = fmaxf(__uint_as_float(rr[0]), __uint_as_float(rr[1])); }
    { const auto rr = __builtin_amdgcn_permlane32_swap(__float_as_uint(v), __float_as_uint(v), false, false); v = fmaxf(__uint_as_float(rr[0]), __uint_as_float(rr[1])); }
    return v; }
__device__ __forceinline__ float sink_bound(const float* s6) { float m = 0.f;
#pragma unroll
    for (int i = 0; i < 6; ++i) m = fmaxf(m, fabsf(s6[i]) * 1.4426950408889634f);
    return m; }
__device__ __forceinline__ int modrow(int row) { return row < SEQ ? 0 : (row < NLAT ? 1 : 2); }

__host__ __device__ __forceinline__ int pos128(int d) { const int half = d >> 6, r = d & 63, n = r >> 5, r2 = r & 31, wcl = r2 >> 4, r3 = r2 & 15; return (half * 2 + wcl) * 32 + (r3 >> 2) * 8 + n * 4 + (r3 & 3); }
__host__ __device__ __forceinline__ int pos64(int d) { const int wcl = d >> 5, r = d & 31, n = r >> 4, r3 = r & 15; return wcl * 32 + (r3 >> 2) * 8 + n * 4 + (r3 & 3); }
#ifndef LDS_XPOSE_V2
#define LDS_XPOSE_V2 2
#endif
template <int MODE  > __device__ __forceinline__ void transpose_item(f32x4 (&v)[16], const float* __restrict__ W, int N, int k0, int n0, bf16_t* __restrict__ dst  , int ldd, int perm, LAS float* scr, int lane) {
    const int kq = lane >> 4, nq = lane & 15;
    if (MODE != 2) {
#pragma unroll
        for (int i = 0; i < 16; ++i) v[i] = __builtin_nontemporal_load((const f32x4*)(W + (size_t)(k0 + 4 * i + kq) * N + n0 + 4 * nq)); }
    if (MODE == 1) return;
#pragma unroll
    for (int i = 0; i < 16; ++i) {
#if LDS_XPOSE_V2
        *(LAS f32x4*)(scr + (4 * i + kq) * 64 + ((nq ^ (2 * (i >> 1))) << 2)) = v[i];
#else
        LAS float* s = scr + (4 * i + kq) * 65 + 4 * nq; s[0] = v[i][0]; s[1] = v[i][1]; s[2] = v[i][2]; s[3] = v[i][3];
#endif
    }
    asm volatile("s_waitcnt lgkmcnt(0)" ::: "memory");
#if LDS_XPOSE_V2 == 2
#pragma unroll
    for (int j = 0; j < 2; ++j) { const int c = lane & 7, ch = j * 8 + (lane >> 3); f32x4 x[8];
#pragma unroll
        for (int t = 0; t < 8; ++t) x[t] = *(const LAS f32x4*)(scr + (8 * c + t) * 64 + ((ch ^ (2 * c)) << 2));
#pragma unroll
        for (int e = 0; e < 4; ++e) { const int sc = n0 + 4 * ch + e; const int drow = perm == 0 ? sc : (perm == 1 ? (sc & ~127) + pos128(sc & 127) : (sc & ~63) + pos64(sc & 63));
            u32x4 o; o.x = cvt_pk_bf16(x[0][e], x[1][e]); o.y = cvt_pk_bf16(x[2][e], x[3][e]); o.z = cvt_pk_bf16(x[4][e], x[5][e]); o.w = cvt_pk_bf16(x[6][e], x[7][e]);
            *(u32x4*)(dst + (size_t)drow * ldd + 8 * c) = o; } }
#else
#pragma unroll
    for (int j = 0; j < 8; ++j) { const int n = j * 8 + (lane >> 3), c = lane & 7;
#if LDS_XPOSE_V2
        const LAS float* s = scr + (8 * c) * 64 + (((n >> 2) ^ (2 * c)) << 2) + (n & 3); constexpr int PT = 64;
#else
        const LAS float* s = scr + (8 * c) * 65 + n; constexpr int PT = 65;
#endif
        const int sc = n0 + n; const int drow = perm == 0 ? sc : (perm == 1 ? (sc & ~127) + pos128(sc & 127) : (sc & ~63) + pos64(sc & 63));
        u32x4 o; o.x = cvt_pk_bf16(s[0 * PT], s[1 * PT]); o.y = cvt_pk_bf16(s[2 * PT], s[3 * PT]); o.z = cvt_pk_bf16(s[4 * PT], s[5 * PT]); o.w = cvt_pk_bf16(s[6 * PT], s[7 * PT]);
        *(u32x4*)(dst + (size_t)drow * ldd + 8 * c) = o; }
#endif
    asm volatile("s_waitcnt lgkmcnt(0)" ::: "memory");
}
template <int MODE> __device__ __forceinline__ void transpose_item_f8(f32x4 (&v)[16], const float* __restrict__ W, int N, int k0, int n0, unsigned char* __restrict__ dst  , int ldd, float mul, LAS float* scr, int lane, int perm = 0) {
    const int kq = lane >> 4, nq = lane & 15;
    if (MODE != 2) {
#pragma unroll
        for (int i = 0; i < 16; ++i) v[i] = __builtin_nontemporal_load((const f32x4*)(W + (size_t)(k0 + 4 * i + kq) * N + n0 + 4 * nq)); }
    if (MODE == 1) return;
#pragma unroll
    for (int i = 0; i < 16; ++i) {
#if LDS_XPOSE_V2
        *(LAS f32x4*)(scr + (4 * i + kq) * 64 + ((nq ^ (2 * (i >> 1))) << 2)) = v[i] * mul;
#else
        LAS float* s = scr + (4 * i + kq) * 65 + 4 * nq; s[0] = v[i][0] * mul; s[1] = v[i][1] * mul; s[2] = v[i][2] * mul; s[3] = v[i][3] * mul;
#endif
    }
    asm volatile("s_waitcnt lgkmcnt(0)" ::: "memory");
#if LDS_XPOSE_V2 == 2
    { const int c = lane & 3, ch = lane >> 2; f32x4 x[16];
#pragma unroll
        for (int t = 0; t < 16; ++t) x[t] = *(const LAS f32x4*)(scr + (16 * c + t) * 64 + ((ch ^ (4 * c + 2 * (t >> 3))) << 2));
#pragma unroll
        for (int e = 0; e < 4; ++e) { const int sc = n0 + 4 * ch + e; const int drow = perm == 0 ? sc : (perm == 1 ? (sc & ~127) + pos128(sc & 127) : (sc & ~63) + pos64(sc & 63));
            u32x4 o; o.x = pk4_fp8(x[0][e], x[1][e], x[2][e], x[3][e]); o.y = pk4_fp8(x[4][e], x[5][e], x[6][e], x[7][e]);
            o.z = pk4_fp8(x[8][e], x[9][e], x[10][e], x[11][e]); o.w = pk4_fp8(x[12][e], x[13][e], x[14][e], x[15][e]);
            *(u32x4*)(dst + (size_t)drow * ldd + 16 * c) = o; } }
#else
#pragma unroll
    for (int j = 0; j < 4; ++j) { const int n = j * 16 + (lane >> 2), c = lane & 3;
#if LDS_XPOSE_V2
        const LAS float* s = scr + (16 * c) * 64 + (((n >> 2) ^ (4 * c)) << 2) + (n & 3); const LAS float* s2 = scr + (16 * c) * 64 + (((n >> 2) ^ (4 * c + 2)) << 2) + (n & 3); constexpr int PT = 64;
#else
        const LAS float* s = scr + (16 * c) * 65 + n; const LAS float* s2 = s; constexpr int PT = 65;
#endif
        u32x4 o; o.x = pk4_fp8(s[0 * PT], s[1 * PT], s[2 * PT], s[3 * PT]); o.y = pk4_fp8(s[4 * PT], s[5 * PT], s[6 * PT], s[7 * PT]);
        o.z = pk4_fp8(s2[8 * PT], s2[9 * PT], s2[10 * PT], s2[11 * PT]); o.w = pk4_fp8(s2[12 * PT], s2[13 * PT], s2[14 * PT], s2[15 * PT]);
        const int sc = n0 + n; const int drow = perm == 0 ? sc : (perm == 1 ? (sc & ~127) + pos128(sc & 127) : (sc & ~63) + pos64(sc & 63));
        *(u32x4*)(dst + (size_t)drow * ldd + 16 * c) = o; }
#endif
    asm volatile("s_waitcnt lgkmcnt(0)" ::: "memory");
}
__host__ __device__ __forceinline__ bool win_fp8_tile(int pn) { return FP8_GATES && (pn >= 16 || (FP8_AC && !(pn == 2 || pn == 3 || pn == 4 || pn == 5 || pn == 11 || pn == 12))); }
__host__ __device__ __forceinline__ int win_perm(int c) { return c < 256 ? 1 : c < 512 ? 0 : c < 1024 ? 2 : c < 1536 ? 0 : c < 1792 ? 1 : c < 2048 ? 0 : c < 2816 ? 1 : c < 3328 ? 2 : c < 4096 ? 1 : 0; }
constexpr int CV_I_IN = 32 * 160, CV_I_BRA = 12 * 32, CV_I_BRB = 8 * 32, CV_I_OUT = 32 * 32, CV_I_G = 32 * 16, CV_I_D = 16 * 32;
constexpr int CV_D1 = CV_I_IN + 2 * CV_I_BRA + CV_I_BRB + CV_I_OUT;
constexpr int CV_PER_L = CV_D1 + 16 * (2 * CV_I_G + CV_I_D);
template <int MODE> __device__ __forceinline__ void conv_item_m(f32x4 (&v)[16], const Args& A, int it, LAS float* scr, int lane) {
    unsigned char* ws = A.ws;
    constexpr int I_IN = CV_I_IN, I_BRA = CV_I_BRA, I_BRB = CV_I_BRB, I_OUT = CV_I_OUT, I_G = CV_I_G, I_D = CV_I_D, PER_L = CV_PER_L;
    {
        const int l = it / PER_L; int r = it % PER_L;
        if (r < I_IN) { const int kb = r / 160, nb = r % 160;
            if (win_fp8_tile(nb >> 2)) { transpose_item_f8<MODE>(v, A.in[8] + (size_t)l * DM * INW, INW, kb * 64, nb * 64, (unsigned char*)(ws + WS_WIN8) + ((size_t)l * INW) * DM + kb * 64, DM, 64.f, scr, lane, FUSE_QK ? win_perm(nb * 64) : 0); return; }
            transpose_item<MODE>(v, A.in[8] + (size_t)l * DM * INW, INW, kb * 64, nb * 64, (bf16_t*)(ws + WS_WIN) + ((size_t)l * INW) * DM + kb * 64, DM, FUSE_QK ? win_perm(nb * 64) : 0, scr, lane); return; } r -= I_IN;
        if (r < I_BRA) { const int kb = r / 32, nb = r % 32;
            if (FP8_BR) transpose_item_f8<MODE>(v, A.in[21] + (size_t)l * 768 * DM, DM, kb * 64, nb * 64, (unsigned char*)(ws + WS_WBR8) + ((size_t)l * DM) * DM + kb * 64, DM, 64.f, scr, lane);
            else transpose_item<MODE>(v, A.in[21] + (size_t)l * 768 * DM, DM, kb * 64, nb * 64, (bf16_t*)(ws + WS_WBR) + ((size_t)l * DM) * DM + kb * 64, DM, 0, scr, lane);
            return; } r -= I_BRA;
        if (r < I_BRB) { const int kb = r / 32, nb = r % 32; transpose_item<MODE>(v, A.in[22] + (size_t)l * 512 * DM, DM, kb * 64, nb * 64, (bf16_t*)(ws + WS_WBR) + ((size_t)l * DM) * DM + 768 + kb * 64, DM, 0, scr, lane); return; } r -= I_BRB;
        if (r < I_BRA) { const int kb = r / 32, nb = r % 32;
            if (FP8_BR) transpose_item_f8<MODE>(v, A.in[23] + (size_t)l * 768 * DM, DM, kb * 64, nb * 64, (unsigned char*)(ws + WS_WBR8) + ((size_t)l * DM) * DM + 1280 + kb * 64, DM, 64.f, scr, lane);
            else transpose_item<MODE>(v, A.in[23] + (size_t)l * 768 * DM, DM, kb * 64, nb * 64, (bf16_t*)(ws + WS_WBR) + ((size_t)l * DM) * DM + 1280 + kb * 64, DM, 0, scr, lane);
            return; } r -= I_BRA;
        if (r < I_OUT) { const int kb = r / 32, nb = r % 32;
            if (FP8_OUT) transpose_item_f8<MODE>(v, A.in[24] + (size_t)l * DM * DM, DM, kb * 64, nb * 64, (unsigned char*)(ws + WS_WOUT) + ((size_t)l * DM) * DM + kb * 64, DM, 64.f, scr, lane);
            else transpose_item<MODE>(v, A.in[24] + (size_t)l * DM * DM, DM, kb * 64, nb * 64, (bf16_t*)(ws + WS_WOUT) + ((size_t)l * DM) * DM + kb * 64, DM, 0, scr, lane);
            return; } r -= I_OUT;
        const int e = r / (2 * I_G + I_D); r %= (2 * I_G + I_D);
        if (r < 2 * I_G) { const int up = r / I_G; r %= I_G; const int kb = r / 16, nb = r % 16, f0 = nb * 64;
            const size_t drow0 = ((size_t)l * 16 + e) * 2048 + (f0 >> 7) * 256 + up * 128 + (f0 & 127) - f0;
            if (FP8_EXPERTS) transpose_item_f8<MODE>(v, A.in[26 + up] + ((size_t)l * 16 + e) * DM * FF, FF, kb * 64, f0, (unsigned char*)(ws + WS_W1) + drow0 * DM + kb * 64, DM, 64.f, scr, lane);
            else transpose_item<MODE>(v, A.in[26 + up] + ((size_t)l * 16 + e) * DM * FF, FF, kb * 64, f0, (bf16_t*)(ws + WS_W1) + drow0 * DM + kb * 64, DM, 0, scr, lane);
            return; }
        r -= 2 * I_G;
        { const int kb = r / 32, nb = r % 32;
          if (FP8_EXPERTS) transpose_item_f8<MODE>(v, A.in[28] + ((size_t)l * 16 + e) * FF * DM, DM, kb * 64, nb * 64, (unsigned char*)(ws + WS_W2) + (((size_t)l * 16 + e) * 2048) * FF + kb * 64, FF, 64.f, scr, lane);
          else transpose_item<MODE>(v, A.in[28] + ((size_t)l * 16 + e) * FF * DM, DM, kb * 64, nb * 64, (bf16_t*)(ws + WS_W2) + (((size_t)l * 16 + e) * 2048) * FF + kb * 64, FF, 0, scr, lane); }
    }
}
__device__ __forceinline__ void conv_item(const Args& A, int it, LAS float* scr, int lane) { f32x4 v[16]; conv_item_m<0>(v, A, it, scr, lane); }
__device__ __forceinline__ void bg_loop(const Args& A, LAS unsigned char* lds, unsigned* ctl, volatile LAS unsigned* MISC, int seam, int force_upto, int G) {
    int tz = threadIdx.x; asm volatile("" : "+v"(tz)); const int tid = tz, lane = tz & 63, wave = __builtin_amdgcn_readfirstlane(tz >> 6);
    LAS float* scr = (LAS float*)(lds + wave * 16640);
    unsigned* bgq = ctl + CW_BGQ; unsigned* done = ctl + CW_DONE + 64 * seam;
    __syncthreads();
    if (tid == 0) (void)xb_add(done, 1u);
    for (;;) {
        if (tid == 0) { unsigned base = 0xffffffffu; const unsigned head = xb_ld(bgq);
            if (head < (unsigned)CV_PER_L && (head < (unsigned)force_upto || xb_ld(done) < (unsigned)G)) base = xb_add(bgq, 8u);
            MISC[1] = base; }
        __syncthreads();
        const unsigned base = MISC[1];
        __syncthreads();
        if (base >= (unsigned)CV_PER_L) break;
        const int item = (int)base + wave; if (item < CV_PER_L) conv_item(A, CV_PER_L + item, scr, lane);
    }
}
__device__ __forceinline__ void p0_prologue(const Args& A, LAS unsigned char* lds, int wave, int lane, int gw, int NGW, int n_items) {
    unsigned char* ws = A.ws;
    LAS float* scr = (LAS float*)(lds + wave * 16640);
    for (int it = gw; it < n_items; it += NGW) conv_item(A, it, scr, lane);
    float* r128 = (float*)(ws + WS_ROPE128); float* r64 = (float*)(ws + WS_ROPE64);
    for (int i = gw * 64 + lane; i < 4096 * 64; i += NGW * 64) { const int t = i >> 6, j = i & 63, q = j & 31, pos = j < 32 ? (t >> 6) : (t & 63);
        const float ang = (float)pos * powf(10000.f, -(float)(2 * q) / 64.f); r128[2 * i] = cosf(ang); r128[2 * i + 1] = sinf(ang); }
    for (int i = gw * 64 + lane; i < 4096 * 32; i += NGW * 64) { const int t = i >> 5, j = i & 31, q = j & 15, pos = j < 16 ? (t >> 6) : (t & 63);
        const float ang = (float)pos * powf(10000.f, -(float)(2 * q) / 32.f); r64[2 * i] = cosf(ang); r64[2 * i + 1] = sinf(ang); }
}
__device__ __forceinline__ void p0_convert_dyn2(const Args& A, LAS unsigned char* lds, unsigned* q, volatile LAS unsigned* MISC, int tid, int wave, int lane, int n_items, int item0) {
    LAS float* scr = (LAS float*)(lds + wave * 16640);
    unsigned nxt = 0u; if (tid == 0) nxt = xb_add(q, 16u);
    for (;;) {
        if (tid == 0) MISC[2] = nxt;
        __syncthreads();
        const unsigned base = MISC[2];
        if (base >= (unsigned)n_items) break;
        if (tid == 0) nxt = xb_add(q, 16u);
        const int ia = (int)base + wave, ib = ia + 8; f32x4 va[16], vb[16];
        if (ia < n_items) conv_item_m<1>(va, A, item0 + ia, scr, lane);
        if (ib < n_items) conv_item_m<1>(vb, A, item0 + ib, scr, lane);
        if (ia < n_items) conv_item_m<2>(va, A, item0 + ia, scr, lane);
        if (ib < n_items) conv_item_m<2>(vb, A, item0 + ib, scr, lane);
        __syncthreads();
    }
    __syncthreads();
}
__device__ __forceinline__ void p0_convert_dyn(const Args& A, LAS unsigned char* lds, unsigned* q, volatile LAS unsigned* MISC, int tid, int wave, int lane, int n_items, int item0 = 0) {
    LAS float* scr = (LAS float*)(lds + wave * 16640);
    unsigned nxt = 0u; if (tid == 0) nxt = xb_add(q, 8u);
    for (;;) {
        if (tid == 0) MISC[2] = nxt;
        __syncthreads();
        const unsigned base = MISC[2];
        if (base >= (unsigned)n_items) break;
        if (tid == 0) nxt = xb_add(q, 8u);
        const int item = (int)base + wave; if (item < n_items) conv_item(A, item0 + item, scr, lane);
        __syncthreads();
    }
    __syncthreads();
}
__device__ __forceinline__ void p0_modv(const Args& A, LAS unsigned char* lds, int tid, int lane, int wave, int wg, int G, int job0 = 0, int job1 = 2 * 96) {
    LAS float* sv = (LAS float*)lds;
    LAS float* part = (LAS float*)(lds + 24576);
    for (int i = tid; i < 3 * DM; i += NTHR) { const int r = i / DM, k = i % DM; const float v = r < 2 ? A.in[1][r * DM + k] : A.in[3][k]; sv[i] = v / (1.f + expf(-v)); }
    __syncthreads();
    float* modv = (float*)(A.ws + WS_MODV);
    for (int job = job0 + wg; job < job1; job += G) {
        const int l = job / 96, cg = job % 96, j = cg * 128 + lane * 2;
        const float* w = A.in[4] + (size_t)l * DM * MODW + (size_t)(wave * 256) * MODW + j;
        f32x2 a0 = {0.f, 0.f}, a1 = a0, a2 = a0;
#pragma unroll 16
        for (int k = 0; k < 256; ++k) { const f32x2 wv = __builtin_nontemporal_load((const f32x2*)(w + (size_t)k * MODW)); const int kk = wave * 256 + k; a0 = a0 + wv * sv[kk]; a1 = a1 + wv * sv[DM + kk]; a2 = a2 + wv * sv[2 * DM + kk]; }
        LAS float* pw = part + wave * 384 + lane * 2;
        pw[0] = a0[0]; pw[1] = a0[1]; pw[128] = a1[0]; pw[129] = a1[1]; pw[256] = a2[0]; pw[257] = a2[1];
        __syncthreads();
        if (wave < 3) { float s0 = 0.f, s1 = 0.f;
#pragma unroll
            for (int q = 0; q < 8; ++q) { s0 += part[q * 384 + wave * 128 + lane * 2]; s1 += part[q * 384 + wave * 128 + lane * 2 + 1]; }
            const f32x2 bb = *(const f32x2*)(A.in[5] + l * MODW + j);
            *(f32x2*)(modv + (size_t)(l * 3 + wave) * MODW + j) = (f32x2){s0 + bb[0], s1 + bb[1]}; }
        __syncthreads();
    }
}

__device__ __forceinline__ float treduce16(const float (&v)[16], int lane) {
    const bool b3 = (lane & 8) != 0, b2 = (lane & 4) != 0;
    float a[8], b[4], c[2];
#pragma unroll
    for (int i = 0; i < 8; ++i) { const auto rr = __builtin_amdgcn_permlane32_swap(__float_as_uint(v[i]), __float_as_uint(v[i + 8]), false, false); a[i] = __uint_as_float(rr[0]) + __uint_as_float(rr[1]); }
#pragma unroll
    for (int i = 0; i < 4; ++i) { const auto rr = __builtin_amdgcn_permlane16_swap(__float_as_uint(a[i]), __float_as_uint(a[i + 4]), false, false); b[i] = __uint_as_float(rr[0]) + __uint_as_float(rr[1]); }
#pragma unroll
    for (int i = 0; i < 2; ++i) { const float keep = b3 ? b[i + 2] : b[i], send = b3 ? b[i] : b[i + 2]; c[i] = keep + dppm<0x128>(send); }
    const float keep = b2 ? c[1] : c[0], send = b2 ? c[0] : c[1]; float d = keep + dppm<0x141>(send);
    d += dppm<0x4E>(d); d += dppm<0xB1>(d); return d;
}
template <int MODE  >
__device__ __forceinline__ void row_phase_a(const Args& A, int l, int lane, int gw, int NGW) {
    unsigned char* ws = A.ws; float* X = (float*)(ws + WS_X); bf16_t* H = (bf16_t*)(ws + WS_H); const bf16_t* Y = (const bf16_t*)(ws + WS_Y); const int* SEL = (const int*)(ws + WS_SEL);
    const float* modv = (const float*)(ws + WS_MODV);
    const int nrows = MODE == 2 ? NLAT : MROWS;
    if ((ROUTER_V3 || FUSE_ROUTER) && MODE != 2 && gw < 3) {
        const float* sh2 = modv + (size_t)(l * 3 + gw) * MODW + 3 * DM; const float* wr = A.in[25] + (size_t)l * DM * 16; float pb[16];
#pragma unroll
        for (int e = 0; e < 16; ++e) pb[e] = 0.f;
        for (int i = 0; i < 32; ++i) { const int k = lane + 64 * i; const float s = sh2[k];
#pragma unroll
            for (int q = 0; q < 4; ++q) { const f32x4 w4 = *(const f32x4*)(wr + (size_t)k * 16 + 4 * q); pb[4 * q] += s * w4[0]; pb[4 * q + 1] += s * w4[1]; pb[4 * q + 2] += s * w4[2]; pb[4 * q + 3] += s * w4[3]; } }
        const float bt = treduce16(pb, lane);
        if ((lane & 3) == 0) ((float*)(ws + WS_BIASR))[(l * 3 + gw) * 16 + (lane >> 2)] = bt;
    }
#ifndef CONV_IN_EXP
#define CONV_IN_EXP 0
#endif
#ifndef CONV_EXP_PART1
#define CONV_EXP_PART1 4352
#endif
#ifndef MODV1_IN_ATT
#define MODV1_IN_ATT 0
#endif
#ifndef P0_DYN
#define P0_DYN 1
#endif
#ifndef CONV_IN_ATT
#define CONV_IN_ATT 2
#endif
#ifndef NORM_EVEN
#define NORM_EVEN 1
#endif
    const bool evn = NORM_EVEN && NGW == 2048 && nrows == 256 * 34;
    const int r_lo = evn ? (gw >> 3) * 34 + (gw & 7) : gw, r_hi = evn ? (gw >> 3) * 34 + 34 : nrows, r_st = evn ? 8 : NGW;
    for (int row = r_lo; row < r_hi; row += r_st) {
        f32x4 v[8];
        if (MODE == 0) { const float* src = row < NLAT ? A.in[0] + (size_t)row * DM : A.in[2] + (size_t)(row - NLAT) * DM;
#pragma unroll
            for (int i = 0; i < 8; ++i) v[i] = *(const f32x4*)(src + (lane + 64 * i) * 4); }
        else {
            const float* xr = X + (size_t)row * DM;
#pragma unroll
            for (int i = 0; i < 8; ++i) v[i] = *(const f32x4*)(xr + (lane + 64 * i) * 4);
            const float* g2 = modv + (size_t)((l - 1) * 3 + modrow(row)) * MODW + 5 * DM;
            f32x4 acc[8];
#pragma unroll
            for (int i = 0; i < 8; ++i) acc[i] = (f32x4){0.f, 0.f, 0.f, 0.f};
            const int mysel = lane < 16 ? SEL[(size_t)row * 16 + lane] : -1;
            for (int e = 0; e < 16; ++e) { const int slot = __builtin_amdgcn_readlane(mysel, e); if (slot < 0) continue;
                const bf16_t* yr = Y + ((size_t)e * EROWS + slot) * DM;
#pragma unroll
                for (int i = 0; i < 8; ++i) { const u32x2 w = *(const u32x2*)(yr + (lane + 64 * i) * 4); acc[i][0] += bf_lo(w.x); acc[i][1] += bf_hi(w.x); acc[i][2] += bf_lo(w.y); acc[i][3] += bf_hi(w.y); } }
#pragma unroll
            for (int i = 0; i < 8; ++i) { const f32x4 g = *(const f32x4*)(g2 + (lane + 64 * i) * 4); v[i] = v[i] + g * acc[i]; }
            float* dst = MODE == 2 ? A.out + (size_t)row * DM : X + (size_t)row * DM;
#pragma unroll
            for (int i = 0; i < 8; ++i) *(f32x4*)(dst + (lane + 64 * i) * 4) = v[i];
        }
        if (MODE == 2) continue;
        float ss = 0.f;
#pragma unroll
        for (int i = 0; i < 8; ++i) ss += (v[i][0] * v[i][0] + v[i][1] * v[i][1]) + (v[i][2] * v[i][2] + v[i][3] * v[i][3]);
        const float rstd = rsqrtf(wave_sum(ss, lane) * (1.f / DM) + EPS);
        const float* mv = modv + (size_t)(l * 3 + modrow(row)) * MODW; const float* gain = A.in[6] + l * DM;
#pragma unroll
        for (int i = 0; i < 8; ++i) { const int c = (lane + 64 * i) * 4; const f32x4 g = *(const f32x4*)(gain + c), sh = *(const f32x4*)(mv + c), sc = *(const f32x4*)(mv + DM + c);
            const f32x4 h = v[i] * rstd * g * (sc + 1.f) + sh; u32x2 w; w.x = cvt_pk_bf16(h[0], h[1]); w.y = cvt_pk_bf16(h[2], h[3]); *(u32x2*)(H + (size_t)row * DM + c) = w;
            if (FP8_GATES) *(unsigned*)((unsigned char*)(ws + WS_H8) + (size_t)row * DM + c) = pk4_fp8(h[0], h[1], h[2], h[3]); }
    }
}
#ifndef ROUTER_PK
#define ROUTER_PK 1
#endif
#ifndef ROUTER_PROBE
#define ROUTER_PROBE 0
#endif
__device__ __forceinline__ void row_phase_g(const Args& A, LAS unsigned char* lds, int l, int tid, int lane, int wave, int wg, int G, bool prb = false) {
    unsigned char* ws = A.ws; const float* X = (const float*)(ws + WS_X); bf16_t* H = (bf16_t*)(ws + WS_H); float* AFFT = (float*)(ws + WS_AFFT);
    const float* modv = (const float*)(ws + WS_MODV); const float* wr = A.in[25] + (size_t)l * DM * 16; const float* gain = A.in[7] + l * DM;
    LAS float* part = (LAS float*)lds;
    LAS float* biasp = part + 2 * 640;
    const int k0 = wave * 256 + lane * 4;
    const int ecode = ((lane >> 5) & 1) * 8 + ((lane >> 4) & 1) * 4 + ((lane >> 3) & 1) * 2 + ((lane >> 2) & 1);
    float Wl[4][16], gsc[4], sh[4]; float bias_e = 0.f; int cur_mr = -1;
    const int ngr = MROWS / 4, gq = ngr / G, grm = ngr % G, g0 = wg < grm ? wg * (gq + 1) : grm * (gq + 1) + (wg - grm) * gq; (void)g0;
    const bool even = (G == 256) && (MROWS == 256 * 34);
    const int rbase = even ? wg * 34 : 4 * g0, nri = (ROUTER_PROBE == 6 && prb) ? 0 : (ROUTER_PROBE >= 4 && prb) ? 4 : (even ? 34 : 4 * (wg < grm ? gq + 1 : gq));
#define RG_ROW(i) (rbase + (i))
    f32x4 xq[4], xnq[4];
#pragma unroll
    for (int j = 0; j < 4; ++j) { xnq[j] = (f32x4){0.f, 0.f, 0.f, 0.f}; if (j < nri) xnq[j] = *(const f32x4*)(X + (size_t)RG_ROW(j) * DM + k0); }
    __syncthreads();
    for (int i0 = 0; i0 < nri; i0 += 4) {
#pragma unroll
        for (int j = 0; j < 4; ++j) { xq[j] = xnq[j]; if (i0 + 4 + j < nri && !(ROUTER_PROBE == 3 && prb)) xnq[j] = *(const f32x4*)(X + (size_t)RG_ROW(i0 + 4 + j) * DM + k0); }
        const int mr = modrow(RG_ROW(i0));
        if (mr != cur_mr) {
            cur_mr = mr; const float* mv = modv + (size_t)(l * 3 + mr) * MODW;
            const f32x4 g4 = *(const f32x4*)(gain + k0), sh4 = *(const f32x4*)(mv + 3 * DM + k0), sc4 = *(const f32x4*)(mv + 4 * DM + k0);
            float pb[16];
#pragma unroll
            for (int e = 0; e < 16; ++e) pb[e] = 0.f;
#pragma unroll
            for (int jj = 0; jj < 4; ++jj) { gsc[jj] = g4[jj] * (1.f + sc4[jj]); sh[jj] = sh4[jj];
#pragma unroll
                for (int q = 0; q < 4; ++q) { f32x4 w4; if (ROUTER_PROBE == 5 && prb) w4 = (f32x4){0.01f * jj, 0.02f, 0.03f * q, 0.04f}; else w4 = *(const f32x4*)(wr + (size_t)(k0 + jj) * 16 + 4 * q);
#pragma unroll
                    for (int t = 0; t < 4; ++t) { Wl[jj][4 * q + t] = gsc[jj] * w4[t]; pb[4 * q + t] += sh[jj] * w4[t]; } } }
            const float bt = treduce16(pb, lane);
            __syncthreads();
            if ((lane & 3) == 0) biasp[wave * 16 + ecode] = bt;
            __syncthreads();
            bias_e = 0.f;
            if (lane < 16) {
#pragma unroll
                for (int w = 0; w < 8; ++w) bias_e += biasp[w * 16 + lane]; }
        }
        LAS float* pp = part + ((i0 >> 2) & 1) * 640;
#pragma unroll
        for (int j = 0; j < 4; ++j) {
            const f32x4 x = xq[j]; float pl[16];
#if ROUTER_PK
            {
                const f32x2 x0 = {x[0], x[0]}, x1 = {x[1], x[1]}, x2 = {x[2], x[2]}, x3 = {x[3], x[3]};
#pragma unroll
                for (int e2 = 0; e2 < 8; ++e2) { const f32x2 w0 = {Wl[0][2 * e2], Wl[0][2 * e2 + 1]}, w1 = {Wl[1][2 * e2], Wl[1][2 * e2 + 1]}, w2 = {Wl[2][2 * e2], Wl[2][2 * e2 + 1]}, w3 = {Wl[3][2 * e2], Wl[3][2 * e2 + 1]};
                    f32x2 a = x0 * w0; a = __builtin_elementwise_fma(x1, w1, a); a = __builtin_elementwise_fma(x2, w2, a); a = __builtin_elementwise_fma(x3, w3, a); pl[2 * e2] = a[0]; pl[2 * e2 + 1] = a[1]; } }
#else
#pragma unroll
            for (int e = 0; e < 16; ++e) pl[e] = x[0] * Wl[0][e] + x[1] * Wl[1][e] + x[2] * Wl[2][e] + x[3] * Wl[3][e];
#endif
            float pt; if (ROUTER_PROBE == 1 && prb) pt = pl[lane & 15]; else pt = treduce16(pl, lane);
            const float ssw = wave_sum((x[0] * x[0] + x[1] * x[1]) + (x[2] * x[2] + x[3] * x[3]), lane);
            if ((lane & 3) == 0) pp[(j * 8 + wave) * 20 + ecode] = pt;
            if (lane == 0) pp[(j * 8 + wave) * 20 + 16] = ssw;
        }
        __syncthreads();
#pragma unroll
        for (int j = 0; j < 4; ++j) {
            if (i0 + j >= nri) break;
            const int row = RG_ROW(i0 + j); const f32x4 x = xq[j];
            float sst = 0.f;
#pragma unroll
            for (int w = 0; w < 8; ++w) sst += pp[(j * 8 + w) * 20 + 16];
            const float rstd = rsqrtf(sst * (1.f / DM) + EPS);
            { u32x2 w2; w2.x = cvt_pk_bf16(x[0] * rstd * gsc[0] + sh[0], x[1] * rstd * gsc[1] + sh[1]); w2.y = cvt_pk_bf16(x[2] * rstd * gsc[2] + sh[2], x[3] * rstd * gsc[3] + sh[3]);
              if (!(ROUTER_PROBE == 2 && prb)) *(u32x2*)(H + (size_t)row * DM + k0) = w2; }
            if (wave == j) {
                float t = 0.f;
                if (lane < 16) {
#pragma unroll
                    for (int w = 0; w < 8; ++w) t += pp[(j * 8 + w) * 20 + lane]; }
                const float logit = lane < 16 ? rstd * t + bias_e : -3.0e38f;
                const float mx = row_max16(logit);
                const float ex = lane < 16 ? expf(logit - mx) : 0.f; const float s = row_sum16(ex);
                if (lane < 16) AFFT[(size_t)lane * MROWS + row] = ex / s;
            }
        }
    }
    __syncthreads();
}
#undef RG_ROW
__device__ __forceinline__ void row_phase_g3(const Args& A, LAS unsigned char* lds, int l, int tid, int lane, int wave, int wg, int G) {
    unsigned char* ws = A.ws; const float* X = (const float*)(ws + WS_X); bf16_t* H = (bf16_t*)(ws + WS_H); float* AFFT = (float*)(ws + WS_AFFT);
    const float* modv = (const float*)(ws + WS_MODV); const float* wr = A.in[25] + (size_t)l * DM * 16; const float* gain = A.in[7] + l * DM; const float* biasr = (const float*)(ws + WS_BIASR) + l * 48;
    LAS f32x4* Wl = (LAS f32x4*)lds;
    const int ngr = MROWS / 4, gq = ngr / G, grm = ngr % G, g0 = wg < grm ? wg * (gq + 1) : grm * (gq + 1) + (wg - grm) * gq, nrows = 4 * (wg < grm ? gq + 1 : gq), row0 = 4 * g0;
    const int ecode = lane >> 2;
    int cur_mr = -1; f32x4 gsc[8], sh[8]; float bias_e = 0.f;
    f32x4 xn[8];
    { const int r = row0 + wave; if (wave < nrows) {
#pragma unroll
        for (int i = 0; i < 8; ++i) xn[i] = *(const f32x4*)(X + (size_t)r * DM + (lane + 64 * i) * 4); } }
    for (int rb = 0; rb < nrows; rb += 8) {
        const int mr_lo = modrow(row0 + rb), mr_hi = modrow(row0 + (rb + 7 < nrows ? rb + 7 : nrows - 1));
        for (int pass = 0; pass < (mr_lo == mr_hi ? 1 : 2); ++pass) {
            const int mr = pass == 0 ? mr_lo : mr_hi;
            if (mr != cur_mr) {
                cur_mr = mr; const float* mv = modv + (size_t)(l * 3 + mr) * MODW;
                __syncthreads();
                for (int t = tid; t < 8192; t += NTHR) { const int ln = t & 63, q = (t >> 6) & 3, j = (t >> 8) & 3, i = t >> 10, k = 4 * (ln + 64 * i) + j;
                    const float g = gain[k] * (1.f + mv[4 * DM + k]); const f32x4 w4 = *(const f32x4*)(wr + (size_t)k * 16 + 4 * q); Wl[t] = w4 * g; }
#pragma unroll
                for (int i = 0; i < 8; ++i) { const int c = (lane + 64 * i) * 4; const f32x4 g4 = *(const f32x4*)(gain + c), sc4 = *(const f32x4*)(mv + 4 * DM + c); gsc[i] = g4 * (sc4 + 1.f); sh[i] = *(const f32x4*)(mv + 3 * DM + c); }
                bias_e = biasr[mr * 16 + ecode];
                __syncthreads();
            }
            const int ri = rb + wave; const bool mine = ri < nrows && modrow(row0 + ri) == mr && (pass == 0 || mr_lo != mr_hi);
            if (mine && !(pass == 1 && modrow(row0 + ri) == mr_lo)) {
                const int row = row0 + ri; f32x4 x[8];
#pragma unroll
                for (int i = 0; i < 8; ++i) x[i] = xn[i];
                if (ri + 8 < nrows) {
#pragma unroll
                    for (int i = 0; i < 8; ++i) xn[i] = *(const f32x4*)(X + (size_t)(row + 8) * DM + (lane + 64 * i) * 4); }
                float pl[16]; float ss = 0.f;
#pragma unroll
                for (int e = 0; e < 16; ++e) pl[e] = 0.f;
#pragma unroll
                for (int i = 0; i < 8; ++i) { ss += (x[i][0] * x[i][0] + x[i][1] * x[i][1]) + (x[i][2] * x[i][2] + x[i][3] * x[i][3]);
#pragma unroll
                    for (int j = 0; j < 4; ++j)
#pragma unroll
                        for (int q = 0; q < 4; ++q) { const f32x4 w4 = Wl[((i * 4 + j) * 4 + q) * 64 + lane]; const float xv = x[i][j];
                            pl[4 * q] += xv * w4[0]; pl[4 * q + 1] += xv * w4[1]; pl[4 * q + 2] += xv * w4[2]; pl[4 * q + 3] += xv * w4[3]; } }
                const float pt = treduce16(pl, lane);
                const float rstd = rsqrtf(wave_sum(ss, lane) * (1.f / DM) + EPS);
#pragma unroll
                for (int i = 0; i < 8; ++i) { const f32x4 h = x[i] * rstd * gsc[i] + sh[i]; u32x2 w2; w2.x = cvt_pk_bf16(h[0], h[1]); w2.y = cvt_pk_bf16(h[2], h[3]); *(u32x2*)(H + (size_t)row * DM + (lane + 64 * i) * 4) = w2; }
                const float logit = rstd * pt + bias_e;
                float mx = logit;
#pragma unroll
                for (int o = 4; o < 64; o <<= 1) mx = fmaxf(mx, shx(mx, lane, o));
                const float ex = expf(logit - mx); float s = ex;
#pragma unroll
                for (int o = 4; o < 64; o <<= 1) s += shx(s, lane, o);
                if ((lane & 3) == 0) AFFT[(size_t)ecode * MROWS + row] = ex / s;
            }
        }
    }
    __syncthreads();
}
__device__ __forceinline__ void row_phase_c(const Args& A, int l, int lane, int gw, int NGW) {
    unsigned char* ws = A.ws; bf16_t* P = (bf16_t*)(ws + WS_P); const float* r128 = (const float*)(ws + WS_ROPE128); const float* r64 = (const float*)(ws + WS_ROPE64);
    constexpr float QS128 = 0.08838834764831845f * LOG2E, QS64 = 0.125f * LOG2E;
    for (int job = gw; job < MROWS * 12; job += NGW) {
        const int row = job / 12, j = job % 12; const bool lat = row < NLAT; const int t = row & (SEQ - 1);
        bf16_t* p = P + (size_t)row * INW;
        if (j < 8) {
            const int hsel = lane >> 5, i = lane & 31; int col; const float* gain; float qs = 1.f;
            if (j == 0) { col = hsel * 128; gain = A.in[10] + l * 128; }
            else if (j == 1) { col = 1536 + hsel * 128; gain = A.in[19] + l * 128; }
            else if (j < 5) { col = 2048 + ((j - 2) * 2 + hsel) * 128; gain = A.in[9] + l * 128; qs = QS128; }
            else { col = 3328 + ((j - 5) * 2 + hsel) * 128; gain = A.in[18] + l * 128; qs = QS128; }
            float x0 = bf2f(p[col + i]), x1 = bf2f(p[col + i + 32]), x2 = bf2f(p[col + i + 64]), x3 = bf2f(p[col + i + 96]);
            float ss = x0 * x0 + x1 * x1 + x2 * x2 + x3 * x3;
#pragma unroll
            for (int o = 1; o < 32; o <<= 1) ss += shx(ss, lane, o);
            const float rstd = rsqrtf(ss * (1.f / 128.f) + EPS) * qs;
            x0 *= rstd * gain[i]; x1 *= rstd * gain[i + 32]; x2 *= rstd * gain[i + 64]; x3 *= rstd * gain[i + 96];
            if (lat) { const float* rp = r128 + (size_t)t * 128; const float cr = rp[2 * i], sr = rp[2 * i + 1], cc = rp[2 * (32 + i)], sc = rp[2 * (32 + i) + 1];
                const float y0 = x0 * cr - x1 * sr, y1 = x1 * cr + x0 * sr, y2 = x2 * cc - x3 * sc, y3 = x3 * cc + x2 * sc; x0 = y0; x1 = y1; x2 = y2; x3 = y3; }
            p[col + i] = (bf16_t)(cvt_pk_bf16(x0, 0.f) & 0xffffu); p[col + i + 32] = (bf16_t)(cvt_pk_bf16(x1, 0.f) & 0xffffu);
            p[col + i + 64] = (bf16_t)(cvt_pk_bf16(x2, 0.f) & 0xffffu); p[col + i + 96] = (bf16_t)(cvt_pk_bf16(x3, 0.f) & 0xffffu);
        } else {
            const int hsel = lane >> 4, i = lane & 15; int col; const float* gain; float qs = 1.f;
            if (j < 10) { col = 512 + ((j - 8) * 4 + hsel) * 64; gain = A.in[12] + l * 64; }
            else { col = 2816 + ((j - 10) * 4 + hsel) * 64; gain = A.in[11] + l * 64; qs = QS64; }
            float x0 = bf2f(p[col + i]), x1 = bf2f(p[col + i + 16]), x2 = bf2f(p[col + i + 32]), x3 = bf2f(p[col + i + 48]);
            float ss = x0 * x0 + x1 * x1 + x2 * x2 + x3 * x3;
#pragma unroll
            for (int o = 1; o < 16; o <<= 1) ss += shx(ss, lane, o);
            const float rstd = rsqrtf(ss * (1.f / 64.f) + EPS) * qs;
            x0 *= rstd * gain[i]; x1 *= rstd * gain[i + 16]; x2 *= rstd * gain[i + 32]; x3 *= rstd * gain[i + 48];
            if (lat) { const float* rp = r64 + (size_t)t * 64; const float cr = rp[2 * i], sr = rp[2 * i + 1], cc = rp[2 * (16 + i)], sc = rp[2 * (16 + i) + 1];
                const float y0 = x0 * cr - x1 * sr, y1 = x1 * cr + x0 * sr, y2 = x2 * cc - x3 * sc, y3 = x3 * cc + x2 * sc; x0 = y0; x1 = y1; x2 = y2; x3 = y3; }
            p[col + i] = (bf16_t)(cvt_pk_bf16(x0, 0.f) & 0xffffu); p[col + i + 16] = (bf16_t)(cvt_pk_bf16(x1, 0.f) & 0xffffu);
            p[col + i + 32] = (bf16_t)(cvt_pk_bf16(x2, 0.f) & 0xffffu); p[col + i + 48] = (bf16_t)(cvt_pk_bf16(x3, 0.f) & 0xffffu);
        }
    }
}
#ifndef RANK_GQ
#define RANK_GQ 4
#endif
__device__ __forceinline__ void rank_pair(const Args& A, LAS unsigned char* lds, int set, int e, int tok0, int ntok_here, int n, int cap, int tid, int wave, int lane) {
    unsigned char* ws = A.ws; const unsigned* AFFT = (const unsigned*)(ws + WS_AFFT); int* SEL = (int*)(ws + WS_SEL); float* GW = (float*)(ws + WS_GW);
    const bf16_t* H = (const bf16_t*)(ws + WS_H); bf16_t* XG = (bf16_t*)(ws + WS_XG);
    LAS unsigned* col = (LAS unsigned*)lds; LAS unsigned* list = (LAS unsigned*)(lds + 16384); LAS unsigned* wd = (LAS unsigned*)(lds + 20480);
    const int base = set < 2 ? set * SEQ : NLAT + (set - 2) * CTXL;
    __syncthreads();
    unsigned mv[8];
#pragma unroll
    for (int j = 0; j < 8; ++j) { const int i = tid + j * NTHR; const unsigned v = i < n ? AFFT[(size_t)e * MROWS + base + i] : 0u; mv[j] = v; if (i < n) col[i] = v; }
    if (tid == 0) wd[40] = 0u;
    unsigned T = 0u;
    for (int bit = 30; bit >= 0; --bit) {
        const unsigned cand = T | (1u << bit); unsigned c = 0u;
#pragma unroll
        for (int j = 0; j < 8; ++j) c += (unsigned)__popcll(__ballot(mv[j] >= cand));
        LAS unsigned* cw = wd + (bit & 1) * 8;
        if (lane == 0) cw[wave] = c;
        __syncthreads();
        unsigned tot = 0u;
#pragma unroll
        for (int w = 0; w < 8; ++w) tot += cw[w];
        if (tot >= (unsigned)cap) T = cand;
    }
    unsigned cg = 0u, pg = 0u, pe = 0u;
#pragma unroll
    for (int j = 0; j < 8; ++j) { const int i = tid + j * NTHR; cg += (unsigned)__popcll(__ballot(mv[j] > T)); pg += (unsigned)__popcll(__ballot(i < tok0 && mv[j] > T)); pe += (unsigned)__popcll(__ballot(i < tok0 && mv[j] == T)); }
    const int t = tok0 + tid; const bool have = tid < ntok_here; const unsigned mine = have ? col[t] : 0u;
    const bool isg = have && mine > T, isq = have && mine == T;
    const unsigned long long bg = __ballot(isg), bq = __ballot(isq); const unsigned long long lt = (1ull << lane) - 1ull;
    if (lane == 0) { wd[16 + wave] = cg; wd[24 + wave] = pg; wd[32 + wave] = pe; wd[48 + wave] = (unsigned)__popcll(bg); wd[56 + wave] = (unsigned)__popcll(bq); }
    __syncthreads();
    unsigned count_gt = 0u, base_gt = 0u, base_eq = 0u;
#pragma unroll
    for (int w = 0; w < 8; ++w) { count_gt += wd[16 + w]; base_gt += wd[24 + w]; base_eq += wd[32 + w]; if (w < wave) { base_gt += wd[48 + w]; base_eq += wd[56 + w]; } }
    const unsigned need_eq = (unsigned)cap - count_gt;
    const unsigned gt_before = base_gt + (unsigned)__popcll(bg & lt), eq_before = base_eq + (unsigned)__popcll(bq & lt);
    const bool chosen = isg || (isq && eq_before < need_eq);
    if (have) {
        int pos = -1;
        if (chosen) { const unsigned slot = gt_before + (eq_before < need_eq ? eq_before : need_eq); pos = set < 2 ? set * 512 + (int)slot : 1024 + (set - 2) * 32 + (int)slot; GW[e * EPAD + pos] = __uint_as_float(mine);
            const unsigned k = atomicAdd((unsigned*)(wd + 40), 1u); list[2 * k] = (unsigned)(base + t); list[2 * k + 1] = (unsigned)pos; }
        SEL[(size_t)(base + t) * 16 + e] = pos;
    }
    __syncthreads();
    const int nsel = (int)wd[40];
    constexpr int GQ = RANK_GQ;
    for (int k0 = wave; k0 < nsel; k0 += GQ * NWAVES) {
        u32x4 v[GQ][4]; unsigned pos[GQ]; bool ok[GQ];
#pragma unroll
        for (int q = 0; q < GQ; ++q) { const int k = k0 + q * NWAVES; ok[q] = k < nsel; const unsigned row = ok[q] ? list[2 * k] : 0u; pos[q] = ok[q] ? list[2 * k + 1] : 0u;
            const u32x4* src = (const u32x4*)(H + (size_t)row * DM);
            if (ok[q]) {
#pragma unroll
                for (int i = 0; i < 4; ++i) v[q][i] = FP8_EXPERTS ? src[lane * 4 + i] : src[lane + 64 * i]; } }
#pragma unroll
        for (int q = 0; q < GQ; ++q) { if (!ok[q]) continue;
            if (FP8_EXPERTS) { u32x4 o0, o1;
                o0.x = pk4_fp8(bf_lo(v[q][0].x), bf_hi(v[q][0].x), bf_lo(v[q][0].y), bf_hi(v[q][0].y)); o0.y = pk4_fp8(bf_lo(v[q][0].z), bf_hi(v[q][0].z), bf_lo(v[q][0].w), bf_hi(v[q][0].w));
                o0.z = pk4_fp8(bf_lo(v[q][1].x), bf_hi(v[q][1].x), bf_lo(v[q][1].y), bf_hi(v[q][1].y)); o0.w = pk4_fp8(bf_lo(v[q][1].z), bf_hi(v[q][1].z), bf_lo(v[q][1].w), bf_hi(v[q][1].w));
                o1.x = pk4_fp8(bf_lo(v[q][2].x), bf_hi(v[q][2].x), bf_lo(v[q][2].y), bf_hi(v[q][2].y)); o1.y = pk4_fp8(bf_lo(v[q][2].z), bf_hi(v[q][2].z), bf_lo(v[q][2].w), bf_hi(v[q][2].w));
                o1.z = pk4_fp8(bf_lo(v[q][3].x), bf_hi(v[q][3].x), bf_lo(v[q][3].y), bf_hi(v[q][3].y)); o1.w = pk4_fp8(bf_lo(v[q][3].z), bf_hi(v[q][3].z), bf_lo(v[q][3].w), bf_hi(v[q][3].w));
                u32x4* dst = (u32x4*)((unsigned char*)XG + ((size_t)e * EPAD + pos[q]) * DM); dst[lane * 2] = o0; dst[lane * 2 + 1] = o1; }
            else { u32x4* dst = (u32x4*)(XG + ((size_t)e * EPAD + pos[q]) * DM);
#pragma unroll
                for (int i = 0; i < 4; ++i) dst[lane + 64 * i] = v[q][i]; } }
    }
}
__device__ __forceinline__ void phase_rank(const Args& A, LAS unsigned char* lds, int l, int wg, int G, int tid, int wave, int lane) {
#ifndef RANK_XCD
#define RANK_XCD 0
#endif
#ifndef E_XCD
#define E_XCD 1
#endif
    if (RANK_XCD && E_XCD && G == 256) {
        const int x = wg & 7, k = wg >> 3; rank_pair(A, lds, k >> 4, 2 * x + ((k >> 3) & 1), (k & 7) * 512, 512, SEQ, 512, tid, wave, lane); }
    else
    for (int w = wg; w < 256; w += G) { const int pair = w >> 3, chunk = w & 7; rank_pair(A, lds, pair >> 4, pair & 15, chunk * 512, 512, SEQ, 512, tid, wave, lane); }
#ifndef RANK_CTX_SPLIT
#define RANK_CTX_SPLIT 0
#endif
    if (l == 0) {
        if (RANK_CTX_SPLIT) for (int w = wg; w < 256; w += G) rank_pair(A, lds, 2 + (w >> 7), (w >> 3) & 15, (w & 7) * 32, 32, CTXL, 32, tid, wave, lane);
        else for (int w = wg; w < 32; w += G) rank_pair(A, lds, 2 + (w >> 4), w & 15, 0, 256, CTXL, 32, tid, wave, lane); }
    __syncthreads();
}

#ifndef E_XCD
#define E_XCD 1
#endif
#ifndef IN_BLOCK
#define IN_BLOCK 0
#endif
#ifndef IN_XCD
#define IN_XCD 1
#endif
struct SchedIn { const char* A; const char* B; int G, c, l;
    __device__ __forceinline__ bool next(int i, pg8::GUnit& u) const { long L = (long)i * G + c; int pm, pn;
        if (!FP8_GATES) {
            if (l == 0) { if (!pg8::grid_order(L, 34, 40, pm, pn)) return false; }
            else { if (L < 1280) { pg8::grid_order(L, 32, 40, pm, pn); } else if (L < 1296) { const int r = (int)L - 1280; pm = 32 + (r >> 3); pn = r & 7; } else return false; }
        } else if (!FP8_AC) {
            if (l == 0) { if (!pg8::grid_order(L, 34, 16, pm, pn)) return false; }
            else { if (L < 512) { pg8::grid_order(L, 32, 16, pm, pn); } else if (L < 528) { const int r = (int)L - 512; pm = 32 + (r >> 3); pn = r & 7; } else return false; }
        } else {
            if (IN_BLOCK && G == 256 && (l == 1 || (CTX_CHAIN && CTX_GATES_IN_CHAIN))) {
                if (i > 0) return false; const int x = c & 7, k = c >> 3; int q6;
                if (k < 24) { pm = 4 * x + k / 6; q6 = k % 6; pn = q6 < 4 ? 2 + q6 : 7 + q6; }
                else { const int sidx = k - 24, nb = l == 0 ? (x < 4 ? 2 : 1) : 1; if (sidx >= nb) return false;
                    if (l == 0) { const int g = x < 4 ? 2 * x + sidx : 8 + (x - 4); pm = 32 + g / 6; q6 = g % 6; pn = q6 < 4 ? 2 + q6 : 7 + q6; }
                    else { pm = 32 + (x >> 2); pn = 2 + (x & 3); } }
                u.a = A + (size_t)pm * 256 * DM * 2; u.b = B + (size_t)pn * 256 * DM * 2; u.nt = DM / 64; u.pm = pm; u.pn = pn; u.aux = 0; return true; }
            if (IN_XCD && G == 256) L = (long)i * G + ((c & 7) * 32 + (c >> 3));
            const int nlat = (l == 0 ? 34 : 32) * 6;
            if (L < nlat) { const int q = (int)(L % 6); pm = (int)(L / 6); pn = q < 4 ? 2 + q : 7 + q; }
            else if (l == 1 && L < nlat + 8) { const int r = (int)L - nlat; pm = 32 + (r >> 2); pn = 2 + (r & 3); } else return false;
        }
        u.a = A + (size_t)pm * 256 * DM * 2; u.b = B + (size_t)pn * 256 * DM * 2; u.nt = DM / 64; u.pm = pm; u.pn = pn; u.aux = 0; return true; } };
struct SchedIn8 { const char* A; const char* B; int G, c, l;
    __device__ __forceinline__ bool next(int i, pg8::GUnit& u) const { long L; int pm, pn;
        if (!FP8_AC) { const int nM = l == 0 ? 34 : 32;
            if (G == 256) { const int lo = l == 0 ? 32 : 16, n2 = 256 - lo, hi0 = l == 0 ? 176 : 16, hi1 = l == 0 ? 256 : 32;
                if (i < 2) L = (long)i * 256 + c; else if (i == 2) { if (c < lo) return false; L = 512 + (c - lo); } else if (i == 3) { if (c < hi0 || c >= hi1) return false; L = 512 + n2 + (c - hi0); } else return false; }
            else L = (long)i * G + c;
            if (!pg8::grid_order(L, nM, 24, pm, pn)) return false; pn += 16;
        } else {
            constexpr bool CG = CTX_CHAIN && CTX_GATES_IN_CHAIN;
            if (IN_BLOCK && G == 256 && (l == 1 || CG)) {
                const int x = c & 7, k = c >> 3; int q;
                if (i < 4) { pm = 4 * x + (k >> 3); q = 8 * i + (k & 7); pn = q < 2 ? q : (q < 7 ? 4 + q : 6 + q); }
                else { const int sidx = k - 24, nb = l == 0 ? (x < 4 ? 2 : 1) : 1, nf = l == 0 ? (x < 4 ? 2 : 3) : 1;
                    if (sidx < nb || i > 5) return false; const int n = 2 * (sidx - nb) + (i - 4); if (n >= 8 + nf) return false;
                    if (n < 8) { pm = 4 * x + (n >> 1); pn = 38 + (n & 1); }
                    else { const int r = n - 8;
                        if (l == 0) { const int gf = x < 4 ? 2 * x + r : 8 + 3 * (x - 4) + r; pm = 32 + gf / 10; q = gf % 10; pn = q < 2 ? q : (q < 7 ? 4 + q : 6 + q); }
                        else { pm = 32 + (x >> 2); q = x & 3; pn = q < 2 ? q : 4 + q; } } }
                u.a = A + (size_t)pm * 256 * DM; u.b = B + (size_t)pn * 256 * DM; u.nt = DM / 128; u.pm = pm; u.pn = pn; u.aux = 0; return true; }
            const int ntot = l == 0 ? (CG ? 1108 : 1156) : 1096, nlat = l == 0 ? (CG ? 1088 : 1156) : 1088;
            if (G == 256) { int cnt, start; const int c = IN_XCD ? ((this->c & 7) * 32 + (this->c >> 3)) : this->c;
                if (l == 0 && CG) { if (c < 204) { cnt = 4; start = 4 * c; } else if (c < 236) { cnt = 6; start = 816 + 6 * (c - 204); } else { cnt = 5; start = 1008 + 5 * (c - 236); } }
                else if (l == 0) { if (c < 28) { cnt = 5; start = 5 * c; } else if (c < 204) { cnt = 4; start = 140 + 4 * (c - 28); } else { cnt = 6; start = 844 + 6 * (c - 204); } }
                else { if (c < 200) { cnt = 4; start = 4 * c; } else if (c < 240) { cnt = 5; start = 800 + 5 * (c - 200); } else { cnt = 6; start = 1000 + 6 * (c - 240); } }
                if (i >= cnt) return false; L = start + i; }
            else L = (long)i * G + c;
            if (L >= ntot) return false;
            if (L < nlat) { const int q = (int)(L % 34); pm = (int)(L / 34); pn = q < 2 ? q : (q < 7 ? 4 + q : 6 + q); }
            else if (l == 0) { const int r = (int)L - nlat; pm = 32 + r / 10; const int q = r % 10; pn = q < 2 ? q : (q < 7 ? 4 + q : 6 + q); }
            else { const int r = (int)L - nlat; pm = 32 + (r >> 2); const int q = r & 3; pn = q < 2 ? q : 4 + q; }
        }
        u.a = A + (size_t)pm * 256 * DM; u.b = B + (size_t)pn * 256 * DM; u.nt = DM / 128; u.pm = pm; u.pn = pn; u.aux = 0; return true; } };
struct EpiIn { static constexpr bool PERM = true, KEEPS = false, QSKIP = false; float gmul  ; bf16_t* P; LAS float* ssx; const float* r128; const float* r64; const float *kn_a, *kn_b, *kn_c, *qn_a, *qn_b, *qn_c;
    __device__ __forceinline__ void operator()(f32x4 (&acc)[2][2][4][2], const pg8::GUnit& u, int wr, int wc, int fr, int fq) const {
        const int row0 = u.pm * 256 + wr * 64 + fr, col0 = u.pn * 256 + wc * 32 + 8 * fq, pn = u.pn;
        int cls = 0; const float* gain = nullptr; float qs = 1.f;
        constexpr float QS128 = 0.08838834764831845f * LOG2E, QS64 = 0.125f * LOG2E;
        if (pn >= 16) cls = 1;
        else if (FUSE_QK) {
            if (pn == 0) { cls = 2; gain = kn_a; } else if (pn == 6) { cls = 2; gain = kn_c; } else if (pn >= 8 && pn <= 10) { cls = 2; gain = qn_a; qs = QS128; } else if (pn >= 13) { cls = 2; gain = qn_c; qs = QS128; }
            else if (pn == 2 || pn == 3) { cls = 3; gain = kn_b; } else if (pn == 11 || pn == 12) { cls = 3; gain = qn_b; qs = QS64; }
        }
        if (cls < 2) {
#pragma unroll
            for (int ai = 0; ai < 2; ++ai)
#pragma unroll
                for (int m = 0; m < 4; ++m) { bf16_t* rowp = P + (size_t)(row0 + ai * 128 + m * 16) * INW + col0;
#pragma unroll
                    for (int bj = 0; bj < 2; ++bj) { f32x4 v0 = acc[ai][bj][m][0] * gmul, v1 = acc[ai][bj][m][1] * gmul;
                        if (cls == 1) {
#pragma unroll
                            for (int j = 0; j < 4; ++j) { v0[j] = fast_sigmoid(v0[j]); v1[j] = fast_sigmoid(v1[j]); } }
                        u32x4 w; w.x = cvt_pk_bf16(v0[0], v0[1]); w.y = cvt_pk_bf16(v0[2], v0[3]); w.z = cvt_pk_bf16(v1[0], v1[1]); w.w = cvt_pk_bf16(v1[2], v1[3]);
                        *(u32x4*)(rowp + bj * 128) = w; } }
            return;
        }
        const int lane = fq * 16 + fr; const bool lat = u.pm < 32; const bool h128 = cls == 2;
        float ss[2][4][2];
#pragma unroll
        for (int ai = 0; ai < 2; ++ai)
#pragma unroll
            for (int m = 0; m < 4; ++m)
#pragma unroll
                for (int bj = 0; bj < 2; ++bj) { const f32x4 a = acc[ai][bj][m][0] * gmul, b = acc[ai][bj][m][1] * gmul;
                    float s = (a[0] * a[0] + a[1] * a[1]) + (a[2] * a[2] + a[3] * a[3]) + (b[0] * b[0] + b[1] * b[1]) + (b[2] * b[2] + b[3] * b[3]);
                    s = xsum32(xsum16(s)); ss[ai][m][bj] = s; }
        if (fq == 0) {
#pragma unroll
            for (int ai = 0; ai < 2; ++ai)
#pragma unroll
                for (int m = 0; m < 4; ++m)
#pragma unroll
                    for (int bj = 0; bj < 2; ++bj) ssx[(ai * 128 + wr * 64 + m * 16 + fr) * 8 + bj * 4 + wc] = ss[ai][m][bj]; }
        asm volatile("s_waitcnt lgkmcnt(0)" ::: "memory"); __builtin_amdgcn_s_barrier(); asm volatile("" ::: "memory");
        const int dimA = h128 ? ((wc >= 2 ? 64 : 0) + (wc & 1) * 16 + fq * 4) : ((wc & 1) * 32 + fq * 4);
        const int q0 = h128 ? ((wc >= 2 ? 32 : 0) + (wc & 1) * 16 + fq * 4) : ((wc & 1) * 16 + fq * 4);
        const f32x4 ga = *(const f32x4*)(gain + dimA), gb = *(const f32x4*)(gain + dimA + (h128 ? 32 : 16));
        const float inv_dh = h128 ? (1.f / 128.f) : (1.f / 64.f);
#pragma unroll
        for (int ai = 0; ai < 2; ++ai)
#pragma unroll
            for (int m = 0; m < 4; ++m) { const int rl = ai * 128 + wr * 64 + m * 16 + fr, row = u.pm * 256 + rl; bf16_t* rowp = P + (size_t)row * INW + col0;
                f32x4 cv = {1.f, 1.f, 1.f, 1.f}, sv = {0.f, 0.f, 0.f, 0.f};
                if (lat) { const float* rp = (h128 ? r128 + (size_t)(row & (SEQ - 1)) * 128 : r64 + (size_t)(row & (SEQ - 1)) * 64) + 2 * q0;
                    const f32x4 c01 = *(const f32x4*)rp, c23 = *(const f32x4*)(rp + 4); cv = (f32x4){c01[0], c01[2], c23[0], c23[2]}; sv = (f32x4){c01[1], c01[3], c23[1], c23[3]}; }
#pragma unroll
                for (int bj = 0; bj < 2; ++bj) { const f32x4 p4 = *(const LAS f32x4*)(ssx + rl * 8 + bj * 4);
                    const float tot = h128 ? (p4[0] + p4[1]) + (p4[2] + p4[3]) : (wc < 2 ? p4[0] + p4[1] : p4[2] + p4[3]);
                    const float rstd = rsqrtf(tot * inv_dh + EPS) * qs * gmul;
                    const f32x4 xa = acc[ai][bj][m][0] * rstd * ga, xb = acc[ai][bj][m][1] * rstd * gb;
                    const f32x4 ya = xa * cv - xb * sv, yb = xb * cv + xa * sv;
                    u32x4 w; w.x = cvt_pk_bf16(ya[0], ya[1]); w.y = cvt_pk_bf16(ya[2], ya[3]); w.z = cvt_pk_bf16(yb[0], yb[1]); w.w = cvt_pk_bf16(yb[2], yb[3]);
                    *(u32x4*)(rowp + bj * 128) = w; } }
    } };
struct SchedBr { const char* A; const char* B; const char* A8; const char* B8; int G, c, ntiles_m;
    __device__ __forceinline__ bool next(int i, pg8::GUnit& u) const { const int s = i % 3; const long L = (long)(i / 3) * G + c; int pm, pn; if (!pg8::grid_order(L, ntiles_m, 8, pm, pn)) return false;
        const int koff = s == 0 ? 0 : (s == 1 ? 768 : 1280); u.pm = pm; u.pn = pn; u.aux = s;
        if (FP8_BR && s != 1) { u.a = A8 + (size_t)pm * 256 * DM + koff; u.b = B8 + (size_t)pn * 256 * DM + koff; u.nt = 6; u.f8 = 1; }
        else { u.a = A + ((size_t)pm * 256 * DM + koff) * 2; u.b = B + ((size_t)pn * 256 * DM + koff) * 2; u.nt = s == 1 ? 8 : 12; u.f8 = 0; }
        return true; } };
struct EpiBr { static constexpr bool PERM = true, KEEPS = true, QSKIP = false; const bf16_t* P; bf16_t* MM;
    __device__ __forceinline__ bool keep(const pg8::GUnit& u) const { return u.aux < 2; }
    __device__ __forceinline__ void operator()(f32x4 (&acc)[2][2][4][2], const pg8::GUnit& u, int wr, int wc, int fr, int fq) const {
        const int row0 = u.pm * 256 + wr * 64 + fr, col0 = u.pn * 256 + wc * 32 + 8 * fq, s = u.aux;
#pragma unroll
        for (int ai = 0; ai < 2; ++ai)
#pragma unroll
            for (int m = 0; m < 4; ++m) { const size_t row = (size_t)(row0 + ai * 128 + m * 16); const bf16_t* gp = P + row * INW + 4096 + s * 2048 + col0; bf16_t* mp = MM + row * DM + col0;
#pragma unroll
                for (int bj = 0; bj < 2; ++bj) { const u32x4 g = *(const u32x4*)(gp + bj * 128);
                    f32x4 g0 = {bf_lo(g.x), bf_hi(g.x), bf_lo(g.y), bf_hi(g.y)}, g1 = {bf_lo(g.z), bf_hi(g.z), bf_lo(g.w), bf_hi(g.w)};
                    if (s < 2) { const u32x4 h = *(const u32x4*)(gp + 2048 + bj * 128);
                        const f32x4 h0 = {bf_lo(h.x), bf_hi(h.x), bf_lo(h.y), bf_hi(h.y)}, h1 = {bf_lo(h.z), bf_hi(h.z), bf_lo(h.w), bf_hi(h.w)};
                        const float bs = 1.f;
#pragma unroll
                        for (int j = 0; j < 4; ++j) { g0[j] *= bs * __builtin_amdgcn_rcpf(fmaxf(h0[j], 1e-20f)); g1[j] *= bs * __builtin_amdgcn_rcpf(fmaxf(h1[j], 1e-20f)); }
                        acc[ai][bj][m][0] = acc[ai][bj][m][0] * g0; acc[ai][bj][m][1] = acc[ai][bj][m][1] * g1; }
                    else { constexpr float fs = 1.f; const f32x4 v0 = acc[ai][bj][m][0] * g0 * fs, v1 = acc[ai][bj][m][1] * g1 * fs;
                        if (FP8_OUT) { u32x2 w; w.x = pk4_fp8(v0[0], v0[1], v0[2], v0[3]); w.y = pk4_fp8(v1[0], v1[1], v1[2], v1[3]); *(u32x2*)((unsigned char*)MM + row * DM + col0 + bj * 128) = w; }
                        else { u32x4 w; w.x = cvt_pk_bf16(v0[0], v0[1]); w.y = cvt_pk_bf16(v0[2], v0[3]); w.z = cvt_pk_bf16(v1[0], v1[1]); w.w = cvt_pk_bf16(v1[2], v1[3]);
                        *(u32x4*)(mp + bj * 128) = w; } } } }
    } };
struct SchedBrAC { const char* A8; const char* B8; int G, c, ntiles_m;
    __device__ __forceinline__ bool next(int i, pg8::GUnit& u) const { const int s = (i & 1) * 2; const long L = (long)(i >> 1) * G + c; int pm, pn; if (!pg8::grid_order(L, ntiles_m, 8, pm, pn)) return false;
        const int koff = s == 0 ? 0 : 1280; u.a = A8 + (size_t)pm * 256 * DM + koff; u.b = B8 + (size_t)pn * 256 * DM + koff; u.nt = 6; u.pm = pm; u.pn = pn; u.aux = s; u.f8 = 1; return true; } };
struct SchedBrB { const char* A; const char* B; int G, c, ntiles_m;
    __device__ __forceinline__ bool next(int i, pg8::GUnit& u) const { const long L = (long)i * G + c; int pm, pn; if (!pg8::grid_order(L, ntiles_m, 8, pm, pn)) return false;
        u.a = A + ((size_t)pm * 256 * DM + 768) * 2; u.b = B + ((size_t)pn * 256 * DM + 768) * 2; u.nt = 8; u.pm = pm; u.pn = pn; u.aux = 1; u.f8 = 0; return true; } };
struct SchedOneBrAC { const char* A8; const char* B8; int pm, pn;
    __device__ __forceinline__ bool next(int i, pg8::GUnit& u) const { if (i >= 2) return false; const int s = i * 2, koff = s == 0 ? 0 : 1280;
        u.a = A8 + (size_t)pm * 256 * DM + koff; u.b = B8 + (size_t)pn * 256 * DM + koff; u.nt = 6; u.pm = pm; u.pn = pn; u.aux = s; u.f8 = 1; return true; } };
struct SchedOneBrB { const char* A; const char* B; int pm, pn;
    __device__ __forceinline__ bool next(int i, pg8::GUnit& u) const { if (i >= 1) return false;
        u.a = A + ((size_t)pm * 256 * DM + 768) * 2; u.b = B + ((size_t)pn * 256 * DM + 768) * 2; u.nt = 8; u.pm = pm; u.pn = pn; u.aux = 1; u.f8 = 0; return true; } };
struct EpiBrAC { static constexpr bool PERM = true, KEEPS = true, QSKIP = false; const bf16_t* P; bf16_t* MM;
    __device__ __forceinline__ bool keep(const pg8::GUnit& u) const { return u.aux == 0; }
    __device__ __forceinline__ void operator()(f32x4 (&acc)[2][2][4][2], const pg8::GUnit& u, int wr, int wc, int fr, int fq) const {
        const int row0 = u.pm * 256 + wr * 64 + fr, col0 = u.pn * 256 + wc * 32 + 8 * fq, s = u.aux;
#pragma unroll
        for (int ai = 0; ai < 2; ++ai)
#pragma unroll
            for (int m = 0; m < 4; ++m) { const size_t row = (size_t)(row0 + ai * 128 + m * 16); const bf16_t* gp = P + row * INW + 4096 + col0; bf16_t* mp = MM + row * DM + col0;
#pragma unroll
                for (int bj = 0; bj < 2; ++bj) { const u32x4 gc = *(const u32x4*)(gp + 2 * 2048 + bj * 128);
                    f32x4 c0 = {bf_lo(gc.x), bf_hi(gc.x), bf_lo(gc.y), bf_hi(gc.y)}, c1 = {bf_lo(gc.z), bf_hi(gc.z), bf_lo(gc.w), bf_hi(gc.w)};
                    if (s == 0) { const u32x4 ga = *(const u32x4*)(gp + bj * 128);
                        const f32x4 a0 = {bf_lo(ga.x), bf_hi(ga.x), bf_lo(ga.y), bf_hi(ga.y)}, a1 = {bf_lo(ga.z), bf_hi(ga.z), bf_lo(ga.w), bf_hi(ga.w)};
#pragma unroll
                        for (int j = 0; j < 4; ++j) { c0[j] = a0[j] * __builtin_amdgcn_rcpf(fmaxf(c0[j], 1e-20f)); c1[j] = a1[j] * __builtin_amdgcn_rcpf(fmaxf(c1[j], 1e-20f)); }
                        acc[ai][bj][m][0] = acc[ai][bj][m][0] * c0; acc[ai][bj][m][1] = acc[ai][bj][m][1] * c1; }
                    else { const f32x4 v0 = acc[ai][bj][m][0] * c0 * (1.f / 64.f), v1 = acc[ai][bj][m][1] * c1 * (1.f / 64.f); u32x4 w;
                        w.x = cvt_pk_bf16(v0[0], v0[1]); w.y = cvt_pk_bf16(v0[2], v0[3]); w.z = cvt_pk_bf16(v1[0], v1[1]); w.w = cvt_pk_bf16(v1[2], v1[3]);
                        *(u32x4*)(mp + bj * 128) = w; } } }
    } };
struct EpiBrB { static constexpr bool PERM = true, KEEPS = false, QSKIP = false; const bf16_t* P; bf16_t* MM;
    __device__ __forceinline__ void operator()(f32x4 (&acc)[2][2][4][2], const pg8::GUnit& u, int wr, int wc, int fr, int fq) const {
        const int row0 = u.pm * 256 + wr * 64 + fr, col0 = u.pn * 256 + wc * 32 + 8 * fq;
#pragma unroll
        for (int ai = 0; ai < 2; ++ai)
#pragma unroll
            for (int m = 0; m < 4; ++m) { const size_t row = (size_t)(row0 + ai * 128 + m * 16); const bf16_t* gp = P + row * INW + 4096 + 2048 + col0; bf16_t* mp = MM + row * DM + col0;
#pragma unroll
                for (int bj = 0; bj < 2; ++bj) { const u32x4 g = *(const u32x4*)(gp + bj * 128); const u32x4 pv = *(const u32x4*)(mp + bj * 128);
                    const f32x4 v0 = acc[ai][bj][m][0], v1 = acc[ai][bj][m][1]; u32x4 w;
                    w.x = cvt_pk_bf16(bf_lo(pv.x) + bf_lo(g.x) * v0[0], bf_hi(pv.x) + bf_hi(g.x) * v0[1]); w.y = cvt_pk_bf16(bf_lo(pv.y) + bf_lo(g.y) * v0[2], bf_hi(pv.y) + bf_hi(g.y) * v0[3]);
                    w.z = cvt_pk_bf16(bf_lo(pv.z) + bf_lo(g.z) * v1[0], bf_hi(pv.z) + bf_hi(g.z) * v1[1]); w.w = cvt_pk_bf16(bf_lo(pv.w) + bf_lo(g.w) * v1[2], bf_hi(pv.w) + bf_hi(g.w) * v1[3]);
                    *(u32x4*)(mp + bj * 128) = w; } }
    } };
struct SchedOut { const char* A; const char* B; int G, c, ntiles_m;
    __device__ __forceinline__ bool next(int i, pg8::GUnit& u) const { const long L = (long)i * G + c; int pm, pn; if (!pg8::grid_order(L, ntiles_m, 8, pm, pn)) return false;
        constexpr int OS = FP8_OUT ? 1 : 2; u.a = A + (size_t)pm * 256 * DM * OS; u.b = B + (size_t)pn * 256 * DM * OS; u.nt = DM * OS / 128; u.pm = pm; u.pn = pn; u.aux = 0; return true; } };
struct EpiOut { static constexpr bool PERM = false, KEEPS = false, QSKIP = false; const float* base_lat; const float* base_ctx; float* X; const float* g1;
    __device__ __forceinline__ void operator()(f32x4 (&acc)[2][2][4][2], const pg8::GUnit& u, int wr, int wc, int fr, int fq) const {
        const int row0 = u.pm * 256 + wr * 64 + fr, col0 = u.pn * 256 + wc * 32 + 4 * fq; const float* gv = g1 + (size_t)(u.pm < 16 ? 0 : (u.pm < 32 ? 1 : 2)) * MODW + col0;
        f32x4 g[2][2];
#pragma unroll
        for (int bj = 0; bj < 2; ++bj)
#pragma unroll
            for (int n = 0; n < 2; ++n) g[bj][n] = *(const f32x4*)(gv + bj * 128 + n * 16);
#pragma unroll
        for (int ai = 0; ai < 2; ++ai)
#pragma unroll
            for (int m = 0; m < 4; ++m) { const int row = row0 + ai * 128 + m * 16; const float* bp = (u.pm < 32 ? base_lat + (size_t)row * DM : base_ctx + (size_t)(row - NLAT) * DM) + col0; float* xp = X + (size_t)row * DM + col0;
#pragma unroll
                for (int bj = 0; bj < 2; ++bj)
#pragma unroll
                    for (int n = 0; n < 2; ++n) { const f32x4 b = *(const f32x4*)(bp + bj * 128 + n * 16); *(f32x4*)(xp + bj * 128 + n * 16) = b + g[bj][n] * (acc[ai][bj][m][n] * (FP8_OUT ? (1.f / 64.f) : 1.f)); }
                asm volatile("" ::: "memory"); }
    } };
struct SchedE1 { const char* A; const char* B; int G, c, nrt;
    __device__ __forceinline__ bool next(int i, pg8::GUnit& u) const { int pn, e, rt;
        if (E_XCD && G == 256) {
            const int x = c & 7, k = c >> 3, ui = i * 32 + k, per = nrt * 8; if (ui >= 2 * per) return false;
            e = 2 * x + ui / per; const int rem = ui % per; rt = rem >> 3; pn = rem & 7;
        } else { const long L = (long)i * G + c; if (L >= (long)16 * nrt * 8) return false;
            pn = (int)(L & 7); const int er = (int)(L >> 3); e = er / nrt; rt = er % nrt; }
        constexpr int ES = FP8_EXPERTS ? 1 : 2; u.a = A + ((size_t)e * EPAD + rt * 256) * DM * ES; u.b = B + ((size_t)e * 2048 + pn * 256) * DM * ES; u.nt = DM * ES / 128; u.pm = rt; u.pn = pn; u.aux = e; u.q = rt == 4; return true; } };
struct EpiE1 { static constexpr bool PERM = true, KEEPS = false, QSKIP = true; bf16_t* ACT; int nrows;
    __device__ __forceinline__ void operator()(f32x4 (&acc)[2][2][4][2], const pg8::GUnit& u, int wr, int wc, int fr, int fq) const {
        const int row0 = u.pm * 256 + wr * 64 + fr, col0 = u.pn * 128 + wc * 32 + 8 * fq;
#pragma unroll
        for (int ai = 0; ai < 2; ++ai)
#pragma unroll
            for (int m = 0; m < 4; ++m) { const int row = row0 + ai * 128 + m * 16; if (row >= nrows) continue;
                constexpr float WS = FP8_EXPERTS ? (1.f / 64.f) : 1.f;
                const f32x4 g0 = acc[ai][0][m][0] * WS, g1 = acc[ai][0][m][1] * WS, u0 = acc[ai][1][m][0] * WS, u1 = acc[ai][1][m][1] * WS; f32x4 a0, a1;
#pragma unroll
                for (int j = 0; j < 4; ++j) { a0[j] = g0[j] * fast_sigmoid(g0[j]) * u0[j]; a1[j] = g1[j] * fast_sigmoid(g1[j]) * u1[j]; }
                if (FP8_EXPERTS) { u32x2 w; w.x = pk4_fp8(a0[0], a0[1], a0[2], a0[3]); w.y = pk4_fp8(a1[0], a1[1], a1[2], a1[3]); *(u32x2*)((unsigned char*)ACT + ((size_t)u.aux * EPAD + row) * FF + col0) = w; }
                else { u32x4 w; w.x = cvt_pk_bf16(a0[0], a0[1]); w.y = cvt_pk_bf16(a0[2], a0[3]); w.z = cvt_pk_bf16(a1[0], a1[1]); w.w = cvt_pk_bf16(a1[2], a1[3]);
                *(u32x4*)(ACT + ((size_t)u.aux * EPAD + row) * FF + col0) = w; } }
    } };
struct SchedE2 { const char* A; const char* B; int G, c, nrt;
    __device__ __forceinline__ bool next(int i, pg8::GUnit& u) const { int pn, e, rt;
        if (E_XCD && G == 256) {
            const int x = c & 7, k = c >> 3, ui = i * 32 + k, per = nrt * 8; if (ui >= 2 * per) return false;
            e = 2 * x + ui / per; const int rem = ui % per; rt = rem >> 3; pn = rem & 7;
        } else { const long L = (long)i * G + c; if (L >= (long)16 * nrt * 8) return false;
            pn = (int)(L & 7); const int er = (int)(L >> 3); e = er / nrt; rt = er % nrt; }
        constexpr int ES = FP8_EXPERTS ? 1 : 2; u.a = A + ((size_t)e * EPAD + rt * 256) * FF * ES; u.b = B + ((size_t)e * 2048 + pn * 256) * FF * ES; u.nt = FF * ES / 128; u.pm = rt; u.pn = pn; u.aux = e; u.q = rt == 4; return true; } };
struct EpiE2 { static constexpr bool PERM = true, KEEPS = false, QSKIP = true; bf16_t* Y; const float* GW; int nrows;
    __device__ __forceinline__ void operator()(f32x4 (&acc)[2][2][4][2], const pg8::GUnit& u, int wr, int wc, int fr, int fq) const {
        const int row0 = u.pm * 256 + wr * 64 + fr, col0 = u.pn * 256 + wc * 32 + 8 * fq;
#pragma unroll
        for (int ai = 0; ai < 2; ++ai)
#pragma unroll
            for (int m = 0; m < 4; ++m) { const int row = row0 + ai * 128 + m * 16; if (row >= nrows) continue; const float gw = GW[u.aux * EPAD + row] * (FP8_EXPERTS ? (1.f / 64.f) : 1.f);
                bf16_t* yp = Y + ((size_t)u.aux * EROWS + row) * DM + col0;
#pragma unroll
                for (int bj = 0; bj < 2; ++bj) { const f32x4 v0 = acc[ai][bj][m][0] * gw, v1 = acc[ai][bj][m][1] * gw;
                    u32x4 w; w.x = cvt_pk_bf16(v0[0], v0[1]); w.y = cvt_pk_bf16(v0[2], v0[3]); w.z = cvt_pk_bf16(v1[0], v1[1]); w.w = cvt_pk_bf16(v1[2], v1[3]);
                    *(u32x4*)(yp + bj * 128) = w; } }
    } };

template <int KIND> __device__ __forceinline__ void attn_decode(int idx, bool ctx, att::AUnit& u, const float* sink_l) {
    u.dpos = 0; u.sink2 = 0.f;
    if (KIND == 0) {
        if (!ctx) { const int b = idx / 96, r = idx % 96, h = r / 16, qb = r % 16;
            u.qrow0 = b * SEQ + qb * 256; u.qcol = 2048 + h * 128; u.kcol = (h / 3) * 128; u.vcol = 256 + (h / 3) * 128; u.ocol = h * 128; u.nlat_t = 64; u.lat_row0 = b * SEQ; u.ctx_row0 = NLAT + b * CTXL; }
        else { const int b = idx / 6, h = idx % 6;
            u.qrow0 = NLAT + b * CTXL; u.qcol = 2048 + h * 128; u.kcol = (h / 3) * 128; u.vcol = 256 + (h / 3) * 128; u.ocol = h * 128; u.nlat_t = 0; u.lat_row0 = 0; u.ctx_row0 = NLAT + b * CTXL; }
    } else if (KIND == 1) {
        if (!ctx) { const int b = idx / 128, r = idx % 128, h = r / 32, qb = r % 32;
            u.qrow0 = b * SEQ + qb * 128; u.qcol = 2816 + h * 128; u.kcol = 512 + h * 128; u.vcol = 1024 + h * 128; u.ocol = 768 + h * 128; u.nlat_t = 64; u.lat_row0 = b * SEQ; u.ctx_row0 = NLAT + b * CTXL; }
        else { const int b = idx / 8, r = idx % 8, h = r / 2, qb = r % 2;
            u.qrow0 = NLAT + b * CTXL + qb * 128; u.qcol = 2816 + h * 128; u.kcol = 512 + h * 128; u.vcol = 1024 + h * 128; u.ocol = 768 + h * 128; u.nlat_t = 0; u.lat_row0 = 0; u.ctx_row0 = NLAT + b * CTXL; }
    } else {
        if (!ctx) { const int b = idx / 96, r = idx % 96, h = r / 16, qb = r % 16; const int t0 = qb * 256; const int lo = t0 - 128 < 0 ? 0 : t0 - 128, hi = t0 + 384 > SEQ ? SEQ : t0 + 384;
            u.qrow0 = b * SEQ + t0; u.qcol = 3328 + h * 128; u.kcol = 1536 + (h / 3) * 128; u.vcol = 1792 + (h / 3) * 128; u.ocol = 1280 + h * 128; u.nlat_t = (hi - lo) / 64; u.lat_row0 = b * SEQ + lo; u.ctx_row0 = NLAT + b * CTXL;
            u.dpos = lo - t0; u.sink2 = sink_l[h] * LOG2E; }
        else { const int b = idx / 6, h = idx % 6;
            u.qrow0 = NLAT + b * CTXL; u.qcol = 3328 + h * 128; u.kcol = 1536 + (h / 3) * 128; u.vcol = 1792 + (h / 3) * 128; u.ocol = 1280 + h * 128; u.nlat_t = 0; u.lat_row0 = 0; u.ctx_row0 = NLAT + b * CTXL; u.sink2 = sink_l[h] * LOG2E; }
    }
}
__device__ __forceinline__ void publish_inc(unsigned* ctr, int tid) {
    asm volatile("s_waitcnt vmcnt(0)" ::: "memory"); __syncthreads();
    if (tid == 0) { __builtin_amdgcn_fence(__ATOMIC_RELEASE, "agent"); asm volatile("s_waitcnt vmcnt(0)" ::: "memory"); (void)xb_add(ctr, 1u); }
}
__device__ __forceinline__ void wait_ge(unsigned* ctr, unsigned want, int tid) {
    if (tid == 0) { unsigned sp = 0u; while (xb_ld(ctr) < want) { __builtin_amdgcn_s_sleep(2); if (++sp > (1u << 20)) break; }
        __builtin_amdgcn_fence(__ATOMIC_ACQUIRE, "agent"); asm volatile("s_waitcnt vmcnt(0)" ::: "memory"); }
    __syncthreads();
}
__device__ __forceinline__ void router_tile(const Args& A, int l, int pm, int pn, unsigned* pctr) {
    int tz = threadIdx.x; asm volatile("" : "+v"(tz)); const int tid = tz, lane = tz & 63, wave = __builtin_amdgcn_readfirstlane(tz >> 6);
    unsigned char* ws = A.ws; const float* X = (const float*)(ws + WS_X); bf16_t* H = (bf16_t*)(ws + WS_H); float* AFFT = (float*)(ws + WS_AFFT); float* XCH = (float*)(ws + WS_XCH);
    const int mr = pm < 16 ? 0 : (pm < 32 ? 1 : 2);
    const float* mv = (const float*)(ws + WS_MODV) + (size_t)(l * 3 + mr) * MODW; const float* wr = A.in[25] + (size_t)l * DM * 16; const float* gain = A.in[7] + l * DM;
    const float* biasr = (const float*)(ws + WS_BIASR) + (l * 3 + mr) * 16;
    if (tid == 0) { __builtin_amdgcn_fence(__ATOMIC_ACQUIRE, "agent"); asm volatile("s_waitcnt vmcnt(0)" ::: "memory"); }
    __syncthreads();
    const int c0 = pn * 256 + 4 * lane, row0 = pm * 256 + wave * 32;
    f32x4 gsc, sh; { const f32x4 g4 = *(const f32x4*)(gain + c0), sc4 = *(const f32x4*)(mv + 4 * DM + c0); gsc = g4 * (sc4 + 1.f); sh = *(const f32x4*)(mv + 3 * DM + c0); }
    f32x4 x[32];
#pragma unroll
    for (int i = 0; i < 32; ++i) x[i] = *(const f32x4*)(X + (size_t)(row0 + i) * DM + c0);
    {   float Wl[4][16];
#pragma unroll
        for (int j = 0; j < 4; ++j)
#pragma unroll
            for (int q = 0; q < 4; ++q) { const f32x4 w4 = *(const f32x4*)(wr + (size_t)(c0 + j) * 16 + 4 * q);
#pragma unroll
                for (int t = 0; t < 4; ++t) Wl[j][4 * q + t] = gsc[j] * w4[t]; }
#pragma unroll
        for (int i = 0; i < 32; ++i) { float pl[16];
#pragma unroll
            for (int e = 0; e < 16; ++e) pl[e] = x[i][0] * Wl[0][e] + x[i][1] * Wl[1][e] + x[i][2] * Wl[2][e] + x[i][3] * Wl[3][e];
            const float pt = treduce16(pl, lane);
            const float ss = wave_sum((x[i][0] * x[i][0] + x[i][1] * x[i][1]) + (x[i][2] * x[i][2] + x[i][3] * x[i][3]), lane);
            float* slot = XCH + ((size_t)(row0 + i) * 8 + pn) * 20;
            if ((lane & 3) == 0) slot[lane >> 2] = pt;
            if (lane == 0) slot[16] = ss; }
    }
    publish_inc(pctr, tid);
    wait_ge(pctr, 8u, tid);
    const float bias = lane < 16 ? biasr[lane] : 0.f;
#pragma unroll
    for (int i0 = 0; i0 < 32; i0 += 8) { float part[8];
#pragma unroll
        for (int i = 0; i < 8; ++i) { const int row = row0 + i0 + i; float s = 0.f;
            if (lane < 17) {
#pragma unroll
                for (int q = 0; q < 8; ++q) s += XCH[((size_t)row * 8 + q) * 20 + lane]; }
            part[i] = s; }
#pragma unroll
        for (int i = 0; i < 8; ++i) { const int row = row0 + i0 + i;
            const float sst = __uint_as_float((unsigned)__builtin_amdgcn_readlane((int)__float_as_uint(part[i]), 16));
            const float rstd = rsqrtf(sst * (1.f / DM) + EPS);
            { const f32x4 h = x[i0 + i] * rstd * gsc + sh; u32x2 w2; w2.x = cvt_pk_bf16(h[0], h[1]); w2.y = cvt_pk_bf16(h[2], h[3]); *(u32x2*)(H + (size_t)row * DM + c0) = w2; }
            if (pn == 0) {
                const float logit = lane < 16 ? rstd * part[i] + bias : -3.0e38f; const float mx = row_max16(logit);
                const float ex = lane < 16 ? expf(logit - mx) : 0.f; const float s = row_sum16(ex);
                if (lane < 16) AFFT[(size_t)lane * MROWS + row] = ex / s; } }
    }
}
struct SchedOneBr { const char* A; const char* B; const char* A8; const char* B8; int pm, pn;
    __device__ __forceinline__ bool next(int i, pg8::GUnit& u) const { if (i >= 3) return false; const int s = i, koff = s == 0 ? 0 : (s == 1 ? 768 : 1280); u.pm = pm; u.pn = pn; u.aux = s;
        if (FP8_BR && s != 1) { u.a = A8 + (size_t)pm * 256 * DM + koff; u.b = B8 + (size_t)pn * 256 * DM + koff; u.nt = 6; u.f8 = 1; }
        else { u.a = A + ((size_t)pm * 256 * DM + koff) * 2; u.b = B + ((size_t)pn * 256 * DM + koff) * 2; u.nt = s == 1 ? 8 : 12; u.f8 = 0; }
        return true; } };
struct SchedGate3 { const char* A; const char* B; int pm, pn;
    __device__ __forceinline__ bool next(int i, pg8::GUnit& u) const { if (i >= 3) return false; const int gp = 16 + 8 * i + pn;
        u.a = A + (size_t)pm * 256 * DM; u.b = B + (size_t)gp * 256 * DM; u.nt = DM / 128; u.pm = pm; u.pn = gp; u.aux = 0; return true; } };
struct SchedOneOut { const char* A; const char* B; int pm, pn;
    __device__ __forceinline__ bool next(int i, pg8::GUnit& u) const { if (i >= 1) return false; constexpr int OS = FP8_OUT ? 1 : 2;
        u.a = A + (size_t)pm * 256 * DM * OS; u.b = B + (size_t)pn * 256 * DM * OS; u.nt = DM * OS / 128; u.pm = pm; u.pn = pn; u.aux = 0; return true; } };

constexpr int N_PHASES = 22;
__global__ void __launch_bounds__(NTHR, 2) mega(Args args) {
    extern __shared__ __attribute__((aligned(16))) unsigned char lds_raw[];
    LAS unsigned char* lds = (LAS unsigned char*)lds_raw;
    const int G = gridDim.x, wg = blockIdx.x, NGW = G * NWAVES;
    unsigned char* ws = args.ws; unsigned* ctl = (unsigned*)(ws + WS_CTL);
    volatile LAS unsigned* MISC = (volatile LAS unsigned*)(lds + MISC_OFF);
    if (threadIdx.x < 32) MISC[threadIdx.x] = 0u;
    __syncthreads();
    const int lo = args.ph_lo, hi = args.ph_hi; const bool multi = (hi - lo) > 1;
    const bool fuse_router = FUSE_ROUTER && CTX_CHAIN && G == 256;
    XcdBarrier bar; bar.bar = ctl + CW_BAR; bar.x = 0; bar.st = nullptr;
    if (multi) bar = xcd_barrier_post(ctl + CW_BAR, MISC + 8);
#ifndef PH_MASK
#define PH_MASK 0xffffffffu
#endif
#define PHON(b) ((PH_MASK >> (b)) & 1u)
#ifndef REP_MASK
#define REP_MASK 0u
#endif
#define REPEAT(b) _Pragma("unroll 1") for (int rep = 0; rep < ((((REP_MASK >> (b)) & 1u) && ((b) != 6 || l == 0)) ? 2 : 1); ++rep)
#define REPBAR() do { if (rep && multi) xcd_barrier(bar); } while (0)
#define IN(k) (lo <= (k) && (k) < hi)
#define HIDE_TID() int tz = threadIdx.x; asm volatile("" : "+v"(tz)); const int tid = tz, lane = tz & 63, wave = __builtin_amdgcn_readfirstlane(tz >> 6), gw = wg * NWAVES + wave; (void)tid; (void)lane; (void)wave; (void)gw
#define SEAM(k) do { if (IN(k) && IN((k) + 1)) xcd_barrier(bar); } while (0)
#define SEAM_BG(k, force_upto) do { if (IN(k) && IN((k) + 1)) { if (BG_CONV && multi) bg_loop(args, lds, ctl, MISC, (k), (force_upto), G); xcd_barrier(bar); } } while (0)
    if (PHON(0) && IN(0)) _Pragma("unroll 1") for (int rep = 0; rep < ((REP_MASK & 1u) ? 2 : 1); ++rep) { REPBAR(); HIDE_TID();
#ifndef P0_PROBE
#define P0_PROBE 0
#endif
        if (!(P0_PROBE == 1 && rep == 0 && (REP_MASK & 1u))) p0_modv(args, lds, tid, lane, wave, wg, G, 0, (MODV1_IN_ATT && CONV_IN_ATT == 2 && P0_DYN && multi && !BG_CONV) ? 96 : 2 * 96);
#ifndef P0_DYN
#define P0_DYN 1
#endif
        if (!(P0_PROBE == 2 && rep == 0 && (REP_MASK & 1u))) {
#ifndef CONV_PIPE
#define CONV_PIPE 1
#endif
#ifndef CONV_IN_ATT
#define CONV_IN_ATT 2
#endif
#ifndef CONV_SEL
#define CONV_SEL(wg) ((((wg) >> 3) & 3) == 3)
#endif
            if (P0_DYN && multi && !BG_CONV) { p0_convert_dyn(args, lds, ctl + CW_BGQ + 64 + 64 * rep, MISC, tid, wave, lane, CONV_IN_ATT == 2 ? CV_D1 : (CONV_IN_ATT ? CV_PER_L : 2 * CV_PER_L)); p0_prologue(args, lds, wave, lane, gw, NGW, 0); }
            else p0_prologue(args, lds, wave, lane, gw, NGW, (BG_CONV && multi) ? CV_PER_L : 2 * CV_PER_L); } }
    SEAM(0);
#pragma unroll 1
    for (int l = 0; l < 2; ++l) {
        const int pb = 1 + 10 * l;
        const float* modv_l = (const float*)(ws + WS_MODV) + (size_t)l * 3 * MODW;
#ifdef BAR_PROBE
        if (multi && l == 0) { for (int bi = 0; bi < BAR_PROBE; ++bi) xcd_barrier(bar); }
#endif
        if (PHON(1) && IN(pb + 0)) { HIDE_TID(); if (l == 0) row_phase_a<0>(args, l, lane, gw, NGW); else row_phase_a<1>(args, l, lane, gw, NGW); }
        SEAM_BG(pb + 0, l == 1 ? CV_D1 : 0);
        if (PHON(2) && IN(pb + 1)) REPEAT(2) {
            REPBAR();
            SchedIn S{(const char*)(ws + WS_H), (const char*)(ws + WS_WIN) + (size_t)l * INW * DM * 2, G, wg, l}; EpiIn E{1.f, (bf16_t*)(ws + WS_P), (LAS float*)(lds + RING_BYTES), (const float*)(ws + WS_ROPE128), (const float*)(ws + WS_ROPE64), args.in[10] + l * 128, args.in[12] + l * 64, args.in[19] + l * 128, args.in[9] + l * 128, args.in[11] + l * 64, args.in[18] + l * 128};
            if (!IN_BLOCK) pg8::gemm_phase<EpiIn, SchedIn>(lds, DM * 2, DM * 2, S, E);
            if (FP8_GATES) { SchedIn8 S8{(const char*)(ws + WS_H8), (const char*)(ws + WS_WIN8) + (size_t)l * INW * DM, G, wg, l}; const EpiIn E8{1.f / 64.f, (bf16_t*)(ws + WS_P), (LAS float*)(lds + RING_BYTES), (const float*)(ws + WS_ROPE128), (const float*)(ws + WS_ROPE64), args.in[10] + l * 128, args.in[12] + l * 64, args.in[19] + l * 128, args.in[9] + l * 128, args.in[11] + l * 64, args.in[18] + l * 128};
                pg8::gemm_phase<EpiIn, SchedIn8, true>(lds, DM, DM, S8, E8); }
            if (IN_BLOCK) pg8::gemm_phase<EpiIn, SchedIn>(lds, DM * 2, DM * 2, S, E);
        }
        SEAM_BG(pb + 1, 0);
        if (!FUSE_QK) { if (PHON(3) && IN(pb + 2)) { HIDE_TID(); row_phase_c(args, l, lane, gw, NGW); }
        SEAM(pb + 2); }
        if (PHON(4) && IN(pb + 3)) REPEAT(4) {
            REPBAR(); HIDE_TID();
            const float lambda_init = 0.8f - 0.6f * expf(-0.3f * (float)l);
            float lam; { const float a = wave_sum(args.in[13][l * 64 + lane] * args.in[14][l * 64 + lane], lane), b = wave_sum(args.in[15][l * 64 + lane] * args.in[16][l * 64 + lane], lane); lam = expf(a) - expf(b) + lambda_init; lam = __uint_as_float((unsigned)__builtin_amdgcn_readfirstlane((int)__float_as_uint(lam))); }
            const bf16_t* P = (const bf16_t*)(ws + WS_P); bf16_t* O = (bf16_t*)(ws + WS_OATT);
#ifndef ATT_NOMAX
#define ATT_NOMAX 1
#endif
            bool nomax_ac = false, nomax_b = false;
            if (ATT_NOMAX) {
                const float ga = fmaxf(fabsf(args.in[9][l * 128 + lane]), fabsf(args.in[9][l * 128 + 64 + lane])), ka = fmaxf(fabsf(args.in[10][l * 128 + lane]), fabsf(args.in[10][l * 128 + 64 + lane]));
                const float gc = fmaxf(fabsf(args.in[18][l * 128 + lane]), fabsf(args.in[18][l * 128 + 64 + lane])), kc = fmaxf(fabsf(args.in[19][l * 128 + lane]), fabsf(args.in[19][l * 128 + 64 + lane]));
                const float gb = fabsf(args.in[11][l * 64 + lane]), kb = fabsf(args.in[12][l * 64 + lane]);
                const float ba = wave_max(ga, lane) * wave_max(ka, lane), bc = wave_max(gc, lane) * wave_max(kc, lane), bb = wave_max(gb, lane) * wave_max(kb, lane);
                const float sk = fabsf(sink_bound(args.in[20] + l * 6));
                nomax_ac = __builtin_amdgcn_readfirstlane((int)(fmaxf(ba, bc) * 16.33f < 100.f && sk < 60.f)) != 0;
                nomax_b = __builtin_amdgcn_readfirstlane((int)(bb * 11.55f < 100.f)) != 0;
            }
            const float* sink_l = args.in[20] + l * 6; const float* subln = args.in[17] + l * 128;
#ifndef ATT_KINDS
#define ATT_KINDS 7
#endif
            const bool ctxl = (l == 0);
            unsigned* qb = ctl + CW_QUEUE + 64 * (rep * 16 + l * 8); unsigned* cctr = ctl + CW_CTX + 128 * rep;
            if (CONV_IN_ATT == 2 && P0_DYN && multi && !BG_CONV && rep == 0 && CONV_SEL(wg)) {
                if (MODV1_IN_ATT && l == 0) { p0_modv(args, lds, tid, lane, wave, (wg >> 5) * 8 + (wg & 7), 64, 96, 2 * 96); __syncthreads(); }
#ifndef CONV_SPLIT_BR
#define CONV_SPLIT_BR 0
#endif
                const int i0 = l == 0 ? CV_D1 : (CONV_SPLIT_BR ? CV_PER_L + CV_I_IN : CV_PER_L + CV_D1);
                const int nn = l == 0 ? ((CONV_IN_EXP && E_XCD && G == 256) ? CV_PER_L - CV_D1 : (CONV_SPLIT_BR ? CV_PER_L - CV_D1 + CV_I_IN : CV_PER_L)) : (CONV_SPLIT_BR ? CV_PER_L - CV_I_IN : CV_PER_L - CV_D1);
                if (CONV_PIPE) p0_convert_dyn2(args, lds, ctl + CW_BGQ + 192 + 64 * l, MISC, tid, wave, lane, nn, i0); else p0_convert_dyn(args, lds, ctl + CW_BGQ + 192 + 64 * l, MISC, tid, wave, lane, nn, i0); }
            else if (CONV_IN_ATT == 1 && P0_DYN && multi && !BG_CONV && l == 0 && rep == 0 && CONV_SEL(wg)) { if (CONV_PIPE) p0_convert_dyn2(args, lds, ctl + CW_BGQ + 192, MISC, tid, wave, lane, CV_PER_L, CV_PER_L); else p0_convert_dyn(args, lds, ctl + CW_BGQ + 192, MISC, tid, wave, lane, CV_PER_L, CV_PER_L); }
#define ATT_CLAIM(q) ({ __syncthreads(); if (tid == 0) MISC[0] = atomicAdd(qb + 64 * (q), 1u); __syncthreads(); __builtin_amdgcn_readfirstlane((int)MISC[0]); })
#define ATT_RUN(KIND, idx, isctx) do { att::AUnit u; attn_decode<KIND>(idx, isctx, u, sink_l); unsigned char* o8_ = FP8_BR ? (unsigned char*)(ws + WS_OATT8) : (unsigned char*)nullptr; \
    if (ATT_NOMAX && (KIND == 1 ? nomax_b : nomax_ac)) att::attn_unit<KIND, 20>(u, P, O, o8_, (LAS char*)lds, lam, 1.f - lambda_init, subln); else att::attn_unit<KIND>(u, P, O, o8_, (LAS char*)lds, lam, 1.f - lambda_init, subln); } while (0)
#ifndef ATT_PROBE
#define ATT_PROBE 0
#endif
#ifndef ATT_PROBE_KINDS
#define ATT_PROBE_KINDS 7
#endif
            if (ATT_PROBE && multi) {
                unsigned* qp = ctl + CW_QUEUE + 64 * (16 + l * 8);
#define ATT_CLAIMP(q) ({ __syncthreads(); if (tid == 0) MISC[0] = atomicAdd(qp + 64 * (q), 1u); __syncthreads(); __builtin_amdgcn_readfirstlane((int)MISC[0]); })
#define ATT_RUNP(KIND, idx) do { att::AUnit u; attn_decode<KIND>(idx, false, u, sink_l); att::attn_unit<KIND, ATT_PROBE == 1 ? 8 : ATT_PROBE>(u, P, O, FP8_BR ? (unsigned char*)(ws + WS_OATT8) : (unsigned char*)nullptr, (LAS char*)lds, lam, 1.f - lambda_init, subln); } while (0)
                if (ATT_PROBE_KINDS & 1) for (;;) { const int qi = ATT_CLAIMP(1); if (qi >= 192) break; ATT_RUNP(0, qi); }
                if (ATT_PROBE_KINDS & 2) for (;;) { const int qi = ATT_CLAIMP(2); if (qi >= 256) break; ATT_RUNP(1, qi); }
                if (ATT_PROBE_KINDS & 4) for (;;) { const int qi = ATT_CLAIMP(3); if (qi >= 192) break; ATT_RUNP(2, qi); }
                xcd_barrier(bar);
            }
#define ATT_CHAIN_BODY() do { \
                        if (FP8_GATES && FP8_AC && CTX_GATES_IN_CHAIN) { \
                            SchedGate3 S{(const char*)(ws + WS_H8), (const char*)(ws + WS_WIN8) + (size_t)l * INW * DM, pm, pn}; \
                            const EpiIn E8{1.f / 64.f, (bf16_t*)(ws + WS_P), (LAS float*)(lds + RING_BYTES), (const float*)(ws + WS_ROPE128), (const float*)(ws + WS_ROPE64), args.in[10] + l * 128, args.in[12] + l * 64, args.in[19] + l * 128, args.in[9] + l * 128, args.in[11] + l * 64, args.in[18] + l * 128}; \
                            pg8::gemm_phase<EpiIn, SchedGate3, true>(lds, DM, DM, S, E8); } \
                        wait_ge(cctr, 40u, tid); \
                        { SchedOneBr S{(const char*)(ws + WS_OATT), (const char*)(ws + WS_WBR) + (size_t)l * DM * DM * 2, (const char*)(ws + WS_OATT8), (const char*)(ws + WS_WBR8) + (size_t)l * DM * DM, pm, pn}; EpiBr E{(const bf16_t*)(ws + WS_P), (bf16_t*)(ws + WS_MM)}; \
                          if (FP8_BR) { SchedOneBrAC S1{(const char*)(ws + WS_OATT8), (const char*)(ws + WS_WBR8) + (size_t)l * DM * DM, pm, pn}; EpiBrAC E1{(const bf16_t*)(ws + WS_P), (bf16_t*)(ws + WS_MM)}; \
                              pg8::gemm_phase<EpiBrAC, SchedOneBrAC, true>(lds, DM, DM, S1, E1); \
                              SchedOneBrB S2{(const char*)(ws + WS_OATT), (const char*)(ws + WS_WBR) + (size_t)l * DM * DM * 2, pm, pn}; EpiBrB E2{(const bf16_t*)(ws + WS_P), (bf16_t*)(ws + WS_MM)}; \
                              pg8::gemm_phase<EpiBrB, SchedOneBrB>(lds, DM * 2, DM * 2, S2, E2); } \
                          else pg8::gemm_phase<EpiBr, SchedOneBr>(lds, DM * 2, DM * 2, S, E); } \
                        publish_inc(cctr + 64, tid); \
                        wait_ge(cctr + 64, 16u, tid); \
                        { SchedOneOut S{(const char*)(ws + WS_MM), (const char*)(ws + WS_WOUT) + (size_t)l * DM * DM * (FP8_OUT ? 1 : 2), pm, pn}; \
                          EpiOut E{args.in[0], args.in[2], (float*)(ws + WS_X), modv_l + 2 * DM}; \
                          if (FP8_OUT) pg8::gemm_phase<EpiOut, SchedOneOut, true>(lds, DM, DM, S, E); else pg8::gemm_phase<EpiOut, SchedOneOut>(lds, DM * 2, DM * 2, S, E); } \
                        if (fuse_router) router_tile(args, l, pm, pn, ctl + CW_RP + 64 * (64 * l + pm)); \
    } while (0)
#ifndef ATT_ONEQ
#define ATT_ONEQ 1
#endif
#if ATT_ONEQ && ATT_KINDS == 7
            {
                const int nch = (ctxl && CTX_CHAIN) ? 16 : 0, ncA = ctxl ? 12 : 0, ncB = ctxl ? 16 : 0;
                const int e0 = ctxl ? 12 : 0, e1 = e0 + ncA + 192, e2 = e1 + ncB + nch + 256, e3 = e2 + 192;
                int gi = ATT_CLAIM(0);
                for (; gi < e0; gi = ATT_CLAIM(0)) { ATT_RUN(2, gi, true); if (CTX_CHAIN) publish_inc(cctr, tid); }
                for (; gi < e1; gi = ATT_CLAIM(0)) { const int qi = gi - e0; const bool isctx = qi < ncA; ATT_RUN(0, isctx ? qi : qi - ncA, isctx); if (CTX_CHAIN && isctx) publish_inc(cctr, tid); }
                for (; gi < e2; gi = ATT_CLAIM(0)) { const int qi = gi - e1; const int nctx = ncB;
                    if (qi >= nctx && qi < nctx + nch) {
                        const int j = qi - nctx, pm = 32 + (j >> 3), pn = j & 7;
                        ATT_CHAIN_BODY();
                        continue; }
                    const bool isctx = qi < nctx; ATT_RUN(1, isctx ? qi : qi - nctx - nch, isctx); if (CTX_CHAIN && isctx) publish_inc(cctr, tid); }
                for (; gi < e3; gi = ATT_CLAIM(0)) { ATT_RUN(2, gi - e2, false); }
            }
#else
            if (ctxl && (ATT_KINDS & 4)) for (;;) { const int qi = ATT_CLAIM(0); if (qi >= 12) break; ATT_RUN(2, qi, true); if (CTX_CHAIN) publish_inc(cctr, tid); }
#ifndef ATT_XCD
#define ATT_XCD 0
#endif
            const bool axcd = ATT_XCD && G == 256;
            if (ATT_KINDS & 1) { const int nctx = ctxl ? 12 : 0, nlatq = axcd ? 0 : 192;
                for (;;) { const int qi = ATT_CLAIM(1); if (qi >= nctx + nlatq) break; const bool isctx = qi < nctx; ATT_RUN(0, isctx ? qi : qi - nctx, isctx); if (CTX_CHAIN && isctx) publish_inc(cctr, tid); }
                if (axcd) { const int x = wg & 7, k = wg >> 3; if (k < 24) { const int u_ = (x & 1) * 24 + k, g_ = x >> 1; ATT_RUN(0, (g_ >> 1) * 96 + ((g_ & 1) * 3 + u_ / 16) * 16 + (u_ & 15), false); } } }
            if (ATT_KINDS & 2) { const int nctx = ctxl ? 16 : 0, nch = (ctxl && CTX_CHAIN) ? 16 : 0;
                for (;;) { const int qi = ATT_CLAIM(2); if (qi >= nctx + nch + (axcd ? 0 : 256)) break;
                    if (qi >= nctx && qi < nctx + nch) {
                        const int j = qi - nctx, pm = 32 + (j >> 3), pn = j & 7;
                        ATT_CHAIN_BODY();
                        continue; }
                    const bool isctx = qi < nctx; ATT_RUN(1, isctx ? qi : qi - nctx - nch, isctx); if (CTX_CHAIN && isctx) publish_inc(cctr, tid); }
                if (axcd) ATT_RUN(1, (wg & 7) * 32 + (wg >> 3), false); }
            if (ATT_KINDS & 4) for (;;) { const int qi = ATT_CLAIM(3); if (qi >= 192) break; ATT_RUN(2, qi, false); }
#endif
#undef ATT_CLAIM
#undef ATT_RUN
#undef ATT_CHAIN_BODY
        }
        SEAM_BG(pb + 3, 0);
        if (PHON(5) && IN(pb + 4)) REPEAT(5) {
            REPBAR();
            SchedBr S{(const char*)(ws + WS_OATT), (const char*)(ws + WS_WBR) + (size_t)l * DM * DM * 2, (const char*)(ws + WS_OATT8), (const char*)(ws + WS_WBR8) + (size_t)l * DM * DM, G, wg, (l == 0 && !CTX_CHAIN) ? 34 : 32}; EpiBr E{(const bf16_t*)(ws + WS_P), (bf16_t*)(ws + WS_MM)};
            if (FP8_BR) { const int ntm = (l == 0 && !CTX_CHAIN) ? 34 : 32;
                SchedBrAC S1{(const char*)(ws + WS_OATT8), (const char*)(ws + WS_WBR8) + (size_t)l * DM * DM, G, wg, ntm}; EpiBrAC E1{(const bf16_t*)(ws + WS_P), (bf16_t*)(ws + WS_MM)};
                pg8::gemm_phase<EpiBrAC, SchedBrAC, true>(lds, DM, DM, S1, E1);
                SchedBrB S2{(const char*)(ws + WS_OATT), (const char*)(ws + WS_WBR) + (size_t)l * DM * DM * 2, G, wg, ntm}; EpiBrB E2{(const bf16_t*)(ws + WS_P), (bf16_t*)(ws + WS_MM)};
                pg8::gemm_phase<EpiBrB, SchedBrB>(lds, DM * 2, DM * 2, S2, E2); }
            else pg8::gemm_phase<EpiBr, SchedBr>(lds, DM * 2, DM * 2, S, E);
        }
        SEAM(pb + 4);
        if (PHON(6) && IN(pb + 5)) REPEAT(6) {
            REPBAR();
            SchedOut S{(const char*)(ws + WS_MM), (const char*)(ws + WS_WOUT) + (size_t)l * DM * DM * (FP8_OUT ? 1 : 2), G, wg, (l == 0 && !CTX_CHAIN) ? 34 : 32};
            const float* X = (const float*)(ws + WS_X);
            EpiOut E{l == 0 ? args.in[0] : X, l == 0 ? args.in[2] : X + (size_t)NLAT * DM, (float*)(ws + WS_X), modv_l + 2 * DM};
            if (FP8_OUT) pg8::gemm_phase<EpiOut, SchedOut, true>(lds, DM, DM, S, E); else pg8::gemm_phase<EpiOut, SchedOut>(lds, DM * 2, DM * 2, S, E);
            if (fuse_router) { int pm, pn; if (pg8::grid_order((long)wg, 32, 8, pm, pn)) router_tile(args, l, pm, pn, ctl + CW_RP + 64 * (64 * l + pm)); }
        }
        SEAM(pb + 5);
        if (!fuse_router) { if (PHON(7) && IN(pb + 6)) REPEAT(7) { REPBAR(); HIDE_TID(); if (ROUTER_V3) row_phase_g3(args, lds, l, tid, lane, wave, wg, G); else row_phase_g(args, lds, l, tid, lane, wave, wg, G, ROUTER_PROBE != 0 && rep == 0 && ((REP_MASK >> 7) & 1u)); }
        SEAM(pb + 6); }
        if (PHON(8) && IN(pb + 7)) REPEAT(8) { REPBAR(); HIDE_TID(); phase_rank(args, lds, l, wg, G, tid, wave, lane); }
        SEAM_BG(pb + 7, l == 1 ? CV_PER_L : 0);
        if (PHON(9) && IN(pb + 8)) REPEAT(9) {
            REPBAR();
            SchedE1 S{(const char*)(ws + WS_XG), (const char*)(ws + WS_W1) + (size_t)l * 16 * 2048 * DM * (FP8_EXPERTS ? 1 : 2), G, wg, l == 0 ? 5 : 4}; EpiE1 E{(bf16_t*)(ws + WS_ACT), l == 0 ? EROWS : 1024};
            if (FP8_EXPERTS) pg8::gemm_phase<EpiE1, SchedE1, true>(lds, DM, DM, S, E); else pg8::gemm_phase<EpiE1, SchedE1>(lds, DM * 2, DM * 2, S, E);
            if (CONV_IN_EXP && CONV_IN_ATT == 2 && P0_DYN && E_XCD && multi && !BG_CONV && G == 256 && l == 0 && rep == 0 && (wg >> 3) >= 16) { HIDE_TID(); p0_convert_dyn2(args, lds, ctl + CW_BGQ + 320, MISC, tid, wave, lane, CONV_EXP_PART1, CV_PER_L); }
        }
        SEAM_BG(pb + 8, 0);
        if (PHON(10) && IN(pb + 9)) REPEAT(10) {
            REPBAR();
            SchedE2 S{(const char*)(ws + WS_ACT), (const char*)(ws + WS_W2) + (size_t)l * 16 * 2048 * FF * (FP8_EXPERTS ? 1 : 2), G, wg, l == 0 ? 5 : 4}; EpiE2 E{(bf16_t*)(ws + WS_Y), (const float*)(ws + WS_GW), l == 0 ? EROWS : 1024};
            if (FP8_EXPERTS) pg8::gemm_phase<EpiE2, SchedE2, true>(lds, FF, FF, S, E); else pg8::gemm_phase<EpiE2, SchedE2>(lds, FF * 2, FF * 2, S, E);
            if (CONV_IN_EXP && CONV_IN_ATT == 2 && P0_DYN && E_XCD && multi && !BG_CONV && G == 256 && l == 0 && rep == 0 && (wg >> 3) >= 16) { HIDE_TID(); p0_convert_dyn2(args, lds, ctl + CW_BGQ + 384, MISC, tid, wave, lane, CV_D1 - CONV_EXP_PART1, CV_PER_L + CONV_EXP_PART1); }
        }
        SEAM_BG(pb + 9, 0);
    }
    if (PHON(11) && IN(21)) { HIDE_TID(); row_phase_a<2>(args, 2, lane, gw, NGW); }
#undef IN
#undef SEAM
}

static int g_grid = 0;
static bool setup() {
    if (g_grid) return g_grid > 0;
    int dev = 0, cus = 0, per_cu = 0;
    if (hipGetDevice(&dev) != hipSuccess || hipDeviceGetAttribute(&cus, hipDeviceAttributeMultiprocessorCount, dev) != hipSuccess) { g_grid = -1; return false; }
    if (hipFuncSetAttribute((const void*)mega, hipFuncAttributeMaxDynamicSharedMemorySize, LDS_BYTES) != hipSuccess) { fprintf(stderr, "kernel_launch: hipFuncSetAttribute failed\n"); g_grid = -1; return false; }
    if (hipOccupancyMaxActiveBlocksPerMultiprocessor(&per_cu, (const void*)mega, NTHR, LDS_BYTES) != hipSuccess || per_cu < 1) { fprintf(stderr, "kernel_launch: occupancy query says %d\n", per_cu); (void)hipGetLastError(); }
    g_grid = cus;
    return true;
}
static void run(void* const* d_in, void* d_out, void* d_ws, bool one_launch, int ph_end, hipStream_t stream) {
    if (!setup()) return;
    (void)hipMemsetAsync((char*)d_ws + WS_CTL, 0, CTL_ZERO_BYTES, stream);
    Args a{}; for (int i = 0; i < 29; ++i) a.in[i] = (const float*)d_in[i];
    a.out = (float*)d_out; a.ws = (unsigned char*)d_ws;
    if (one_launch) { a.ph_lo = 0; a.ph_hi = ph_end; hipLaunchKernelGGL(mega, dim3(g_grid), dim3(NTHR), LDS_BYTES, stream, a); }
    else for (int p = 0; p < ph_end; ++p) { a.ph_lo = p; a.ph_hi = p + 1; hipLaunchKernelGGL(mega, dim3(g_grid), dim3(NTHR), LDS_BYTES, stream, a); }
}
}
#ifndef ONE_LAUNCH
#define ONE_LAUNCH 0
#endif
extern "C" void kernel_launch(void* const* d_in, const int* in_sizes, int n_in, void* d_out, int out_size, void* d_ws, size_t ws_size, hipStream_t stream) {
    if (n_in != 29 || ws_size < fk::WS_END) { fprintf(stderr, "kernel_launch: unexpected n_in %d / ws %zu\n", n_in, ws_size); return; }
    fk::run(d_in, d_out, d_ws, ONE_LAUNCH != 0, fk::N_PHASES, stream);
}
```

```cpp
#include <hip/hip_runtime.h>
#include <cstdio>
#include <cstdint>
#include <cmath>
#define ONE_LAUNCH 1
#define ROW_NTL 1
#define LAS __attribute__((address_space(3)))
#define GAS __attribute__((address_space(1)))
typedef unsigned short bf16_t;
typedef short bf16x8 __attribute__((ext_vector_type(8)));
typedef short s16x4 __attribute__((ext_vector_type(4)));
typedef float f32x2 __attribute__((ext_vector_type(2)));
typedef float f32x4 __attribute__((ext_vector_type(4)));
typedef float f32x16 __attribute__((ext_vector_type(16)));
typedef unsigned u32x2 __attribute__((ext_vector_type(2)));
typedef unsigned u32x4 __attribute__((ext_vector_type(4)));
typedef int i32x4 __attribute__((ext_vector_type(4)));
typedef int i32x8 __attribute__((ext_vector_type(8)));

__device__ __forceinline__ unsigned cvt_pk_bf16(float lo, float hi) { unsigned r; asm volatile("v_cvt_pk_bf16_f32 %0, %1, %2" : "=v"(r) : "v"(lo), "v"(hi)); return r; }
__device__ __forceinline__ float bf_lo(unsigned w) { return __uint_as_float(w << 16); }
__device__ __forceinline__ float bf_hi(unsigned w) { return __uint_as_float(w & 0xffff0000u); }
__device__ __forceinline__ float bf2f(bf16_t b) { return __uint_as_float(((unsigned)b) << 16); }
__device__ __forceinline__ float shx(float v, int lane, int o) { return __uint_as_float((unsigned)__builtin_amdgcn_ds_bpermute((lane ^ o) << 2, (int)__float_as_uint(v))); }
__device__ __forceinline__ unsigned pk4_fp8(float a, float b, float c, float d) { int w = __builtin_amdgcn_cvt_pk_fp8_f32(a, b, 0, false); w = __builtin_amdgcn_cvt_pk_fp8_f32(c, d, w, true); return (unsigned)w; }
__device__ __forceinline__ float fast_sigmoid(float x) { return __builtin_amdgcn_rcpf(1.f + __builtin_amdgcn_exp2f(-1.4426950408889634f * x)); }

namespace pg8 {
constexpr int BM = 256, BK = 64, HALF = 128, HTB = HALF * BK * 2  , STAGE_BYTES = 8 * HTB;
__host__ __device__ __forceinline__ int lds_byte(int r, int c) { const int st = (r >> 4) * 2 + (c >> 5), rr = r & 15, cc = c & 31, ob = rr * 64 + cc * 2; return st * 1024 + (ob ^ (((ob >> 9) & 1) << 5)); }
__host__ __device__ __forceinline__ void stage_rc(int b, int& R, int& C) { const int st = b / 1024, sb = b % 1024, swz = sb ^ (((sb >> 9) & 1) << 5); R = (st >> 1) * 16 + swz / 64; C = (st & 1) * 32 + (swz % 64) / 2; }
__host__ __device__ __forceinline__ int perm32(int rho) { const int n = rho >> 4, i = rho & 15; return 8 * (i >> 2) + 4 * n + (i & 3); }

struct GUnit { const char* a; const char* b; int nt; int pm, pn, aux; int f8; int q; };

__device__ __forceinline__ bool grid_order(long L, int nM, int nN, int& pm, int& pn) {
    const int nwg = nM * nN; if (L >= nwg) return false;
    int wgid = (int)L; { const int q = nwg / 8, r = nwg % 8, xcd = wgid % 8, off = wgid / 8; wgid = (xcd < r ? xcd * (q + 1) : r * (q + 1) + (xcd - r) * q) + off; }
    const int nig = 8 * nN, gid = wgid / nig, fm = gid * 8, gsz = (nM - fm) < 8 ? (nM - fm) : 8;
    pm = fm + ((wgid % nig) % gsz); pn = (wgid % nig) / gsz; return true;
}

template <class Epi, class Sched, bool F8 = false>
__device__ __forceinline__ void gemm_phase(LAS unsigned char* lds, const int lda, const int ldb, const Sched& S, const Epi& E) {
    int tz = threadIdx.x; asm volatile("" : "+v"(tz));
    const int tid = tz, wid = __builtin_amdgcn_readfirstlane(tid >> 6), lane = tid & 63, wr = wid >> 2, wc = wid & 3, fr = lane & 15, fq = lane >> 4;
    unsigned voffA[2], voffB[2];
#pragma unroll
    for (int i = 0; i < 2; ++i) { int R, C; stage_rc(tid * 16 + i * 8192, R, C); const int Rb = Epi::PERM ? ((R & ~31) + perm32(R & 31)) : R;
        voffA[i] = (unsigned)(R * lda + C * 2); voffB[i] = (unsigned)(Rb * ldb + C * 2); }
    const size_t kstep = (size_t)(BK * 2);
    const size_t hstepA = (size_t)HALF * lda, hstepB = (size_t)HALF * ldb;
    const unsigned ldsw = (unsigned)wid * 1024u;
    const int aoff = lds_byte(wr * 64 + fr, fq * 8), boff = lds_byte(wc * 32 + fr, fq * 8);
#define PG8_SA(b, h) (((b) * 2 + (h)) * HTB)
#define PG8_SB(b, h) ((4 + (b) * 2 + (h)) * HTB)
#define PG8_STAGE(bufoff, gbase, voff) do { _Pragma("unroll") for (int _i = 0; _i < 2; ++_i) \
        __builtin_amdgcn_global_load_lds((const unsigned*)((const char*)(gbase) + (voff)[_i]), (LAS unsigned*)(lds + (bufoff) + ldsw + _i * 8192), 16, 0, 0); } while (0)
#define PG8_LDA16(dst, b, h) do { _Pragma("unroll") for (int m = 0; m < 4; ++m) _Pragma("unroll") for (int k = 0; k < 2; ++k) dst[m][k] = *(const LAS bf16x8*)(lds + PG8_SA(b, h) + aoff + m * 2048 + k * 1024); } while (0)
#define PG8_LDB16(dst, b, h) do { _Pragma("unroll") for (int n = 0; n < 2; ++n) _Pragma("unroll") for (int k = 0; k < 2; ++k) dst[n][k] = *(const LAS bf16x8*)(lds + PG8_SB(b, h) + boff + n * 2048 + k * 1024); } while (0)
#define PG8_LD8(p) __builtin_shufflevector(*(const LAS i32x4*)(p), *(const LAS i32x4*)((p) + 1024), 0, 1, 2, 3, 4, 5, 6, 7)
#define PG8_LDA8(dst, b, h) do { _Pragma("unroll") for (int m = 0; m < 4; ++m) dst[m] = PG8_LD8(lds + PG8_SA(b, h) + aoff + m * 2048); } while (0)
#define PG8_LDB8(dst, b, h) do { _Pragma("unroll") for (int n = 0; n < 2; ++n) dst[n] = PG8_LD8(lds + PG8_SB(b, h) + boff + n * 2048); } while (0)
#define PG8_LDA(dst, b, h) do { if constexpr (F8) PG8_LDA8(dst##8, b, h); else PG8_LDA16(dst, b, h); } while (0)
#define PG8_LDB(dst, b, h) do { if constexpr (F8) PG8_LDB8(dst##8, b, h); else PG8_LDB16(dst, b, h); } while (0)
#define PG8_MMA16(ai, bj, At, Bt) do { __builtin_amdgcn_s_setprio(1); _Pragma("unroll") for (int m = 0; m < 4; ++m) _Pragma("unroll") for (int n = 0; n < 2; ++n) _Pragma("unroll") for (int k = 0; k < 2; ++k) \
        acc[ai][bj][m][n] = __builtin_amdgcn_mfma_f32_16x16x32_bf16(Bt[n][k], At[m][k], acc[ai][bj][m][n], 0, 0, 0); __builtin_amdgcn_s_setprio(0); } while (0)
#define PG8_MMA8(ai, bj, At, Bt) do { __builtin_amdgcn_s_setprio(1); _Pragma("unroll") for (int m = 0; m < 4; ++m) _Pragma("unroll") for (int n = 0; n < 2; ++n) \
        asm volatile("v_mfma_f32_16x16x128_f8f6f4 %0, %1, %2, %0" : "+v"(acc[ai][bj][m][n]) : "v"(Bt[n]), "v"(At[m])); __builtin_amdgcn_s_setprio(0); } while (0)
#define PG8_MFMA_DRAIN() do { if constexpr (F8) asm volatile("s_nop 15\n\ts_nop 15" ::: "memory"); } while (0)
#define PG8_MMA(ai, bj, At, Bt) do { if constexpr (F8) PG8_MMA8(ai, bj, At##8, Bt##8); else PG8_MMA16(ai, bj, At, Bt); } while (0)
#define PG8_WAIT_V(n) asm volatile("s_waitcnt vmcnt(" #n ")" ::: "memory")
#define PG8_WAIT_L(n) asm volatile("s_waitcnt lgkmcnt(" #n ")" ::: "memory")
#define PG8_BAR __builtin_amdgcn_s_barrier()
#define PG8_SCHED __builtin_amdgcn_sched_barrier(0)
    GUnit cur, nxt; int ui = 0;
    if (!S.next(0, cur)) return;
    f32x4 acc[2][2][4][2];
#pragma unroll
    for (int a = 0; a < 2; ++a)
#pragma unroll
        for (int b = 0; b < 2; ++b)
#pragma unroll
            for (int m = 0; m < 4; ++m)
#pragma unroll
                for (int n = 0; n < 2; ++n) acc[a][b][m][n] = (f32x4){0.f, 0.f, 0.f, 0.f};
    bf16x8 At[4][2], B0[2][2], B1[2][2];
    i32x8 At8[4], B08[2], B18[2];
    const char* cA = cur.a; const char* cB = cur.b;
    PG8_STAGE(PG8_SB(0, 0), cB, voffB); PG8_STAGE(PG8_SB(0, 1), cB + hstepB, voffB); PG8_STAGE(PG8_SA(0, 0), cA, voffA); PG8_STAGE(PG8_SA(0, 1), cA + hstepA, voffA);
    if (wr == 1) PG8_BAR;
    PG8_WAIT_V(2); PG8_BAR;
    PG8_STAGE(PG8_SB(1, 0), cB + kstep, voffB); PG8_STAGE(PG8_SA(1, 0), cA + kstep, voffA); PG8_STAGE(PG8_SB(1, 1), cB + hstepB + kstep, voffB);
    PG8_WAIT_V(6); PG8_BAR;
    for (;;) {
        const bool has_next = S.next(ui + 1, nxt);
        const char* nA = has_next ? nxt.a : cA; const char* nB = has_next ? nxt.b : cB;
        const int nt = cur.nt;
        bool qs = false; if constexpr (Epi::QSKIP) qs = cur.q != 0;
        const bool do0 = !(qs && wr == 1), do1 = !qs;
#pragma unroll 1
        for (int t = 0; t < nt; t += 2) {
            const bool last = (t == nt - 2);
            const char* a1 = cA + (size_t)(t + 1) * kstep;
            const char* a2 = last ? nA : cA + (size_t)(t + 2) * kstep; const char* b2 = last ? nB : cB + (size_t)(t + 2) * kstep;
            const char* a3 = a2 + kstep; const char* b3 = b2 + kstep;
            PG8_LDB(B0, 0, 0); PG8_LDB(B1, 0, 1); PG8_SCHED; PG8_LDA(At, 0, 0); PG8_STAGE(PG8_SA(1, 1), a1 + hstepA, voffA);
            PG8_WAIT_V(8); PG8_WAIT_L(0); PG8_BAR; if (do0) { PG8_MMA(0, 0, At, B0); PG8_MMA(0, 1, At, B1); } PG8_BAR; PG8_SCHED;
            PG8_LDA(At, 0, 1); PG8_STAGE(PG8_SB(0, 0), b2, voffB); PG8_STAGE(PG8_SB(0, 1), b2 + hstepB, voffB); PG8_STAGE(PG8_SA(0, 0), a2, voffA);
            PG8_WAIT_V(8); PG8_WAIT_L(0); PG8_BAR; if (do1) { PG8_MMA(1, 0, At, B0); PG8_MMA(1, 1, At, B1); } PG8_BAR; PG8_SCHED;
            PG8_LDB(B0, 1, 0); PG8_LDB(B1, 1, 1); PG8_SCHED; PG8_LDA(At, 1, 0); PG8_STAGE(PG8_SA(0, 1), a2 + hstepA, voffA);
            PG8_WAIT_V(8); PG8_WAIT_L(0); PG8_BAR; if (do0) { PG8_MMA(0, 0, At, B0); PG8_MMA(0, 1, At, B1); } PG8_BAR; PG8_SCHED;
            PG8_LDA(At, 1, 1); PG8_STAGE(PG8_SB(1, 0), b3, voffB); PG8_STAGE(PG8_SB(1, 1), b3 + hstepB, voffB); PG8_STAGE(PG8_SA(1, 0), a3, voffA);
            PG8_WAIT_V(8); PG8_WAIT_L(0); PG8_BAR; if (do1) { PG8_MMA(1, 0, At, B0); PG8_MMA(1, 1, At, B1); } PG8_BAR; PG8_SCHED;
        }
        if (wr == 0) PG8_BAR;
        PG8_MFMA_DRAIN();
        E(acc, cur, wr, wc, fr, fq);
        if (!has_next) break;
        bool zero = true; if constexpr (Epi::KEEPS) zero = !E.keep(cur);
        if (zero) {
#pragma unroll
        for (int a = 0; a < 2; ++a)
#pragma unroll
            for (int b = 0; b < 2; ++b)
#pragma unroll
                for (int m = 0; m < 4; ++m)
#pragma unroll
                    for (int n = 0; n < 2; ++n) acc[a][b][m][n] = (f32x4){0.f, 0.f, 0.f, 0.f};
        }
        cur = nxt; cA = nA; cB = nB; ++ui;
        if (wr == 1) PG8_BAR;
    }
    PG8_WAIT_V(0);
    PG8_BAR;
#undef PG8_SA
#undef PG8_SB
#undef PG8_STAGE
#undef PG8_LDA
#undef PG8_LDB
#undef PG8_MMA
#undef PG8_MMA8
#undef PG8_MFMA_DRAIN
#undef PG8_MMA16
#undef PG8_LDA8
#undef PG8_LDB8
#undef PG8_LDA16
#undef PG8_LDB16
#undef PG8_LD8
#undef PG8_WAIT_V
#undef PG8_WAIT_L
#undef PG8_BAR
#undef PG8_SCHED
}
template <class Epi, class Sched>
__device__ __forceinline__ void gemm_phase_mx(LAS unsigned char* lds, const int lda, const int ldb, const int lda8, const int ldb8, const Sched& S, const Epi& E) {
    int tz = threadIdx.x; asm volatile("" : "+v"(tz));
    const int tid = tz, wid = __builtin_amdgcn_readfirstlane(tid >> 6), lane = tid & 63, wr = wid >> 2, wc = wid & 3, fr = lane & 15, fq = lane >> 4;
    unsigned voffA[2], voffB[2], voffA8[2], voffB8[2];
#pragma unroll
    for (int i = 0; i < 2; ++i) { int R, C; stage_rc(tid * 16 + i * 8192, R, C); const int Rb = Epi::PERM ? ((R & ~31) + perm32(R & 31)) : R;
        voffA[i] = (unsigned)(R * lda + C * 2); voffB[i] = (unsigned)(Rb * ldb + C * 2); voffA8[i] = (unsigned)(R * lda8 + C * 2); voffB8[i] = (unsigned)(Rb * ldb8 + C * 2); }
    const size_t kstep = (size_t)(BK * 2);
    const size_t hsA = (size_t)HALF * lda, hsB = (size_t)HALF * ldb, hsA8 = (size_t)HALF * lda8, hsB8 = (size_t)HALF * ldb8;
    const unsigned ldsw = (unsigned)wid * 1024u;
    const int aoff = lds_byte(wr * 64 + fr, fq * 8), boff = lds_byte(wc * 32 + fr, fq * 8);
#define MX_SA(b, h) (((b) * 2 + (h)) * HTB)
#define MX_SB(b, h) ((4 + (b) * 2 + (h)) * HTB)
#define MX_STG(bufoff, gptr, v8, v16, fl) do { _Pragma("unroll") for (int _i = 0; _i < 2; ++_i) { const unsigned _v = (fl) ? (v8)[_i] : (v16)[_i]; \
        __builtin_amdgcn_global_load_lds((const unsigned*)((const char*)(gptr) + _v), (LAS unsigned*)(lds + (bufoff) + ldsw + _i * 8192), 16, 0, 0); } } while (0)
#define MX_STAGE_A(bufoff, gptr, fl) MX_STG(bufoff, gptr, voffA8, voffA, fl)
#define MX_STAGE_B(bufoff, gptr, fl) MX_STG(bufoff, gptr, voffB8, voffB, fl)
#define MX_HSA(fl) ((fl) ? hsA8 : hsA)
#define MX_HSB(fl) ((fl) ? hsB8 : hsB)
#define MX_LDA16(dst, b, h) do { _Pragma("unroll") for (int m = 0; m < 4; ++m) _Pragma("unroll") for (int k = 0; k < 2; ++k) dst[m][k] = *(const LAS bf16x8*)(lds + MX_SA(b, h) + aoff + m * 2048 + k * 1024); } while (0)
#define MX_LDB16(dst, b, h) do { _Pragma("unroll") for (int n = 0; n < 2; ++n) _Pragma("unroll") for (int k = 0; k < 2; ++k) dst[n][k] = *(const LAS bf16x8*)(lds + MX_SB(b, h) + boff + n * 2048 + k * 1024); } while (0)
#define MX_LD8(p) __builtin_shufflevector(*(const LAS i32x4*)(p), *(const LAS i32x4*)((p) + 1024), 0, 1, 2, 3, 4, 5, 6, 7)
#define MX_LDA8(dst, b, h) do { _Pragma("unroll") for (int m = 0; m < 4; ++m) dst[m] = MX_LD8(lds + MX_SA(b, h) + aoff + m * 2048); } while (0)
#define MX_LDB8(dst, b, h) do { _Pragma("unroll") for (int n = 0; n < 2; ++n) dst[n] = MX_LD8(lds + MX_SB(b, h) + boff + n * 2048); } while (0)
#define MX_HALF(x, k) ((k) == 0 ? __builtin_shufflevector(x, x, 0, 1, 2, 3) : __builtin_shufflevector(x, x, 4, 5, 6, 7))
#define MX_MMA16(ai, bj, At, Bt) do { __builtin_amdgcn_s_setprio(1); _Pragma("unroll") for (int k = 0; k < 2; ++k) _Pragma("unroll") for (int m = 0; m < 4; ++m) _Pragma("unroll") for (int n = 0; n < 2; ++n) \
        acc[ai][bj][m][n] = __builtin_amdgcn_mfma_f32_16x16x32_bf16(__builtin_bit_cast(bf16x8, MX_HALF(Bt[n], k)), __builtin_bit_cast(bf16x8, MX_HALF(At[m], k)), acc[ai][bj][m][n], 0, 0, 0); __builtin_amdgcn_s_setprio(0); } while (0)
#define MX_MMA8(ai, bj, At, Bt) do { __builtin_amdgcn_s_setprio(1); _Pragma("unroll") for (int m = 0; m < 4; ++m) _Pragma("unroll") for (int n = 0; n < 2; ++n) \
        asm volatile("v_mfma_f32_16x16x128_f8f6f4 %0, %1, %2, %0" : "+v"(acc[ai][bj][m][n]) : "v"(Bt[n]), "v"(At[m])); __builtin_amdgcn_s_setprio(0); } while (0)
#define MX_WAIT_V(n) asm volatile("s_waitcnt vmcnt(" #n ")" ::: "memory")
#define MX_WAIT_L(n) asm volatile("s_waitcnt lgkmcnt(" #n ")" ::: "memory")
#define MX_BAR __builtin_amdgcn_s_barrier()
#define MX_SCHED __builtin_amdgcn_sched_barrier(0)
    GUnit cur, nxt; int ui = 0;
    if (!S.next(0, cur)) return;
    f32x4 acc[2][2][4][2];
#pragma unroll
    for (int a = 0; a < 2; ++a)
#pragma unroll
        for (int b = 0; b < 2; ++b)
#pragma unroll
            for (int m = 0; m < 4; ++m)
#pragma unroll
                for (int n = 0; n < 2; ++n) acc[a][b][m][n] = (f32x4){0.f, 0.f, 0.f, 0.f};
    i32x8 At8[4], B08[2], B18[2];
    const char* cA = cur.a; const char* cB = cur.b;
    { const bool fc = cur.f8 != 0;
      MX_STAGE_B(MX_SB(0, 0), cB, fc); MX_STAGE_B(MX_SB(0, 1), cB + MX_HSB(fc), fc); MX_STAGE_A(MX_SA(0, 0), cA, fc); MX_STAGE_A(MX_SA(0, 1), cA + MX_HSA(fc), fc);
      if (wr == 1) MX_BAR;
      MX_WAIT_V(2); MX_BAR;
      MX_STAGE_B(MX_SB(1, 0), cB + kstep, fc); MX_STAGE_A(MX_SA(1, 0), cA + kstep, fc); MX_STAGE_B(MX_SB(1, 1), cB + MX_HSB(fc) + kstep, fc);
      MX_WAIT_V(6); MX_BAR; }
    for (;;) {
        const bool has_next = S.next(ui + 1, nxt);
        const char* nA = has_next ? nxt.a : cA; const char* nB = has_next ? nxt.b : cB;
        const bool fc = cur.f8 != 0, fnx = has_next ? (nxt.f8 != 0) : fc;
        const int nt = cur.nt;
#pragma unroll 1
        for (int t = 0; t < nt; t += 2) {
            const bool last = (t == nt - 2); const bool f2 = last ? fnx : fc;
            const char* a1 = cA + (size_t)(t + 1) * kstep;
            const char* a2 = last ? nA : cA + (size_t)(t + 2) * kstep; const char* b2 = last ? nB : cB + (size_t)(t + 2) * kstep;
            const char* a3 = a2 + kstep; const char* b3 = b2 + kstep;
            MX_LDB8(B08, 0, 0); MX_LDB8(B18, 0, 1); MX_SCHED; MX_LDA8(At8, 0, 0);
            MX_STAGE_A(MX_SA(1, 1), a1 + MX_HSA(fc), fc);
            MX_WAIT_V(8); MX_WAIT_L(0); MX_BAR; if (fc) { MX_MMA8(0, 0, At8, B08); MX_MMA8(0, 1, At8, B18); } else { MX_MMA16(0, 0, At8, B08); MX_MMA16(0, 1, At8, B18); } MX_BAR; MX_SCHED;
            MX_LDA8(At8, 0, 1);
            MX_STAGE_B(MX_SB(0, 0), b2, f2); MX_STAGE_B(MX_SB(0, 1), b2 + MX_HSB(f2), f2); MX_STAGE_A(MX_SA(0, 0), a2, f2);
            MX_WAIT_V(8); MX_WAIT_L(0); MX_BAR; if (fc) { MX_MMA8(1, 0, At8, B08); MX_MMA8(1, 1, At8, B18); } else { MX_MMA16(1, 0, At8, B08); MX_MMA16(1, 1, At8, B18); } MX_BAR; MX_SCHED;
            MX_LDB8(B08, 1, 0); MX_LDB8(B18, 1, 1); MX_SCHED; MX_LDA8(At8, 1, 0);
            MX_STAGE_A(MX_SA(0, 1), a2 + MX_HSA(f2), f2);
            MX_WAIT_V(8); MX_WAIT_L(0); MX_BAR; if (fc) { MX_MMA8(0, 0, At8, B08); MX_MMA8(0, 1, At8, B18); } else { MX_MMA16(0, 0, At8, B08); MX_MMA16(0, 1, At8, B18); } MX_BAR; MX_SCHED;
            MX_LDA8(At8, 1, 1);
            MX_STAGE_B(MX_SB(1, 0), b3, f2); MX_STAGE_B(MX_SB(1, 1), b3 + MX_HSB(f2), f2); MX_STAGE_A(MX_SA(1, 0), a3, f2);
            MX_WAIT_V(8); MX_WAIT_L(0); MX_BAR; if (fc) { MX_MMA8(1, 0, At8, B08); MX_MMA8(1, 1, At8, B18); } else { MX_MMA16(1, 0, At8, B08); MX_MMA16(1, 1, At8, B18); } MX_BAR; MX_SCHED;
        }
        if (wr == 0) MX_BAR;
        asm volatile("s_nop 15\n\ts_nop 15" ::: "memory");
        E(acc, cur, wr, wc, fr, fq);
        if (!has_next) break;
        bool zero = true; if constexpr (Epi::KEEPS) zero = !E.keep(cur);
        if (zero) {
#pragma unroll
        for (int a = 0; a < 2; ++a)
#pragma unroll
            for (int b = 0; b < 2; ++b)
#pragma unroll
                for (int m = 0; m < 4; ++m)
#pragma unroll
                    for (int n = 0; n < 2; ++n) acc[a][b][m][n] = (f32x4){0.f, 0.f, 0.f, 0.f};
        }
        cur = nxt; cA = nA; cB = nB; ++ui;
        if (wr == 1) MX_BAR;
    }
    MX_WAIT_V(0);
    MX_BAR;
#undef MX_SA
#undef MX_SB
#undef MX_STG
#undef MX_STAGE_A
#undef MX_STAGE_B
#undef MX_HSA
#undef MX_HSB
#undef MX_LDA16
#undef MX_LDB16
#undef MX_LD8
#undef MX_HALF
#undef MX_LDA8
#undef MX_LDB8
#undef MX_MMA16
#undef MX_MMA8
#undef MX_WAIT_V
#undef MX_WAIT_L
#undef MX_BAR
#undef MX_SCHED
}
}
#ifndef ATT_STAGGER
#define ATT_STAGGER 0
#endif
#ifndef ATT_NT_ST
#define ATT_NT_ST 1
#endif
#ifndef ATT_PRIO
#define ATT_PRIO 1
#endif
#ifndef ATT_PKSUM
#define ATT_PKSUM 0
#endif
#ifndef ATT_WIDE_ST
#define ATT_WIDE_ST 1
#endif
#ifndef ATT_ILV
#define ATT_ILV 0
#endif
#ifndef ATT_NV
#define ATT_NV 5
#endif
#ifndef ATT_NE
#define ATT_NE 1
#endif
#ifndef ATT_QKPIPE
#define ATT_QKPIPE 1
#endif
namespace att {
constexpr int LDP = 10240, LDO = 2048, KVBLK = 64;
constexpr int SHM_V = KVBLK * 128 * 2, SHM_K = KVBLK * 128 * 2;
constexpr int LDS_WS = 2 * SHM_V + 2 * SHM_K, LDS_BYTES = LDS_WS + 8 * 64 * 4;
constexpr float THR2 = 11.5415603f;
#define KSWZ(row, colB) ((row) * 256 + ((colB) ^ (((row) & 7) << 4)))
#define SBAR() __builtin_amdgcn_sched_barrier(0)
__device__ __forceinline__ int crow(int r, int hi) { return (r & 3) + 8 * (r >> 2) + 4 * hi; }

struct AUnit {
    int qrow0;
    int qcol, kcol, vcol;
    int ocol;
    int nlat_t;
    int lat_row0;
    int ctx_row0;
    int dpos;
    float sink2;
};

#define AEXP(x) (VAR == 2 ? (x) * 0.001f : __builtin_amdgcn_exp2f(x))
template <int KIND, int VAR = 0> __device__ __forceinline__ void partialSM(f32x16& p0, f32x16& p1, float& m_reg, float& mn, float& alpha, bool do_mask, int jrel, int hi) {
    if (KIND == 2) { if (do_mask) {
#pragma unroll
        for (int r = 0; r < 16; ++r) { const int d0 = jrel + crow(r, hi), d1 = d0 + 32;
            p0[r] = (d0 <= 128 && d0 >= -128) ? p0[r] : -1e30f; p1[r] = (d1 <= 128 && d1 >= -128) ? p1[r] : -1e30f; } } }
    if (VAR == 20) {
        mn = 0.f; alpha = 1.f;
#pragma unroll
        for (int r = 0; r < 16; ++r) p0[r] = __builtin_amdgcn_exp2f(p0[r]);
        return; }
    float pmax = p0[0];
#pragma unroll
    for (int r = 1; r < 16; ++r) pmax = fmaxf(pmax, p0[r]);
#pragma unroll
    for (int r = 0; r < 16; ++r) pmax = fmaxf(pmax, p1[r]);
    { auto rr = __builtin_amdgcn_permlane32_swap(__float_as_uint(pmax), __float_as_uint(pmax), false, false);
      pmax = fmaxf(__uint_as_float(rr[0]), __uint_as_float(rr[1])); }
    if (__builtin_expect(__all(pmax - m_reg <= THR2), 1)) { mn = m_reg; alpha = 1.f; }
    else { mn = fmaxf(m_reg, pmax); alpha = __builtin_amdgcn_exp2f(m_reg - mn); m_reg = mn; }
#pragma unroll
    for (int r = 0; r < 16; ++r) p0[r] = p0[r] - mn;
#pragma unroll
    for (int r = 0; r < 16; ++r) p1[r] = p1[r] - mn;
#pragma unroll
    for (int r = 0; r < 16; ++r) p0[r] = AEXP(p0[r]);
}
template <int VAR = 0> __device__ __forceinline__ void finishSM(f32x16& p0, f32x16& p1, float alpha, float& l_reg, bf16x8& pa0, bf16x8& pa1, bf16x8& pa2, bf16x8& pa3) {
#pragma unroll
    for (int r = 0; r < 16; ++r) p1[r] = AEXP(p1[r]);
#if ATT_PKSUM
    f32x2 s2a = {p0[0], p0[1]}, s2b = {p1[0], p1[1]};
#pragma unroll
    for (int r = 1; r < 8; ++r) { s2a = s2a + (f32x2){p0[2 * r], p0[2 * r + 1]}; s2b = s2b + (f32x2){p1[2 * r], p1[2 * r + 1]}; }
    s2a = s2a + s2b; float ps = s2a[0] + s2a[1];
#else
    float ps = 0;
#pragma unroll
    for (int r = 0; r < 16; ++r) ps += p0[r];
#pragma unroll
    for (int r = 0; r < 16; ++r) ps += p1[r];
#endif
    { auto rr = __builtin_amdgcn_permlane32_swap(__float_as_uint(ps), __float_as_uint(ps), false, false);
      ps = __uint_as_float(rr[0]) + __uint_as_float(rr[1]); }
    l_reg = VAR == 20 ? l_reg + ps : l_reg * alpha + ps;
#define PK4(P, BASE, OUT) do { unsigned a0 = cvt_pk_bf16(P[BASE + 0], P[BASE + 1]), a1 = cvt_pk_bf16(P[BASE + 2], P[BASE + 3]);   \
    unsigned b0 = cvt_pk_bf16(P[BASE + 4], P[BASE + 5]), b1 = cvt_pk_bf16(P[BASE + 6], P[BASE + 7]);                              \
    auto r0 = __builtin_amdgcn_permlane32_swap(a0, b0, false, false); auto r1 = __builtin_amdgcn_permlane32_swap(a1, b1, false, false); \
    u32x4 w = {r0[0], r1[0], r0[1], r1[1]}; OUT = *reinterpret_cast<bf16x8*>(&w); } while (0)
    PK4(p0, 0, pa0); PK4(p0, 8, pa1); PK4(p1, 0, pa2); PK4(p1, 8, pa3);
#undef PK4
}
template <int DQ, int VAR = 0> __device__ __forceinline__ void qkt(f32x16& p0, f32x16& p1, const LAS char* Ks, const bf16x8* qr, int r32, int hi, int dbase) {
    p0 = f32x16{}; p1 = f32x16{};
    if (VAR == 3) {
#pragma unroll
        for (int r = 0; r < 16; ++r) { p0[r] = (float)(r + r32) * 0.01f; p1[r] = (float)(r - hi) * 0.02f; }
        return; }
#if ATT_QKPIPE
    bf16x8 kb[2][2];
    { const int cb = (dbase * 16 + hi * 8) * 2; kb[0][0] = *reinterpret_cast<const LAS bf16x8*>(Ks + KSWZ(r32, cb)); kb[0][1] = *reinterpret_cast<const LAS bf16x8*>(Ks + KSWZ(32 + r32, cb)); }
#pragma unroll
    for (int d0 = 0; d0 < DQ; ++d0) {
        if (VAR == 9) { kb[(d0 + 1) & 1][0] = kb[d0 & 1][0]; kb[(d0 + 1) & 1][1] = kb[d0 & 1][1]; }
        else if (d0 + 1 < DQ) { const int cb = ((dbase + d0 + 1) * 16 + hi * 8) * 2;
            kb[(d0 + 1) & 1][0] = *reinterpret_cast<const LAS bf16x8*>(Ks + KSWZ(r32, cb)); kb[(d0 + 1) & 1][1] = *reinterpret_cast<const LAS bf16x8*>(Ks + KSWZ(32 + r32, cb)); }
        p0 = __builtin_amdgcn_mfma_f32_32x32x16_bf16(kb[d0 & 1][0], qr[d0], p0, 0, 0, 0);
        p1 = __builtin_amdgcn_mfma_f32_32x32x16_bf16(kb[d0 & 1][1], qr[d0], p1, 0, 0, 0); }
    if (VAR != 9 && !ATT_ILV) { __builtin_amdgcn_sched_group_barrier(0x100, 2, 0);
#pragma unroll
    for (int d0 = 0; d0 < DQ; ++d0) { if (d0 + 1 < DQ) __builtin_amdgcn_sched_group_barrier(0x100, 2, 0); __builtin_amdgcn_sched_group_barrier(0x008, 2, 0); } }
#else
#pragma unroll
    for (int d0 = 0; d0 < DQ; ++d0) { const int cb = ((dbase + d0) * 16 + hi * 8) * 2;
        const bf16x8 b0 = *reinterpret_cast<const LAS bf16x8*>(Ks + KSWZ(r32, cb));
        const bf16x8 b1 = *reinterpret_cast<const LAS bf16x8*>(Ks + KSWZ(32 + r32, cb));
        p0 = __builtin_amdgcn_mfma_f32_32x32x16_bf16(b0, qr[d0], p0, 0, 0, 0);
        p1 = __builtin_amdgcn_mfma_f32_32x32x16_bf16(b1, qr[d0], p1, 0, 0, 0); }
#endif
}
__device__ __forceinline__ int v_st(int k, int c) { const int kk = (k & ~0xC) | ((k & 4) << 1) | ((k & 8) >> 1); return ((kk >> 3) * 4 + (c >> 5)) * 512 + ((kk & 7) * 32 + (c & 31)) * 2; }
__device__ __forceinline__ int v_rd_base(int lane) { return ((lane & 3) << 3) | (((lane >> 2) & 3) << 6) | (((lane >> 4) & 1) << 5) | (((lane >> 5) & 1) << 8); }
constexpr int v_rd_off(int d0, int ks, int half) { return d0 * 512 + ks * 4096 + half * 2048; }
template <int OFF> __device__ __forceinline__ s16x4 tr_read(int vb) {
    s16x4 r; asm volatile("ds_read_b64_tr_b16 %0, %1 offset:%2" : "=&v"(r) : "v"(vb), "i"(OFF) : "memory"); return r;
}
template <int D0> __device__ __forceinline__ void pv_one(f32x16& od, int vb, bf16x8 pa0, bf16x8 pa1, bf16x8 pa2, bf16x8 pa3) {
    const s16x4 l0 = tr_read<v_rd_off(D0, 0, 0)>(vb), h0 = tr_read<v_rd_off(D0, 0, 1)>(vb), l1 = tr_read<v_rd_off(D0, 1, 0)>(vb), h1 = tr_read<v_rd_off(D0, 1, 1)>(vb);
    const s16x4 l2 = tr_read<v_rd_off(D0, 2, 0)>(vb), h2 = tr_read<v_rd_off(D0, 2, 1)>(vb), l3 = tr_read<v_rd_off(D0, 3, 0)>(vb), h3 = tr_read<v_rd_off(D0, 3, 1)>(vb);
    asm volatile("s_waitcnt lgkmcnt(0)" ::: "memory"); SBAR();
#define PKV(L, H) (bf16x8){L[0], L[1], L[2], L[3], H[0], H[1], H[2], H[3]}
    od = __builtin_amdgcn_mfma_f32_32x32x16_bf16(pa0, PKV(l0, h0), od, 0, 0, 0);
    od = __builtin_amdgcn_mfma_f32_32x32x16_bf16(pa1, PKV(l1, h1), od, 0, 0, 0);
    od = __builtin_amdgcn_mfma_f32_32x32x16_bf16(pa2, PKV(l2, h2), od, 0, 0, 0);
    od = __builtin_amdgcn_mfma_f32_32x32x16_bf16(pa3, PKV(l3, h3), od, 0, 0, 0);
#undef PKV
}
__device__ __forceinline__ void pv_d0(f32x16* o, int vb, bf16x8 pa0, bf16x8 pa1, bf16x8 pa2, bf16x8 pa3) {
    pv_one<0>(o[0], vb, pa0, pa1, pa2, pa3); pv_one<1>(o[1], vb, pa0, pa1, pa2, pa3); pv_one<2>(o[2], vb, pa0, pa1, pa2, pa3); pv_one<3>(o[3], vb, pa0, pa1, pa2, pa3);
}

template <int D0> __device__ __forceinline__ void pv_one_b(f32x16& od, const LAS char* vp, bf16x8 pa0, bf16x8 pa1, bf16x8 pa2, bf16x8 pa3) {
#define TRB(OFF) __builtin_amdgcn_ds_read_tr16_b64_v4i16((LAS s16x4*)(vp + (OFF)))
    const s16x4 l0 = TRB(v_rd_off(D0, 0, 0)), h0 = TRB(v_rd_off(D0, 0, 1)), l1 = TRB(v_rd_off(D0, 1, 0)), h1 = TRB(v_rd_off(D0, 1, 1));
    const s16x4 l2 = TRB(v_rd_off(D0, 2, 0)), h2 = TRB(v_rd_off(D0, 2, 1)), l3 = TRB(v_rd_off(D0, 3, 0)), h3 = TRB(v_rd_off(D0, 3, 1));
#undef TRB
#define PKV(L, H) (bf16x8){L[0], L[1], L[2], L[3], H[0], H[1], H[2], H[3]}
    od = __builtin_amdgcn_mfma_f32_32x32x16_bf16(pa0, PKV(l0, h0), od, 0, 0, 0);
    od = __builtin_amdgcn_mfma_f32_32x32x16_bf16(pa1, PKV(l1, h1), od, 0, 0, 0);
    od = __builtin_amdgcn_mfma_f32_32x32x16_bf16(pa2, PKV(l2, h2), od, 0, 0, 0);
    od = __builtin_amdgcn_mfma_f32_32x32x16_bf16(pa3, PKV(l3, h3), od, 0, 0, 0);
#undef PKV
}
__device__ __forceinline__ void pv_d0_b(f32x16* o, const LAS char* vp, bf16x8 pa0, bf16x8 pa1, bf16x8 pa2, bf16x8 pa3) {
    pv_one_b<0>(o[0], vp, pa0, pa1, pa2, pa3); pv_one_b<1>(o[1], vp, pa0, pa1, pa2, pa3); pv_one_b<2>(o[2], vp, pa0, pa1, pa2, pa3); pv_one_b<3>(o[3], vp, pa0, pa1, pa2, pa3);
}
template <int NM, int NV> __device__ __forceinline__ void ilv_qk() {
    __builtin_amdgcn_sched_group_barrier(0x100, 4, 0);
#pragma unroll
    for (int i = 0; i < NM; ++i) { __builtin_amdgcn_sched_group_barrier(0x008, 1, 0); __builtin_amdgcn_sched_group_barrier(0x400, ATT_NE, 0); __builtin_amdgcn_sched_group_barrier(0x002, NV, 0); if ((i & 1) && i + 3 < NM) __builtin_amdgcn_sched_group_barrier(0x100, 2, 0); }
}
template <int NV> __device__ __forceinline__ void ilv_pv() {
    __builtin_amdgcn_sched_group_barrier(0x100, 8, 0);
#pragma unroll
    for (int i = 0; i < 16; ++i) { __builtin_amdgcn_sched_group_barrier(0x008, 1, 0); __builtin_amdgcn_sched_group_barrier(0x002, NV, 0); __builtin_amdgcn_sched_group_barrier(0x400, ATT_NE, 0); if (i < 12) __builtin_amdgcn_sched_group_barrier(0x100, 2, 0); }
}
__device__ __forceinline__ float vadd_pin(float a, float b) { float r; asm volatile("v_add_f32 %0, %1, %2" : "=v"(r) : "v"(a), "v"(b)); return r; }
__device__ __forceinline__ float vexp_pin(float a) { float r; asm volatile("v_exp_f32 %0, %1" : "=v"(r) : "v"(a)); return r; }
__device__ __forceinline__ void plswap_pin(unsigned& a, unsigned& b) { asm volatile("v_permlane32_swap_b32 %0, %1" : "+v"(a), "+v"(b)); }
template <int DQ>
__device__ __forceinline__ void qk_fin(f32x16& q0, f32x16& q1, const LAS char* Ks, const bf16x8* qr, int r32, int hi, int dbase,
                                       f32x16& p0, f32x16& p1, float alpha, float& l_reg, bf16x8& pa0, bf16x8& pa1, bf16x8& pa2, bf16x8& pa3) {
    q0 = f32x16{}; q1 = f32x16{};
    constexpr int SPM = 8 / DQ;
    bf16x8 ka, kc;
    { const int cb = (dbase * 16 + hi * 8) * 2; ka = *reinterpret_cast<const LAS bf16x8*>(Ks + KSWZ(r32, cb)); kc = *reinterpret_cast<const LAS bf16x8*>(Ks + KSWZ(32 + r32, cb)); }
    float psa = 0.f, psb = 0.f; unsigned c0 = 0, c1 = 0, c2 = 0, c3 = 0;
#define QF_PERM(OUT) do { plswap_pin(c0, c2); plswap_pin(c1, c3); u32x4 w_ = {c0, c1, c2, c3}; OUT = *reinterpret_cast<bf16x8*>(&w_); } while (0)
#define QF_CVT(P, B, k) do { const unsigned v_ = cvt_pk_bf16(P[(B) + 2 * (k)], P[(B) + 2 * (k) + 1]); if ((k) == 0) c0 = v_; else if ((k) == 1) c1 = v_; else if ((k) == 2) c2 = v_; else c3 = v_; } while (0)
#pragma unroll
    for (int d0 = 0; d0 < DQ; ++d0) {
        const int cbn = ((dbase + d0 + 1) * 16 + hi * 8) * 2;
#pragma unroll
        for (int h = 0; h < 2; ++h) {
            SBAR();
            if (h == 0) { q0 = __builtin_amdgcn_mfma_f32_32x32x16_bf16(ka, qr[d0], q0, 0, 0, 0); if (d0 + 1 < DQ) ka = *reinterpret_cast<const LAS bf16x8*>(Ks + KSWZ(r32, cbn)); }
            else        { q1 = __builtin_amdgcn_mfma_f32_32x32x16_bf16(kc, qr[d0], q1, 0, 0, 0); if (d0 + 1 < DQ) kc = *reinterpret_cast<const LAS bf16x8*>(Ks + KSWZ(32 + r32, cbn)); }
#pragma unroll
            for (int s_ = 0; s_ < SPM; ++s_) { const int i = (2 * d0 + h) * SPM + s_;
                p1[i] = vexp_pin(p1[i]); psa = vadd_pin(psa, p0[i]); if (i > 0) psb = vadd_pin(psb, p1[i - 1]);
                if (i < 4) QF_CVT(p0, 0, i); else if (i == 4) QF_PERM(pa0);
                else if (i < 9) QF_CVT(p0, 8, i - 5); else if (i == 9) QF_PERM(pa1);
                else if (i < 14) QF_CVT(p1, 0, i - 10); else if (i == 14) QF_PERM(pa2); }
        }
    }
    SBAR();
    psb += p1[15];
    QF_CVT(p1, 8, 0); QF_CVT(p1, 8, 1); QF_CVT(p1, 8, 2); QF_CVT(p1, 8, 3); QF_PERM(pa3);
    float ps = psa + psb;
    { auto rr = __builtin_amdgcn_permlane32_swap(__float_as_uint(ps), __float_as_uint(ps), false, false); ps = __uint_as_float(rr[0]) + __uint_as_float(rr[1]); }
    l_reg = l_reg * alpha + ps;
#undef QF_PERM
#undef QF_CVT
}
template <int KIND, bool G2, int VAR>
__device__ __forceinline__ void attn_unit_impl(const AUnit u, const bf16_t* __restrict__ P, bf16_t* __restrict__ O, unsigned char* __restrict__ O8  , LAS char* lds, float lam, float osc, const float* __restrict__ subln) {
    constexpr int DQ = KIND == 1 ? 4 : 8;
    int tz = threadIdx.x; asm volatile("" : "+v"(tz));
    const int tid = tz, wid = __builtin_amdgcn_readfirstlane(tid >> 6), lane = tid & 63, r32 = lane & 31, hi = lane >> 5;
    if (ATT_PRIO && wid >= 4) __builtin_amdgcn_s_setprio(1);
    LAS char* V_lds = lds; LAS char* K_lds = lds + 2 * SHM_V;
    LAS float* ws = (LAS float*)(lds + LDS_WS) + wid * 64; LAS float* li_l = ws; LAS float* al_l = ws + 32;
    float m_reg = VAR == 20 ? 0.f : -1e30f, l_reg = 0; f32x16 o[4] = {}; bf16x8 qr[DQ];
    const int wq = KIND == 1 ? (wid & 3) : wid, mp = KIND == 1 ? (wid >> 2) : 0, dbase = mp * 4;
    const bf16_t* Qw = P + (long)(u.qrow0 + wq * 32 + r32) * LDP + u.qcol + mp * 64 + hi * 8;
#pragma unroll
    for (int d0 = 0; d0 < DQ; ++d0) qr[d0] = *reinterpret_cast<const bf16x8*>(Qw + d0 * 16);
    const int sr = tid >> 4, sc = (tid & 15) * 8, vst0 = v_st(sr, sc), vst1 = v_st(32 + sr, sc);
    const int vb0 = (int)(unsigned)(size_t)V_lds + v_rd_base(lane);
    const int NT = 4 + u.nlat_t;
    const bf16_t* Kc = P + u.kcol + sc; const bf16_t* Vc = P + u.vcol + sc;
    struct { bf16x8 vs0, vs1, ks0, ks1; } sr_[2];
#define TROW(t) ((t) < 4 ? u.ctx_row0 + (t) * KVBLK : u.lat_row0 + ((t) - 4) * KVBLK)
#define SLOAD(i, t) do { if (VAR >= 5 && VAR <= 6 && (t) > 0) break; const long _r0 = (long)(TROW(t) + sr) * LDP, _r1 = _r0 + 32L * LDP; \
    sr_[i].vs0 = *reinterpret_cast<const bf16x8*>(Vc + _r0); sr_[i].vs1 = *reinterpret_cast<const bf16x8*>(Vc + _r1); \
    sr_[i].ks0 = *reinterpret_cast<const bf16x8*>(Kc + _r0); sr_[i].ks1 = *reinterpret_cast<const bf16x8*>(Kc + _r1); } while (0)
#define SWRITE(b, i) do { if (VAR == 6 && started) break; *(LAS bf16x8*)(V_lds + (b) * SHM_V + vst0) = sr_[i].vs0; *(LAS bf16x8*)(V_lds + (b) * SHM_V + vst1) = sr_[i].vs1; const int kc = sc * 2; \
    *(LAS bf16x8*)(K_lds + (b) * SHM_K + KSWZ(sr, kc)) = sr_[i].ks0; *(LAS bf16x8*)(K_lds + (b) * SHM_K + KSWZ(32 + sr, kc)) = sr_[i].ks1; } while (0)
#define SWAIT() asm volatile("s_waitcnt vmcnt(4)" ::: "memory")
#define RESC(a) do { if (VAR != 20 && __any((a) < 1.f)) { if (hi == 0) al_l[r32] = (a); asm volatile("s_waitcnt lgkmcnt(0)" ::: "memory"); \
    _Pragma("unroll") for (int d = 0; d < 4; ++d) _Pragma("unroll") for (int r = 0; r < 16; ++r) o[d][r] *= al_l[crow(r, hi)]; } } while (0)
    const int jq = u.dpos - (wq * 32 + r32);
#define JREL(t) (jq + ((t) - 4) * KVBLK)
#define PVD(vb) do { if (VAR == 10) { const s16x4 l0 = tr_read<v_rd_off(0, 0, 0)>(vb), h0 = tr_read<v_rd_off(0, 0, 1)>(vb), l1 = tr_read<v_rd_off(0, 1, 0)>(vb), h1 = tr_read<v_rd_off(0, 1, 1)>(vb); asm volatile("s_waitcnt lgkmcnt(0)" ::: "memory"); \
        const bf16x8 f0 = (bf16x8){l0[0], l0[1], l0[2], l0[3], h0[0], h0[1], h0[2], h0[3]}, f1 = (bf16x8){l1[0], l1[1], l1[2], l1[3], h1[0], h1[1], h1[2], h1[3]}; \
        _Pragma("unroll") for (int d_ = 0; d_ < 4; ++d_) { o[d_] = __builtin_amdgcn_mfma_f32_32x32x16_bf16(pa0, f0, o[d_], 0, 0, 0); o[d_] = __builtin_amdgcn_mfma_f32_32x32x16_bf16(pa1, f1, o[d_], 0, 0, 0); o[d_] = __builtin_amdgcn_mfma_f32_32x32x16_bf16(pa2, f0, o[d_], 0, 0, 0); o[d_] = __builtin_amdgcn_mfma_f32_32x32x16_bf16(pa3, f1, o[d_], 0, 0, 0); } } else if (VAR == 4) { const u32x4 a_ = *(const u32x4*)&pa0, b_ = *(const u32x4*)&pa1, c_ = *(const u32x4*)&pa2, d_ = *(const u32x4*)&pa3; const u32x4 x_ = a_ ^ b_ ^ c_ ^ d_; o[0][0] += __uint_as_float((x_.x ^ x_.y ^ x_.z ^ x_.w) & 0x3fffffffu) * 1e-30f; } else if (ATT_ILV) pv_d0_b(o, (const LAS char*)(size_t)0 + (vb), pa0, pa1, pa2, pa3); else pv_d0(o, vb, pa0, pa1, pa2, pa3); } while (0)
#define LSYNC() do { if (VAR != 7) __syncthreads(); } while (0)
    f32x16 pA0, pA1, pB0, pB1; float mnA, mnB, alA, alB; bf16x8 pa0, pa1, pa2, pa3;
    constexpr int SE = 0, SO = 1; bool started = false;
    SLOAD(SE, 0); asm volatile("s_waitcnt vmcnt(0)" ::: "memory"); SWRITE(0, SE); __syncthreads();
    qkt<DQ, VAR>(pA0, pA1, K_lds, qr, r32, hi, dbase); partialSM<KIND, VAR>(pA0, pA1, m_reg, mnA, alA, false, 0, hi);
    SLOAD(SO, 1); if (2 < NT) SLOAD(SE, 2);
    SWAIT(); SWRITE(1, SO); __syncthreads(); started = true;
    constexpr bool g2 = G2;
    for (int j = 1; j + 1 < NT; j += 2) {
        if (!g2) {
            if (ATT_ILV == 2 && (VAR == 0 || VAR == 8 || VAR == 20)) { SBAR(); qk_fin<DQ>(pB0, pB1, K_lds + SHM_K, qr, r32, hi, dbase, pA0, pA1, alA, l_reg, pa0, pa1, pa2, pa3); SBAR(); } else {
            SBAR(); qkt<DQ, VAR>(pB0, pB1, K_lds + SHM_K, qr, r32, hi, dbase);
            finishSM<VAR>(pA0, pA1, alA, l_reg, pa0, pa1, pa2, pa3); if (ATT_ILV == 1) ilv_qk<2 * DQ, ATT_NV>(); SBAR(); }
            SLOAD(SO, j + 2); SBAR();
            PVD(vb0); partialSM<KIND, VAR>(pB0, pB1, m_reg, mnB, alB, j >= 4, JREL(j), hi); if (ATT_ILV == 1) ilv_pv<ATT_NV>();
        } else {
            SBAR(); finishSM<VAR>(pA0, pA1, alA, l_reg, pa0, pa1, pa2, pa3); SBAR();
            qkt<DQ, VAR>(pB0, pB1, K_lds + SHM_K, qr, r32, hi, dbase); SLOAD(SO, j + 2); SBAR();
            partialSM<KIND, VAR>(pB0, pB1, m_reg, mnB, alB, j >= 4, JREL(j), hi); SBAR();
            PVD(vb0);
        }
        LSYNC(); SWAIT(); SWRITE(0, SE);
        RESC(alB); LSYNC();
        if (!g2) {
            if (ATT_ILV == 2 && (VAR == 0 || VAR == 8 || VAR == 20)) { SBAR(); qk_fin<DQ>(pA0, pA1, K_lds, qr, r32, hi, dbase, pB0, pB1, alB, l_reg, pa0, pa1, pa2, pa3); SBAR(); } else {
            SBAR(); qkt<DQ, VAR>(pA0, pA1, K_lds, qr, r32, hi, dbase);
            finishSM<VAR>(pB0, pB1, alB, l_reg, pa0, pa1, pa2, pa3); if (ATT_ILV == 1) ilv_qk<2 * DQ, ATT_NV>(); SBAR(); }
            if (j + 3 < NT) SLOAD(SE, j + 3); SBAR();
            PVD(vb0 + SHM_V); partialSM<KIND, VAR>(pA0, pA1, m_reg, mnA, alA, j + 1 >= 4, JREL(j + 1), hi); if (ATT_ILV == 1) ilv_pv<ATT_NV>();
        } else {
            SBAR(); finishSM<VAR>(pB0, pB1, alB, l_reg, pa0, pa1, pa2, pa3); SBAR();
            qkt<DQ, VAR>(pA0, pA1, K_lds, qr, r32, hi, dbase); if (j + 3 < NT) SLOAD(SE, j + 3); SBAR();
            partialSM<KIND, VAR>(pA0, pA1, m_reg, mnA, alA, j + 1 >= 4, JREL(j + 1), hi); SBAR();
            PVD(vb0 + SHM_V);
        }
        LSYNC(); SWAIT(); SWRITE(1, SO);
        RESC(alA); LSYNC();
    }
    SBAR(); qkt<DQ, VAR>(pB0, pB1, K_lds + SHM_K, qr, r32, hi, dbase);
    finishSM<VAR>(pA0, pA1, alA, l_reg, pa0, pa1, pa2, pa3); SBAR();
    PVD(vb0); partialSM<KIND, VAR>(pB0, pB1, m_reg, mnB, alB, NT - 1 >= 4, JREL(NT - 1), hi);
    __syncthreads(); RESC(alB);
    finishSM<VAR>(pB0, pB1, alB, l_reg, pa0, pa1, pa2, pa3); SBAR();
    PVD(vb0 + SHM_V);
    if (KIND == 2) l_reg += __builtin_amdgcn_exp2f(u.sink2 - m_reg);
    if (hi == 0) li_l[r32] = l_reg; asm volatile("s_waitcnt lgkmcnt(0)" ::: "memory");
    float rli[16];
#pragma unroll
    for (int r = 0; r < 16; ++r) rli[r] = __builtin_amdgcn_rcpf(li_l[crow(r, hi)]);
    const bool st_ok = VAR == 0 || VAR == 20 || u.sink2 == 1234.5f;
    if (KIND != 1) {
        if (!st_ok) {} else if (O8) {
#if ATT_WIDE_ST
            LAS unsigned char* stg = (LAS unsigned char*)K_lds + wid * 4096;
#pragma unroll
            for (int r = 0; r < 16; ++r) { const int orow = crow(r, hi);
#pragma unroll
                for (int d0 = 0; d0 < 4; ++d0) { const float v = o[d0][r] * rli[r]; stg[orow * 128 + d0 * 32 + r32] = (unsigned char)(__builtin_amdgcn_cvt_pk_fp8_f32(v, v, 0, false) & 0xff); } }
            asm volatile("s_waitcnt lgkmcnt(0)" ::: "memory");
            unsigned char* Og = O8 + (long)(u.qrow0 + wid * 32) * LDO + u.ocol;
#pragma unroll
            for (int j = 0; j < 4; ++j) { const int c = j * 64 + lane; const u32x4 w = *(const LAS u32x4*)(stg + c * 16); if (ATT_NT_ST) __builtin_nontemporal_store(w, (u32x4*)(Og + (long)(c >> 3) * LDO + (c & 7) * 16)); else *(u32x4*)(Og + (long)(c >> 3) * LDO + (c & 7) * 16) = w; }
#else
            unsigned char* Ow8 = O8 + (long)(u.qrow0 + wid * 32) * LDO + u.ocol + r32;
#pragma unroll
            for (int r = 0; r < 16; ++r) { const int orow = crow(r, hi);
#pragma unroll
                for (int d0 = 0; d0 < 4; ++d0) { const float v = o[d0][r] * rli[r]; Ow8[(long)orow * LDO + d0 * 32] = (unsigned char)(__builtin_amdgcn_cvt_pk_fp8_f32(v, v, 0, false) & 0xff); } }
#endif
        }
        else { bf16_t* Ow = O + (long)(u.qrow0 + wid * 32) * LDO + u.ocol + r32;
#pragma unroll
        for (int r = 0; r < 16; ++r) { const int orow = crow(r, hi);
#pragma unroll
            for (int d0 = 0; d0 < 4; ++d0) Ow[(long)orow * LDO + d0 * 32] = (bf16_t)(cvt_pk_bf16(o[d0][r] * rli[r], 0.f) & 0xffffu); } }
        __syncthreads();
    } else {
        __syncthreads();
        LAS float* X2 = (LAS float*)lds + (wid & 3) * 4096;
        if (wid >= 4) {
#pragma unroll
            for (int r = 0; r < 16; ++r) { const int orow = crow(r, hi);
#pragma unroll
                for (int d0 = 0; d0 < 4; ++d0) X2[orow * 128 + d0 * 32 + r32] = o[d0][r] * rli[r]; }
        }
        __syncthreads();
        if (wid < 4 && st_ok) {
            float ss[16];
#pragma unroll
            for (int r = 0; r < 16; ++r) { const int orow = crow(r, hi); float s = 0.f;
#pragma unroll
                for (int d0 = 0; d0 < 4; ++d0) { const float v = o[d0][r] * rli[r] - lam * X2[orow * 128 + d0 * 32 + r32]; o[d0][r] = v; s += v * v; }
                ss[r] = s; }
#pragma unroll
            for (int off = 1; off < 32; off <<= 1) {
#pragma unroll
                for (int r = 0; r < 16; ++r) ss[r] += shx(ss[r], lane, off); }
            float g4[4];
#pragma unroll
            for (int d0 = 0; d0 < 4; ++d0) g4[d0] = subln[d0 * 32 + r32] * osc;
#if ATT_WIDE_ST
            LAS bf16_t* stg = (LAS bf16_t*)X2;
#pragma unroll
            for (int r = 0; r < 16; ++r) { const int orow = crow(r, hi); const float rs = rsqrtf(ss[r] * (1.f / 128.f) + 1e-6f);
#pragma unroll
                for (int d0 = 0; d0 < 4; ++d0) stg[orow * 128 + d0 * 32 + r32] = (bf16_t)(cvt_pk_bf16(o[d0][r] * rs * g4[d0], 0.f) & 0xffffu); }
            asm volatile("s_waitcnt lgkmcnt(0)" ::: "memory");
            bf16_t* Og = O + (long)(u.qrow0 + wid * 32) * LDO + u.ocol;
#pragma unroll
            for (int j = 0; j < 8; ++j) { const int c = j * 64 + lane; const u32x4 w = *(const LAS u32x4*)((const LAS char*)stg + c * 16); if (ATT_NT_ST) __builtin_nontemporal_store(w, (u32x4*)(Og + (long)(c >> 4) * LDO + (c & 15) * 8)); else *(u32x4*)(Og + (long)(c >> 4) * LDO + (c & 15) * 8) = w; }
#else
            bf16_t* Ow = O + (long)(u.qrow0 + wid * 32) * LDO + u.ocol + r32;
#pragma unroll
            for (int r = 0; r < 16; ++r) { const int orow = crow(r, hi); const float rs = rsqrtf(ss[r] * (1.f / 128.f) + 1e-6f);
#pragma unroll
                for (int d0 = 0; d0 < 4; ++d0) Ow[(long)orow * LDO + d0 * 32] = (bf16_t)(cvt_pk_bf16(o[d0][r] * rs * g4[d0], 0.f) & 0xffffu); }
#endif
        }
        __syncthreads();
    }
#undef TROW
#undef SLOAD
#undef SWRITE
#undef SWAIT
#undef RESC
#undef JREL
#undef PVD
#undef LSYNC
    if (ATT_PRIO) __builtin_amdgcn_s_setprio(0);
}
template <int KIND, int VAR = 0>
__device__ __forceinline__ void attn_unit(const AUnit u, const bf16_t* __restrict__ P, bf16_t* __restrict__ O, unsigned char* __restrict__ O8, LAS char* lds, float lam, float osc, const float* __restrict__ subln) {
    const int wv_ = __builtin_amdgcn_readfirstlane((int)(threadIdx.x >> 6));
    if (ATT_STAGGER && (ATT_STAGGER == 1 ? wv_ >= 4 : ATT_STAGGER == 2 ? (wv_ & 1) : ((wv_ >> 1) & 1))) attn_unit_impl<KIND, true, VAR>(u, P, O, O8, lds, lam, osc, subln);
    else attn_unit_impl<KIND, false, VAR>(u, P, O, O8, lds, lam, osc, subln);
}
}
#define XB_TMO      128
#define XB_XCNT(j)  (256  + 64 * (j))
#define XB_XSUB(j)  (1280 + 64 * (j))
#define XB_XGEN(j)  (2304 + 64 * (j))
#define XB_TOP      3328
#define XB_TOPGEN   3392
#define XCD_BAR_WORDS 3456
#define XB_SPIN_CAP (1u << 18)
__device__ __forceinline__ unsigned xb_ld(unsigned* p)              { return __hip_atomic_load(p, __ATOMIC_RELAXED, __HIP_MEMORY_SCOPE_AGENT); }
__device__ __forceinline__ unsigned xb_add(unsigned* p, unsigned v) { return __hip_atomic_fetch_add(p, v, __ATOMIC_RELAXED, __HIP_MEMORY_SCOPE_AGENT); }
__device__ __forceinline__ unsigned xb_xcc_id() { return (unsigned)__builtin_amdgcn_s_getreg((3 << 11) | 20) & 0xFu; }
#define XB_SPIN(cond, bar) do { unsigned _sp = 0; while (cond) { __builtin_amdgcn_s_sleep(1); \
    if ((++_sp & 255u) == 0u) { if (xb_ld(&(bar)[XB_TMO])) break; if (_sp > XB_SPIN_CAP) { atomicAdd(&(bar)[XB_TMO], 1u); break; } } } } while (0)
struct XcdBarrier { unsigned* bar; unsigned x; volatile LAS unsigned* st; };
__device__ __forceinline__ XcdBarrier xcd_barrier_post(unsigned* bar, volatile LAS unsigned* st) {
    XcdBarrier b; b.bar = bar; b.x = xb_xcc_id(); b.st = st;
    if (threadIdx.x == 0) (void)xb_add(&bar[XB_XCNT(b.x)], 1u);
    return b;
}
__device__ __forceinline__ void xcd_barrier_complete(unsigned* bar, unsigned x, unsigned& nloc, unsigned& nx) {
    const unsigned G = gridDim.x * gridDim.y * gridDim.z;
    unsigned sum, cnt, mine, sp = 0u;
    for (;;) {
        sum = 0u; cnt = 0u; mine = 0u;
#pragma unroll
        for (unsigned j = 0; j < 16; ++j) { const unsigned c = xb_ld(&bar[XB_XCNT(j)]); sum += c; cnt += (c > 0u) ? 1u : 0u; mine = (j == x) ? c : mine; }
        if (sum == G) break;
        __builtin_amdgcn_s_sleep(1);
        if ((++sp & 255u) == 0u) { if (xb_ld(&bar[XB_TMO])) break; if (sp > XB_SPIN_CAP) { atomicAdd(&bar[XB_TMO], 1u); break; } }
    }
    nloc = mine > 0u ? mine : 1u; nx = cnt > 0u ? cnt : 1u;
}
__device__ __forceinline__ void xcd_barrier(const XcdBarrier& b) {
    asm volatile("s_waitcnt vmcnt(0)" ::: "memory");
    __syncthreads();
    if (threadIdx.x == 0) {
        unsigned* bar = b.bar;
        __builtin_amdgcn_s_waitcnt(0);
        unsigned nloc = b.st[0], nx = b.st[1];
        if (nloc == 0u) { xcd_barrier_complete(bar, b.x, nloc, nx); b.st[0] = nloc; b.st[1] = nx; }
        const unsigned old = xb_add(&bar[XB_XSUB(b.x)], 1u);
        const unsigned gen = old / nloc;
        if (old + 1u == (gen + 1u) * nloc) {
            __builtin_amdgcn_fence(__ATOMIC_RELEASE, "agent");
            asm volatile("s_waitcnt vmcnt(0)" ::: "memory");
            const unsigned og = xb_add(&bar[XB_TOP], 1u);
            const unsigned tg = og / nx;
            if (og + 1u == (tg + 1u) * nx) xb_add(&bar[XB_TOPGEN], 1u);
            else XB_SPIN(xb_ld(&bar[XB_TOPGEN]) == tg, bar);
            __builtin_amdgcn_fence(__ATOMIC_ACQUIRE, "agent");
            xb_add(&bar[XB_XGEN(b.x)], 1u);
            asm volatile("s_waitcnt vmcnt(0)" ::: "memory");
        } else {
            XB_SPIN(xb_ld(&bar[XB_XGEN(b.x)]) == gen, bar);
            __builtin_amdgcn_fence(__ATOMIC_ACQUIRE, "agent");
            asm volatile("s_waitcnt vmcnt(0)" ::: "memory");
        }
    }
    __syncthreads();
}

#ifndef FUSE_QK
#define FUSE_QK 1
#endif
#ifndef FP8_EXPERTS
#define FP8_EXPERTS 1
#endif
#ifndef FP8_AC
#define FP8_AC 1
#endif
#ifndef FP8_OUT
#define FP8_OUT 0
#endif
#ifndef FP8_BR
#define FP8_BR 1
#endif
#ifndef FP8_GATES
#define FP8_GATES 1
#endif
#ifndef CTX_CHAIN
#define CTX_CHAIN 1
#endif
#ifndef BG_CONV
#define BG_CONV 0
#endif
#ifndef FUSE_ROUTER
#define FUSE_ROUTER 0
#endif
#ifndef ROUTER_V3
#define ROUTER_V3 0
#endif
#ifndef CTX_GATES_IN_CHAIN
#define CTX_GATES_IN_CHAIN 1
#endif
namespace fk {
constexpr int DM = 2048, SEQ = 4096, CTXL = 256, NLAT = 8192, MROWS = 8704, INW = 10240, NEXP = 16, FF = 1024, MODW = 12288;
constexpr int EROWS = 1088, EPAD = 1280;
constexpr float EPS = 1e-6f, LOG2E = 1.4426950408889634f;
constexpr int NWAVES = 8, NTHR = 512;
constexpr size_t MiB = 1u << 20;
constexpr size_t WS_CTL = 0, CTL_ZERO_BYTES = 1 * MiB;
constexpr size_t WS_MODV = 512 * 1024  , WS_ROPE128 = 2 * MiB, WS_ROPE64 = 4 * MiB, WS_AFFT = 5 * MiB, WS_SEL = 6 * MiB, WS_GW = 7 * MiB, WS_BIASR = 7 * MiB + 128 * 1024  ;
constexpr size_t WS_H = 8 * MiB, WS_P = 42 * MiB, WS_XG = 42 * MiB, WS_ACT = 122 * MiB, WS_OATT = 212 * MiB, WS_MM = 246 * MiB, WS_Y = 212 * MiB, WS_X = 280 * MiB;
constexpr size_t WS_WIN8 = 588 * MiB  , WS_H8 = 640 * MiB  , WS_WBR8 = 660 * MiB  , WS_OATT8 = 672 * MiB  , WS_XCH = 692 * MiB  ;
static_assert(!FP8_GATES || FP8_EXPERTS, "WIN8 / H8 live in the half of the W1 region that the fp8 expert weights leave free");
constexpr size_t WS_WIN = 348 * MiB, WS_WBR = 428 * MiB, WS_WOUT = 444 * MiB, WS_W1 = 460 * MiB, WS_W2 = 716 * MiB, WS_END = 844 * MiB;
static_assert((size_t)MROWS * DM * 2 <= 34 * MiB && (size_t)MROWS * INW * 2 <= 170 * MiB && (size_t)16 * EPAD * DM * 2 <= 80 * MiB && (size_t)16 * EPAD * FF * 2 <= 40 * MiB &&
              (size_t)16 * EROWS * DM * 2 <= 68 * MiB && (size_t)MROWS * DM * 4 <= 68 * MiB, "d_ws map");
constexpr int CW_BAR = 4096;
constexpr int CW_QUEUE = 1024;
constexpr int CW_BGQ = 3520;
constexpr int CW_RP = 10240;
constexpr int CW_DONE = 8192;
constexpr int CW_CTX = 3200;
constexpr int RING_BYTES = 131072, LDS_BYTES = 147456, MISC_OFF = LDS_BYTES - 256;

typedef const float* cfp;
struct Args { cfp in[29]; float* out; unsigned char* ws; int ph_lo, ph_hi; };

template <int CTRL> __device__ __forceinline__ float dppm(float v) { return __uint_as_float((unsigned)__builtin_amdgcn_update_dpp(0, (int)__float_as_uint(v), CTRL, 0xf, 0xf, false)); }
__device__ __forceinline__ float xsum16(float v) { const auto rr = __builtin_amdgcn_permlane16_swap(__float_as_uint(v), __float_as_uint(v), false, false); return __uint_as_float(rr[0]) + __uint_as_float(rr[1]); }
__device__ __forceinline__ float xsum32(float v) { const auto rr = __builtin_amdgcn_permlane32_swap(__float_as_uint(v), __float_as_uint(v), false, false); return __uint_as_float(rr[0]) + __uint_as_float(rr[1]); }
__device__ __forceinline__ float row_sum16(float v) { v += dppm<0xB1>(v); v += dppm<0x4E>(v); v += dppm<0x141>(v); v += dppm<0x140>(v); return v; }
__device__ __forceinline__ float row_max16(float v) { v = fmaxf(v, dppm<0xB1>(v)); v = fmaxf(v, dppm<0x4E>(v)); v = fmaxf(v, dppm<0x141>(v)); v = fmaxf(v, dppm<0x140>(v)); return v; }
__device__ __forceinline__ float wave_sum(float v, int lane) { (void)lane; return xsum32(xsum16(row_sum16(v))); }
__device__ __forceinline__ float wave_max(float v, int lane) { (void)lane; v = row_max16(v);
    { const auto rr = __builtin_amdgcn_permlane16_swap(__float_as_uint(v), __float_as_uint(v), false, false); v = fmaxf(__uint_as_float(rr[0]), __uint_as_float(rr[1])); }
    { const auto rr = __builtin_amdgcn_permlane32_swap(__float_as_uint(v), __float_as_uint(v), false, false); v = fmaxf(__uint_as_float(rr[0]), __uint_as_float(rr[1])); }
    return v; }
__device__ __forceinline__ float sink_bound(const float* s6) { float m = 0.f;
#pragma unroll
    for (int i = 0; i < 6; ++i) m = fmaxf(m, fabsf(s6[i]) * 1.4426950408889634f);
    return m; }
__device__ __forceinline__ int modrow(int row) { return row < SEQ ? 0 : (row < NLAT ? 1 : 2); }

__host__ __device__ __forceinline__ int pos128(int d) { const int half = d >> 6, r = d & 63, n = r >> 5, r2 = r & 31, wcl = r2 >> 4, r3 = r2 & 15; return (half * 2 + wcl) * 32 + (r3 >> 2) * 8 + n * 4 + (r3 & 3); }
__host__ __device__ __forceinline__ int pos64(int d) { const int wcl = d >> 5, r = d & 31, n = r >> 4, r3 = r & 15; return wcl * 32 + (r3 >> 2) * 8 + n * 4 + (r3 & 3); }
#ifndef EPI_NT
#define EPI_NT 0
#endif
#ifndef CONV_NT
#define CONV_NT 1
#endif
#ifndef LDS_XPOSE_V2
#define LDS_XPOSE_V2 2
#endif
template <int MODE  > __device__ __forceinline__ void transpose_item(f32x4 (&v)[16], const float* __restrict__ W, int N, int k0, int n0, bf16_t* __restrict__ dst  , int ldd, int perm, LAS float* scr, int lane) {
    const int kq = lane >> 4, nq = lane & 15;
    if (MODE != 2) {
#pragma unroll
        for (int i = 0; i < 16; ++i) v[i] = __builtin_nontemporal_load((const f32x4*)(W + (size_t)(k0 + 4 * i + kq) * N + n0 + 4 * nq)); }
    if (MODE == 1) return;
#pragma unroll
    for (int i = 0; i < 16; ++i) {
#if LDS_XPOSE_V2
        *(LAS f32x4*)(scr + (4 * i + kq) * 64 + ((nq ^ (2 * (i >> 1))) << 2)) = v[i];
#else
        LAS float* s = scr + (4 * i + kq) * 65 + 4 * nq; s[0] = v[i][0]; s[1] = v[i][1]; s[2] = v[i][2]; s[3] = v[i][3];
#endif
    }
    asm volatile("s_waitcnt lgkmcnt(0)" ::: "memory");
#if LDS_XPOSE_V2 == 2
#pragma unroll
    for (int j = 0; j < 2; ++j) { const int c = lane & 7, ch = j * 8 + (lane >> 3); f32x4 x[8];
#pragma unroll
        for (int t = 0; t < 8; ++t) x[t] = *(const LAS f32x4*)(scr + (8 * c + t) * 64 + ((ch ^ (2 * c)) << 2));
#pragma unroll
        for (int e = 0; e < 4; ++e) { const int sc = n0 + 4 * ch + e; const int drow = perm == 0 ? sc : (perm == 1 ? (sc & ~127) + pos128(sc & 127) : (sc & ~63) + pos64(sc & 63));
            u32x4 o; o.x = cvt_pk_bf16(x[0][e], x[1][e]); o.y = cvt_pk_bf16(x[2][e], x[3][e]); o.z = cvt_pk_bf16(x[4][e], x[5][e]); o.w = cvt_pk_bf16(x[6][e], x[7][e]);
            if (CONV_NT) __builtin_nontemporal_store(o, (u32x4*)(dst + (size_t)drow * ldd + 8 * c)); else *(u32x4*)(dst + (size_t)drow * ldd + 8 * c) = o; } }
#else
#pragma unroll
    for (int j = 0; j < 8; ++j) { const int n = j * 8 + (lane >> 3), c = lane & 7;
#if LDS_XPOSE_V2
        const LAS float* s = scr + (8 * c) * 64 + (((n >> 2) ^ (2 * c)) << 2) + (n & 3); constexpr int PT = 64;
#else
        const LAS float* s = scr + (8 * c) * 65 + n; constexpr int PT = 65;
#endif
        const int sc = n0 + n; const int drow = perm == 0 ? sc : (perm == 1 ? (sc & ~127) + pos128(sc & 127) : (sc & ~63) + pos64(sc & 63));
        u32x4 o; o.x = cvt_pk_bf16(s[0 * PT], s[1 * PT]); o.y = cvt_pk_bf16(s[2 * PT], s[3 * PT]); o.z = cvt_pk_bf16(s[4 * PT], s[5 * PT]); o.w = cvt_pk_bf16(s[6 * PT], s[7 * PT]);
        *(u32x4*)(dst + (size_t)drow * ldd + 8 * c) = o; }
#endif
    asm volatile("s_waitcnt lgkmcnt(0)" ::: "memory");
}
template <int MODE> __device__ __forceinline__ void transpose_item_f8(f32x4 (&v)[16], const float* __restrict__ W, int N, int k0, int n0, unsigned char* __restrict__ dst  , int ldd, float mul, LAS float* scr, int lane, int perm = 0) {
    const int kq = lane >> 4, nq = lane & 15;
    if (MODE != 2) {
#pragma unroll
        for (int i = 0; i < 16; ++i) v[i] = __builtin_nontemporal_load((const f32x4*)(W + (size_t)(k0 + 4 * i + kq) * N + n0 + 4 * nq)); }
    if (MODE == 1) return;
#pragma unroll
    for (int i = 0; i < 16; ++i) {
#if LDS_XPOSE_V2
        *(LAS f32x4*)(scr + (4 * i + kq) * 64 + ((nq ^ (2 * (i >> 1))) << 2)) = v[i] * mul;
#else
        LAS float* s = scr + (4 * i + kq) * 65 + 4 * nq; s[0] = v[i][0] * mul; s[1] = v[i][1] * mul; s[2] = v[i][2] * mul; s[3] = v[i][3] * mul;
#endif
    }
    asm volatile("s_waitcnt lgkmcnt(0)" ::: "memory");
#if LDS_XPOSE_V2 == 2
    { const int c = lane & 3, ch = lane >> 2; f32x4 x[16];
#pragma unroll
        for (int t = 0; t < 16; ++t) x[t] = *(const LAS f32x4*)(scr + (16 * c + t) * 64 + ((ch ^ (4 * c + 2 * (t >> 3))) << 2));
#pragma unroll
        for (int e = 0; e < 4; ++e) { const int sc = n0 + 4 * ch + e; const int drow = perm == 0 ? sc : (perm == 1 ? (sc & ~127) + pos128(sc & 127) : (sc & ~63) + pos64(sc & 63));
            u32x4 o; o.x = pk4_fp8(x[0][e], x[1][e], x[2][e], x[3][e]); o.y = pk4_fp8(x[4][e], x[5][e], x[6][e], x[7][e]);
            o.z = pk4_fp8(x[8][e], x[9][e], x[10][e], x[11][e]); o.w = pk4_fp8(x[12][e], x[13][e], x[14][e], x[15][e]);
            if (CONV_NT) __builtin_nontemporal_store(o, (u32x4*)(dst + (size_t)drow * ldd + 16 * c)); else *(u32x4*)(dst + (size_t)drow * ldd + 16 * c) = o; } }
#else
#pragma unroll
    for (int j = 0; j < 4; ++j) { const int n = j * 16 + (lane >> 2), c = lane & 3;
#if LDS_XPOSE_V2
        const LAS float* s = scr + (16 * c) * 64 + (((n >> 2) ^ (4 * c)) << 2) + (n & 3); const LAS float* s2 = scr + (16 * c) * 64 + (((n >> 2) ^ (4 * c + 2)) << 2) + (n & 3); constexpr int PT = 64;
#else
        const LAS float* s = scr + (16 * c) * 65 + n; const LAS float* s2 = s; constexpr int PT = 65;
#endif
        u32x4 o; o.x = pk4_fp8(s[0 * PT], s[1 * PT], s[2 * PT], s[3 * PT]); o.y = pk4_fp8(s[4 * PT], s[5 * PT], s[6 * PT], s[7 * PT]);
        o.z = pk4_fp8(s2[8 * PT], s2[9 * PT], s2[10 * PT], s2[11 * PT]); o.w = pk4_fp8(s2[12 * PT], s2[13 * PT], s2[14 * PT], s2[15 * PT]);
        const int sc = n0 + n; const int drow = perm == 0 ? sc : (perm == 1 ? (sc & ~127) + pos128(sc & 127) : (sc & ~63) + pos64(sc & 63));
        *(u32x4*)(dst + (size_t)drow * ldd + 16 * c) = o; }
#endif
    asm volatile("s_waitcnt lgkmcnt(0)" ::: "memory");
}
__host__ __device__ __forceinline__ bool win_fp8_tile(int pn) { return FP8_GATES && (pn >= 16 || (FP8_AC && !(pn == 2 || pn == 3 || pn == 4 || pn == 5 || pn == 11 || pn == 12))); }
__host__ __device__ __forceinline__ int win_perm(int c) { return c < 256 ? 1 : c < 512 ? 0 : c < 1024 ? 2 : c < 1536 ? 0 : c < 1792 ? 1 : c < 2048 ? 0 : c < 2816 ? 1 : c < 3328 ? 2 : c < 4096 ? 1 : 0; }
constexpr int CV_I_IN = 32 * 160, CV_I_BRA = 12 * 32, CV_I_BRB = 8 * 32, CV_I_OUT = 32 * 32, CV_I_G = 32 * 16, CV_I_D = 16 * 32;
constexpr int CV_D1 = CV_I_IN + 2 * CV_I_BRA + CV_I_BRB + CV_I_OUT;
constexpr int CV_PER_L = CV_D1 + 16 * (2 * CV_I_G + CV_I_D);
template <int MODE> __device__ __forceinline__ void conv_item_m(f32x4 (&v)[16], const Args& A, int it, LAS float* scr, int lane) {
    unsigned char* ws = A.ws;
    constexpr int I_IN = CV_I_IN, I_BRA = CV_I_BRA, I_BRB = CV_I_BRB, I_OUT = CV_I_OUT, I_G = CV_I_G, I_D = CV_I_D, PER_L = CV_PER_L;
    {
        const int l = it / PER_L; int r = it % PER_L;
        if (r < I_IN) { const int kb = r / 160, nb = r % 160;
            if (win_fp8_tile(nb >> 2)) { transpose_item_f8<MODE>(v, A.in[8] + (size_t)l * DM * INW, INW, kb * 64, nb * 64, (unsigned char*)(ws + WS_WIN8) + ((size_t)l * INW) * DM + kb * 64, DM, 64.f, scr, lane, FUSE_QK ? win_perm(nb * 64) : 0); return; }
            transpose_item<MODE>(v, A.in[8] + (size_t)l * DM * INW, INW, kb * 64, nb * 64, (bf16_t*)(ws + WS_WIN) + ((size_t)l * INW) * DM + kb * 64, DM, FUSE_QK ? win_perm(nb * 64) : 0, scr, lane); return; } r -= I_IN;
        if (r < I_BRA) { const int kb = r / 32, nb = r % 32;
            if (FP8_BR) transpose_item_f8<MODE>(v, A.in[21] + (size_t)l * 768 * DM, DM, kb * 64, nb * 64, (unsigned char*)(ws + WS_WBR8) + ((size_t)l * DM) * DM + kb * 64, DM, 64.f, scr, lane);
            else transpose_item<MODE>(v, A.in[21] + (size_t)l * 768 * DM, DM, kb * 64, nb * 64, (bf16_t*)(ws + WS_WBR) + ((size_t)l * DM) * DM + kb * 64, DM, 0, scr, lane);
            return; } r -= I_BRA;
        if (r < I_BRB) { const int kb = r / 32, nb = r % 32; transpose_item<MODE>(v, A.in[22] + (size_t)l * 512 * DM, DM, kb * 64, nb * 64, (bf16_t*)(ws + WS_WBR) + ((size_t)l * DM) * DM + 768 + kb * 64, DM, 0, scr, lane); return; } r -= I_BRB;
        if (r < I_BRA) { const int kb = r / 32, nb = r % 32;
            if (FP8_BR) transpose_item_f8<MODE>(v, A.in[23] + (size_t)l * 768 * DM, DM, kb * 64, nb * 64, (unsigned char*)(ws + WS_WBR8) + ((size_t)l * DM) * DM + 1280 + kb * 64, DM, 64.f, scr, lane);
            else transpose_item<MODE>(v, A.in[23] + (size_t)l * 768 * DM, DM, kb * 64, nb * 64, (bf16_t*)(ws + WS_WBR) + ((size_t)l * DM) * DM + 1280 + kb * 64, DM, 0, scr, lane);
            return; } r -= I_BRA;
        if (r < I_OUT) { const int kb = r / 32, nb = r % 32;
            if (FP8_OUT) transpose_item_f8<MODE>(v, A.in[24] + (size_t)l * DM * DM, DM, kb * 64, nb * 64, (unsigned char*)(ws + WS_WOUT) + ((size_t)l * DM) * DM + kb * 64, DM, 64.f, scr, lane);
            else transpose_item<MODE>(v, A.in[24] + (size_t)l * DM * DM, DM, kb * 64, nb * 64, (bf16_t*)(ws + WS_WOUT) + ((size_t)l * DM) * DM + kb * 64, DM, 0, scr, lane);
            return; } r -= I_OUT;
        const int e = r / (2 * I_G + I_D); r %= (2 * I_G + I_D);
        if (r < 2 * I_G) { const int up = r / I_G; r %= I_G; const int kb = r / 16, nb = r % 16, f0 = nb * 64;
            const size_t drow0 = ((size_t)l * 16 + e) * 2048 + (f0 >> 7) * 256 + up * 128 + (f0 & 127) - f0;
            if (FP8_EXPERTS) transpose_item_f8<MODE>(v, A.in[26 + up] + ((size_t)l * 16 + e) * DM * FF, FF, kb * 64, f0, (unsigned char*)(ws + WS_W1) + drow0 * DM + kb * 64, DM, 64.f, scr, lane);
            else transpose_item<MODE>(v, A.in[26 + up] + ((size_t)l * 16 + e) * DM * FF, FF, kb * 64, f0, (bf16_t*)(ws + WS_W1) + drow0 * DM + kb * 64, DM, 0, scr, lane);
            return; }
        r -= 2 * I_G;
        { const int kb = r / 32, nb = r % 32;
          if (FP8_EXPERTS) transpose_item_f8<MODE>(v, A.in[28] + ((size_t)l * 16 + e) * FF * DM, DM, kb * 64, nb * 64, (unsigned char*)(ws + WS_W2) + (((size_t)l * 16 + e) * 2048) * FF + kb * 64, FF, 64.f, scr, lane);
          else transpose_item<MODE>(v, A.in[28] + ((size_t)l * 16 + e) * FF * DM, DM, kb * 64, nb * 64, (bf16_t*)(ws + WS_W2) + (((size_t)l * 16 + e) * 2048) * FF + kb * 64, FF, 0, scr, lane); }
    }
}
__device__ __forceinline__ void conv_item(const Args& A, int it, LAS float* scr, int lane) { f32x4 v[16]; conv_item_m<0>(v, A, it, scr, lane); }
__device__ __forceinline__ void bg_loop(const Args& A, LAS unsigned char* lds, unsigned* ctl, volatile LAS unsigned* MISC, int seam, int force_upto, int G) {
    int tz = threadIdx.x; asm volatile("" : "+v"(tz)); const int tid = tz, lane = tz & 63, wave = __builtin_amdgcn_readfirstlane(tz >> 6);
    LAS float* scr = (LAS float*)(lds + wave * 16640);
    unsigned* bgq = ctl + CW_BGQ; unsigned* done = ctl + CW_DONE + 64 * seam;
    __syncthreads();
    if (tid == 0) (void)xb_add(done, 1u);
    for (;;) {
        if (tid == 0) { unsigned base = 0xffffffffu; const unsigned head = xb_ld(bgq);
            if (head < (unsigned)CV_PER_L && (head < (unsigned)force_upto || xb_ld(done) < (unsigned)G)) base = xb_add(bgq, 8u);
            MISC[1] = base; }
        __syncthreads();
        const unsigned base = MISC[1];
        __syncthreads();
        if (base >= (unsigned)CV_PER_L) break;
        const int item = (int)base + wave; if (item < CV_PER_L) conv_item(A, CV_PER_L + item, scr, lane);
    }
}
__device__ __forceinline__ void p0_prologue(const Args& A, LAS unsigned char* lds, int wave, int lane, int gw, int NGW, int n_items) {
    unsigned char* ws = A.ws;
    LAS float* scr = (LAS float*)(lds + wave * 16640);
    for (int it = gw; it < n_items; it += NGW) conv_item(A, it, scr, lane);
    float* r128 = (float*)(ws + WS_ROPE128); float* r64 = (float*)(ws + WS_ROPE64);
    for (int i = gw * 64 + lane; i < 4096 * 64; i += NGW * 64) { const int t = i >> 6, j = i & 63, q = j & 31, pos = j < 32 ? (t >> 6) : (t & 63);
        const float ang = (float)pos * powf(10000.f, -(float)(2 * q) / 64.f); r128[2 * i] = cosf(ang); r128[2 * i + 1] = sinf(ang); }
    for (int i = gw * 64 + lane; i < 4096 * 32; i += NGW * 64) { const int t = i >> 5, j = i & 31, q = j & 15, pos = j < 16 ? (t >> 6) : (t & 63);
        const float ang = (float)pos * powf(10000.f, -(float)(2 * q) / 32.f); r64[2 * i] = cosf(ang); r64[2 * i + 1] = sinf(ang); }
}
__device__ __forceinline__ void p0_convert_dyn2(const Args& A, LAS unsigned char* lds, unsigned* q, volatile LAS unsigned* MISC, int tid, int wave, int lane, int n_items, int item0) {
    LAS float* scr = (LAS float*)(lds + wave * 16640);
    unsigned nxt = 0u; if (tid == 0) nxt = xb_add(q, 16u);
    for (;;) {
        if (tid == 0) MISC[2] = nxt;
        __syncthreads();
        const unsigned base = MISC[2];
        if (base >= (unsigned)n_items) break;
        if (tid == 0) nxt = xb_add(q, 16u);
        const int ia = (int)base + wave, ib = ia + 8; f32x4 va[16], vb[16];
        if (ia < n_items) conv_item_m<1>(va, A, item0 + ia, scr, lane);
        if (ib < n_items) conv_item_m<1>(vb, A, item0 + ib, scr, lane);
        if (ia < n_items) conv_item_m<2>(va, A, item0 + ia, scr, lane);
        if (ib < n_items) conv_item_m<2>(vb, A, item0 + ib, scr, lane);
        __syncthreads();
    }
    __syncthreads();
}
__device__ __forceinline__ void p0_convert_dyn3(const Args& A, LAS unsigned char* lds, unsigned* q, volatile LAS unsigned* MISC, int tid, int wave, int lane, int n_items, int item0) {
    LAS float* scr = (LAS float*)(lds + wave * 16640);
    if (tid == 0) { const unsigned c0 = xb_add(q, 16u); const unsigned c1 = xb_add(q, 16u); MISC[2] = c0; MISC[3] = c1; }
    __syncthreads();
    unsigned cur = MISC[2], nx = MISC[3];
    __syncthreads();
    f32x4 va[16], vb[16];
    if (cur < (unsigned)n_items) { conv_item_m<1>(va, A, item0 + (int)cur + wave, scr, lane); conv_item_m<1>(vb, A, item0 + (int)cur + 8 + wave, scr, lane); }
    for (;;) {
        if (cur >= (unsigned)n_items) break;
        unsigned claim = 0u; if (tid == 0) claim = xb_add(q, 16u);
        const bool more = nx < (unsigned)n_items;
        conv_item_m<2>(va, A, item0 + (int)cur + wave, scr, lane);     if (more) conv_item_m<1>(va, A, item0 + (int)nx + wave, scr, lane);
        conv_item_m<2>(vb, A, item0 + (int)cur + 8 + wave, scr, lane); if (more) conv_item_m<1>(vb, A, item0 + (int)nx + 8 + wave, scr, lane);
        if (tid == 0) MISC[2] = claim;
        __syncthreads();
        cur = nx; nx = MISC[2];
        __syncthreads();
    }
    __syncthreads();
}
__device__ __forceinline__ void p0_convert_dyn(const Args& A, LAS unsigned char* lds, unsigned* q, volatile LAS unsigned* MISC, int tid, int wave, int lane, int n_items, int item0 = 0) {
    LAS float* scr = (LAS float*)(lds + wave * 16640);
    unsigned nxt = 0u; if (tid == 0) nxt = xb_add(q, 8u);
    for (;;) {
        if (tid == 0) MISC[2] = nxt;
        __syncthreads();
        const unsigned base = MISC[2];
        if (base >= (unsigned)n_items) break;
        if (tid == 0) nxt = xb_add(q, 8u);
        const int item = (int)base + wave; if (item < n_items) conv_item(A, item0 + item, scr, lane);
        __syncthreads();
    }
    __syncthreads();
}
__device__ __forceinline__ void p0_modv(const Args& A, LAS unsigned char* lds, int tid, int lane, int wave, int wg, int G, int job0 = 0, int job1 = 2 * 96) {
    LAS float* sv = (LAS float*)lds;
    LAS float* part = (LAS float*)(lds + 24576);
    for (int i = tid; i < 3 * DM; i += NTHR) { const int r = i / DM, k = i % DM; const float v = r < 2 ? A.in[1][r * DM + k] : A.in[3][k]; sv[i] = v / (1.f + expf(-v)); }
    __syncthreads();
    float* modv = (float*)(A.ws + WS_MODV);
    for (int job = job0 + wg; job < job1; job += G) {
        const int l = job / 96, cg = job % 96, j = cg * 128 + lane * 2;
        const float* w = A.in[4] + (size_t)l * DM * MODW + (size_t)(wave * 256) * MODW + j;
        f32x2 a0 = {0.f, 0.f}, a1 = a0, a2 = a0;
#pragma unroll 16
        for (int k = 0; k < 256; ++k) { const f32x2 wv = __builtin_nontemporal_load((const f32x2*)(w + (size_t)k * MODW)); const int kk = wave * 256 + k; a0 = a0 + wv * sv[kk]; a1 = a1 + wv * sv[DM + kk]; a2 = a2 + wv * sv[2 * DM + kk]; }
        LAS float* pw = part + wave * 384 + lane * 2;
        pw[0] = a0[0]; pw[1] = a0[1]; pw[128] = a1[0]; pw[129] = a1[1]; pw[256] = a2[0]; pw[257] = a2[1];
        __syncthreads();
        if (wave < 3) { float s0 = 0.f, s1 = 0.f;
#pragma unroll
            for (int q = 0; q < 8; ++q) { s0 += part[q * 384 + wave * 128 + lane * 2]; s1 += part[q * 384 + wave * 128 + lane * 2 + 1]; }
            const f32x2 bb = *(const f32x2*)(A.in[5] + l * MODW + j);
            *(f32x2*)(modv + (size_t)(l * 3 + wave) * MODW + j) = (f32x2){s0 + bb[0], s1 + bb[1]}; }
        __syncthreads();
    }
}

__device__ __forceinline__ float treduce16(const float (&v)[16], int lane) {
    const bool b3 = (lane & 8) != 0, b2 = (lane & 4) != 0;
    float a[8], b[4], c[2];
#pragma unroll
    for (int i = 0; i < 8; ++i) { const auto rr = __builtin_amdgcn_permlane32_swap(__float_as_uint(v[i]), __float_as_uint(v[i + 8]), false, false); a[i] = __uint_as_float(rr[0]) + __uint_as_float(rr[1]); }
#pragma unroll
    for (int i = 0; i < 4; ++i) { const auto rr = __builtin_amdgcn_permlane16_swap(__float_as_uint(a[i]), __float_as_uint(a[i + 4]), false, false); b[i] = __uint_as_float(rr[0]) + __uint_as_float(rr[1]); }
#pragma unroll
    for (int i = 0; i < 2; ++i) { const float keep = b3 ? b[i + 2] : b[i], send = b3 ? b[i] : b[i + 2]; c[i] = keep + dppm<0x128>(send); }
    const float keep = b2 ? c[1] : c[0], send = b2 ? c[0] : c[1]; float d = keep + dppm<0x141>(send);
    d += dppm<0x4E>(d); d += dppm<0xB1>(d); return d;
}
template <int MODE  >
__device__ __forceinline__ void row_phase_a(const Args& A, int l, int lane, int gw, int NGW) {
    unsigned char* ws = A.ws; float* X = (float*)(ws + WS_X); bf16_t* H = (bf16_t*)(ws + WS_H); const bf16_t* Y = (const bf16_t*)(ws + WS_Y); const int* SEL = (const int*)(ws + WS_SEL);
    const float* modv = (const float*)(ws + WS_MODV);
    const int nrows = MODE == 2 ? NLAT : MROWS;
    if ((ROUTER_V3 || FUSE_ROUTER) && MODE != 2 && gw < 3) {
        const float* sh2 = modv + (size_t)(l * 3 + gw) * MODW + 3 * DM; const float* wr = A.in[25] + (size_t)l * DM * 16; float pb[16];
#pragma unroll
        for (int e = 0; e < 16; ++e) pb[e] = 0.f;
        for (int i = 0; i < 32; ++i) { const int k = lane + 64 * i; const float s = sh2[k];
#pragma unroll
            for (int q = 0; q < 4; ++q) { const f32x4 w4 = *(const f32x4*)(wr + (size_t)k * 16 + 4 * q); pb[4 * q] += s * w4[0]; pb[4 * q + 1] += s * w4[1]; pb[4 * q + 2] += s * w4[2]; pb[4 * q + 3] += s * w4[3]; } }
        const float bt = treduce16(pb, lane);
        if ((lane & 3) == 0) ((float*)(ws + WS_BIASR))[(l * 3 + gw) * 16 + (lane >> 2)] = bt;
    }
#ifndef CONV_IN_EXP
#define CONV_IN_EXP 0
#endif
#ifndef CONV_EXP_PART1
#define CONV_EXP_PART1 4352
#endif
#ifndef MODV1_IN_ATT
#define MODV1_IN_ATT 0
#endif
#ifndef P0_DYN
#define P0_DYN 1
#endif
#ifndef CONV_IN_ATT
#define CONV_IN_ATT 2
#endif
#ifndef ROW_NTL
#define ROW_NTL 0
#endif
#ifndef ROW_NT
#define ROW_NT 0
#endif
#ifndef NORM_EVEN
#define NORM_EVEN 1
#endif
    const bool evn = NORM_EVEN && NGW == 2048 && nrows == 256 * 34;
    const int r_lo = evn ? (gw >> 3) * 34 + (gw & 7) : gw, r_hi = evn ? (gw >> 3) * 34 + 34 : nrows, r_st = evn ? 8 : NGW;
    for (int row = r_lo; row < r_hi; row += r_st) {
        f32x4 v[8];
        if (MODE == 0) { const float* src = row < NLAT ? A.in[0] + (size_t)row * DM : A.in[2] + (size_t)(row - NLAT) * DM;
#pragma unroll
            for (int i = 0; i < 8; ++i) v[i] = *(const f32x4*)(src + (lane + 64 * i) * 4); }
        else {
            const float* xr = X + (size_t)row * DM;
#pragma unroll
            for (int i = 0; i < 8; ++i) v[i] = ROW_NTL ? __builtin_nontemporal_load((const f32x4*)(xr + (lane + 64 * i) * 4)) : *(const f32x4*)(xr + (lane + 64 * i) * 4);
            const float* g2 = modv + (size_t)((l - 1) * 3 + modrow(row)) * MODW + 5 * DM;
            f32x4 acc[8];
#pragma unroll
            for (int i = 0; i < 8; ++i) acc[i] = (f32x4){0.f, 0.f, 0.f, 0.f};
            const int mysel = lane < 16 ? SEL[(size_t)row * 16 + lane] : -1;
            for (int e = 0; e < 16; ++e) { const int slot = __builtin_amdgcn_readlane(mysel, e); if (slot < 0) continue;
                const bf16_t* yr = Y + ((size_t)e * EROWS + slot) * DM;
#pragma unroll
                for (int i = 0; i < 8; ++i) { const u32x2 w = ROW_NTL ? __builtin_nontemporal_load((const u32x2*)(yr + (lane + 64 * i) * 4)) : *(const u32x2*)(yr + (lane + 64 * i) * 4); acc[i][0] += bf_lo(w.x); acc[i][1] += bf_hi(w.x); acc[i][2] += bf_lo(w.y); acc[i][3] += bf_hi(w.y); } }
#pragma unroll
            for (int i = 0; i < 8; ++i) { const f32x4 g = *(const f32x4*)(g2 + (lane + 64 * i) * 4); v[i] = v[i] + g * acc[i]; }
            float* dst = MODE == 2 ? A.out + (size_t)row * DM : X + (size_t)row * DM;
#pragma unroll
            for (int i = 0; i < 8; ++i) { if (ROW_NT) __builtin_nontemporal_store(v[i], (f32x4*)(dst + (lane + 64 * i) * 4)); else *(f32x4*)(dst + (lane + 64 * i) * 4) = v[i]; }
        }
        if (MODE == 2) continue;
        float ss = 0.f;
#pragma unroll
        for (int i = 0; i < 8; ++i) ss += (v[i][0] * v[i][0] + v[i][1] * v[i][1]) + (v[i][2] * v[i][2] + v[i][3] * v[i][3]);
        const float rstd = rsqrtf(wave_sum(ss, lane) * (1.f / DM) + EPS);
        const float* mv = modv + (size_t)(l * 3 + modrow(row)) * MODW; const float* gain = A.in[6] + l * DM;
#pragma unroll
        for (int i = 0; i < 8; ++i) { const int c = (lane + 64 * i) * 4; const f32x4 g = *(const f32x4*)(gain + c), sh = *(const f32x4*)(mv + c), sc = *(const f32x4*)(mv + DM + c);
            const f32x4 h = v[i] * rstd * g * (sc + 1.f) + sh; u32x2 w; w.x = cvt_pk_bf16(h[0], h[1]); w.y = cvt_pk_bf16(h[2], h[3]); if (ROW_NT) __builtin_nontemporal_store(w, (u32x2*)(H + (size_t)row * DM + c)); else *(u32x2*)(H + (size_t)row * DM + c) = w;
            if (FP8_GATES) { const unsigned q8 = pk4_fp8(h[0], h[1], h[2], h[3]); if (ROW_NT) __builtin_nontemporal_store(q8, (unsigned*)((unsigned char*)(ws + WS_H8) + (size_t)row * DM + c)); else *(unsigned*)((unsigned char*)(ws + WS_H8) + (size_t)row * DM + c) = q8; } }
    }
}
#ifndef ROUTER_PK
#define ROUTER_PK 1
#endif
#ifndef ROUTER_PROBE
#define ROUTER_PROBE 0
#endif
__device__ __forceinline__ void row_phase_g(const Args& A, LAS unsigned char* lds, int l, int tid, int lane, int wave, int wg, int G, bool prb = false) {
    unsigned char* ws = A.ws; const float* X = (const float*)(ws + WS_X); bf16_t* H = (bf16_t*)(ws + WS_H); float* AFFT = (float*)(ws + WS_AFFT);
    const float* modv = (const float*)(ws + WS_MODV); const float* wr = A.in[25] + (size_t)l * DM * 16; const float* gain = A.in[7] + l * DM;
    LAS float* part = (LAS float*)lds;
    LAS float* biasp = part + 2 * 640;
    const int k0 = wave * 256 + lane * 4;
    const int ecode = ((lane >> 5) & 1) * 8 + ((lane >> 4) & 1) * 4 + ((lane >> 3) & 1) * 2 + ((lane >> 2) & 1);
    float Wl[4][16], gsc[4], sh[4]; float bias_e = 0.f; int cur_mr = -1;
    const int ngr = MROWS / 4, gq = ngr / G, grm = ngr % G, g0 = wg < grm ? wg * (gq + 1) : grm * (gq + 1) + (wg - grm) * gq; (void)g0;
    const bool even = (G == 256) && (MROWS == 256 * 34);
    const int rbase = even ? wg * 34 : 4 * g0, nri = (ROUTER_PROBE == 6 && prb) ? 0 : (ROUTER_PROBE >= 4 && prb) ? 4 : (even ? 34 : 4 * (wg < grm ? gq + 1 : gq));
#define RG_ROW(i) (rbase + (i))
    f32x4 xq[4], xnq[4];
#pragma unroll
    for (int j = 0; j < 4; ++j) { xnq[j] = (f32x4){0.f, 0.f, 0.f, 0.f}; if (j < nri) xnq[j] = (ROW_NTL ? __builtin_nontemporal_load((const f32x4*)(X + (size_t)RG_ROW(j) * DM + k0)) : *(const f32x4*)(X + (size_t)RG_ROW(j) * DM + k0)); }
    __syncthreads();
    for (int i0 = 0; i0 < nri; i0 += 4) {
#pragma unroll
        for (int j = 0; j < 4; ++j) { xq[j] = xnq[j]; if (i0 + 4 + j < nri && !(ROUTER_PROBE == 3 && prb)) xnq[j] = (ROW_NTL ? __builtin_nontemporal_load((const f32x4*)(X + (size_t)RG_ROW(i0 + 4 + j) * DM + k0)) : *(const f32x4*)(X + (size_t)RG_ROW(i0 + 4 + j) * DM + k0)); }
        const int mr = modrow(RG_ROW(i0));
        if (mr != cur_mr) {
            cur_mr = mr; const float* mv = modv + (size_t)(l * 3 + mr) * MODW;
            const f32x4 g4 = *(const f32x4*)(gain + k0), sh4 = *(const f32x4*)(mv + 3 * DM + k0), sc4 = *(const f32x4*)(mv + 4 * DM + k0);
            float pb[16];
#pragma unroll
            for (int e = 0; e < 16; ++e) pb[e] = 0.f;
#pragma unroll
            for (int jj = 0; jj < 4; ++jj) { gsc[jj] = g4[jj] * (1.f + sc4[jj]); sh[jj] = sh4[jj];
#pragma unroll
                for (int q = 0; q < 4; ++q) { f32x4 w4; if (ROUTER_PROBE == 5 && prb) w4 = (f32x4){0.01f * jj, 0.02f, 0.03f * q, 0.04f}; else w4 = *(const f32x4*)(wr + (size_t)(k0 + jj) * 16 + 4 * q);
#pragma unroll
                    for (int t = 0; t < 4; ++t) { Wl[jj][4 * q + t] = gsc[jj] * w4[t]; pb[4 * q + t] += sh[jj] * w4[t]; } } }
            const float bt = treduce16(pb, lane);
            __syncthreads();
            if ((lane & 3) == 0) biasp[wave * 16 + ecode] = bt;
            __syncthreads();
            bias_e = 0.f;
            if (lane < 16) {
#pragma unroll
                for (int w = 0; w < 8; ++w) bias_e += biasp[w * 16 + lane]; }
        }
        LAS float* pp = part + ((i0 >> 2) & 1) * 640;
#pragma unroll
        for (int j = 0; j < 4; ++j) {
            const f32x4 x = xq[j]; float pl[16];
#if ROUTER_PK
            {
                const f32x2 x0 = {x[0], x[0]}, x1 = {x[1], x[1]}, x2 = {x[2], x[2]}, x3 = {x[3], x[3]};
#pragma unroll
                for (int e2 = 0; e2 < 8; ++e2) { const f32x2 w0 = {Wl[0][2 * e2], Wl[0][2 * e2 + 1]}, w1 = {Wl[1][2 * e2], Wl[1][2 * e2 + 1]}, w2 = {Wl[2][2 * e2], Wl[2][2 * e2 + 1]}, w3 = {Wl[3][2 * e2], Wl[3][2 * e2 + 1]};
                    f32x2 a = x0 * w0; a = __builtin_elementwise_fma(x1, w1, a); a = __builtin_elementwise_fma(x2, w2, a); a = __builtin_elementwise_fma(x3, w3, a); pl[2 * e2] = a[0]; pl[2 * e2 + 1] = a[1]; } }
#else
#pragma unroll
            for (int e = 0; e < 16; ++e) pl[e] = x[0] * Wl[0][e] + x[1] * Wl[1][e] + x[2] * Wl[2][e] + x[3] * Wl[3][e];
#endif
            float pt; if (ROUTER_PROBE == 1 && prb) pt = pl[lane & 15]; else pt = treduce16(pl, lane);
            const float ssw = wave_sum((x[0] * x[0] + x[1] * x[1]) + (x[2] * x[2] + x[3] * x[3]), lane);
            if ((lane & 3) == 0) pp[(j * 8 + wave) * 20 + ecode] = pt;
            if (lane == 0) pp[(j * 8 + wave) * 20 + 16] = ssw;
        }
        __syncthreads();
#pragma unroll
        for (int j = 0; j < 4; ++j) {
            if (i0 + j >= nri) break;
            const int row = RG_ROW(i0 + j); const f32x4 x = xq[j];
            float sst = 0.f;
#pragma unroll
            for (int w = 0; w < 8; ++w) sst += pp[(j * 8 + w) * 20 + 16];
            const float rstd = rsqrtf(sst * (1.f / DM) + EPS);
            { u32x2 w2; w2.x = cvt_pk_bf16(x[0] * rstd * gsc[0] + sh[0], x[1] * rstd * gsc[1] + sh[1]); w2.y = cvt_pk_bf16(x[2] * rstd * gsc[2] + sh[2], x[3] * rstd * gsc[3] + sh[3]);
              if (!(ROUTER_PROBE == 2 && prb)) { if (ROW_NT) __builtin_nontemporal_store(w2, (u32x2*)(H + (size_t)row * DM + k0)); else *(u32x2*)(H + (size_t)row * DM + k0) = w2; } }
            if (wave == j) {
                float t = 0.f;
                if (lane < 16) {
#pragma unroll
                    for (int w = 0; w < 8; ++w) t += pp[(j * 8 + w) * 20 + lane]; }
                const float logit = lane < 16 ? rstd * t + bias_e : -3.0e38f;
                const float mx = row_max16(logit);
                const float ex = lane < 16 ? expf(logit - mx) : 0.f; const float s = row_sum16(ex);
                if (lane < 16) AFFT[(size_t)lane * MROWS + row] = ex / s;
            }
        }
    }
    __syncthreads();
}
#undef RG_ROW
__device__ __forceinline__ void row_phase_g3(const Args& A, LAS unsigned char* lds, int l, int tid, int lane, int wave, int wg, int G) {
    unsigned char* ws = A.ws; const float* X = (const float*)(ws + WS_X); bf16_t* H = (bf16_t*)(ws + WS_H); float* AFFT = (float*)(ws + WS_AFFT);
    const float* modv = (const float*)(ws + WS_MODV); const float* wr = A.in[25] + (size_t)l * DM * 16; const float* gain = A.in[7] + l * DM; const float* biasr = (const float*)(ws + WS_BIASR) + l * 48;
    LAS f32x4* Wl = (LAS f32x4*)lds;
    const int ngr = MROWS / 4, gq = ngr / G, grm = ngr % G, g0 = wg < grm ? wg * (gq + 1) : grm * (gq + 1) + (wg - grm) * gq, nrows = 4 * (wg < grm ? gq + 1 : gq), row0 = 4 * g0;
    const int ecode = lane >> 2;
    int cur_mr = -1; f32x4 gsc[8], sh[8]; float bias_e = 0.f;
    f32x4 xn[8];
    { const int r = row0 + wave; if (wave < nrows) {
#pragma unroll
        for (int i = 0; i < 8; ++i) xn[i] = *(const f32x4*)(X + (size_t)r * DM + (lane + 64 * i) * 4); } }
    for (int rb = 0; rb < nrows; rb += 8) {
        const int mr_lo = modrow(row0 + rb), mr_hi = modrow(row0 + (rb + 7 < nrows ? rb + 7 : nrows - 1));
        for (int pass = 0; pass < (mr_lo == mr_hi ? 1 : 2); ++pass) {
            const int mr = pass == 0 ? mr_lo : mr_hi;
            if (mr != cur_mr) {
                cur_mr = mr; const float* mv = modv + (size_t)(l * 3 + mr) * MODW;
                __syncthreads();
                for (int t = tid; t < 8192; t += NTHR) { const int ln = t & 63, q = (t >> 6) & 3, j = (t >> 8) & 3, i = t >> 10, k = 4 * (ln + 64 * i) + j;
                    const float g = gain[k] * (1.f + mv[4 * DM + k]); const f32x4 w4 = *(const f32x4*)(wr + (size_t)k * 16 + 4 * q); Wl[t] = w4 * g; }
#pragma unroll
                for (int i = 0; i < 8; ++i) { const int c = (lane + 64 * i) * 4; const f32x4 g4 = *(const f32x4*)(gain + c), sc4 = *(const f32x4*)(mv + 4 * DM + c); gsc[i] = g4 * (sc4 + 1.f); sh[i] = *(const f32x4*)(mv + 3 * DM + c); }
                bias_e = biasr[mr * 16 + ecode];
                __syncthreads();
            }
            const int ri = rb + wave; const bool mine = ri < nrows && modrow(row0 + ri) == mr && (pass == 0 || mr_lo != mr_hi);
            if (mine && !(pass == 1 && modrow(row0 + ri) == mr_lo)) {
                const int row = row0 + ri; f32x4 x[8];
#pragma unroll
                for (int i = 0; i < 8; ++i) x[i] = xn[i];
                if (ri + 8 < nrows) {
#pragma unroll
                    for (int i = 0; i < 8; ++i) xn[i] = *(const f32x4*)(X + (size_t)(row + 8) * DM + (lane + 64 * i) * 4); }
                float pl[16]; float ss = 0.f;
#pragma unroll
                for (int e = 0; e < 16; ++e) pl[e] = 0.f;
#pragma unroll
                for (int i = 0; i < 8; ++i) { ss += (x[i][0] * x[i][0] + x[i][1] * x[i][1]) + (x[i][2] * x[i][2] + x[i][3] * x[i][3]);
#pragma unroll
                    for (int j = 0; j < 4; ++j)
#pragma unroll
                        for (int q = 0; q < 4; ++q) { const f32x4 w4 = Wl[((i * 4 + j) * 4 + q) * 64 + lane]; const float xv = x[i][j];
                            pl[4 * q] += xv * w4[0]; pl[4 * q + 1] += xv * w4[1]; pl[4 * q + 2] += xv * w4[2]; pl[4 * q + 3] += xv * w4[3]; } }
                const float pt = treduce16(pl, lane);
                const float rstd = rsqrtf(wave_sum(ss, lane) * (1.f / DM) + EPS);
#pragma unroll
                for (int i = 0; i < 8; ++i) { const f32x4 h = x[i] * rstd * gsc[i] + sh[i]; u32x2 w2; w2.x = cvt_pk_bf16(h[0], h[1]); w2.y = cvt_pk_bf16(h[2], h[3]); *(u32x2*)(H + (size_t)row * DM + (lane + 64 * i) * 4) = w2; }
                const float logit = rstd * pt + bias_e;
                float mx = logit;
#pragma unroll
                for (int o = 4; o < 64; o <<= 1) mx = fmaxf(mx, shx(mx, lane, o));
                const float ex = expf(logit - mx); float s = ex;
#pragma unroll
                for (int o = 4; o < 64; o <<= 1) s += shx(s, lane, o);
                if ((lane & 3) == 0) AFFT[(size_t)ecode * MROWS + row] = ex / s;
            }
        }
    }
    __syncthreads();
}
__device__ __forceinline__ void row_phase_c(const Args& A, int l, int lane, int gw, int NGW) {
    unsigned char* ws = A.ws; bf16_t* P = (bf16_t*)(ws + WS_P); const float* r128 = (const float*)(ws + WS_ROPE128); const float* r64 = (const float*)(ws + WS_ROPE64);
    constexpr float QS128 = 0.08838834764831845f * LOG2E, QS64 = 0.125f * LOG2E;
    for (int job = gw; job < MROWS * 12; job += NGW) {
        const int row = job / 12, j = job % 12; const bool lat = row < NLAT; const int t = row & (SEQ - 1);
        bf16_t* p = P + (size_t)row * INW;
        if (j < 8) {
            const int hsel = lane >> 5, i = lane & 31; int col; const float* gain; float qs = 1.f;
            if (j == 0) { col = hsel * 128; gain = A.in[10] + l * 128; }
            else if (j == 1) { col = 1536 + hsel * 128; gain = A.in[19] + l * 128; }
            else if (j < 5) { col = 2048 + ((j - 2) * 2 + hsel) * 128; gain = A.in[9] + l * 128; qs = QS128; }
            else { col = 3328 + ((j - 5) * 2 + hsel) * 128; gain = A.in[18] + l * 128; qs = QS128; }
            float x0 = bf2f(p[col + i]), x1 = bf2f(p[col + i + 32]), x2 = bf2f(p[col + i + 64]), x3 = bf2f(p[col + i + 96]);
            float ss = x0 * x0 + x1 * x1 + x2 * x2 + x3 * x3;
#pragma unroll
            for (int o = 1; o < 32; o <<= 1) ss += shx(ss, lane, o);
            const float rstd = rsqrtf(ss * (1.f / 128.f) + EPS) * qs;
            x0 *= rstd * gain[i]; x1 *= rstd * gain[i + 32]; x2 *= rstd * gain[i + 64]; x3 *= rstd * gain[i + 96];
            if (lat) { const float* rp = r128 + (size_t)t * 128; const float cr = rp[2 * i], sr = rp[2 * i + 1], cc = rp[2 * (32 + i)], sc = rp[2 * (32 + i) + 1];
                const float y0 = x0 * cr - x1 * sr, y1 = x1 * cr + x0 * sr, y2 = x2 * cc - x3 * sc, y3 = x3 * cc + x2 * sc; x0 = y0; x1 = y1; x2 = y2; x3 = y3; }
            p[col + i] = (bf16_t)(cvt_pk_bf16(x0, 0.f) & 0xffffu); p[col + i + 32] = (bf16_t)(cvt_pk_bf16(x1, 0.f) & 0xffffu);
            p[col + i + 64] = (bf16_t)(cvt_pk_bf16(x2, 0.f) & 0xffffu); p[col + i + 96] = (bf16_t)(cvt_pk_bf16(x3, 0.f) & 0xffffu);
        } else {
            const int hsel = lane >> 4, i = lane & 15; int col; const float* gain; float qs = 1.f;
            if (j < 10) { col = 512 + ((j - 8) * 4 + hsel) * 64; gain = A.in[12] + l * 64; }
            else { col = 2816 + ((j - 10) * 4 + hsel) * 64; gain = A.in[11] + l * 64; qs = QS64; }
            float x0 = bf2f(p[col + i]), x1 = bf2f(p[col + i + 16]), x2 = bf2f(p[col + i + 32]), x3 = bf2f(p[col + i + 48]);
            float ss = x0 * x0 + x1 * x1 + x2 * x2 + x3 * x3;
#pragma unroll
            for (int o = 1; o < 16; o <<= 1) ss += shx(ss, lane, o);
            const float rstd = rsqrtf(ss * (1.f / 64.f) + EPS) * qs;
            x0 *= rstd * gain[i]; x1 *= rstd * gain[i + 16]; x2 *= rstd * gain[i + 32]; x3 *= rstd * gain[i + 48];
            if (lat) { const float* rp = r64 + (size_t)t * 64; const float cr = rp[2 * i], sr = rp[2 * i + 1], cc = rp[2 * (16 + i)], sc = rp[2 * (16 + i) + 1];
                const float y0 = x0 * cr - x1 * sr, y1 = x1 * cr + x0 * sr, y2 = x2 * cc - x3 * sc, y3 = x3 * cc + x2 * sc; x0 = y0; x1 = y1; x2 = y2; x3 = y3; }
            p[col + i] = (bf16_t)(cvt_pk_bf16(x0, 0.f) & 0xffffu); p[col + i + 16] = (bf16_t)(cvt_pk_bf16(x1, 0.f) & 0xffffu);
            p[col + i + 32] = (bf16_t)(cvt_pk_bf16(x2, 0.f) & 0xffffu); p[col + i + 48] = (bf16_t)(cvt_pk_bf16(x3, 0.f) & 0xffffu);
        }
    }
}
#ifndef RANK_GQ
#define RANK_GQ 4
#endif
__device__ __forceinline__ void rank_pair(const Args& A, LAS unsigned char* lds, int set, int e, int tok0, int ntok_here, int n, int cap, int tid, int wave, int lane) {
    unsigned char* ws = A.ws; const unsigned* AFFT = (const unsigned*)(ws + WS_AFFT); int* SEL = (int*)(ws + WS_SEL); float* GW = (float*)(ws + WS_GW);
    const bf16_t* H = (const bf16_t*)(ws + WS_H); bf16_t* XG = (bf16_t*)(ws + WS_XG);
    LAS unsigned* col = (LAS unsigned*)lds; LAS unsigned* list = (LAS unsigned*)(lds + 16384); LAS unsigned* wd = (LAS unsigned*)(lds + 20480);
    const int base = set < 2 ? set * SEQ : NLAT + (set - 2) * CTXL;
    __syncthreads();
    unsigned mv[8];
#pragma unroll
    for (int j = 0; j < 8; ++j) { const int i = tid + j * NTHR; const unsigned v = i < n ? AFFT[(size_t)e * MROWS + base + i] : 0u; mv[j] = v; if (i < n) col[i] = v; }
    if (tid == 0) wd[40] = 0u;
    unsigned T = 0u;
    for (int bit = 30; bit >= 0; --bit) {
        const unsigned cand = T | (1u << bit); unsigned c = 0u;
#pragma unroll
        for (int j = 0; j < 8; ++j) c += (unsigned)__popcll(__ballot(mv[j] >= cand));
        LAS unsigned* cw = wd + (bit & 1) * 8;
        if (lane == 0) cw[wave] = c;
        __syncthreads();
        unsigned tot = 0u;
#pragma unroll
        for (int w = 0; w < 8; ++w) tot += cw[w];
        if (tot >= (unsigned)cap) T = cand;
    }
    unsigned cg = 0u, pg = 0u, pe = 0u;
#pragma unroll
    for (int j = 0; j < 8; ++j) { const int i = tid + j * NTHR; cg += (unsigned)__popcll(__ballot(mv[j] > T)); pg += (unsigned)__popcll(__ballot(i < tok0 && mv[j] > T)); pe += (unsigned)__popcll(__ballot(i < tok0 && mv[j] == T)); }
    const int t = tok0 + tid; const bool have = tid < ntok_here; const unsigned mine = have ? col[t] : 0u;
    const bool isg = have && mine > T, isq = have && mine == T;
    const unsigned long long bg = __ballot(isg), bq = __ballot(isq); const unsigned long long lt = (1ull << lane) - 1ull;
    if (lane == 0) { wd[16 + wave] = cg; wd[24 + wave] = pg; wd[32 + wave] = pe; wd[48 + wave] = (unsigned)__popcll(bg); wd[56 + wave] = (unsigned)__popcll(bq); }
    __syncthreads();
    unsigned count_gt = 0u, base_gt = 0u, base_eq = 0u;
#pragma unroll
    for (int w = 0; w < 8; ++w) { count_gt += wd[16 + w]; base_gt += wd[24 + w]; base_eq += wd[32 + w]; if (w < wave) { base_gt += wd[48 + w]; base_eq += wd[56 + w]; } }
    const unsigned need_eq = (unsigned)cap - count_gt;
    const unsigned gt_before = base_gt + (unsigned)__popcll(bg & lt), eq_before = base_eq + (unsigned)__popcll(bq & lt);
    const bool chosen = isg || (isq && eq_before < need_eq);
    if (have) {
        int pos = -1;
        if (chosen) { const unsigned slot = gt_before + (eq_before < need_eq ? eq_before : need_eq); pos = set < 2 ? set * 512 + (int)slot : 1024 + (set - 2) * 32 + (int)slot; GW[e * EPAD + pos] = __uint_as_float(mine);
            const unsigned k = atomicAdd((unsigned*)(wd + 40), 1u); list[2 * k] = (unsigned)(base + t); list[2 * k + 1] = (unsigned)pos; }
        SEL[(size_t)(base + t) * 16 + e] = pos;
    }
    __syncthreads();
    const int nsel = (int)wd[40];
    constexpr int GQ = RANK_GQ;
    for (int k0 = wave; k0 < nsel; k0 += GQ * NWAVES) {
        u32x4 v[GQ][4]; unsigned pos[GQ]; bool ok[GQ];
#pragma unroll
        for (int q = 0; q < GQ; ++q) { const int k = k0 + q * NWAVES; ok[q] = k < nsel; const unsigned row = ok[q] ? list[2 * k] : 0u; pos[q] = ok[q] ? list[2 * k + 1] : 0u;
            const u32x4* src = (const u32x4*)(H + (size_t)row * DM);
            if (ok[q]) {
#pragma unroll
                for (int i = 0; i < 4; ++i) v[q][i] = FP8_EXPERTS ? src[lane * 4 + i] : src[lane + 64 * i]; } }
#pragma unroll
        for (int q = 0; q < GQ; ++q) { if (!ok[q]) continue;
            if (FP8_EXPERTS) { u32x4 o0, o1;
                o0.x = pk4_fp8(bf_lo(v[q][0].x), bf_hi(v[q][0].x), bf_lo(v[q][0].y), bf_hi(v[q][0].y)); o0.y = pk4_fp8(bf_lo(v[q][0].z), bf_hi(v[q][0].z), bf_lo(v[q][0].w), bf_hi(v[q][0].w));
                o0.z = pk4_fp8(bf_lo(v[q][1].x), bf_hi(v[q][1].x), bf_lo(v[q][1].y), bf_hi(v[q][1].y)); o0.w = pk4_fp8(bf_lo(v[q][1].z), bf_hi(v[q][1].z), bf_lo(v[q][1].w), bf_hi(v[q][1].w));
                o1.x = pk4_fp8(bf_lo(v[q][2].x), bf_hi(v[q][2].x), bf_lo(v[q][2].y), bf_hi(v[q][2].y)); o1.y = pk4_fp8(bf_lo(v[q][2].z), bf_hi(v[q][2].z), bf_lo(v[q][2].w), bf_hi(v[q][2].w));
                o1.z = pk4_fp8(bf_lo(v[q][3].x), bf_hi(v[q][3].x), bf_lo(v[q][3].y), bf_hi(v[q][3].y)); o1.w = pk4_fp8(bf_lo(v[q][3].z), bf_hi(v[q][3].z), bf_lo(v[q][3].w), bf_hi(v[q][3].w));
                u32x4* dst = (u32x4*)((unsigned char*)XG + ((size_t)e * EPAD + pos[q]) * DM); dst[lane * 2] = o0; dst[lane * 2 + 1] = o1; }
            else { u32x4* dst = (u32x4*)(XG + ((size_t)e * EPAD + pos[q]) * DM);
#pragma unroll
                for (int i = 0; i < 4; ++i) dst[lane + 64 * i] = v[q][i]; } }
    }
}
__device__ __forceinline__ void phase_rank(const Args& A, LAS unsigned char* lds, int l, int wg, int G, int tid, int wave, int lane) {
#ifndef RANK_XCD
#define RANK_XCD 0
#endif
#ifndef E_XCD
#define E_XCD 1
#endif
    if (RANK_XCD && E_XCD && G == 256) {
        const int x = wg & 7, k = wg >> 3; rank_pair(A, lds, k >> 4, 2 * x + ((k >> 3) & 1), (k & 7) * 512, 512, SEQ, 512, tid, wave, lane); }
    else
    for (int w = wg; w < 256; w += G) { const int pair = w >> 3, chunk = w & 7; rank_pair(A, lds, pair >> 4, pair & 15, chunk * 512, 512, SEQ, 512, tid, wave, lane); }
#ifndef RANK_CTX_SPLIT
#define RANK_CTX_SPLIT 0
#endif
    if (l == 0) {
        if (RANK_CTX_SPLIT) for (int w = wg; w < 256; w += G) rank_pair(A, lds, 2 + (w >> 7), (w >> 3) & 15, (w & 7) * 32, 32, CTXL, 32, tid, wave, lane);
        else for (int w = wg; w < 32; w += G) rank_pair(A, lds, 2 + (w >> 4), w & 15, 0, 256, CTXL, 32, tid, wave, lane); }
    __syncthreads();
}

#ifndef E_XCD
#define E_XCD 1
#endif
#ifndef IN_BLOCK
#define IN_BLOCK 0
#endif
#ifndef IN_XCD
#define IN_XCD 1
#endif
struct SchedIn { const char* A; const char* B; int G, c, l;
    __device__ __forceinline__ bool next(int i, pg8::GUnit& u) const { long L = (long)i * G + c; int pm, pn;
        if (!FP8_GATES) {
            if (l == 0) { if (!pg8::grid_order(L, 34, 40, pm, pn)) return false; }
            else { if (L < 1280) { pg8::grid_order(L, 32, 40, pm, pn); } else if (L < 1296) { const int r = (int)L - 1280; pm = 32 + (r >> 3); pn = r & 7; } else return false; }
        } else if (!FP8_AC) {
            if (l == 0) { if (!pg8::grid_order(L, 34, 16, pm, pn)) return false; }
            else { if (L < 512) { pg8::grid_order(L, 32, 16, pm, pn); } else if (L < 528) { const int r = (int)L - 512; pm = 32 + (r >> 3); pn = r & 7; } else return false; }
        } else {
            if (IN_BLOCK && G == 256 && (l == 1 || (CTX_CHAIN && CTX_GATES_IN_CHAIN))) {
                if (i > 0) return false; const int x = c & 7, k = c >> 3; int q6;
                if (k < 24) { pm = 4 * x + k / 6; q6 = k % 6; pn = q6 < 4 ? 2 + q6 : 7 + q6; }
                else { const int sidx = k - 24, nb = l == 0 ? (x < 4 ? 2 : 1) : 1; if (sidx >= nb) return false;
                    if (l == 0) { const int g = x < 4 ? 2 * x + sidx : 8 + (x - 4); pm = 32 + g / 6; q6 = g % 6; pn = q6 < 4 ? 2 + q6 : 7 + q6; }
                    else { pm = 32 + (x >> 2); pn = 2 + (x & 3); } }
                u.a = A + (size_t)pm * 256 * DM * 2; u.b = B + (size_t)pn * 256 * DM * 2; u.nt = DM / 64; u.pm = pm; u.pn = pn; u.aux = 0; return true; }
            if (IN_XCD && G == 256) L = (long)i * G + ((c & 7) * 32 + (c >> 3));
            const int nlat = (l == 0 ? 34 : 32) * 6;
            if (L < nlat) { const int q = (int)(L % 6); pm = (int)(L / 6); pn = q < 4 ? 2 + q : 7 + q; }
            else if (l == 1 && L < nlat + 8) { const int r = (int)L - nlat; pm = 32 + (r >> 2); pn = 2 + (r & 3); } else return false;
        }
        u.a = A + (size_t)pm * 256 * DM * 2; u.b = B + (size_t)pn * 256 * DM * 2; u.nt = DM / 64; u.pm = pm; u.pn = pn; u.aux = 0; return true; } };
struct SchedIn8 { const char* A; const char* B; int G, c, l;
    __device__ __forceinline__ bool next(int i, pg8::GUnit& u) const { long L; int pm, pn;
        if (!FP8_AC) { const int nM = l == 0 ? 34 : 32;
            if (G == 256) { const int lo = l == 0 ? 32 : 16, n2 = 256 - lo, hi0 = l == 0 ? 176 : 16, hi1 = l == 0 ? 256 : 32;
                if (i < 2) L = (long)i * 256 + c; else if (i == 2) { if (c < lo) return false; L = 512 + (c - lo); } else if (i == 3) { if (c < hi0 || c >= hi1) return false; L = 512 + n2 + (c - hi0); } else return false; }
            else L = (long)i * G + c;
            if (!pg8::grid_order(L, nM, 24, pm, pn)) return false; pn += 16;
        } else {
            constexpr bool CG = CTX_CHAIN && CTX_GATES_IN_CHAIN;
            if (IN_BLOCK && G == 256 && (l == 1 || CG)) {
                const int x = c & 7, k = c >> 3; int q;
                if (i < 4) { pm = 4 * x + (k >> 3); q = 8 * i + (k & 7); pn = q < 2 ? q : (q < 7 ? 4 + q : 6 + q); }
                else { const int sidx = k - 24, nb = l == 0 ? (x < 4 ? 2 : 1) : 1, nf = l == 0 ? (x < 4 ? 2 : 3) : 1;
                    if (sidx < nb || i > 5) return false; const int n = 2 * (sidx - nb) + (i - 4); if (n >= 8 + nf) return false;
                    if (n < 8) { pm = 4 * x + (n >> 1); pn = 38 + (n & 1); }
                    else { const int r = n - 8;
                        if (l == 0) { const int gf = x < 4 ? 2 * x + r : 8 + 3 * (x - 4) + r; pm = 32 + gf / 10; q = gf % 10; pn = q < 2 ? q : (q < 7 ? 4 + q : 6 + q); }
                        else { pm = 32 + (x >> 2); q = x & 3; pn = q < 2 ? q : 4 + q; } } }
                u.a = A + (size_t)pm * 256 * DM; u.b = B + (size_t)pn * 256 * DM; u.nt = DM / 128; u.pm = pm; u.pn = pn; u.aux = 0; return true; }
            const int ntot = l == 0 ? (CG ? 1108 : 1156) : 1096, nlat = l == 0 ? (CG ? 1088 : 1156) : 1088;
            if (G == 256) { int cnt, start; const int c = IN_XCD ? ((this->c & 7) * 32 + (this->c >> 3)) : this->c;
                if (l == 0 && CG) { if (c < 204) { cnt = 4; start = 4 * c; } else if (c < 236) { cnt = 6; start = 816 + 6 * (c - 204); } else { cnt = 5; start = 1008 + 5 * (c - 236); } }
                else if (l == 0) { if (c < 28) { cnt = 5; start = 5 * c; } else if (c < 204) { cnt = 4; start = 140 + 4 * (c - 28); } else { cnt = 6; start = 844 + 6 * (c - 204); } }
                else { if (c < 200) { cnt = 4; start = 4 * c; } else if (c < 240) { cnt = 5; start = 800 + 5 * (c - 200); } else { cnt = 6; start = 1000 + 6 * (c - 240); } }
                if (i >= cnt) return false; L = start + i; }
            else L = (long)i * G + c;
            if (L >= ntot) return false;
            if (L < nlat) { const int q = (int)(L % 34); pm = (int)(L / 34); pn = q < 2 ? q : (q < 7 ? 4 + q : 6 + q); }
            else if (l == 0) { const int r = (int)L - nlat; pm = 32 + r / 10; const int q = r % 10; pn = q < 2 ? q : (q < 7 ? 4 + q : 6 + q); }
            else { const int r = (int)L - nlat; pm = 32 + (r >> 2); const int q = r & 3; pn = q < 2 ? q : 4 + q; }
        }
        u.a = A + (size_t)pm * 256 * DM; u.b = B + (size_t)pn * 256 * DM; u.nt = DM / 128; u.pm = pm; u.pn = pn; u.aux = 0; return true; } };
struct EpiIn { static constexpr bool PERM = true, KEEPS = false, QSKIP = false; float gmul  ; bf16_t* P; LAS float* ssx; const float* r128; const float* r64; const float *kn_a, *kn_b, *kn_c, *qn_a, *qn_b, *qn_c;
    __device__ __forceinline__ void operator()(f32x4 (&acc)[2][2][4][2], const pg8::GUnit& u, int wr, int wc, int fr, int fq) const {
        const int row0 = u.pm * 256 + wr * 64 + fr, col0 = u.pn * 256 + wc * 32 + 8 * fq, pn = u.pn;
        int cls = 0; const float* gain = nullptr; float qs = 1.f;
        constexpr float QS128 = 0.08838834764831845f * LOG2E, QS64 = 0.125f * LOG2E;
        if (pn >= 16) cls = 1;
        else if (FUSE_QK) {
            if (pn == 0) { cls = 2; gain = kn_a; } else if (pn == 6) { cls = 2; gain = kn_c; } else if (pn >= 8 && pn <= 10) { cls = 2; gain = qn_a; qs = QS128; } else if (pn >= 13) { cls = 2; gain = qn_c; qs = QS128; }
            else if (pn == 2 || pn == 3) { cls = 3; gain = kn_b; } else if (pn == 11 || pn == 12) { cls = 3; gain = qn_b; qs = QS64; }
        }
        if (cls < 2) {
#pragma unroll
            for (int ai = 0; ai < 2; ++ai)
#pragma unroll
                for (int m = 0; m < 4; ++m) { bf16_t* rowp = P + (size_t)(row0 + ai * 128 + m * 16) * INW + col0;
#pragma unroll
                    for (int bj = 0; bj < 2; ++bj) { f32x4 v0 = acc[ai][bj][m][0] * gmul, v1 = acc[ai][bj][m][1] * gmul;
                        if (cls == 1) {
#pragma unroll
                            for (int j = 0; j < 4; ++j) { v0[j] = fast_sigmoid(v0[j]); v1[j] = fast_sigmoid(v1[j]); } }
                        u32x4 w; w.x = cvt_pk_bf16(v0[0], v0[1]); w.y = cvt_pk_bf16(v0[2], v0[3]); w.z = cvt_pk_bf16(v1[0], v1[1]); w.w = cvt_pk_bf16(v1[2], v1[3]);
                        if (EPI_NT) __builtin_nontemporal_store(w, (u32x4*)(rowp + bj * 128)); else *(u32x4*)(rowp + bj * 128) = w; } }
            return;
        }
        const int lane = fq * 16 + fr; const bool lat = u.pm < 32; const bool h128 = cls == 2;
        float ss[2][4][2];
#pragma unroll
        for (int ai = 0; ai < 2; ++ai)
#pragma unroll
            for (int m = 0; m < 4; ++m)
#pragma unroll
                for (int bj = 0; bj < 2; ++bj) { const f32x4 a = acc[ai][bj][m][0] * gmul, b = acc[ai][bj][m][1] * gmul;
                    float s = (a[0] * a[0] + a[1] * a[1]) + (a[2] * a[2] + a[3] * a[3]) + (b[0] * b[0] + b[1] * b[1]) + (b[2] * b[2] + b[3] * b[3]);
                    s = xsum32(xsum16(s)); ss[ai][m][bj] = s; }
        if (fq == 0) {
#pragma unroll
            for (int ai = 0; ai < 2; ++ai)
#pragma unroll
                for (int m = 0; m < 4; ++m)
#pragma unroll
                    for (int bj = 0; bj < 2; ++bj) ssx[(ai * 128 + wr * 64 + m * 16 + fr) * 8 + bj * 4 + wc] = ss[ai][m][bj]; }
        asm volatile("s_waitcnt lgkmcnt(0)" ::: "memory"); __builtin_amdgcn_s_barrier(); asm volatile("" ::: "memory");
        const int dimA = h128 ? ((wc >= 2 ? 64 : 0) + (wc & 1) * 16 + fq * 4) : ((wc & 1) * 32 + fq * 4);
        const int q0 = h128 ? ((wc >= 2 ? 32 : 0) + (wc & 1) * 16 + fq * 4) : ((wc & 1) * 16 + fq * 4);
        const f32x4 ga = *(const f32x4*)(gain + dimA), gb = *(const f32x4*)(gain + dimA + (h128 ? 32 : 16));
        const float inv_dh = h128 ? (1.f / 128.f) : (1.f / 64.f);
#pragma unroll
        for (int ai = 0; ai < 2; ++ai)
#pragma unroll
            for (int m = 0; m < 4; ++m) { const int rl = ai * 128 + wr * 64 + m * 16 + fr, row = u.pm * 256 + rl; bf16_t* rowp = P + (size_t)row * INW + col0;
                f32x4 cv = {1.f, 1.f, 1.f, 1.f}, sv = {0.f, 0.f, 0.f, 0.f};
                if (lat) { const float* rp = (h128 ? r128 + (size_t)(row & (SEQ - 1)) * 128 : r64 + (size_t)(row & (SEQ - 1)) * 64) + 2 * q0;
                    const f32x4 c01 = *(const f32x4*)rp, c23 = *(const f32x4*)(rp + 4); cv = (f32x4){c01[0], c01[2], c23[0], c23[2]}; sv = (f32x4){c01[1], c01[3], c23[1], c23[3]}; }
#pragma unroll
                for (int bj = 0; bj < 2; ++bj) { const f32x4 p4 = *(const LAS f32x4*)(ssx + rl * 8 + bj * 4);
                    const float tot = h128 ? (p4[0] + p4[1]) + (p4[2] + p4[3]) : (wc < 2 ? p4[0] + p4[1] : p4[2] + p4[3]);
                    const float rstd = rsqrtf(tot * inv_dh + EPS) * qs * gmul;
                    const f32x4 xa = acc[ai][bj][m][0] * rstd * ga, xb = acc[ai][bj][m][1] * rstd * gb;
                    const f32x4 ya = xa * cv - xb * sv, yb = xb * cv + xa * sv;
                    u32x4 w; w.x = cvt_pk_bf16(ya[0], ya[1]); w.y = cvt_pk_bf16(ya[2], ya[3]); w.z = cvt_pk_bf16(yb[0], yb[1]); w.w = cvt_pk_bf16(yb[2], yb[3]);
                    if (EPI_NT) __builtin_nontemporal_store(w, (u32x4*)(rowp + bj * 128)); else *(u32x4*)(rowp + bj * 128) = w; } }
    } };
struct SchedBr { const char* A; const char* B; const char* A8; const char* B8; int G, c, ntiles_m;
    __device__ __forceinline__ bool next(int i, pg8::GUnit& u) const { const int s = i % 3; const long L = (long)(i / 3) * G + c; int pm, pn; if (!pg8::grid_order(L, ntiles_m, 8, pm, pn)) return false;
        const int koff = s == 0 ? 0 : (s == 1 ? 768 : 1280); u.pm = pm; u.pn = pn; u.aux = s;
        if (FP8_BR && s != 1) { u.a = A8 + (size_t)pm * 256 * DM + koff; u.b = B8 + (size_t)pn * 256 * DM + koff; u.nt = 6; u.f8 = 1; }
        else { u.a = A + ((size_t)pm * 256 * DM + koff) * 2; u.b = B + ((size_t)pn * 256 * DM + koff) * 2; u.nt = s == 1 ? 8 : 12; u.f8 = 0; }
        return true; } };
struct EpiBr { static constexpr bool PERM = true, KEEPS = true, QSKIP = false; const bf16_t* P; bf16_t* MM;
    __device__ __forceinline__ bool keep(const pg8::GUnit& u) const { return u.aux < 2; }
    __device__ __forceinline__ void operator()(f32x4 (&acc)[2][2][4][2], const pg8::GUnit& u, int wr, int wc, int fr, int fq) const {
        const int row0 = u.pm * 256 + wr * 64 + fr, col0 = u.pn * 256 + wc * 32 + 8 * fq, s = u.aux;
#pragma unroll
        for (int ai = 0; ai < 2; ++ai)
#pragma unroll
            for (int m = 0; m < 4; ++m) { const size_t row = (size_t)(row0 + ai * 128 + m * 16); const bf16_t* gp = P + row * INW + 4096 + s * 2048 + col0; bf16_t* mp = MM + row * DM + col0;
#pragma unroll
                for (int bj = 0; bj < 2; ++bj) { const u32x4 g = *(const u32x4*)(gp + bj * 128);
                    f32x4 g0 = {bf_lo(g.x), bf_hi(g.x), bf_lo(g.y), bf_hi(g.y)}, g1 = {bf_lo(g.z), bf_hi(g.z), bf_lo(g.w), bf_hi(g.w)};
                    if (s < 2) { const u32x4 h = *(const u32x4*)(gp + 2048 + bj * 128);
                        const f32x4 h0 = {bf_lo(h.x), bf_hi(h.x), bf_lo(h.y), bf_hi(h.y)}, h1 = {bf_lo(h.z), bf_hi(h.z), bf_lo(h.w), bf_hi(h.w)};
                        const float bs = 1.f;
#pragma unroll
                        for (int j = 0; j < 4; ++j) { g0[j] *= bs * __builtin_amdgcn_rcpf(fmaxf(h0[j], 1e-20f)); g1[j] *= bs * __builtin_amdgcn_rcpf(fmaxf(h1[j], 1e-20f)); }
                        acc[ai][bj][m][0] = acc[ai][bj][m][0] * g0; acc[ai][bj][m][1] = acc[ai][bj][m][1] * g1; }
                    else { constexpr float fs = 1.f; const f32x4 v0 = acc[ai][bj][m][0] * g0 * fs, v1 = acc[ai][bj][m][1] * g1 * fs;
                        if (FP8_OUT) { u32x2 w; w.x = pk4_fp8(v0[0], v0[1], v0[2], v0[3]); w.y = pk4_fp8(v1[0], v1[1], v1[2], v1[3]); *(u32x2*)((unsigned char*)MM + row * DM + col0 + bj * 128) = w; }
                        else { u32x4 w; w.x = cvt_pk_bf16(v0[0], v0[1]); w.y = cvt_pk_bf16(v0[2], v0[3]); w.z = cvt_pk_bf16(v1[0], v1[1]); w.w = cvt_pk_bf16(v1[2], v1[3]);
                        *(u32x4*)(mp + bj * 128) = w; } } } }
    } };
struct SchedBrAC { const char* A8; const char* B8; int G, c, ntiles_m;
    __device__ __forceinline__ bool next(int i, pg8::GUnit& u) const { const int s = (i & 1) * 2; const long L = (long)(i >> 1) * G + c; int pm, pn; if (!pg8::grid_order(L, ntiles_m, 8, pm, pn)) return false;
        const int koff = s == 0 ? 0 : 1280; u.a = A8 + (size_t)pm * 256 * DM + koff; u.b = B8 + (size_t)pn * 256 * DM + koff; u.nt = 6; u.pm = pm; u.pn = pn; u.aux = s; u.f8 = 1; return true; } };
struct SchedBrB { const char* A; const char* B; int G, c, ntiles_m;
    __device__ __forceinline__ bool next(int i, pg8::GUnit& u) const { const long L = (long)i * G + c; int pm, pn; if (!pg8::grid_order(L, ntiles_m, 8, pm, pn)) return false;
        u.a = A + ((size_t)pm * 256 * DM + 768) * 2; u.b = B + ((size_t)pn * 256 * DM + 768) * 2; u.nt = 8; u.pm = pm; u.pn = pn; u.aux = 1; u.f8 = 0; return true; } };
struct SchedOneBrAC { const char* A8; const char* B8; int pm, pn;
    __device__ __forceinline__ bool next(int i, pg8::GUnit& u) const { if (i >= 2) return false; const int s = i * 2, koff = s == 0 ? 0 : 1280;
        u.a = A8 + (size_t)pm * 256 * DM + koff; u.b = B8 + (size_t)pn * 256 * DM + koff; u.nt = 6; u.pm = pm; u.pn = pn; u.aux = s; u.f8 = 1; return true; } };
struct SchedOneBrB { const char* A; const char* B; int pm, pn;
    __device__ __forceinline__ bool next(int i, pg8::GUnit& u) const { if (i >= 1) return false;
        u.a = A + ((size_t)pm * 256 * DM + 768) * 2; u.b = B + ((size_t)pn * 256 * DM + 768) * 2; u.nt = 8; u.pm = pm; u.pn = pn; u.aux = 1; u.f8 = 0; return true; } };
struct EpiBrAC { static constexpr bool PERM = true, KEEPS = true, QSKIP = false; const bf16_t* P; bf16_t* MM;
    __device__ __forceinline__ bool keep(const pg8::GUnit& u) const { return u.aux == 0; }
    __device__ __forceinline__ void operator()(f32x4 (&acc)[2][2][4][2], const pg8::GUnit& u, int wr, int wc, int fr, int fq) const {
        const int row0 = u.pm * 256 + wr * 64 + fr, col0 = u.pn * 256 + wc * 32 + 8 * fq, s = u.aux;
#pragma unroll
        for (int ai = 0; ai < 2; ++ai)
#pragma unroll
            for (int m = 0; m < 4; ++m) { const size_t row = (size_t)(row0 + ai * 128 + m * 16); const bf16_t* gp = P + row * INW + 4096 + col0; bf16_t* mp = MM + row * DM + col0;
#pragma unroll
                for (int bj = 0; bj < 2; ++bj) { const u32x4 gc = *(const u32x4*)(gp + 2 * 2048 + bj * 128);
                    f32x4 c0 = {bf_lo(gc.x), bf_hi(gc.x), bf_lo(gc.y), bf_hi(gc.y)}, c1 = {bf_lo(gc.z), bf_hi(gc.z), bf_lo(gc.w), bf_hi(gc.w)};
                    if (s == 0) { const u32x4 ga = *(const u32x4*)(gp + bj * 128);
                        const f32x4 a0 = {bf_lo(ga.x), bf_hi(ga.x), bf_lo(ga.y), bf_hi(ga.y)}, a1 = {bf_lo(ga.z), bf_hi(ga.z), bf_lo(ga.w), bf_hi(ga.w)};
#pragma unroll
                        for (int j = 0; j < 4; ++j) { c0[j] = a0[j] * __builtin_amdgcn_rcpf(fmaxf(c0[j], 1e-20f)); c1[j] = a1[j] * __builtin_amdgcn_rcpf(fmaxf(c1[j], 1e-20f)); }
                        acc[ai][bj][m][0] = acc[ai][bj][m][0] * c0; acc[ai][bj][m][1] = acc[ai][bj][m][1] * c1; }
                    else { const f32x4 v0 = acc[ai][bj][m][0] * c0 * (1.f / 64.f), v1 = acc[ai][bj][m][1] * c1 * (1.f / 64.f); u32x4 w;
                        w.x = cvt_pk_bf16(v0[0], v0[1]); w.y = cvt_pk_bf16(v0[2], v0[3]); w.z = cvt_pk_bf16(v1[0], v1[1]); w.w = cvt_pk_bf16(v1[2], v1[3]);
                        *(u32x4*)(mp + bj * 128) = w; } } }
    } };
struct EpiBrB { static constexpr bool PERM = true, KEEPS = false, QSKIP = false; const bf16_t* P; bf16_t* MM;
    __device__ __forceinline__ void operator()(f32x4 (&acc)[2][2][4][2], const pg8::GUnit& u, int wr, int wc, int fr, int fq) const {
        const int row0 = u.pm * 256 + wr * 64 + fr, col0 = u.pn * 256 + wc * 32 + 8 * fq;
#pragma unroll
        for (int ai = 0; ai < 2; ++ai)
#pragma unroll
            for (int m = 0; m < 4; ++m) { const size_t row = (size_t)(row0 + ai * 128 + m * 16); const bf16_t* gp = P + row * INW + 4096 + 2048 + col0; bf16_t* mp = MM + row * DM + col0;
#pragma unroll
                for (int bj = 0; bj < 2; ++bj) { const u32x4 g = *(const u32x4*)(gp + bj * 128); const u32x4 pv = *(const u32x4*)(mp + bj * 128);
                    const f32x4 v0 = acc[ai][bj][m][0], v1 = acc[ai][bj][m][1]; u32x4 w;
                    w.x = cvt_pk_bf16(bf_lo(pv.x) + bf_lo(g.x) * v0[0], bf_hi(pv.x) + bf_hi(g.x) * v0[1]); w.y = cvt_pk_bf16(bf_lo(pv.y) + bf_lo(g.y) * v0[2], bf_hi(pv.y) + bf_hi(g.y) * v0[3]);
                    w.z = cvt_pk_bf16(bf_lo(pv.z) + bf_lo(g.z) * v1[0], bf_hi(pv.z) + bf_hi(g.z) * v1[1]); w.w = cvt_pk_bf16(bf_lo(pv.w) + bf_lo(g.w) * v1[2], bf_hi(pv.w) + bf_hi(g.w) * v1[3]);
                    *(u32x4*)(mp + bj * 128) = w; } }
    } };
struct SchedOut { const char* A; const char* B; int G, c, ntiles_m;
    __device__ __forceinline__ bool next(int i, pg8::GUnit& u) const { const long L = (long)i * G + c; int pm, pn; if (!pg8::grid_order(L, ntiles_m, 8, pm, pn)) return false;
        constexpr int OS = FP8_OUT ? 1 : 2; u.a = A + (size_t)pm * 256 * DM * OS; u.b = B + (size_t)pn * 256 * DM * OS; u.nt = DM * OS / 128; u.pm = pm; u.pn = pn; u.aux = 0; return true; } };
struct EpiOut { static constexpr bool PERM = false, KEEPS = false, QSKIP = false; const float* base_lat; const float* base_ctx; float* X; const float* g1;
    __device__ __forceinline__ void operator()(f32x4 (&acc)[2][2][4][2], const pg8::GUnit& u, int wr, int wc, int fr, int fq) const {
        const int row0 = u.pm * 256 + wr * 64 + fr, col0 = u.pn * 256 + wc * 32 + 4 * fq; const float* gv = g1 + (size_t)(u.pm < 16 ? 0 : (u.pm < 32 ? 1 : 2)) * MODW + col0;
        f32x4 g[2][2];
#pragma unroll
        for (int bj = 0; bj < 2; ++bj)
#pragma unroll
            for (int n = 0; n < 2; ++n) g[bj][n] = *(const f32x4*)(gv + bj * 128 + n * 16);
#pragma unroll
        for (int ai = 0; ai < 2; ++ai)
#pragma unroll
            for (int m = 0; m < 4; ++m) { const int row = row0 + ai * 128 + m * 16; const float* bp = (u.pm < 32 ? base_lat + (size_t)row * DM : base_ctx + (size_t)(row - NLAT) * DM) + col0; float* xp = X + (size_t)row * DM + col0;
#pragma unroll
                for (int bj = 0; bj < 2; ++bj)
#pragma unroll
                    for (int n = 0; n < 2; ++n) { const f32x4 b = *(const f32x4*)(bp + bj * 128 + n * 16); *(f32x4*)(xp + bj * 128 + n * 16) = b + g[bj][n] * (acc[ai][bj][m][n] * (FP8_OUT ? (1.f / 64.f) : 1.f)); }
                asm volatile("" ::: "memory"); }
    } };
struct SchedE1 { const char* A; const char* B; int G, c, nrt;
    __device__ __forceinline__ bool next(int i, pg8::GUnit& u) const { int pn, e, rt;
        if (E_XCD && G == 256) {
            const int x = c & 7, k = c >> 3, ui = i * 32 + k, per = nrt * 8; if (ui >= 2 * per) return false;
            e = 2 * x + ui / per; const int rem = ui % per; rt = rem >> 3; pn = rem & 7;
        } else { const long L = (long)i * G + c; if (L >= (long)16 * nrt * 8) return false;
            pn = (int)(L & 7); const int er = (int)(L >> 3); e = er / nrt; rt = er % nrt; }
        constexpr int ES = FP8_EXPERTS ? 1 : 2; u.a = A + ((size_t)e * EPAD + rt * 256) * DM * ES; u.b = B + ((size_t)e * 2048 + pn * 256) * DM * ES; u.nt = DM * ES / 128; u.pm = rt; u.pn = pn; u.aux = e; u.q = rt == 4; return true; } };
struct EpiE1 { static constexpr bool PERM = true, KEEPS = false, QSKIP = true; bf16_t* ACT; int nrows;
    __device__ __forceinline__ void operator()(f32x4 (&acc)[2][2][4][2], const pg8::GUnit& u, int wr, int wc, int fr, int fq) const {
        const int row0 = u.pm * 256 + wr * 64 + fr, col0 = u.pn * 128 + wc * 32 + 8 * fq;
#pragma unroll
        for (int ai = 0; ai < 2; ++ai)
#pragma unroll
            for (int m = 0; m < 4; ++m) { const int row = row0 + ai * 128 + m * 16; if (row >= nrows) continue;
                constexpr float WS = FP8_EXPERTS ? (1.f / 64.f) : 1.f;
                const f32x4 g0 = acc[ai][0][m][0] * WS, g1 = acc[ai][0][m][1] * WS, u0 = acc[ai][1][m][0] * WS, u1 = acc[ai][1][m][1] * WS; f32x4 a0, a1;
#pragma unroll
                for (int j = 0; j < 4; ++j) { a0[j] = g0[j] * fast_sigmoid(g0[j]) * u0[j]; a1[j] = g1[j] * fast_sigmoid(g1[j]) * u1[j]; }
                if (FP8_EXPERTS) { u32x2 w; w.x = pk4_fp8(a0[0], a0[1], a0[2], a0[3]); w.y = pk4_fp8(a1[0], a1[1], a1[2], a1[3]); *(u32x2*)((unsigned char*)ACT + ((size_t)u.aux * EPAD + row) * FF + col0) = w; }
                else { u32x4 w; w.x = cvt_pk_bf16(a0[0], a0[1]); w.y = cvt_pk_bf16(a0[2], a0[3]); w.z = cvt_pk_bf16(a1[0], a1[1]); w.w = cvt_pk_bf16(a1[2], a1[3]);
                *(u32x4*)(ACT + ((size_t)u.aux * EPAD + row) * FF + col0) = w; } }
    } };
struct SchedE2 { const char* A; const char* B; int G, c, nrt;
    __device__ __forceinline__ bool next(int i, pg8::GUnit& u) const { int pn, e, rt;
        if (E_XCD && G == 256) {
            const int x = c & 7, k = c >> 3, ui = i * 32 + k, per = nrt * 8; if (ui >= 2 * per) return false;
            e = 2 * x + ui / per; const int rem = ui % per; rt = rem >> 3; pn = rem & 7;
        } else { const long L = (long)i * G + c; if (L >= (long)16 * nrt * 8) return false;
            pn = (int)(L & 7); const int er = (int)(L >> 3); e = er / nrt; rt = er % nrt; }
        constexpr int ES = FP8_EXPERTS ? 1 : 2; u.a = A + ((size_t)e * EPAD + rt * 256) * FF * ES; u.b = B + ((size_t)e * 2048 + pn * 256) * FF * ES; u.nt = FF * ES / 128; u.pm = rt; u.pn = pn; u.aux = e; u.q = rt == 4; return true; } };
struct EpiE2 { static constexpr bool PERM = true, KEEPS = false, QSKIP = true; bf16_t* Y; const float* GW; int nrows;
    __device__ __forceinline__ void operator()(f32x4 (&acc)[2][2][4][2], const pg8::GUnit& u, int wr, int wc, int fr, int fq) const {
        const int row0 = u.pm * 256 + wr * 64 + fr, col0 = u.pn * 256 + wc * 32 + 8 * fq;
#pragma unroll
        for (int ai = 0; ai < 2; ++ai)
#pragma unroll
            for (int m = 0; m < 4; ++m) { const int row = row0 + ai * 128 + m * 16; if (row >= nrows) continue; const float gw = GW[u.aux * EPAD + row] * (FP8_EXPERTS ? (1.f / 64.f) : 1.f);
                bf16_t* yp = Y + ((size_t)u.aux * EROWS + row) * DM + col0;
#pragma unroll
                for (int bj = 0; bj < 2; ++bj) { const f32x4 v0 = acc[ai][bj][m][0] * gw, v1 = acc[ai][bj][m][1] * gw;
                    u32x4 w; w.x = cvt_pk_bf16(v0[0], v0[1]); w.y = cvt_pk_bf16(v0[2], v0[3]); w.z = cvt_pk_bf16(v1[0], v1[1]); w.w = cvt_pk_bf16(v1[2], v1[3]);
                    if (EPI_NT) __builtin_nontemporal_store(w, (u32x4*)(yp + bj * 128)); else *(u32x4*)(yp + bj * 128) = w; } }
    } };

template <int KIND> __device__ __forceinline__ void attn_decode(int idx, bool ctx, att::AUnit& u, const float* sink_l) {
    u.dpos = 0; u.sink2 = 0.f;
    if (KIND == 0) {
        if (!ctx) { const int b = idx / 96, r = idx % 96, h = r / 16, qb = r % 16;
            u.qrow0 = b * SEQ + qb * 256; u.qcol = 2048 + h * 128; u.kcol = (h / 3) * 128; u.vcol = 256 + (h / 3) * 128; u.ocol = h * 128; u.nlat_t = 64; u.lat_row0 = b * SEQ; u.ctx_row0 = NLAT + b * CTXL; }
        else { const int b = idx / 6, h = idx % 6;
            u.qrow0 = NLAT + b * CTXL; u.qcol = 2048 + h * 128; u.kcol = (h / 3) * 128; u.vcol = 256 + (h / 3) * 128; u.ocol = h * 128; u.nlat_t = 0; u.lat_row0 = 0; u.ctx_row0 = NLAT + b * CTXL; }
    } else if (KIND == 1) {
        if (!ctx) { const int b = idx / 128, r = idx % 128, h = r / 32, qb = r % 32;
            u.qrow0 = b * SEQ + qb * 128; u.qcol = 2816 + h * 128; u.kcol = 512 + h * 128; u.vcol = 1024 + h * 128; u.ocol = 768 + h * 128; u.nlat_t = 64; u.lat_row0 = b * SEQ; u.ctx_row0 = NLAT + b * CTXL; }
        else { const int b = idx / 8, r = idx % 8, h = r / 2, qb = r % 2;
            u.qrow0 = NLAT + b * CTXL + qb * 128; u.qcol = 2816 + h * 128; u.kcol = 512 + h * 128; u.vcol = 1024 + h * 128; u.ocol = 768 + h * 128; u.nlat_t = 0; u.lat_row0 = 0; u.ctx_row0 = NLAT + b * CTXL; }
    } else {
        if (!ctx) { const int b = idx / 96, r = idx % 96, h = r / 16, qb = r % 16; const int t0 = qb * 256; const int lo = t0 - 128 < 0 ? 0 : t0 - 128, hi = t0 + 384 > SEQ ? SEQ : t0 + 384;
            u.qrow0 = b * SEQ + t0; u.qcol = 3328 + h * 128; u.kcol = 1536 + (h / 3) * 128; u.vcol = 1792 + (h / 3) * 128; u.ocol = 1280 + h * 128; u.nlat_t = (hi - lo) / 64; u.lat_row0 = b * SEQ + lo; u.ctx_row0 = NLAT + b * CTXL;
            u.dpos = lo - t0; u.sink2 = sink_l[h] * LOG2E; }
        else { const int b = idx / 6, h = idx % 6;
            u.qrow0 = NLAT + b * CTXL; u.qcol = 3328 + h * 128; u.kcol = 1536 + (h / 3) * 128; u.vcol = 1792 + (h / 3) * 128; u.ocol = 1280 + h * 128; u.nlat_t = 0; u.lat_row0 = 0; u.ctx_row0 = NLAT + b * CTXL; u.sink2 = sink_l[h] * LOG2E; }
    }
}
__device__ __forceinline__ void publish_inc(unsigned* ctr, int tid) {
    asm volatile("s_waitcnt vmcnt(0)" ::: "memory"); __syncthreads();
    if (tid == 0) { __builtin_amdgcn_fence(__ATOMIC_RELEASE, "agent"); asm volatile("s_waitcnt vmcnt(0)" ::: "memory"); (void)xb_add(ctr, 1u); }
}
__device__ __forceinline__ void wait_ge(unsigned* ctr, unsigned want, int tid) {
    if (tid == 0) { unsigned sp = 0u; while (xb_ld(ctr) < want) { __builtin_amdgcn_s_sleep(2); if (++sp > (1u << 20)) break; }
        __builtin_amdgcn_fence(__ATOMIC_ACQUIRE, "agent"); asm volatile("s_waitcnt vmcnt(0)" ::: "memory"); }
    __syncthreads();
}
__device__ __forceinline__ void router_tile(const Args& A, int l, int pm, int pn, unsigned* pctr) {
    int tz = threadIdx.x; asm volatile("" : "+v"(tz)); const int tid = tz, lane = tz & 63, wave = __builtin_amdgcn_readfirstlane(tz >> 6);
    unsigned char* ws = A.ws; const float* X = (const float*)(ws + WS_X); bf16_t* H = (bf16_t*)(ws + WS_H); float* AFFT = (float*)(ws + WS_AFFT); float* XCH = (float*)(ws + WS_XCH);
    const int mr = pm < 16 ? 0 : (pm < 32 ? 1 : 2);
    const float* mv = (const float*)(ws + WS_MODV) + (size_t)(l * 3 + mr) * MODW; const float* wr = A.in[25] + (size_t)l * DM * 16; const float* gain = A.in[7] + l * DM;
    const float* biasr = (const float*)(ws + WS_BIASR) + (l * 3 + mr) * 16;
    if (tid == 0) { __builtin_amdgcn_fence(__ATOMIC_ACQUIRE, "agent"); asm volatile("s_waitcnt vmcnt(0)" ::: "memory"); }
    __syncthreads();
    const int c0 = pn * 256 + 4 * lane, row0 = pm * 256 + wave * 32;
    f32x4 gsc, sh; { const f32x4 g4 = *(const f32x4*)(gain + c0), sc4 = *(const f32x4*)(mv + 4 * DM + c0); gsc = g4 * (sc4 + 1.f); sh = *(const f32x4*)(mv + 3 * DM + c0); }
    f32x4 x[32];
#pragma unroll
    for (int i = 0; i < 32; ++i) x[i] = *(const f32x4*)(X + (size_t)(row0 + i) * DM + c0);
    {   float Wl[4][16];
#pragma unroll
        for (int j = 0; j < 4; ++j)
#pragma unroll
            for (int q = 0; q < 4; ++q) { const f32x4 w4 = *(const f32x4*)(wr + (size_t)(c0 + j) * 16 + 4 * q);
#pragma unroll
                for (int t = 0; t < 4; ++t) Wl[j][4 * q + t] = gsc[j] * w4[t]; }
#pragma unroll
        for (int i = 0; i < 32; ++i) { float pl[16];
#pragma unroll
            for (int e = 0; e < 16; ++e) pl[e] = x[i][0] * Wl[0][e] + x[i][1] * Wl[1][e] + x[i][2] * Wl[2][e] + x[i][3] * Wl[3][e];
            const float pt = treduce16(pl, lane);
            const float ss = wave_sum((x[i][0] * x[i][0] + x[i][1] * x[i][1]) + (x[i][2] * x[i][2] + x[i][3] * x[i][3]), lane);
            float* slot = XCH + ((size_t)(row0 + i) * 8 + pn) * 20;
            if ((lane & 3) == 0) slot[lane >> 2] = pt;
            if (lane == 0) slot[16] = ss; }
    }
    publish_inc(pctr, tid);
    wait_ge(pctr, 8u, tid);
    const float bias = lane < 16 ? biasr[lane] : 0.f;
#pragma unroll
    for (int i0 = 0; i0 < 32; i0 += 8) { float part[8];
#pragma unroll
        for (int i = 0; i < 8; ++i) { const int row = row0 + i0 + i; float s = 0.f;
            if (lane < 17) {
#pragma unroll
                for (int q = 0; q < 8; ++q) s += XCH[((size_t)row * 8 + q) * 20 + lane]; }
            part[i] = s; }
#pragma unroll
        for (int i = 0; i < 8; ++i) { const int row = row0 + i0 + i;
            const float sst = __uint_as_float((unsigned)__builtin_amdgcn_readlane((int)__float_as_uint(part[i]), 16));
            const float rstd = rsqrtf(sst * (1.f / DM) + EPS);
            { const f32x4 h = x[i0 + i] * rstd * gsc + sh; u32x2 w2; w2.x = cvt_pk_bf16(h[0], h[1]); w2.y = cvt_pk_bf16(h[2], h[3]); *(u32x2*)(H + (size_t)row * DM + c0) = w2; }
            if (pn == 0) {
                const float logit = lane < 16 ? rstd * part[i] + bias : -3.0e38f; const float mx = row_max16(logit);
                const float ex = lane < 16 ? expf(logit - mx) : 0.f; const float s = row_sum16(ex);
                if (lane < 16) AFFT[(size_t)lane * MROWS + row] = ex / s; } }
    }
}
struct SchedOneBr { const char* A; const char* B; const char* A8; const char* B8; int pm, pn;
    __device__ __forceinline__ bool next(int i, pg8::GUnit& u) const { if (i >= 3) return false; const int s = i, koff = s == 0 ? 0 : (s == 1 ? 768 : 1280); u.pm = pm; u.pn = pn; u.aux = s;
        if (FP8_BR && s != 1) { u.a = A8 + (size_t)pm * 256 * DM + koff; u.b = B8 + (size_t)pn * 256 * DM + koff; u.nt = 6; u.f8 = 1; }
        else { u.a = A + ((size_t)pm * 256 * DM + koff) * 2; u.b = B + ((size_t)pn * 256 * DM + koff) * 2; u.nt = s == 1 ? 8 : 12; u.f8 = 0; }
        return true; } };
struct SchedGate3 { const char* A; const char* B; int pm, pn;
    __device__ __forceinline__ bool next(int i, pg8::GUnit& u) const { if (i >= 3) return false; const int gp = 16 + 8 * i + pn;
        u.a = A + (size_t)pm * 256 * DM; u.b = B + (size_t)gp * 256 * DM; u.nt = DM / 128; u.pm = pm; u.pn = gp; u.aux = 0; return true; } };
struct SchedOneOut { const char* A; const char* B; int pm, pn;
    __device__ __forceinline__ bool next(int i, pg8::GUnit& u) const { if (i >= 1) return false; constexpr int OS = FP8_OUT ? 1 : 2;
        u.a = A + (size_t)pm * 256 * DM * OS; u.b = B + (size_t)pn * 256 * DM * OS; u.nt = DM * OS / 128; u.pm = pm; u.pn = pn; u.aux = 0; return true; } };

constexpr int N_PHASES = 22;
__global__ void __launch_bounds__(NTHR, 2) mega(Args args) {
    extern __shared__ __attribute__((aligned(16))) unsigned char lds_raw[];
    LAS unsigned char* lds = (LAS unsigned char*)lds_raw;
    const int G = gridDim.x, wg = blockIdx.x, NGW = G * NWAVES;
    unsigned char* ws = args.ws; unsigned* ctl = (unsigned*)(ws + WS_CTL);
    volatile LAS unsigned* MISC = (volatile LAS unsigned*)(lds + MISC_OFF);
    if (threadIdx.x < 32) MISC[threadIdx.x] = 0u;
    __syncthreads();
    const int lo = args.ph_lo, hi = args.ph_hi; const bool multi = (hi - lo) > 1;
    const bool fuse_router = FUSE_ROUTER && CTX_CHAIN && G == 256;
    XcdBarrier bar; bar.bar = ctl + CW_BAR; bar.x = 0; bar.st = nullptr;
    if (multi) bar = xcd_barrier_post(ctl + CW_BAR, MISC + 8);
#ifndef PH_MASK
#define PH_MASK 0xffffffffu
#endif
#define PHON(b) ((PH_MASK >> (b)) & 1u)
#ifndef REP_MASK
#define REP_MASK 0u
#endif
#define REPEAT(b) _Pragma("unroll 1") for (int rep = 0; rep < ((((REP_MASK >> (b)) & 1u) && ((b) != 6 || l == 0)) ? 2 : 1); ++rep)
#define REPBAR() do { if (rep && multi) xcd_barrier(bar); } while (0)
#define IN(k) (lo <= (k) && (k) < hi)
#define HIDE_TID() int tz = threadIdx.x; asm volatile("" : "+v"(tz)); const int tid = tz, lane = tz & 63, wave = __builtin_amdgcn_readfirstlane(tz >> 6), gw = wg * NWAVES + wave; (void)tid; (void)lane; (void)wave; (void)gw
#define SEAM(k) do { if (IN(k) && IN((k) + 1)) xcd_barrier(bar); } while (0)
#define SEAM_BG(k, force_upto) do { if (IN(k) && IN((k) + 1)) { if (BG_CONV && multi) bg_loop(args, lds, ctl, MISC, (k), (force_upto), G); xcd_barrier(bar); } } while (0)
    if (PHON(0) && IN(0)) _Pragma("unroll 1") for (int rep = 0; rep < ((REP_MASK & 1u) ? 2 : 1); ++rep) { REPBAR(); HIDE_TID();
#ifndef P0_PROBE
#define P0_PROBE 0
#endif
        if (!(P0_PROBE == 1 && rep == 0 && (REP_MASK & 1u))) p0_modv(args, lds, tid, lane, wave, wg, G, 0, (MODV1_IN_ATT && CONV_IN_ATT == 2 && P0_DYN && multi && !BG_CONV) ? 96 : 2 * 96);
#ifndef P0_DYN
#define P0_DYN 1
#endif
        if (!(P0_PROBE == 2 && rep == 0 && (REP_MASK & 1u))) {
#ifndef CONV_PIPE
#define CONV_PIPE 2
#endif
#ifndef CONV_IN_ATT
#define CONV_IN_ATT 2
#endif
#ifndef CONV_SEL
#define CONV_SEL(wg) ((((wg) >> 3) & 3) == 3)
#endif
#ifndef P0_PIPE
#define P0_PIPE 0
#endif
            if (P0_DYN && multi && !BG_CONV) { const int n0_ = CONV_IN_ATT == 2 ? CV_D1 : (CONV_IN_ATT ? CV_PER_L : 2 * CV_PER_L);
                if (P0_PIPE == 2) p0_convert_dyn3(args, lds, ctl + CW_BGQ + 64 + 64 * rep, MISC, tid, wave, lane, n0_, 0); else if (P0_PIPE) p0_convert_dyn2(args, lds, ctl + CW_BGQ + 64 + 64 * rep, MISC, tid, wave, lane, n0_, 0); else p0_convert_dyn(args, lds, ctl + CW_BGQ + 64 + 64 * rep, MISC, tid, wave, lane, n0_);
                p0_prologue(args, lds, wave, lane, gw, NGW, 0); }
            else p0_prologue(args, lds, wave, lane, gw, NGW, (BG_CONV && multi) ? CV_PER_L : 2 * CV_PER_L); } }
    SEAM(0);
#pragma unroll 1
    for (int l = 0; l < 2; ++l) {
        const int pb = 1 + 10 * l;
        const float* modv_l = (const float*)(ws + WS_MODV) + (size_t)l * 3 * MODW;
#ifdef BAR_PROBE
        if (multi && l == 0) { for (int bi = 0; bi < BAR_PROBE; ++bi) xcd_barrier(bar); }
#endif
        if (PHON(1) && IN(pb + 0)) { HIDE_TID(); if (l == 0) row_phase_a<0>(args, l, lane, gw, NGW); else row_phase_a<1>(args, l, lane, gw, NGW); }
        SEAM_BG(pb + 0, l == 1 ? CV_D1 : 0);
        if (PHON(2) && IN(pb + 1)) REPEAT(2) {
            REPBAR();
            SchedIn S{(const char*)(ws + WS_H), (const char*)(ws + WS_WIN) + (size_t)l * INW * DM * 2, G, wg, l}; EpiIn E{1.f, (bf16_t*)(ws + WS_P), (LAS float*)(lds + RING_BYTES), (const float*)(ws + WS_ROPE128), (const float*)(ws + WS_ROPE64), args.in[10] + l * 128, args.in[12] + l * 64, args.in[19] + l * 128, args.in[9] + l * 128, args.in[11] + l * 64, args.in[18] + l * 128};
            if (!IN_BLOCK) pg8::gemm_phase<EpiIn, SchedIn>(lds, DM * 2, DM * 2, S, E);
            if (FP8_GATES) { SchedIn8 S8{(const char*)(ws + WS_H8), (const char*)(ws + WS_WIN8) + (size_t)l * INW * DM, G, wg, l}; const EpiIn E8{1.f / 64.f, (bf16_t*)(ws + WS_P), (LAS float*)(lds + RING_BYTES), (const float*)(ws + WS_ROPE128), (const float*)(ws + WS_ROPE64), args.in[10] + l * 128, args.in[12] + l * 64, args.in[19] + l * 128, args.in[9] + l * 128, args.in[11] + l * 64, args.in[18] + l * 128};
                pg8::gemm_phase<EpiIn, SchedIn8, true>(lds, DM, DM, S8, E8); }
            if (IN_BLOCK) pg8::gemm_phase<EpiIn, SchedIn>(lds, DM * 2, DM * 2, S, E);
        }
        SEAM_BG(pb + 1, 0);
        if (!FUSE_QK) { if (PHON(3) && IN(pb + 2)) { HIDE_TID(); row_phase_c(args, l, lane, gw, NGW); }
        SEAM(pb + 2); }
        if (PHON(4) && IN(pb + 3)) REPEAT(4) {
            REPBAR(); HIDE_TID();
            const float lambda_init = 0.8f - 0.6f * expf(-0.3f * (float)l);
            float lam; { const float a = wave_sum(args.in[13][l * 64 + lane] * args.in[14][l * 64 + lane], lane), b = wave_sum(args.in[15][l * 64 + lane] * args.in[16][l * 64 + lane], lane); lam = expf(a) - expf(b) + lambda_init; lam = __uint_as_float((unsigned)__builtin_amdgcn_readfirstlane((int)__float_as_uint(lam))); }
            const bf16_t* P = (const bf16_t*)(ws + WS_P); bf16_t* O = (bf16_t*)(ws + WS_OATT);
#ifndef ATT_NOMAX
#define ATT_NOMAX 1
#endif
            bool nomax_ac = false, nomax_b = false;
            if (ATT_NOMAX) {
                const float ga = fmaxf(fabsf(args.in[9][l * 128 + lane]), fabsf(args.in[9][l * 128 + 64 + lane])), ka = fmaxf(fabsf(args.in[10][l * 128 + lane]), fabsf(args.in[10][l * 128 + 64 + lane]));
                const float gc = fmaxf(fabsf(args.in[18][l * 128 + lane]), fabsf(args.in[18][l * 128 + 64 + lane])), kc = fmaxf(fabsf(args.in[19][l * 128 + lane]), fabsf(args.in[19][l * 128 + 64 + lane]));
                const float gb = fabsf(args.in[11][l * 64 + lane]), kb = fabsf(args.in[12][l * 64 + lane]);
                const float ba = wave_max(ga, lane) * wave_max(ka, lane), bc = wave_max(gc, lane) * wave_max(kc, lane), bb = wave_max(gb, lane) * wave_max(kb, lane);
                const float sk = fabsf(sink_bound(args.in[20] + l * 6));
                nomax_ac = __builtin_amdgcn_readfirstlane((int)(fmaxf(ba, bc) * 16.33f < 100.f && sk < 60.f)) != 0;
                nomax_b = __builtin_amdgcn_readfirstlane((int)(bb * 11.55f < 100.f)) != 0;
            }
            const float* sink_l = args.in[20] + l * 6; const float* subln = args.in[17] + l * 128;
#ifndef ATT_KINDS
#define ATT_KINDS 7
#endif
            const bool ctxl = (l == 0);
            unsigned* qb = ctl + CW_QUEUE + 64 * (rep * 16 + l * 8); unsigned* cctr = ctl + CW_CTX + 128 * rep;
            if (CONV_IN_ATT == 2 && P0_DYN && multi && !BG_CONV && rep == 0 && CONV_SEL(wg)) {
                if (MODV1_IN_ATT && l == 0) { p0_modv(args, lds, tid, lane, wave, (wg >> 5) * 8 + (wg & 7), 64, 96, 2 * 96); __syncthreads(); }
#ifndef CONV_SPLIT_BR
#define CONV_SPLIT_BR 0
#endif
                const int i0 = l == 0 ? CV_D1 : (CONV_SPLIT_BR ? CV_PER_L + CV_I_IN : CV_PER_L + CV_D1);
                const int nn = l == 0 ? ((CONV_IN_EXP && E_XCD && G == 256) ? CV_PER_L - CV_D1 : (CONV_SPLIT_BR ? CV_PER_L - CV_D1 + CV_I_IN : CV_PER_L)) : (CONV_SPLIT_BR ? CV_PER_L - CV_I_IN : CV_PER_L - CV_D1);
                if (CONV_PIPE == 2) p0_convert_dyn3(args, lds, ctl + CW_BGQ + 192 + 64 * l, MISC, tid, wave, lane, nn, i0); else if (CONV_PIPE) p0_convert_dyn2(args, lds, ctl + CW_BGQ + 192 + 64 * l, MISC, tid, wave, lane, nn, i0); else p0_convert_dyn(args, lds, ctl + CW_BGQ + 192 + 64 * l, MISC, tid, wave, lane, nn, i0); }
            else if (CONV_IN_ATT == 1 && P0_DYN && multi && !BG_CONV && l == 0 && rep == 0 && CONV_SEL(wg)) { if (CONV_PIPE) p0_convert_dyn2(args, lds, ctl + CW_BGQ + 192, MISC, tid, wave, lane, CV_PER_L, CV_PER_L); else p0_convert_dyn(args, lds, ctl + CW_BGQ + 192, MISC, tid, wave, lane, CV_PER_L, CV_PER_L); }
#define ATT_CLAIM(q) ({ __syncthreads(); if (tid == 0) MISC[0] = atomicAdd(qb + 64 * (q), 1u); __syncthreads(); __builtin_amdgcn_readfirstlane((int)MISC[0]); })
#define ATT_RUN(KIND, idx, isctx) do { att::AUnit u; attn_decode<KIND>(idx, isctx, u, sink_l); unsigned char* o8_ = FP8_BR ? (unsigned char*)(ws + WS_OATT8) : (unsigned char*)nullptr; \
    if (ATT_NOMAX && (KIND == 1 ? nomax_b : nomax_ac)) att::attn_unit<KIND, 20>(u, P, O, o8_, (LAS char*)lds, lam, 1.f - lambda_init, subln); else att::attn_unit<KIND>(u, P, O, o8_, (LAS char*)lds, lam, 1.f - lambda_init, subln); } while (0)
#ifndef ATT_PROBE
#define ATT_PROBE 0
#endif
#ifndef ATT_PROBE_KINDS
#define ATT_PROBE_KINDS 7
#endif
            if (ATT_PROBE && multi) {
                unsigned* qp = ctl + CW_QUEUE + 64 * (16 + l * 8);
#define ATT_CLAIMP(q) ({ __syncthreads(); if (tid == 0) MISC[0] = atomicAdd(qp + 64 * (q), 1u); __syncthreads(); __builtin_amdgcn_readfirstlane((int)MISC[0]); })
#define ATT_RUNP(KIND, idx) do { att::AUnit u; attn_decode<KIND>(idx, false, u, sink_l); att::attn_unit<KIND, ATT_PROBE == 1 ? 8 : ATT_PROBE>(u, P, O, FP8_BR ? (unsigned char*)(ws + WS_OATT8) : (unsigned char*)nullptr, (LAS char*)lds, lam, 1.f - lambda_init, subln); } while (0)
                if (ATT_PROBE_KINDS & 1) for (;;) { const int qi = ATT_CLAIMP(1); if (qi >= 192) break; ATT_RUNP(0, qi); }
                if (ATT_PROBE_KINDS & 2) for (;;) { const int qi = ATT_CLAIMP(2); if (qi >= 256) break; ATT_RUNP(1, qi); }
                if (ATT_PROBE_KINDS & 4) for (;;) { const int qi = ATT_CLAIMP(3); if (qi >= 192) break; ATT_RUNP(2, qi); }
                xcd_barrier(bar);
            }
#define ATT_CHAIN_BODY() do { \
                        if (FP8_GATES && FP8_AC && CTX_GATES_IN_CHAIN) { \
                            SchedGate3 S{(const char*)(ws + WS_H8), (const char*)(ws + WS_WIN8) + (size_t)l * INW * DM, pm, pn}; \
                            const EpiIn E8{1.f / 64.f, (bf16_t*)(ws + WS_P), (LAS float*)(lds + RING_BYTES), (const float*)(ws + WS_ROPE128), (const float*)(ws + WS_ROPE64), args.in[10] + l * 128, args.in[12] + l * 64, args.in[19] + l * 128, args.in[9] + l * 128, args.in[11] + l * 64, args.in[18] + l * 128}; \
                            pg8::gemm_phase<EpiIn, SchedGate3, true>(lds, DM, DM, S, E8); } \
                        wait_ge(cctr, 40u, tid); \
                        { SchedOneBr S{(const char*)(ws + WS_OATT), (const char*)(ws + WS_WBR) + (size_t)l * DM * DM * 2, (const char*)(ws + WS_OATT8), (const char*)(ws + WS_WBR8) + (size_t)l * DM * DM, pm, pn}; EpiBr E{(const bf16_t*)(ws + WS_P), (bf16_t*)(ws + WS_MM)}; \
                          if (FP8_BR) { SchedOneBrAC S1{(const char*)(ws + WS_OATT8), (const char*)(ws + WS_WBR8) + (size_t)l * DM * DM, pm, pn}; EpiBrAC E1{(const bf16_t*)(ws + WS_P), (bf16_t*)(ws + WS_MM)}; \
                              pg8::gemm_phase<EpiBrAC, SchedOneBrAC, true>(lds, DM, DM, S1, E1); \
                              SchedOneBrB S2{(const char*)(ws + WS_OATT), (const char*)(ws + WS_WBR) + (size_t)l * DM * DM * 2, pm, pn}; EpiBrB E2{(const bf16_t*)(ws + WS_P), (bf16_t*)(ws + WS_MM)}; \
                              pg8::gemm_phase<EpiBrB, SchedOneBrB>(lds, DM * 2, DM * 2, S2, E2); } \
                          else pg8::gemm_phase<EpiBr, SchedOneBr>(lds, DM * 2, DM * 2, S, E); } \
                        publish_inc(cctr + 64, tid); \
                        wait_ge(cctr + 64, 16u, tid); \
                        { SchedOneOut S{(const char*)(ws + WS_MM), (const char*)(ws + WS_WOUT) + (size_t)l * DM * DM * (FP8_OUT ? 1 : 2), pm, pn}; \
                          EpiOut E{args.in[0], args.in[2], (float*)(ws + WS_X), modv_l + 2 * DM}; \
                          if (FP8_OUT) pg8::gemm_phase<EpiOut, SchedOneOut, true>(lds, DM, DM, S, E); else pg8::gemm_phase<EpiOut, SchedOneOut>(lds, DM * 2, DM * 2, S, E); } \
                        if (fuse_router) router_tile(args, l, pm, pn, ctl + CW_RP + 64 * (64 * l + pm)); \
    } while (0)
#ifndef ATT_ONEQ
#define ATT_ONEQ 1
#endif
#if ATT_ONEQ && ATT_KINDS == 7
            {
                const int nch = (ctxl && CTX_CHAIN) ? 16 : 0, ncA = ctxl ? 12 : 0, ncB = ctxl ? 16 : 0;
                const int e0 = ctxl ? 12 : 0, e1 = e0 + ncA + 192, e2 = e1 + ncB + nch + 256, e3 = e2 + 192;
                int gi = ATT_CLAIM(0);
                for (; gi < e0; gi = ATT_CLAIM(0)) { ATT_RUN(2, gi, true); if (CTX_CHAIN) publish_inc(cctr, tid); }
                for (; gi < e1; gi = ATT_CLAIM(0)) { const int qi = gi - e0; const bool isctx = qi < ncA; ATT_RUN(0, isctx ? qi : qi - ncA, isctx); if (CTX_CHAIN && isctx) publish_inc(cctr, tid); }
                for (; gi < e2; gi = ATT_CLAIM(0)) { const int qi = gi - e1; const int nctx = ncB;
                    if (qi >= nctx && qi < nctx + nch) {
                        const int j = qi - nctx, pm = 32 + (j >> 3), pn = j & 7;
                        ATT_CHAIN_BODY();
                        continue; }
                    const bool isctx = qi < nctx; ATT_RUN(1, isctx ? qi : qi - nctx - nch, isctx); if (CTX_CHAIN && isctx) publish_inc(cctr, tid); }
                for (; gi < e3; gi = ATT_CLAIM(0)) { ATT_RUN(2, gi - e2, false); }
            }
#else
            if (ctxl && (ATT_KINDS & 4)) for (;;) { const int qi = ATT_CLAIM(0); if (qi >= 12) break; ATT_RUN(2, qi, true); if (CTX_CHAIN) publish_inc(cctr, tid); }
#ifndef ATT_XCD
#define ATT_XCD 0
#endif
            const bool axcd = ATT_XCD && G == 256;
            if (ATT_KINDS & 1) { const int nctx = ctxl ? 12 : 0, nlatq = axcd ? 0 : 192;
                for (;;) { const int qi = ATT_CLAIM(1); if (qi >= nctx + nlatq) break; const bool isctx = qi < nctx; ATT_RUN(0, isctx ? qi : qi - nctx, isctx); if (CTX_CHAIN && isctx) publish_inc(cctr, tid); }
                if (axcd) { const int x = wg & 7, k = wg >> 3; if (k < 24) { const int u_ = (x & 1) * 24 + k, g_ = x >> 1; ATT_RUN(0, (g_ >> 1) * 96 + ((g_ & 1) * 3 + u_ / 16) * 16 + (u_ & 15), false); } } }
            if (ATT_KINDS & 2) { const int nctx = ctxl ? 16 : 0, nch = (ctxl && CTX_CHAIN) ? 16 : 0;
                for (;;) { const int qi = ATT_CLAIM(2); if (qi >= nctx + nch + (axcd ? 0 : 256)) break;
                    if (qi >= nctx && qi < nctx + nch) {
                        const int j = qi - nctx, pm = 32 + (j >> 3), pn = j & 7;
                        ATT_CHAIN_BODY();
                        continue; }
                    const bool isctx = qi < nctx; ATT_RUN(1, isctx ? qi : qi - nctx - nch, isctx); if (CTX_CHAIN && isctx) publish_inc(cctr, tid); }
                if (axcd) ATT_RUN(1, (wg & 7) * 32 + (wg >> 3), false); }
            if (ATT_KINDS & 4) for (;;) { const int qi = ATT_CLAIM(3); if (qi >= 192) break; ATT_RUN(2, qi, false); }
#endif
#undef ATT_CLAIM
#undef ATT_RUN
#undef ATT_CHAIN_BODY
        }
        SEAM_BG(pb + 3, 0);
        if (PHON(5) && IN(pb + 4)) REPEAT(5) {
            REPBAR();
            SchedBr S{(const char*)(ws + WS_OATT), (const char*)(ws + WS_WBR) + (size_t)l * DM * DM * 2, (const char*)(ws + WS_OATT8), (const char*)(ws + WS_WBR8) + (size_t)l * DM * DM, G, wg, (l == 0 && !CTX_CHAIN) ? 34 : 32}; EpiBr E{(const bf16_t*)(ws + WS_P), (bf16_t*)(ws + WS_MM)};
            if (FP8_BR) { const int ntm = (l == 0 && !CTX_CHAIN) ? 34 : 32;
                SchedBrAC S1{(const char*)(ws + WS_OATT8), (const char*)(ws + WS_WBR8) + (size_t)l * DM * DM, G, wg, ntm}; EpiBrAC E1{(const bf16_t*)(ws + WS_P), (bf16_t*)(ws + WS_MM)};
                pg8::gemm_phase<EpiBrAC, SchedBrAC, true>(lds, DM, DM, S1, E1);
                SchedBrB S2{(const char*)(ws + WS_OATT), (const char*)(ws + WS_WBR) + (size_t)l * DM * DM * 2, G, wg, ntm}; EpiBrB E2{(const bf16_t*)(ws + WS_P), (bf16_t*)(ws + WS_MM)};
                pg8::gemm_phase<EpiBrB, SchedBrB>(lds, DM * 2, DM * 2, S2, E2); }
            else pg8::gemm_phase<EpiBr, SchedBr>(lds, DM * 2, DM * 2, S, E);
        }
        SEAM(pb + 4);
        if (PHON(6) && IN(pb + 5)) REPEAT(6) {
            REPBAR();
            SchedOut S{(const char*)(ws + WS_MM), (const char*)(ws + WS_WOUT) + (size_t)l * DM * DM * (FP8_OUT ? 1 : 2), G, wg, (l == 0 && !CTX_CHAIN) ? 34 : 32};
            const float* X = (const float*)(ws + WS_X);
            EpiOut E{l == 0 ? args.in[0] : X, l == 0 ? args.in[2] : X + (size_t)NLAT * DM, (float*)(ws + WS_X), modv_l + 2 * DM};
            if (FP8_OUT) pg8::gemm_phase<EpiOut, SchedOut, true>(lds, DM, DM, S, E); else pg8::gemm_phase<EpiOut, SchedOut>(lds, DM * 2, DM * 2, S, E);
            if (fuse_router) { int pm, pn; if (pg8::grid_order((long)wg, 32, 8, pm, pn)) router_tile(args, l, pm, pn, ctl + CW_RP + 64 * (64 * l + pm)); }
        }
        SEAM(pb + 5);
        if (!fuse_router) { if (PHON(7) && IN(pb + 6)) REPEAT(7) { REPBAR(); HIDE_TID(); if (ROUTER_V3) row_phase_g3(args, lds, l, tid, lane, wave, wg, G); else row_phase_g(args, lds, l, tid, lane, wave, wg, G, ROUTER_PROBE != 0 && rep == 0 && ((REP_MASK >> 7) & 1u)); }
        SEAM(pb + 6); }
        if (PHON(8) && IN(pb + 7)) REPEAT(8) { REPBAR(); HIDE_TID(); phase_rank(args, lds, l, wg, G, tid, wave, lane); }
        SEAM_BG(pb + 7, l == 1 ? CV_PER_L : 0);
        if (PHON(9) && IN(pb + 8)) REPEAT(9) {
            REPBAR();
            SchedE1 S{(const char*)(ws + WS_XG), (const char*)(ws + WS_W1) + (size_t)l * 16 * 2048 * DM * (FP8_EXPERTS ? 1 : 2), G, wg, l == 0 ? 5 : 4}; EpiE1 E{(bf16_t*)(ws + WS_ACT), l == 0 ? EROWS : 1024};
            if (FP8_EXPERTS) pg8::gemm_phase<EpiE1, SchedE1, true>(lds, DM, DM, S, E); else pg8::gemm_phase<EpiE1, SchedE1>(lds, DM * 2, DM * 2, S, E);
            if (CONV_IN_EXP && CONV_IN_ATT == 2 && P0_DYN && E_XCD && multi && !BG_CONV && G == 256 && l == 0 && rep == 0 && (wg >> 3) >= 16) { HIDE_TID(); p0_convert_dyn2(args, lds, ctl + CW_BGQ + 320, MISC, tid, wave, lane, CONV_EXP_PART1, CV_PER_L); }
        }
        SEAM_BG(pb + 8, 0);
        if (PHON(10) && IN(pb + 9)) REPEAT(10) {
            REPBAR();
            SchedE2 S{(const char*)(ws + WS_ACT), (const char*)(ws + WS_W2) + (size_t)l * 16 * 2048 * FF * (FP8_EXPERTS ? 1 : 2), G, wg, l == 0 ? 5 : 4}; EpiE2 E{(bf16_t*)(ws + WS_Y), (const float*)(ws + WS_GW), l == 0 ? EROWS : 1024};
            if (FP8_EXPERTS) pg8::gemm_phase<EpiE2, SchedE2, true>(lds, FF, FF, S, E); else pg8::gemm_phase<EpiE2, SchedE2>(lds, FF * 2, FF * 2, S, E);
            if (CONV_IN_EXP && CONV_IN_ATT == 2 && P0_DYN && E_XCD && multi && !BG_CONV && G == 256 && l == 0 && rep == 0 && (wg >> 3) >= 16) { HIDE_TID(); p0_convert_dyn2(args, lds, ctl + CW_BGQ + 384, MISC, tid, wave, lane, CV_D1 - CONV_EXP_PART1, CV_PER_L + CONV_EXP_PART1); }
        }
        SEAM_BG(pb + 9, 0);
    }
    if (PHON(11) && IN(21)) { HIDE_TID(); row_phase_a<2>(args, 2, lane, gw, NGW); }
#undef IN
#undef SEAM
}

static int g_grid = 0;
static bool setup() {
    if (g_grid) return g_grid > 0;
    int dev = 0, cus = 0, per_cu = 0;
    if (hipGetDevice(&dev) != hipSuccess || hipDeviceGetAttribute(&cus, hipDeviceAttributeMultiprocessorCount, dev) != hipSuccess) { g_grid = -1; return false; }
    if (hipFuncSetAttribute((const void*)mega, hipFuncAttributeMaxDynamicSharedMemorySize, LDS_BYTES) != hipSuccess) { fprintf(stderr, "kernel_launch: hipFuncSetAttribute failed\n"); g_grid = -1; return false; }
    if (hipOccupancyMaxActiveBlocksPerMultiprocessor(&per_cu, (const void*)mega, NTHR, LDS_BYTES) != hipSuccess || per_cu < 1) { fprintf(stderr, "kernel_launch: occupancy query says %d\n", per_cu); (void)hipGetLastError(); }
    g_grid = cus;
    return true;
}
static void run(void* const* d_in, void* d_out, void* d_ws, bool one_launch, int ph_end, hipStream_t stream) {
    if (!setup()) return;
    (void)hipMemsetAsync((char*)d_ws + WS_CTL, 0, CTL_ZERO_BYTES, stream);
    Args a{}; for (int i = 0; i < 29; ++i) a.in[i] = (const float*)d_in[i];
    a.out = (float*)d_out; a.ws = (unsigned char*)d_ws;
    if (one_launch) { a.ph_lo = 0; a.ph_hi = ph_end; hipLaunchKernelGGL(mega, dim3(g_grid), dim3(NTHR), LDS_BYTES, stream, a); }
    else for (int p = 0; p < ph_end; ++p) { a.ph_lo = p; a.ph_hi = p + 1; hipLaunchKernelGGL(mega, dim3(g_grid), dim3(NTHR), LDS_BYTES, stream, a); }
}
}
#ifndef ONE_LAUNCH
#define ONE_LAUNCH 0
#endif
extern "C" void kernel_launch(void* const* d_in, const int* in_sizes, int n_in, void* d_out, int out_size, void* d_ws, size_t ws_size, hipStream_t stream) {
    if (n_in != 29 || ws_size < fk::WS_END) { fprintf(stderr, "kernel_launch: unexpected n_in %d / ws %zu\n", n_in, ws_size); return; }
    fk::run(d_in, d_out, d_ws, ONE_LAUNCH != 0, fk::N_PHASES, stream);
}
```
